# Optimizing an MI355X kernel written in HIP

```python
import jax, jax.numpy as jnp
from jax import lax
import numpy as np

D_MODEL = 1024
BATCH = 16
SEQ = 256
DEPTH = 1
DEC_BATCH = 8
DEC_SEQ = 2048
PAST_LEN = 512

GRID_W = 64
D_RNN = D_MODEL
LRU_BLOCKS = 16
LRU_BW = D_RNN // LRU_BLOCKS
CONV_W = 4
LRU_C = 8.0
GLA_HEADS = 4
GLA_DK = D_MODEL // 2 // GLA_HEADS
GLA_DV = D_MODEL // GLA_HEADS
GLA_DK_TOT = GLA_HEADS * GLA_DK
GLA_DV_TOT = GLA_HEADS * GLA_DV
GLA_RANK = 16
GLA_TAU = 16.0
GLA_CHUNK = 64
D_FF = 4 * D_MODEL
N_MOD = 6
EPS = 1e-6
IN_SPLITS = (D_RNN, D_RNN, GLA_DK_TOT, GLA_DK_TOT, GLA_DV_TOT, GLA_DV_TOT, 2 * GLA_RANK, D_MODEL, D_MODEL)
IN_TOTAL = D_RNN * 2 + GLA_DK_TOT * 2 + GLA_DV_TOT * 2 + 2 * GLA_RANK + 2 * D_MODEL

kernel_name = "hybrid_lru_gla_diffusion_step"


def rmsnorm(x, g):
    xf = x.astype(jnp.float32)
    y = xf * lax.rsqrt(jnp.mean(xf * xf, axis=-1, keepdims=True) + EPS)
    return (y * g.astype(jnp.float32)).astype(x.dtype)


def conv_centred(x, w, b):
    T = x.shape[-2]
    pad = [(0, 0)] * (x.ndim - 2) + [((CONV_W - 1) // 2, CONV_W // 2), (0, 0)]
    xp = jnp.pad(x, pad)
    return b + sum(xp[..., k:k + T, :] * w[k] for k in range(CONV_W))


def blockdiag(x, w):
    xb = x.reshape(*x.shape[:-1], LRU_BLOCKS, LRU_BW)
    return jnp.einsum('...nc,ncd->...nd', xb, w).reshape(x.shape)


def rg_lru_scan(xc, wa, ba, wx, bx, L, h0, reverse):
    if reverse:
        xc = jnp.flip(xc, axis=1)
    r = jax.nn.sigmoid(blockdiag(xc, wa) + ba)
    i = jax.nn.sigmoid(blockdiag(xc, wx) + bx)
    log_a = (-LRU_C * r * jax.nn.softplus(-L)).astype(jnp.float32)
    a = jnp.exp(log_a)
    u = jnp.sqrt(-jnp.expm1(2.0 * log_a)) * (i * xc).astype(jnp.float32)
    u = u.at[:, 0].add(a[:, 0] * h0.astype(jnp.float32))

    def comb(lft, rgt):
        al, bl = lft
        ar, br = rgt
        return al * ar, ar * bl + br

    _, h = lax.associative_scan(comb, (a, u), axis=1)
    final = h[:, -1]
    if reverse:
        h = jnp.flip(h, axis=1)
    return h.astype(xc.dtype), final.astype(xc.dtype)


def gla_chunked(q, k, v, log_a, s0):
    B, T, H, DK = q.shape
    DV = v.shape[-1]
    C = GLA_CHUNK
    N = T // C
    f32 = jnp.float32
    qc = q.astype(f32).reshape(B, N, C, H, DK) * (DK ** -0.5)
    kc = k.astype(f32).reshape(B, N, C, H, DK)
    vc = v.astype(f32).reshape(B, N, C, H, DV)
    bcum = jnp.cumsum(log_a.astype(f32).reshape(B, N, C, H, DK), axis=2)
    b_last = bcum[:, :, -1]
    q_e = qc * jnp.exp(bcum)
    k_e = kc * jnp.exp(-bcum)
    k_tail = kc * jnp.exp(b_last[:, :, None] - bcum)
    mask = jnp.tril(jnp.ones((C, C), dtype=bool))
    scores = jnp.where(mask, jnp.einsum('bnchk,bnshk->bnhcs', q_e, k_e), 0.0)
    o_intra = jnp.einsum('bnhcs,bnshv->bnchv', scores, vc)
    kv = jnp.einsum('bnshk,bnshv->bnhkv', k_tail, vc)
    decay = jnp.exp(b_last)

    def step(S, inp):
        d, upd = inp
        return d[..., None] * S + upd, S

    s_final, s_starts = lax.scan(step, s0.astype(f32), (jnp.moveaxis(decay, 1, 0), jnp.moveaxis(kv, 1, 0)))
    s_starts = jnp.moveaxis(s_starts, 0, 1)
    o_inter = jnp.einsum('bnchk,bnhkv->bnchv', q_e, s_starts)
    o = (o_intra + o_inter).reshape(B, T, H, DV)
    return o.astype(q.dtype), s_final.astype(q.dtype)


def to_col_major(t, rows):
    B, T = t.shape[:2]
    rest = t.shape[2:]
    return t.reshape(B, rows, GRID_W, *rest).swapaxes(1, 2).reshape(B, T, *rest)


def from_col_major(t, rows):
    B, T = t.shape[:2]
    rest = t.shape[2:]
    return t.reshape(B, GRID_W, rows, *rest).swapaxes(1, 2).reshape(B, T, *rest)


def token_mix(h, p, lru_h0, gla_s0, rows):
    B, T, _ = h.shape
    z = h @ p['w_in']
    splits = np.cumsum(IN_SPLITS)[:-1].tolist()
    zx, zg, q, k, v, g, lr, ga, gb = jnp.split(z, splits, axis=-1)

    if rows is None:
        xc = conv_centred(zx, p['conv_w'], p['conv_b'])
    else:
        xc = conv_centred(zx.reshape(B, rows, GRID_W, D_RNN), p['conv_w'], p['conv_b']).reshape(B, T, D_RNN)
    hf, sf = rg_lru_scan(xc, p['lru_wa'][0], p['lru_ba'][0], p['lru_wx'][0], p['lru_bx'][0], p['lru_L'][0], lru_h0[:, 0], False)
    hb, sb = rg_lru_scan(xc, p['lru_wa'][1], p['lru_ba'][1], p['lru_wx'][1], p['lru_bx'][1], p['lru_L'][1], lru_h0[:, 1], True)
    y_a = ((hf + hb) * jax.nn.gelu(zg)) @ p['lru_up']

    q = q.reshape(B, T, GLA_HEADS, GLA_DK)
    k = k.reshape(B, T, GLA_HEADS, GLA_DK)
    v = v.reshape(B, T, GLA_HEADS, GLA_DV)
    la_f = (jax.nn.log_sigmoid(lr[..., :GLA_RANK] @ p['gla_w2'][0] + p['gla_b2'][0]) / GLA_TAU).reshape(B, T, GLA_HEADS, GLA_DK)
    la_b = (jax.nn.log_sigmoid(lr[..., GLA_RANK:] @ p['gla_w2'][1] + p['gla_b2'][1]) / GLA_TAU).reshape(B, T, GLA_HEADS, GLA_DK)
    if rows is not None:
        q, k, v, la_f, la_b = (to_col_major(t, rows) for t in (q, k, v, la_f, la_b))
    o_f, gf = gla_chunked(q, k, v, la_f, gla_s0[:, 0])
    o_b, gbs = gla_chunked(jnp.flip(q, 1), jnp.flip(k, 1), jnp.flip(v, 1), jnp.flip(la_b, 1), gla_s0[:, 1])
    o = o_f + jnp.flip(o_b, 1)
    if rows is not None:
        o = from_col_major(o, rows)
    o = rmsnorm(o, p['gla_norm_g']).reshape(B, T, GLA_DV_TOT) * jax.nn.silu(g)
    y_b = o @ p['gla_up']

    m = (jax.nn.sigmoid(ga) * y_a + jax.nn.sigmoid(gb) * y_b) @ p['w_out']
    return m, jnp.stack([sf, sb], axis=1), jnp.stack([gf, gbs], axis=1)


def layer(x, mod, p, lru_h0, gla_s0, rows):
    sh1, sc1, g1, sh2, sc2, g2 = jnp.split(mod, N_MOD, axis=-1)
    ng = p['norm_g']
    h = rmsnorm(x, ng[0]) * (1.0 + sc1) + sh1
    m, s_lru, s_gla = token_mix(h, p, lru_h0, gla_s0, rows)
    x = x + g1 * rmsnorm(m, ng[1])
    h = rmsnorm(x, ng[2]) * (1.0 + sc2) + sh2
    f = jnp.square(jax.nn.relu(h @ p['mlp_w1'])) @ p['mlp_w2']
    x = x + g2 * rmsnorm(f, ng[3])
    return x, s_lru, s_gla


def setup_inputs(seed: int = 0) -> dict:
    key = jax.random.key(seed)
    ks = jax.random.split(key, 26)
    nrm = jax.random.normal
    D = D_MODEL
    u = jax.random.uniform(ks[15], (DEPTH, 2, D_RNN), minval=0.9, maxval=0.999)
    return {
        'x_prompt': nrm(ks[0], (BATCH, SEQ, D), jnp.float32),
        'x_sample': nrm(ks[1], (DEC_BATCH, DEC_SEQ, D), jnp.float32),
        'state_lru': 0.5 * nrm(ks[2], (DEC_BATCH, DEPTH, 2, D_RNN), jnp.float32),
        'state_gla': nrm(ks[3], (DEC_BATCH, DEPTH, 2, GLA_HEADS, GLA_DK, GLA_DV), jnp.float32),
        'c': nrm(ks[4], (DEC_BATCH, D), jnp.float32),
        'c_ctx': nrm(ks[5], (D,), jnp.float32),
        'w_mod': 0.5 * D ** -0.5 * nrm(ks[6], (DEPTH, D, N_MOD * D), jnp.float32),
        'b_mod': 0.02 * nrm(ks[7], (DEPTH, N_MOD * D), jnp.float32),
        'norm_g': 1.0 + 0.02 * nrm(ks[8], (DEPTH, 4, D), jnp.float32),
        'w_in': D ** -0.5 * nrm(ks[9], (DEPTH, D, IN_TOTAL), jnp.float32),
        'conv_w': CONV_W ** -0.5 * nrm(ks[10], (DEPTH, CONV_W, D_RNN), jnp.float32),
        'conv_b': 0.02 * nrm(ks[11], (DEPTH, D_RNN), jnp.float32),
        'lru_wa': LRU_BW ** -0.5 * nrm(ks[12], (DEPTH, 2, LRU_BLOCKS, LRU_BW, LRU_BW), jnp.float32),
        'lru_ba': 0.02 * nrm(ks[13], (DEPTH, 2, D_RNN), jnp.float32),
        'lru_wx': LRU_BW ** -0.5 * nrm(ks[14], (DEPTH, 2, LRU_BLOCKS, LRU_BW, LRU_BW), jnp.float32),
        'lru_bx': 0.02 * nrm(ks[16], (DEPTH, 2, D_RNN), jnp.float32),
        'lru_L': jnp.log(u) - jnp.log1p(-u),
        'lru_up': D_RNN ** -0.5 * nrm(ks[17], (DEPTH, D_RNN, D), jnp.float32),
        'gla_w2': GLA_RANK ** -0.5 * nrm(ks[18], (DEPTH, 2, GLA_RANK, GLA_DK_TOT), jnp.float32),
        'gla_b2': 0.02 * nrm(ks[19], (DEPTH, 2, GLA_DK_TOT), jnp.float32),
        'gla_norm_g': 1.0 + 0.02 * nrm(ks[20], (DEPTH, GLA_DV), jnp.float32),
        'gla_up': GLA_DV_TOT ** -0.5 * nrm(ks[21], (DEPTH, GLA_DV_TOT, D), jnp.float32),
        'w_out': D ** -0.5 * nrm(ks[22], (DEPTH, D, D), jnp.float32),
        'mlp_w1': D ** -0.5 * nrm(ks[23], (DEPTH, D, D_FF), jnp.float32),
        'mlp_w2': D_FF ** -0.5 * nrm(ks[24], (DEPTH, D_FF, D), jnp.float32),
    }


def reference(x_prompt, x_sample, state_lru, state_gla, c, c_ctx, w_mod, b_mod, norm_g, w_in, conv_w, conv_b,
              lru_wa, lru_ba, lru_wx, lru_bx, lru_L, lru_up, gla_w2, gla_b2, gla_norm_g, gla_up, w_out, mlp_w1, mlp_w2):
    rows = x_sample.shape[1] // GRID_W
    B0 = x_prompt.shape[0]
    xp = x_prompt
    xs = x_sample
    lru_states = []
    gla_states = []
    for l in range(DEPTH):
        p = {
            'norm_g': norm_g[l], 'w_in': w_in[l], 'conv_w': conv_w[l], 'conv_b': conv_b[l],
            'lru_wa': lru_wa[l], 'lru_ba': lru_ba[l], 'lru_wx': lru_wx[l], 'lru_bx': lru_bx[l], 'lru_L': lru_L[l],
            'lru_up': lru_up[l], 'gla_w2': gla_w2[l], 'gla_b2': gla_b2[l], 'gla_norm_g': gla_norm_g[l],
            'gla_up': gla_up[l], 'w_out': w_out[l], 'mlp_w1': mlp_w1[l], 'mlp_w2': mlp_w2[l],
        }
        mod_ctx = (jax.nn.silu(c_ctx) @ w_mod[l] + b_mod[l])[None, None, :]
        mod_lat = (jax.nn.silu(c) @ w_mod[l] + b_mod[l])[:, None, :]
        h0_lru = jnp.zeros((B0, 2, D_RNN), xp.dtype)
        h0_gla = jnp.zeros((B0, 2, GLA_HEADS, GLA_DK, GLA_DV), xp.dtype)
        xp, s_lru, s_gla = layer(xp, mod_ctx, p, h0_lru, h0_gla, None)
        lru_states.append(s_lru)
        gla_states.append(s_gla)
        xs, _, _ = layer(xs, mod_lat, p, state_lru[:, l], state_gla[:, l], rows)
    new_state_lru = jnp.stack(lru_states, axis=1)
    new_state_gla = jnp.stack(gla_states, axis=1)
    return (xp, xs, new_state_lru, new_state_gla)
```

```cpp
#include <hip/hip_runtime.h>
#include <hip/hip_cooperative_groups.h>
#include <cstdio>
#include <cstdint>
namespace cg = cooperative_groups;
namespace pg8 {
#define PG8_LAS __attribute__((address_space(3)))
typedef unsigned short bf16_t;
typedef short bf16x8 __attribute__((ext_vector_type(8)));
typedef float f32x4 __attribute__((ext_vector_type(4)));
typedef unsigned u32x4 __attribute__((ext_vector_type(4)));
constexpr int BM = 256, BK = 64, HALF = 128, HTB = HALF * BK * 2  , STAGE_BYTES = 8 * HTB, NXCD = 8, WGM = 8;

__host__ __device__ __forceinline__ int lds_byte(int r, int c) { const int st = (r >> 4) * 2 + (c >> 5), rr = r & 15, cc = c & 31, ob = rr * 64 + cc * 2; return st * 1024 + (ob ^ (((ob >> 9) & 1) << 5)); }
__host__ __device__ __forceinline__ void stage_rc(int b, int& R, int& C) { const int st = b / 1024, sb = b % 1024, swz = sb ^ (((sb >> 9) & 1) << 5); R = (st >> 1) * 16 + swz / 64; C = (st & 1) * 32 + (swz % 64) / 2; }
__host__ __device__ __forceinline__ int perm32(int rho) { const int n = rho >> 4, i = rho & 15; return 8 * (i >> 2) + 4 * n + (i & 3); }

struct Unit { int pm, pn, kq; };
struct Gemm { const bf16_t* A; const bf16_t* Bt; int M, N, K; const bf16_t* A1; const bf16_t* A2; int pn1, pn2; int ld;
    __device__ __forceinline__ const char* abase(int pn) const { return (const char*)(pn < pn1 ? A : (pn < pn2 ? A1 : A2)); } };

struct StaticOrder {
    int nM, nN, nwg, G, c;
    __host__ __device__ void init(int M, int N, int G_, int c_) { nM = M / BM; nN = N / BM; nwg = nM * nN; G = G_; c = c_; }
    __host__ __device__ bool next(int i, Unit& u) const {
        const long L = (long)i * G + c; if (L >= nwg) return false;
        int wgid = (int)L; { const int q = nwg / NXCD, r = nwg % NXCD, xcd = wgid % NXCD, off = wgid / NXCD; wgid = (xcd < r ? xcd * (q + 1) : r * (q + 1) + (xcd - r) * q) + off; }
        const int nig = WGM * nN, gid = wgid / nig, fm = gid * WGM, gsz = (nM - fm) < WGM ? (nM - fm) : WGM;
        u.pm = fm + ((wgid % nig) % gsz); u.pn = (wgid % nig) / gsz; u.kq = 0; return true;
    }
    __device__ __forceinline__ void a_ready(const Unit&) const {}
    __device__ __forceinline__ void done(const Unit&) const {}
};

typedef float f32x2 __attribute__((ext_vector_type(2)));
typedef __bf16 bf16x2_t __attribute__((ext_vector_type(2)));
__device__ __forceinline__ unsigned cvt_pk_bf16(float lo, float hi) { const f32x2 v = {lo, hi}; return __builtin_bit_cast(unsigned, __builtin_convertvector(v, bf16x2_t)); }
template <class Epi, class Sched, bool ALIGN_EPI = false, bool SP2 = false>
__device__ __forceinline__ void gemm_phase(PG8_LAS unsigned char* lds, const Gemm g, const Sched& S, const Epi& E) {
    const int tid = threadIdx.x, wid = __builtin_amdgcn_readfirstlane(tid >> 6), lane = tid & 63, wr = wid >> 2, wc = wid & 3, fr = lane & 15, fq = lane >> 4;
    const int K = g.K, nt = K / BK;
    unsigned voffA[2], voffB[2];
#pragma unroll
    for (int i = 0; i < 2; ++i) { int R, C; stage_rc(tid * 16 + i * 8192, R, C); const int Rb = Epi::PERM ? ((R & ~31) + perm32(R & 31)) : R;
        voffA[i] = (unsigned)(R * g.ld + C) * 2u; voffB[i] = (unsigned)(Rb * g.ld + C) * 2u; }
    const size_t kstep = (size_t)(BK * 2);
    const size_t hstep = (size_t)HALF * g.ld * 2;
    const size_t tstep = 2 * hstep;
    const unsigned ldsw = (unsigned)wid * 1024u;
    const int aoff = lds_byte(wr * 64 + fr, fq * 8), boff = lds_byte(wc * 32 + fr, fq * 8);
#define PG8_SA(b, h) (((b) * 2 + (h)) * HTB)
#define PG8_SB(b, h) ((4 + (b) * 2 + (h)) * HTB)
#define PG8_STAGE(bufoff, gbase, voff) do { _Pragma("unroll") for (int _i = 0; _i < 2; ++_i) \
        __builtin_amdgcn_global_load_lds((const unsigned*)((const char*)(gbase) + (voff)[_i]), (PG8_LAS unsigned*)(lds + (bufoff) + ldsw + _i * 8192), 16, 0, 0); } while (0)
#define PG8_LDA(dst, b, h) do { _Pragma("unroll") for (int m = 0; m < 4; ++m) _Pragma("unroll") for (int k = 0; k < 2; ++k) dst[m][k] = *(const PG8_LAS bf16x8*)(lds + PG8_SA(b, h) + aoff + m * 2048 + k * 1024); } while (0)
#define PG8_LDB(dst, b, h) do { _Pragma("unroll") for (int n = 0; n < 2; ++n) _Pragma("unroll") for (int k = 0; k < 2; ++k) dst[n][k] = *(const PG8_LAS bf16x8*)(lds + PG8_SB(b, h) + boff + n * 2048 + k * 1024); } while (0)
#define PG8_MMA(ai, bj, At, Bt) do { __builtin_amdgcn_s_setprio(1); _Pragma("unroll") for (int m = 0; m < 4; ++m) _Pragma("unroll") for (int n = 0; n < 2; ++n) _Pragma("unroll") for (int k = 0; k < 2; ++k) \
        acc[ai][bj][m][n] = __builtin_amdgcn_mfma_f32_16x16x32_bf16(Bt[n][k], At[m][k], acc[ai][bj][m][n], 0, 0, 0); __builtin_amdgcn_s_setprio(0); } while (0)
#define PG8_WAIT_V(n) asm volatile("s_waitcnt vmcnt(" #n ")" ::: "memory")
#define PG8_WAIT_L(n) asm volatile("s_waitcnt lgkmcnt(" #n ")" ::: "memory")
#define PG8_BAR __builtin_amdgcn_s_barrier()
#define PG8_SCHED __builtin_amdgcn_sched_barrier(0)
    Unit cur, nxt; int ui = 0;
    if (!S.next(0, cur)) return;
    f32x4 acc[2][2][4][2];
#pragma unroll
    for (int a = 0; a < 2; ++a)
#pragma unroll
        for (int b = 0; b < 2; ++b)
#pragma unroll
            for (int m = 0; m < 4; ++m)
#pragma unroll
                for (int n = 0; n < 2; ++n) acc[a][b][m][n] = (f32x4){0.f, 0.f, 0.f, 0.f};
    bf16x8 At[4][2], B0[2][2], B1[2][2];
    const size_t qstep = (size_t)K * 2;
    const char* cA = g.abase(cur.pn) + (size_t)cur.pm * tstep + (size_t)cur.kq * qstep; const char* cB = (const char*)g.Bt + (size_t)cur.pn * tstep + (size_t)cur.kq * qstep;
    S.a_ready(cur);
    if constexpr (SP2) {
        PG8_STAGE(PG8_SB(0, 0), cB, voffB); PG8_STAGE(PG8_SB(0, 1), cB + hstep, voffB); PG8_STAGE(PG8_SA(0, 0), cA, voffA); PG8_STAGE(PG8_SA(0, 1), cA + hstep, voffA);
        if (wr == 1) PG8_BAR;
        PG8_WAIT_V(2); PG8_BAR;
        PG8_STAGE(PG8_SB(1, 0), cB + kstep, voffB); PG8_STAGE(PG8_SA(1, 0), cA + kstep, voffA); PG8_STAGE(PG8_SB(1, 1), cB + hstep + kstep, voffB);
        PG8_WAIT_V(6); PG8_BAR;
    } else {
        PG8_STAGE(PG8_SB(0, 0), cB, voffB); PG8_STAGE(PG8_SA(0, 0), cA, voffA); PG8_STAGE(PG8_SB(0, 1), cB + hstep, voffB); PG8_STAGE(PG8_SA(0, 1), cA + hstep, voffA);
        if (wr == 1) PG8_BAR;
        PG8_WAIT_V(4); PG8_BAR;
        PG8_STAGE(PG8_SB(1, 0), cB + kstep, voffB); PG8_STAGE(PG8_SA(1, 0), cA + kstep, voffA); PG8_STAGE(PG8_SB(1, 1), cB + hstep + kstep, voffB);
        PG8_WAIT_V(6); PG8_BAR;
    }
    for (;;) {
        const bool has_next = S.next(ui + 1, nxt);
        const char* nA = has_next ? g.abase(nxt.pn) + (size_t)nxt.pm * tstep + (size_t)nxt.kq * qstep : cA; const char* nB = has_next ? (const char*)g.Bt + (size_t)nxt.pn * tstep + (size_t)nxt.kq * qstep : cB;
        for (int t = 0; t < nt; t += 2) {
            const bool last = (t == nt - 2);
            const char* a1 = cA + (size_t)(t + 1) * kstep;
            const char* a2 = last ? nA : cA + (size_t)(t + 2) * kstep; const char* b2 = last ? nB : cB + (size_t)(t + 2) * kstep;
            const char* a3 = a2 + kstep; const char* b3 = b2 + kstep;
            if (last && has_next) S.a_ready(nxt);
            if constexpr (SP2) {
            PG8_LDB(B0, 0, 0); PG8_LDB(B1, 0, 1); PG8_SCHED; PG8_LDA(At, 0, 0); PG8_STAGE(PG8_SA(1, 1), a1 + hstep, voffA);
            PG8_WAIT_V(8); PG8_WAIT_L(0); PG8_BAR; PG8_MMA(0, 0, At, B0); PG8_MMA(0, 1, At, B1); PG8_BAR; PG8_SCHED;
            PG8_LDA(At, 0, 1); PG8_STAGE(PG8_SB(0, 0), b2, voffB); PG8_STAGE(PG8_SB(0, 1), b2 + hstep, voffB); PG8_STAGE(PG8_SA(0, 0), a2, voffA);
            PG8_WAIT_V(8); PG8_WAIT_L(0); PG8_BAR; PG8_MMA(1, 0, At, B0); PG8_MMA(1, 1, At, B1); PG8_BAR; PG8_SCHED;
            PG8_LDB(B0, 1, 0); PG8_LDB(B1, 1, 1); PG8_SCHED; PG8_LDA(At, 1, 0); PG8_STAGE(PG8_SA(0, 1), a2 + hstep, voffA);
            PG8_WAIT_V(8); PG8_WAIT_L(0); PG8_BAR; PG8_MMA(0, 0, At, B0); PG8_MMA(0, 1, At, B1); PG8_BAR; PG8_SCHED;
            PG8_LDA(At, 1, 1); PG8_STAGE(PG8_SB(1, 0), b3, voffB); PG8_STAGE(PG8_SB(1, 1), b3 + hstep, voffB); PG8_STAGE(PG8_SA(1, 0), a3, voffA);
            PG8_WAIT_V(8); PG8_WAIT_L(0); PG8_BAR; PG8_MMA(1, 0, At, B0); PG8_MMA(1, 1, At, B1); PG8_BAR; PG8_SCHED;
            } else {
            PG8_LDB(B0, 0, 0); PG8_SCHED; PG8_LDA(At, 0, 0); PG8_STAGE(PG8_SA(1, 1), a1 + hstep, voffA);
            PG8_WAIT_L(8); PG8_BAR; PG8_WAIT_L(0); PG8_MMA(0, 0, At, B0); PG8_BAR; PG8_SCHED;
            PG8_LDB(B1, 0, 1); PG8_STAGE(PG8_SB(0, 0), b2, voffB);
            PG8_BAR; PG8_WAIT_L(0); PG8_MMA(0, 1, At, B1); PG8_BAR;
            PG8_LDA(At, 0, 1); PG8_STAGE(PG8_SA(0, 0), a2, voffA);
            PG8_BAR; PG8_WAIT_L(0); PG8_MMA(1, 0, At, B0); PG8_BAR; PG8_SCHED;
            PG8_STAGE(PG8_SB(0, 1), b2 + hstep, voffB);
            PG8_WAIT_V(6); PG8_BAR; PG8_MMA(1, 1, At, B1); PG8_BAR;
            PG8_LDB(B0, 1, 0); PG8_SCHED; PG8_LDA(At, 1, 0); PG8_STAGE(PG8_SA(0, 1), a2 + hstep, voffA);
            PG8_WAIT_L(8); PG8_BAR; PG8_WAIT_L(0); PG8_MMA(0, 0, At, B0); PG8_BAR; PG8_SCHED;
            PG8_LDB(B1, 1, 1); PG8_STAGE(PG8_SB(1, 0), b3, voffB);
            PG8_BAR; PG8_WAIT_L(0); PG8_MMA(0, 1, At, B1); PG8_BAR;
            PG8_LDA(At, 1, 1); PG8_STAGE(PG8_SA(1, 0), a3, voffA);
            PG8_BAR; PG8_WAIT_L(0); PG8_MMA(1, 0, At, B0); PG8_BAR; PG8_SCHED;
            PG8_STAGE(PG8_SB(1, 1), b3 + hstep, voffB);
            PG8_WAIT_V(6); PG8_BAR; PG8_MMA(1, 1, At, B1); PG8_BAR;
            }
        }
        if constexpr (ALIGN_EPI) { if (wr == 0) PG8_BAR; }
        if constexpr (!Epi::AFTER_DRAIN) { E(acc, cur, wr, wc, fr, fq); S.done(cur); }
        if (!has_next) break;
#pragma unroll
        for (int a = 0; a < 2; ++a)
#pragma unroll
            for (int b = 0; b < 2; ++b)
#pragma unroll
                for (int m = 0; m < 4; ++m)
#pragma unroll
                    for (int n = 0; n < 2; ++n) acc[a][b][m][n] = (f32x4){0.f, 0.f, 0.f, 0.f};
        cur = nxt; cA = nA; cB = nB; ++ui;
        if constexpr (ALIGN_EPI) { if (wr == 1) PG8_BAR; }
    }
    PG8_WAIT_V(0);
    if constexpr (!ALIGN_EPI) { if (wr == 0) PG8_BAR; }
    PG8_BAR;
    if constexpr (Epi::AFTER_DRAIN) { E.fused(acc, cur, wr, wc, fr, fq, lds, wid, lane); S.done(cur); }
#undef PG8_SA
#undef PG8_SB
#undef PG8_STAGE
#undef PG8_LDA
#undef PG8_LDB
#undef PG8_MMA
#undef PG8_WAIT_V
#undef PG8_WAIT_L
#undef PG8_BAR
#undef PG8_SCHED
}
}

#ifndef MK_N_LAUNCHES
#define MK_N_LAUNCHES 1
#endif
#define LAS __attribute__((address_space(3)))
typedef unsigned short bf16;
typedef float f32x4 __attribute__((ext_vector_type(4)));
typedef float f32x2 __attribute__((ext_vector_type(2)));
typedef unsigned u32x4 __attribute__((ext_vector_type(4)));
typedef unsigned u32x2 __attribute__((ext_vector_type(2)));
typedef short bf16x8 __attribute__((ext_vector_type(8)));

constexpr int D = 1024, MP = 4096, ML = 16384, M = MP + ML, NIN = 7200, DFF = 4096;
constexpr float EPS = 1e-6f;
constexpr size_t MiB = 1u << 20;
constexpr size_t WS_MOD = 0;
constexpr size_t WS_BAR = 512 * 1024, WS_BAR_BYTES = 16384;
constexpr size_t WS_SSQ1 = 1 * MiB;
constexpr size_t WS_SSQ2 = 2560 * 1024;
constexpr size_t WS_LR = 4 * MiB;
constexpr size_t WS_WL = 8 * MiB;
constexpr size_t WS_WG = WS_WL + (size_t)2304 * 1024 * 2;
constexpr size_t WS_WY = WS_WG + (size_t)3072 * 1024 * 2;
constexpr size_t WS_WO = WS_WY + (size_t)4096 * 1024 * 2;
constexpr size_t WS_W1 = WS_WO + (size_t)1024 * 1024 * 2;
constexpr size_t WS_W2 = WS_W1 + (size_t)4096 * 1024 * 2;
constexpr size_t WS_S0 = 48 * MiB, SLOT = 40 * MiB;
static_assert(WS_W2 + (size_t)1024 * 4096 * 2 <= WS_S0, "ws map");
constexpr size_t WS_END = WS_S0 + 5 * SLOT;
constexpr int LDS_BYTES = 147456;

struct Args { const float* in[25]; float* out; unsigned char* ws; int ph_lo, ph_hi; };

__device__ __forceinline__ float bf2f(unsigned v) { return __uint_as_float(v << 16); }
__device__ __forceinline__ float bflo(unsigned w) { return __uint_as_float(w << 16); }
__device__ __forceinline__ float bfhi(unsigned w) { return __uint_as_float(w & 0xffff0000u); }
__device__ __forceinline__ unsigned pk2(float lo, float hi) { return pg8::cvt_pk_bf16(lo, hi); }
__device__ __forceinline__ float wave_sum(float v) {
#pragma unroll
    for (int o = 1; o < 64; o <<= 1) v += __shfl_xor(v, o);
    return v;
}
__device__ __forceinline__ float rcpf_(float x) { return __builtin_amdgcn_rcpf(x); }
__device__ __forceinline__ float expf_(float x) { return __builtin_amdgcn_exp2f(x * 1.4426950408889634f); }
__device__ __forceinline__ float logf_(float x) { return __builtin_amdgcn_logf(x) * 0.6931471805599453f; }
__device__ __forceinline__ float sigmoidf_(float x) { return rcpf_(1.0f + expf_(-x)); }
__device__ __forceinline__ float siluf_(float x) { return x * sigmoidf_(x); }
__device__ __forceinline__ float gelu_tanh(float x) { const float t = x * (1.5957691216f + 0.0713548163f * x * x); return x * rcpf_(1.0f + expf_(-t)); }
template <int ACT> __device__ __forceinline__ float actf(float x) {
    if (ACT == 1) return gelu_tanh(x);
    if (ACT == 2) return siluf_(x);
    if (ACT == 3) return sigmoidf_(x);
    if (ACT == 4) { const float m = fmaxf(x, 0.f); return m * m; }
    return x;
}
#define LDS_WAIT() asm volatile("s_waitcnt lgkmcnt(0)" ::: "memory")

#define XB_TMO      128
#define XB_XCNT(j)  (256  + 64 * (j))
#define XB_XSUB(j)  (1280 + 64 * (j))
#define XB_XGEN(j)  (2304 + 64 * (j))
#define XB_TOP      3328
#define XB_TOPGEN   3392
#define XCD_BAR_WORDS 3456
#define XB_SPIN_CAP (1u << 18)

__device__ __forceinline__ unsigned xb_ld(unsigned* p)              { return __hip_atomic_load(p, __ATOMIC_RELAXED, __HIP_MEMORY_SCOPE_AGENT); }
__device__ __forceinline__ unsigned xb_add(unsigned* p, unsigned v) { return __hip_atomic_fetch_add(p, v, __ATOMIC_RELAXED, __HIP_MEMORY_SCOPE_AGENT); }
__device__ __forceinline__ unsigned xb_xcc_id() { return (unsigned)__builtin_amdgcn_s_getreg((3 << 11) | 20) & 0xFu; }
#define XB_SPIN(cond, bar) do { unsigned _sp = 0; while (cond) { __builtin_amdgcn_s_sleep(1); \
    if ((++_sp & 255u) == 0u) { if (xb_ld(&(bar)[XB_TMO])) break; if (_sp > XB_SPIN_CAP) { atomicAdd(&(bar)[XB_TMO], 1u); break; } } } } while (0)

struct XcdBarrier {
    unsigned* bar; unsigned x;
    volatile LAS unsigned* st;
};

__device__ __forceinline__ XcdBarrier xcd_barrier_post(unsigned* bar, volatile LAS unsigned* st) {
    XcdBarrier b; b.bar = bar; b.x = xb_xcc_id(); b.st = st;
    if (threadIdx.x == 0) (void)xb_add(&bar[XB_XCNT(b.x)], 1u);
    return b;
}
__device__ __forceinline__ void xcd_barrier_complete(unsigned* bar, unsigned x, unsigned& nloc, unsigned& nx) {
    const unsigned G = gridDim.x * gridDim.y * gridDim.z;
    unsigned sum, cnt, mine, sp = 0u;
    for (;;) {
        sum = 0u; cnt = 0u; mine = 0u;
#pragma unroll
        for (unsigned j = 0; j < 16; ++j) { const unsigned c = xb_ld(&bar[XB_XCNT(j)]); sum += c; cnt += (c > 0u) ? 1u : 0u; mine = (j == x) ? c : mine; }
        if (sum == G) break;
        __builtin_amdgcn_s_sleep(1);
        if ((++sp & 255u) == 0u) { if (xb_ld(&bar[XB_TMO])) break; if (sp > XB_SPIN_CAP) { atomicAdd(&bar[XB_TMO], 1u); break; } }
    }
    nloc = mine > 0u ? mine : 1u; nx = cnt > 0u ? cnt : 1u;
}

__device__ __forceinline__ void xcd_barrier(const XcdBarrier& b) {
    asm volatile("s_waitcnt vmcnt(0)" ::: "memory");
    __syncthreads();
    if (threadIdx.x == 0) {
        unsigned* bar = b.bar;
        __builtin_amdgcn_s_waitcnt(0);
        unsigned nloc = b.st[0], nx = b.st[1];
        if (nloc == 0u) { xcd_barrier_complete(bar, b.x, nloc, nx); b.st[0] = nloc; b.st[1] = nx; }
        const unsigned old = xb_add(&bar[XB_XSUB(b.x)], 1u);
        const unsigned gen = old / nloc;
        if (old + 1u == (gen + 1u) * nloc) {
            __builtin_amdgcn_fence(__ATOMIC_RELEASE, "agent");
            asm volatile("s_waitcnt vmcnt(0)" ::: "memory");
            const unsigned og = xb_add(&bar[XB_TOP], 1u);
            const unsigned tg = og / nx;
            if (og + 1u == (tg + 1u) * nx) xb_add(&bar[XB_TOPGEN], 1u);
            else XB_SPIN(xb_ld(&bar[XB_TOPGEN]) == tg, bar);
            __builtin_amdgcn_fence(__ATOMIC_ACQUIRE, "agent");
            xb_add(&bar[XB_XGEN(b.x)], 1u);
            asm volatile("s_waitcnt vmcnt(0)" ::: "memory");
        } else {
            XB_SPIN(xb_ld(&bar[XB_XGEN(b.x)]) == gen, bar);
            __builtin_amdgcn_fence(__ATOMIC_ACQUIRE, "agent");
            asm volatile("s_waitcnt vmcnt(0)" ::: "memory");
        }
    }
    __syncthreads();
}

template <int ACT> __device__ __forceinline__ void store_tile(const f32x4 (&acc)[2][2][4][2], bf16* base, int ld, int row0, int col0) {
#pragma unroll
    for (int ai = 0; ai < 2; ++ai)
#pragma unroll
        for (int m = 0; m < 4; ++m) { bf16* rowp = base + (size_t)(row0 + ai * 128 + m * 16) * ld + col0;
#pragma unroll
            for (int bj = 0; bj < 2; ++bj) { const f32x4 v0 = acc[ai][bj][m][0], v1 = acc[ai][bj][m][1];
                u32x4 w; w.x = pk2(actf<ACT>(v0[0]), actf<ACT>(v0[1])); w.y = pk2(actf<ACT>(v0[2]), actf<ACT>(v0[3]));
                w.z = pk2(actf<ACT>(v1[0]), actf<ACT>(v1[1])); w.w = pk2(actf<ACT>(v1[2]), actf<ACT>(v1[3]));
                *(u32x4*)(rowp + bj * 128) = w; } }
}
struct EpiLG {
    static constexpr bool PERM = true, AFTER_DRAIN = false;
    bf16* ZX; bf16* ZG; float* LR; bf16* Q; bf16* K; bf16* V; bf16* G;
    __device__ __forceinline__ void operator()(const f32x4 (&acc)[2][2][4][2], const pg8::Unit& u, int wr, int wc, int fr, int fq) const {
        const int row0 = u.pm * 256 + wr * 64 + fr, cw = wc * 32 + 8 * fq;
        if (u.pn < 4) store_tile<0>(acc, ZX, D, row0, u.pn * 256 + cw);
        else if (u.pn < 8) store_tile<1>(acc, ZG, D, row0, (u.pn - 4) * 256 + cw);
        else if (u.pn == 8) { if (wc == 0) {
#pragma unroll
            for (int ai = 0; ai < 2; ++ai)
#pragma unroll
                for (int m = 0; m < 4; ++m) { float* rp = LR + (size_t)(row0 + ai * 128 + m * 16) * 32 + 8 * fq;
                    *(f32x4*)rp = acc[ai][0][m][0]; *(f32x4*)(rp + 4) = acc[ai][0][m][1]; } } }
        else if (u.pn < 11) store_tile<0>(acc, Q, 512, row0, (u.pn - 9) * 256 + cw);
        else if (u.pn < 13) store_tile<0>(acc, K, 512, row0, (u.pn - 11) * 256 + cw);
        else if (u.pn < 17) store_tile<0>(acc, V, D, row0, (u.pn - 13) * 256 + cw);
        else store_tile<2>(acc, G, D, row0, (u.pn - 17) * 256 + cw);
    }
};
struct EpiYY {
    static constexpr bool PERM = true, AFTER_DRAIN = false;
    bf16* YA; bf16* YB;
    __device__ __forceinline__ void operator()(const f32x4 (&acc)[2][2][4][2], const pg8::Unit& u, int wr, int wc, int fr, int fq) const {
        store_tile<0>(acc, u.pn < 4 ? YA : YB, D, u.pm * 256 + wr * 64 + fr, (u.pn & 3) * 256 + wc * 32 + 8 * fq);
    }
};
struct EpiMM {
    static constexpr bool PERM = true, AFTER_DRAIN = false;
    const bf16* YA; const bf16* YB; bf16* MM;
    __device__ __forceinline__ void operator()(const f32x4 (&acc)[2][2][4][2], const pg8::Unit& u, int wr, int wc, int fr, int fq) const {
        const int row0 = u.pm * 256 + wr * 64 + fr, c0 = u.pn * 128 + wc * 32 + 8 * fq;
#pragma unroll
        for (int ai = 0; ai < 2; ++ai)
#pragma unroll
            for (int m = 0; m < 4; ++m) { const size_t off = (size_t)(row0 + ai * 128 + m * 16) * D + c0;
                const u32x4 ya = *(const u32x4*)(YA + off), yb = *(const u32x4*)(YB + off);
                const f32x4 a0 = acc[ai][0][m][0], a1 = acc[ai][0][m][1], b0 = acc[ai][1][m][0], b1 = acc[ai][1][m][1];
#define MMV(av, bv, yv, zv) ({ const float ea_ = 1.0f + expf_(-(av)), eb_ = 1.0f + expf_(-(bv)); ((yv) * eb_ + (zv) * ea_) * rcpf_(ea_ * eb_); })
                u32x4 w;
                w.x = pk2(MMV(a0[0], b0[0], bflo(ya.x), bflo(yb.x)), MMV(a0[1], b0[1], bfhi(ya.x), bfhi(yb.x)));
                w.y = pk2(MMV(a0[2], b0[2], bflo(ya.y), bflo(yb.y)), MMV(a0[3], b0[3], bfhi(ya.y), bfhi(yb.y)));
                w.z = pk2(MMV(a1[0], b1[0], bflo(ya.z), bflo(yb.z)), MMV(a1[1], b1[1], bfhi(ya.z), bfhi(yb.z)));
                w.w = pk2(MMV(a1[2], b1[2], bflo(ya.w), bflo(yb.w)), MMV(a1[3], b1[3], bfhi(ya.w), bfhi(yb.w)));
#undef MMV
                *(u32x4*)(MM + off) = w; }
    }
};
struct EpiN {
    static constexpr bool PERM = true, AFTER_DRAIN = false;
    bf16* O; float* SSQ;
    __device__ __forceinline__ void operator()(const f32x4 (&acc)[2][2][4][2], const pg8::Unit& u, int wr, int wc, int fr, int fq) const {
        const int row0 = u.pm * 256 + wr * 64 + fr;
        store_tile<0>(acc, O, D, row0, u.pn * 256 + wc * 32 + 8 * fq);
#pragma unroll
        for (int ai = 0; ai < 2; ++ai)
#pragma unroll
            for (int m = 0; m < 4; ++m) { float ss = 0.f;
#pragma unroll
                for (int bj = 0; bj < 2; ++bj)
#pragma unroll
                    for (int n = 0; n < 2; ++n) { const f32x4 v = acc[ai][bj][m][n]; ss += (v[0] * v[0] + v[1] * v[1]) + (v[2] * v[2] + v[3] * v[3]); }
                ss += __shfl_xor(ss, 16); ss += __shfl_xor(ss, 32);
                if (fq == 0) SSQ[(size_t)(row0 + ai * 128 + m * 16) * 16 + u.pn * 4 + wc] = ss; }
    }
};
struct SplitOrder {
    int pm0, G, c;
    __device__ __forceinline__ bool next(int i, pg8::Unit& u) const { const int L = i * G + c; if (L >= 256) return false; u.kq = L & 3; u.pn = (L >> 2) & 3; u.pm = pm0 + (L >> 4); return true; }
    __device__ __forceinline__ void a_ready(const pg8::Unit&) const {}
    __device__ __forceinline__ void done(const pg8::Unit&) const {}
};
struct EpiS {
    static constexpr bool PERM = true, AFTER_DRAIN = false;
    bf16* O; bf16* P; int pm0;
    __device__ __forceinline__ void operator()(const f32x4 (&acc)[2][2][4][2], const pg8::Unit& u, int wr, int wc, int fr, int fq) const {
        const int cw = u.pn * 256 + wc * 32 + 8 * fq;
        if (u.kq == 0) store_tile<0>(acc, O, D, u.pm * 256 + wr * 64 + fr, cw);
        else store_tile<0>(acc, P + (size_t)(u.kq - 1) * 4096 * 1024, D, (u.pm - pm0) * 256 + wr * 64 + fr, cw);
    }
};
struct EpiH {
    static constexpr bool PERM = true, AFTER_DRAIN = false;
    bf16* Hd;
    __device__ __forceinline__ void operator()(const f32x4 (&acc)[2][2][4][2], const pg8::Unit& u, int wr, int wc, int fr, int fq) const {
        store_tile<4>(acc, Hd, DFF, u.pm * 256 + wr * 64 + fr, u.pn * 256 + wc * 32 + 8 * fq);
    }
};

template <bool ILV = false> __device__ __forceinline__ void tr_item(const float* W, int ld, int col0, int ncols, int K, bf16* WT, int row_off, LAS float* scr, int item, int lane) {
    const int nblk = ncols >> 5, kb = item / nblk, nb = item - kb * nblk, k0 = 64 * kb, n0 = 32 * nb;
    const int r0 = ILV ? ((n0 & 1023) >> 7) * 256 + (n0 & 127) + (n0 >> 10) * 128 : n0;
#pragma unroll 8
    for (int i = 0; i < 32; ++i) { const int kk = 2 * i + (lane >> 5); scr[kk * 33 + (lane & 31)] = W[(size_t)(k0 + kk) * ld + col0 + n0 + (lane & 31)]; }
    LDS_WAIT(); asm volatile("" ::: "memory");
    const int c = lane & 7;
#pragma unroll
    for (int j = 0; j < 4; ++j) { const int n = (lane >> 3) + 8 * j; const LAS float* s = scr + (8 * c) * 33 + n;
        u32x4 o; o.x = pk2(s[0 * 33], s[1 * 33]); o.y = pk2(s[2 * 33], s[3 * 33]); o.z = pk2(s[4 * 33], s[5 * 33]); o.w = pk2(s[6 * 33], s[7 * 33]);
        *(u32x4*)(WT + (size_t)(row_off + r0 + n) * K + k0 + 8 * c) = o; }
    LDS_WAIT(); asm volatile("" ::: "memory");
}
__device__ __forceinline__ void phase0(const Args& a, LAS unsigned char* lds, int tid, int lane, int wave) {
    LAS float* SIL = (LAS float*)lds;
    LAS float* RED = (LAS float*)(lds + 36864);
    LAS float* SCR = (LAS float*)(lds + 36864 + 18432 + wave * 8448);
    unsigned char* ws = a.ws;
    float* MOD = (float*)(ws + WS_MOD);
    for (int i = tid; i < 9 * 1024; i += 512) { const float c = i < 8192 ? a.in[4][i] : a.in[5][i - 8192]; SIL[i] = siluf_(c); }
    __syncthreads();
    for (int it = blockIdx.x; it < 96; it += gridDim.x) {
        const float* wp = a.in[6] + (size_t)(wave * 128) * 6144 + it * 64 + lane;
        float acc[9];
#pragma unroll
        for (int j = 0; j < 9; ++j) acc[j] = 0.f;
#pragma unroll 8
        for (int k = 0; k < 128; ++k) { const float w = wp[(size_t)k * 6144];
#pragma unroll
            for (int j = 0; j < 9; ++j) acc[j] += SIL[j * 1024 + wave * 128 + k] * w; }
#pragma unroll
        for (int j = 0; j < 9; ++j) RED[(wave * 9 + j) * 64 + lane] = acc[j];
        __syncthreads();
        for (int o = tid; o < 576; o += 512) { const int j = o >> 6, l = o & 63; float s = a.in[7][it * 64 + l];
#pragma unroll
            for (int w = 0; w < 8; ++w) s += RED[(w * 9 + j) * 64 + l];
            MOD[j * 6144 + it * 64 + l] = s; }
        __syncthreads();
    }
    bf16* WL = (bf16*)(ws + WS_WL); bf16* WG = (bf16*)(ws + WS_WG); bf16* WY = (bf16*)(ws + WS_WY);
    bf16* WO = (bf16*)(ws + WS_WO); bf16* W1 = (bf16*)(ws + WS_W1); bf16* W2 = (bf16*)(ws + WS_W2);
    const float* w_in = a.in[9];
    const bool split = gridDim.x >= 192;
    const int gw = split ? ((int)blockIdx.x - 96) * 8 + wave : (int)blockIdx.x * 8 + wave, NGW = split ? ((int)gridDim.x - 96) * 8 : (int)gridDim.x * 8;
    constexpr int NITEMS = 1024 + 16 + 1536 + 1024 + 512 + 512 + 512 + 2048 + 2048;
    for (int it = gw; it < NITEMS && gw >= 0; it += NGW) {
        int r = it;
        if (r < 1024) { tr_item(w_in, NIN, 0, 2048, 1024, WL, 0, SCR, r, lane); continue; } r -= 1024;
        if (r < 16) { tr_item(w_in, NIN, 5120, 32, 1024, WL, 2048, SCR, r, lane); continue; } r -= 16;
        if (r < 1536) { tr_item(w_in, NIN, 2048, 3072, 1024, WG, 0, SCR, r, lane); continue; } r -= 1536;
        if (r < 1024) { tr_item<true>(w_in, NIN, 5152, 2048, 1024, WY, 0, SCR, r, lane); continue; } r -= 1024;
        if (r < 512) { tr_item(a.in[17], 1024, 0, 1024, 1024, WY, 2048, SCR, r, lane); continue; } r -= 512;
        if (r < 512) { tr_item(a.in[21], 1024, 0, 1024, 1024, WY, 3072, SCR, r, lane); continue; } r -= 512;
        if (r < 512) { tr_item(a.in[22], 1024, 0, 1024, 1024, WO, 0, SCR, r, lane); continue; } r -= 512;
        if (r < 2048) { tr_item(a.in[23], 4096, 0, 4096, 1024, W1, 0, SCR, r, lane); continue; } r -= 2048;
        tr_item(a.in[24], 1024, 0, 1024, 4096, W2, 0, SCR, r, lane);
    }
    { u32x4* z = (u32x4*)(WL + (size_t)2080 * 1024); const u32x4 zz = {0u, 0u, 0u, 0u};
      for (int i = blockIdx.x * 512 + tid; i < 224 * 1024 / 8; i += gridDim.x * 512) z[i] = zz; }
}

__device__ __forceinline__ const float* xrow(const Args& a, int m) { return m < MP ? a.in[0] + (size_t)m * D : a.in[1] + (size_t)(m - MP) * D; }
__device__ __forceinline__ int modgrp(int m) { return m < MP ? 8 : ((m - MP) >> 11); }
__device__ __forceinline__ void phase1(const Args& a, bf16* H, int lane, int wave) {
    const float* MOD = (const float*)(a.ws + WS_MOD); const float* ng = a.in[8];
    const int stride = gridDim.x * 8; int m = blockIdx.x * 8 + wave;
    f32x4 v[4];
    if (m < M) { const f32x4* xr = (const f32x4*)xrow(a, m) + lane;
#pragma unroll
        for (int q = 0; q < 4; ++q) v[q] = xr[64 * q]; }
    for (; m < M; m += stride) {
        f32x4 vn[4]; const int mn = m + stride;
#pragma unroll
        for (int q = 0; q < 4; ++q) vn[q] = v[q];
        if (mn < M) { const f32x4* xr = (const f32x4*)xrow(a, mn) + lane;
#pragma unroll
            for (int q = 0; q < 4; ++q) vn[q] = xr[64 * q]; }
        const float* md = MOD + modgrp(m) * 6144;
        float s = 0.f;
#pragma unroll
        for (int q = 0; q < 4; ++q) s += (v[q][0] * v[q][0] + v[q][1] * v[q][1]) + (v[q][2] * v[q][2] + v[q][3] * v[q][3]);
        const float rstd = rsqrtf(wave_sum(s) * (1.f / D) + EPS);
        u32x2* o = (u32x2*)(H + (size_t)m * D) + lane;
#pragma unroll
        for (int q = 0; q < 4; ++q) { const int c = 4 * (lane + 64 * q);
            const f32x4 g = *(const f32x4*)(ng + c), sh = *(const f32x4*)(md + c), sc = *(const f32x4*)(md + 1024 + c);
            const f32x4 r = v[q] * rstd * g * (sc + 1.0f) + sh;
            u32x2 w; w.x = pk2(r[0], r[1]); w.y = pk2(r[2], r[3]); o[64 * q] = w; }
#pragma unroll
        for (int q = 0; q < 4; ++q) v[q] = vn[q];
    }
}

__device__ __forceinline__ void lru_phase(const Args& a, LAS unsigned char* lds, int tid, int lane, int wave) {
    LAS bf16* XC = (LAS bf16*)lds;
    LAS float* AU = (LAS float*)(lds + 18432);
    LAS float* SUBA = (LAS float*)(lds + 18432 + 69632);
    LAS float* HC = SUBA + 8 * 64 * 2;
    const bf16* ZX = (const bf16*)a.out;
    bf16* HF = (bf16*)(a.ws + WS_S0 + 2 * SLOT); bf16* HB = (bf16*)(a.ws + WS_S0);
    const float* conv_w = a.in[10]; const float* conv_b = a.in[11];
    const int col = lane & 15, quad = lane >> 4, mt = wave & 3, nh = wave >> 2;
    const int vcu = (gridDim.x % 8 == 0) ? (int)(blockIdx.x % 8) * (int)(gridDim.x / 8) + (int)(blockIdx.x / 8) : (int)blockIdx.x;
    for (int u = vcu; u < 768; u += gridDim.x) {
        const bool lat = u < 256; const int v = lat ? u : u - 256; const int b = v >> 5, blk = (v >> 1) & 15, dir = v & 1;
        const int row_base = lat ? MP + b * 2048 : b * 256, nseg = lat ? 32 : 4;
        bf16* HX = dir ? HB : HF;
        const float* wa = a.in[12] + (size_t)(dir * 16 + blk) * 4096; const float* wx = a.in[14] + (size_t)(dir * 16 + blk) * 4096;
        bf16x8 Bf[2][2][2];
#pragma unroll
        for (int nt = 0; nt < 2; ++nt)
#pragma unroll
            for (int kk = 0; kk < 2; ++kk)
#pragma unroll
                for (int i = 0; i < 8; i += 2) { const int k = kk * 32 + quad * 8 + i, n = nh * 32 + nt * 16 + col;
                    const unsigned pa = pk2(wa[k * 64 + n], wa[(k + 1) * 64 + n]), px = pk2(wx[k * 64 + n], wx[(k + 1) * 64 + n]);
                    Bf[0][nt][kk][i] = (short)(pa & 0xffffu); Bf[0][nt][kk][i + 1] = (short)(pa >> 16);
                    Bf[1][nt][kk][i] = (short)(px & 0xffffu); Bf[1][nt][kk][i + 1] = (short)(px >> 16); }
        float ba_[2], bx_[2], c8_[2];
#pragma unroll
        for (int nt = 0; nt < 2; ++nt) { const int ch = dir * 1024 + blk * 64 + nh * 32 + nt * 16 + col;
            ba_[nt] = a.in[13][ch]; bx_[nt] = a.in[15][ch]; c8_[nt] = -8.0f * log1pf(expf(-a.in[16][ch])); }
        if (tid < 64) HC[tid] = lat ? a.in[2][(size_t)(b * 2 + dir) * 1024 + blk * 64 + tid] : 0.f;
        const int tokA = tid >> 3, c8A = (tid & 7) * 8, ch0A = blk * 64 + c8A;
        f32x4 cwv[4][2];
#pragma unroll
        for (int j = 0; j < 4; ++j) { cwv[j][0] = *(const f32x4*)(conv_w + j * 1024 + ch0A); cwv[j][1] = *(const f32x4*)(conv_w + j * 1024 + ch0A + 4); }
        const f32x4 cb0 = *(const f32x4*)(conv_b + ch0A), cb1 = *(const f32x4*)(conv_b + ch0A + 4);
        const int nst = nseg >> 1;
        u32x4 Zg[2][4];
#define LRU_FETCH(t0_) do { _Pragma("unroll") for (int hh_ = 0; hh_ < 2; ++hh_) { const int t0h_ = (t0_) + 64 * hh_; const int lo_ = lat ? t0h_ : 0, hi_ = lat ? t0h_ + 64 : 256; \
            _Pragma("unroll") for (int j_ = 0; j_ < 4; ++j_) { const int t_ = t0h_ + tokA + j_ - 1; \
                Zg[hh_][j_] = (t_ >= lo_ && t_ < hi_) ? *(const u32x4*)(ZX + (size_t)(row_base + t_) * D + ch0A) : (u32x4){0u, 0u, 0u, 0u}; } } } while (0)
        LRU_FETCH((dir ? nst - 1 : 0) * 128);
        for (int s = 0; s < nst; ++s) {
            const int st = dir ? nst - 1 - s : s, t0 = st * 128;
#pragma unroll
            for (int hh = 0; hh < 2; ++hh) {
                f32x4 x0 = cb0, x1 = cb1;
#pragma unroll
                for (int j = 0; j < 4; ++j) { const u32x4 z = Zg[hh][j]; const f32x4 w0 = cwv[j][0], w1 = cwv[j][1];
                    x0[0] += w0[0] * bflo(z.x); x0[1] += w0[1] * bfhi(z.x); x0[2] += w0[2] * bflo(z.y); x0[3] += w0[3] * bfhi(z.y);
                    x1[0] += w1[0] * bflo(z.z); x1[1] += w1[1] * bfhi(z.z); x1[2] += w1[2] * bflo(z.w); x1[3] += w1[3] * bfhi(z.w); }
                u32x4 w; w.x = pk2(x0[0], x0[1]); w.y = pk2(x0[2], x0[3]); w.z = pk2(x1[0], x1[1]); w.w = pk2(x1[2], x1[3]);
                *(LAS u32x4*)(XC + (64 * hh + tokA) * 72 + c8A) = w;
            }
            __syncthreads();
            if (s + 1 < nst) LRU_FETCH((dir ? nst - 2 - s : s + 1) * 128);
#pragma unroll
            for (int hh = 0; hh < 2; ++hh) {
                bf16x8 Af[2];
#pragma unroll
                for (int kk = 0; kk < 2; ++kk) Af[kk] = *(const LAS bf16x8*)(XC + (64 * hh + 16 * mt + col) * 72 + kk * 32 + quad * 8);
                f32x4 ar[2], ai[2];
#pragma unroll
                for (int nt = 0; nt < 2; ++nt) { ar[nt] = (f32x4){0.f, 0.f, 0.f, 0.f}; ai[nt] = (f32x4){0.f, 0.f, 0.f, 0.f};
#pragma unroll
                    for (int kk = 0; kk < 2; ++kk) { ar[nt] = __builtin_amdgcn_mfma_f32_16x16x32_bf16(Af[kk], Bf[0][nt][kk], ar[nt], 0, 0, 0);
                        ai[nt] = __builtin_amdgcn_mfma_f32_16x16x32_bf16(Af[kk], Bf[1][nt][kk], ai[nt], 0, 0, 0); } }
                float xv[2][4];
#pragma unroll
                for (int nt = 0; nt < 2; ++nt)
#pragma unroll
                    for (int j = 0; j < 4; ++j) xv[nt][j] = bf2f((unsigned)XC[(64 * hh + 16 * mt + quad * 4 + j) * 72 + nh * 32 + nt * 16 + col]);
#pragma unroll
                for (int nt = 0; nt < 2; ++nt)
#pragma unroll
                    for (int j = 0; j < 4; ++j) { const int tok = 64 * hh + 16 * mt + quad * 4 + j, chl = nh * 32 + nt * 16 + col;
                        const float er = 1.0f + expf_(-(ar[nt][j] + ba_[nt])), ei = 1.0f + expf_(-(ai[nt][j] + bx_[nt]));
                        const float inv = rcpf_(er * ei), r = inv * ei, ig = inv * er;
                        const float aa = expf_(c8_[nt] * r);
                        const float uu = __builtin_amdgcn_sqrtf(fmaxf(1.0f - aa * aa, 0.f)) * ig * xv[nt][j];
                        typedef float f32x2s __attribute__((ext_vector_type(2)));
                        *(LAS f32x2s*)(AU + (tok * 68 + chl) * 2) = (f32x2s){aa, uu}; }
            }
            __syncthreads();
            {
                typedef float f32x2l __attribute__((ext_vector_type(2)));
                f32x2l p[16];
#pragma unroll
                for (int e = 0; e < 16; ++e) { const int i = wave * 16 + e; const int tok = dir ? 127 - i : i; p[e] = *(const LAS f32x2l*)(AU + (tok * 68 + lane) * 2); }
                float hl = 0.f, cp = 1.f;
#pragma unroll
                for (int e = 0; e < 16; ++e) { hl = p[e].x * hl + p[e].y; cp *= p[e].x; p[e].y = hl; p[e].x = cp; }
                *(LAS f32x2l*)(SUBA + (wave * 64 + lane) * 2) = (f32x2l){cp, hl};
                __syncthreads();
                float c = HC[(s & 1) * 64 + lane];
#pragma unroll
                for (int s2 = 0; s2 < 7; ++s2) { const f32x2l q = *(const LAS f32x2l*)(SUBA + (s2 * 64 + lane) * 2); if (s2 < wave) c = q.x * c + q.y; }
#pragma unroll
                for (int e = 0; e < 16; ++e) { const int i = wave * 16 + e; const int tok = dir ? 127 - i : i; *(LAS f32x2l*)(AU + (tok * 68 + lane) * 2) = (f32x2l){p[e].x, p[e].y + p[e].x * c}; }
                if (wave == 7) HC[((s + 1) & 1) * 64 + lane] = p[15].y + p[15].x * c;
            }
            __syncthreads();
#pragma unroll
            for (int hh = 0; hh < 2; ++hh) {
                const LAS f32x4* hq = (const LAS f32x4*)(AU + ((64 * hh + tokA) * 68 + c8A) * 2);
                const f32x4 q0 = hq[0], q1 = hq[1], q2 = hq[2], q3 = hq[3];
                u32x4 w; w.x = pk2(q0[1], q0[3]); w.y = pk2(q1[1], q1[3]); w.z = pk2(q2[1], q2[3]); w.w = pk2(q3[1], q3[3]);
                *(u32x4*)(HX + (size_t)(row_base + t0 + 64 * hh + tokA) * D + blk * 64 + c8A) = w;
            }
        }
#undef LRU_FETCH
        if (!lat && tid < 64) a.out[(size_t)M * D + (size_t)(b * 2 + dir) * 1024 + blk * 64 + tid] = HC[(nst & 1) * 64 + tid];
        __syncthreads();
    }
}

constexpr size_t WS_DEC = 6656 * 1024;
__device__ __forceinline__ void gla_prep(const Args& a, LAS unsigned char* lds, int tid, bf16* ewd, const bf16* ewa, const bf16* ewb) {
    LAS float* LRS = (LAS float*)lds;
    const float* LR = (const float*)(a.ws + WS_LR);
    bf16* EFb = (bf16*)a.out; bf16* EBb = EFb + (size_t)M * 512;
    float* DECg = (float*)(a.ws + WS_DEC);
    const size_t ew_n = (size_t)M * D / 8, ew_stride = (size_t)gridDim.x * 512; size_t ew_i = (size_t)blockIdx.x * 512 + tid;
    for (int it = blockIdx.x; it < 640; it += gridDim.x) {
        const int gc = it >> 1, dir = it & 1; const bool lat = gc >= 64; const int g2 = lat ? gc - 64 : gc;
        const int b = lat ? (g2 >> 5) : (g2 >> 2), cn = lat ? (g2 & 31) : (g2 & 3), p0 = cn * 64;
        const int row_base = lat ? MP + b * 2048 : b * 256;
        bf16* Eb = dir ? EBb : EFb;
        float w2r[16];
#pragma unroll
        for (int r = 0; r < 16; ++r) w2r[r] = a.in[18][(size_t)(dir * 16 + r) * 512 + tid];
        const float b2v = a.in[19][dir * 512 + tid];
        __syncthreads();
        if (tid < 256) { const int i = tid >> 2; const int p_ = dir ? p0 + 63 - i : p0 + i; const int row = lat ? row_base + (p_ & 31) * 64 + (p_ >> 5) : row_base + p_;
            *(LAS f32x4*)(LRS + i * 16 + (tid & 3) * 4) = *(const f32x4*)(LR + (size_t)row * 32 + dir * 16 + (tid & 3) * 4); }
        __syncthreads();
        float run = 0.f;
#pragma unroll 1
        for (int i8 = 0; i8 < 64; i8 += 8) {
            const bool ew_on = ew_i < ew_n; u32x4 ex0 = {0u, 0u, 0u, 0u}, ex1 = ex0, ey0 = ex0;
            if (ew_on) { ex0 = ((const u32x4*)ewa)[ew_i]; ex1 = ((const u32x4*)ewb)[ew_i]; ey0 = ((const u32x4*)ewd)[ew_i]; }
#pragma unroll
            for (int i7 = 0; i7 < 8; ++i7) { const int i = i8 + i7; const int p_ = dir ? p0 + 63 - i : p0 + i; const int row = lat ? row_base + (p_ & 31) * 64 + (p_ >> 5) : row_base + p_;
                const LAS f32x4* lrp = (const LAS f32x4*)(LRS + i * 16);
                const f32x4 l0 = lrp[0], l1 = lrp[1], l2 = lrp[2], l3 = lrp[3];
                float x = b2v;
                x += l0[0] * w2r[0]; x += l0[1] * w2r[1]; x += l0[2] * w2r[2]; x += l0[3] * w2r[3];
                x += l1[0] * w2r[4]; x += l1[1] * w2r[5]; x += l1[2] * w2r[6]; x += l1[3] * w2r[7];
                x += l2[0] * w2r[8]; x += l2[1] * w2r[9]; x += l2[2] * w2r[10]; x += l2[3] * w2r[11];
                x += l3[0] * w2r[12]; x += l3[1] * w2r[13]; x += l3[2] * w2r[14]; x += l3[3] * w2r[15];
                run += (fminf(x, 0.f) - logf_(1.0f + expf_(-fabsf(x)))) * 0.0625f;
                Eb[(size_t)row * 512 + tid] = (bf16)(pk2(expf_(run), 0.f) & 0xffffu); }
            if (ew_on) { u32x4 o;
#pragma unroll
                for (int e = 0; e < 4; ++e) o[e] = pk2((bflo(ex0[e]) + bflo(ex1[e])) * bflo(ey0[e]), (bfhi(ex0[e]) + bfhi(ex1[e])) * bfhi(ey0[e]));
                ((u32x4*)ewd)[ew_i] = o; ew_i += ew_stride; }
        }
        DECg[((size_t)dir * 320 + gc) * 512 + tid] = expf_(run);
    }
    for (; ew_i < ew_n; ew_i += ew_stride) { const u32x4 ex0 = ((const u32x4*)ewa)[ew_i], ex1 = ((const u32x4*)ewb)[ew_i], ey0 = ((const u32x4*)ewd)[ew_i]; u32x4 o;
#pragma unroll
        for (int e = 0; e < 4; ++e) o[e] = pk2((bflo(ex0[e]) + bflo(ex1[e])) * bflo(ey0[e]), (bfhi(ex0[e]) + bfhi(ex1[e])) * bfhi(ey0[e]));
        ((u32x4*)ewd)[ew_i] = o; }
}

__device__ __forceinline__ void gla_phase(const Args& a, LAS unsigned char* lds, int tid, int lane, int wave) {
    LAS bf16* QE = (LAS bf16*)lds;
    LAS bf16* KE = QE + 64 * 136;
    LAS bf16* ST = KE + 64 * 136;
    LAS bf16* KT = ST + 64 * 136;
    LAS bf16* VT = KT + 128 * 72;
    LAS bf16* PP = VT + 64 * 72;
    LAS bf16* EE = PP + 64 * 72;
    LAS float* DEC = (LAS float*)(EE + 64 * 136);
    const unsigned char* ws = a.ws;
    const bf16* EFb = (const bf16*)a.out; const bf16* EBb = EFb + (size_t)M * 512;
    const float* DECg = (const float*)(ws + WS_DEC);
    const bf16* Qb = (const bf16*)(ws + WS_S0 + 3 * SLOT); const bf16* Kb = Qb + (size_t)M * 512;
    const bf16* Vb = (const bf16*)(ws + WS_S0 + 4 * SLOT);
    bf16* OFb = (bf16*)(a.ws + WS_S0 + 2 * SLOT); bf16* OBb = (bf16*)(a.ws + WS_S0);
    const int ch = tid & 127, sub = __builtin_amdgcn_readfirstlane(tid >> 7);
    const int col = lane & 15, quad = lane >> 4, kt = wave;
    float* SG = a.out + (size_t)M * D + 16 * 2 * 1024;
    const int vcu = (gridDim.x % 8 == 0) ? (int)(blockIdx.x % 8) * (int)(gridDim.x / 8) + (int)(blockIdx.x / 8) : (int)blockIdx.x;
    for (int u = vcu; u < 768; u += gridDim.x) {
        const bool lat = u < 256; const int v = lat ? u : u - 256; const int b = v >> 5, hd = (v >> 3) & 3, dir = (v >> 2) & 1, sl = v & 3;
        const int row_base = lat ? MP + b * 2048 : b * 256, nch = lat ? 32 : 4, gc0 = lat ? 64 + b * 32 : b * 4;
        bf16* Ob = dir ? OBb : OFb; const bf16* Eb = dir ? EBb : EFb;
        f32x4 S[4];
#pragma unroll
        for (int vt = 0; vt < 4; ++vt)
#pragma unroll
            for (int j = 0; j < 4; ++j)
                S[vt][j] = lat ? a.in[3][((((size_t)(b * 2 + dir) * 4 + hd) * 128 + 16 * kt + quad * 4 + j) * 256) + sl * 64 + 16 * vt + col] : 0.f;
#define GROWP(p0_, i) ({ const int p_ = dir ? (p0_) + 63 - (i) : (p0_) + (i); lat ? row_base + (p_ & 31) * 64 + (p_ >> 5) : row_base + p_; })
        u32x4 QgA[2], KgA[2], EgA[2], VgA, QgB[2], KgB[2], EgB[2], VgB; f32x2 etgA, etgB;
#define GLA_FETCH(X, cn_) do { const int p0_ = (cn_) * 64; \
            _Pragma("unroll") for (int e_ = 0; e_ < 2; ++e_) { const int pc_ = tid + e_ * 512; const size_t ro_ = (size_t)GROWP(p0_, pc_ >> 4) * 512 + hd * 128 + (pc_ & 15) * 8; \
                Qg##X[e_] = *(const u32x4*)(Qb + ro_); Kg##X[e_] = *(const u32x4*)(Kb + ro_); Eg##X[e_] = *(const u32x4*)(Eb + ro_); } \
            Vg##X = *(const u32x4*)(Vb + (size_t)GROWP(p0_, tid & 63) * D + hd * 256 + sl * 64 + (tid >> 6) * 8); \
            etg##X = *(const f32x2*)(DECg + ((size_t)dir * 320 + gc0 + (cn_)) * 512 + hd * 128 + 2 * lane); } while (0)
#define GLA_CHUNK(X, n) do { const int cn = dir ? nch - 1 - (n) : (n), p0 = cn * 64; \
            __syncthreads(); \
_Pragma("unroll") \
            for (int vt = 0; vt < 4; ++vt) { u32x2 w; w.x = pk2(S[vt][0], S[vt][1]); w.y = pk2(S[vt][2], S[vt][3]); \
                *(LAS u32x2*)(ST + (16 * vt + col) * 136 + 16 * kt + quad * 4) = w; } \
_Pragma("unroll") \
            for (int e = 0; e < 2; ++e) { const int pc = tid + e * 512, o_ = (pc >> 4) * 136 + (pc & 15) * 8; \
                *(LAS u32x4*)(QE + o_) = Qg##X[e]; *(LAS u32x4*)(KE + o_) = Kg##X[e]; *(LAS u32x4*)(EE + o_) = Eg##X[e]; } \
            {   const int i = tid & 63, v8 = (tid >> 6) * 8; const u32x4 z = Vg##X; \
                VT[(v8 + 0) * 72 + i] = (bf16)(z.x & 0xffffu); VT[(v8 + 1) * 72 + i] = (bf16)(z.x >> 16); \
                VT[(v8 + 2) * 72 + i] = (bf16)(z.y & 0xffffu); VT[(v8 + 3) * 72 + i] = (bf16)(z.y >> 16); \
                VT[(v8 + 4) * 72 + i] = (bf16)(z.z & 0xffffu); VT[(v8 + 5) * 72 + i] = (bf16)(z.z >> 16); \
                VT[(v8 + 6) * 72 + i] = (bf16)(z.w & 0xffffu); VT[(v8 + 7) * 72 + i] = (bf16)(z.w >> 16); } \
            const f32x2 etot = etg##X; \
            if (wave == 0) *(LAS f32x2*)(DEC + 2 * lane) = etot; \
            __syncthreads(); \
            if ((n) + 2 < nch) GLA_FETCH(X, dir ? nch - 3 - (n) : (n) + 2); \
            {     \
                unsigned qw[8], kw_[8], ew[8]; \
_Pragma("unroll") \
                for (int e = 0; e < 8; ++e) { const int o_ = (wave * 8 + e) * 136 + 2 * lane; qw[e] = *(const LAS unsigned*)(QE + o_); kw_[e] = *(const LAS unsigned*)(KE + o_); ew[e] = *(const LAS unsigned*)(EE + o_); } \
                float t0v[8], t1v[8]; \
_Pragma("unroll") \
                for (int e = 0; e < 8; ++e) { const float E0 = bflo(ew[e]), E1 = bfhi(ew[e]); const float R0 = rcpf_(E0), R1 = rcpf_(E1); \
                    const float q0 = bflo(qw[e]) * E0 * 0.08838834764831845f, q1 = bfhi(qw[e]) * E1 * 0.08838834764831845f; \
                    const float k0 = bflo(kw_[e]) * R0, k1 = bfhi(kw_[e]) * R1; t0v[e] = k0 * etot.x; t1v[e] = k1 * etot.y; \
                    qw[e] = pk2(q0, q1); kw_[e] = pk2(k0, k1); } \
_Pragma("unroll") \
                for (int e = 0; e < 8; ++e) { const int o_ = (wave * 8 + e) * 136 + 2 * lane; *(LAS unsigned*)(QE + o_) = qw[e]; *(LAS unsigned*)(KE + o_) = kw_[e]; } \
                u32x4 w0, w1; w0.x = pk2(t0v[0], t0v[1]); w0.y = pk2(t0v[2], t0v[3]); w0.z = pk2(t0v[4], t0v[5]); w0.w = pk2(t0v[6], t0v[7]); \
                w1.x = pk2(t1v[0], t1v[1]); w1.y = pk2(t1v[2], t1v[3]); w1.z = pk2(t1v[4], t1v[5]); w1.w = pk2(t1v[6], t1v[7]); \
                *(LAS u32x4*)(KT + (2 * lane) * 72 + wave * 8) = w0; *(LAS u32x4*)(KT + (2 * lane + 1) * 72 + wave * 8) = w1; } \
            __syncthreads(); \
            {     \
                const int st = wave >> 1, ct0 = 2 * (wave & 1); \
                f32x4 acc0 = {0.f, 0.f, 0.f, 0.f}, acc1 = {0.f, 0.f, 0.f, 0.f}; \
                if (st <= ct0 + 1) { \
_Pragma("unroll") \
                    for (int kk = 0; kk < 4; ++kk) { const bf16x8 ak = *(const LAS bf16x8*)(KE + (16 * st + col) * 136 + kk * 32 + quad * 8); \
                        if (st <= ct0) { const bf16x8 bq0 = *(const LAS bf16x8*)(QE + (16 * ct0 + col) * 136 + kk * 32 + quad * 8); acc0 = __builtin_amdgcn_mfma_f32_16x16x32_bf16(ak, bq0, acc0, 0, 0, 0); } \
                        const bf16x8 bq1 = *(const LAS bf16x8*)(QE + (16 * (ct0 + 1) + col) * 136 + kk * 32 + quad * 8); acc1 = __builtin_amdgcn_mfma_f32_16x16x32_bf16(ak, bq1, acc1, 0, 0, 0); } \
                } \
_Pragma("unroll") \
                for (int j = 0; j < 4; ++j) { if (16 * st + quad * 4 + j > 16 * ct0 + col) acc0[j] = 0.f; if (16 * st + quad * 4 + j > 16 * (ct0 + 1) + col) acc1[j] = 0.f; } \
                u32x2 w0, w1; w0.x = pk2(acc0[0], acc0[1]); w0.y = pk2(acc0[2], acc0[3]); w1.x = pk2(acc1[0], acc1[1]); w1.y = pk2(acc1[2], acc1[3]); \
                *(LAS u32x2*)(PP + (16 * ct0 + col) * 72 + 16 * st + quad * 4) = w0; *(LAS u32x2*)(PP + (16 * (ct0 + 1) + col) * 72 + 16 * st + quad * 4) = w1; \
            } \
            __syncthreads(); \
            {     \
                const int vt_ = wave >> 1, ct0 = 2 * (wave & 1); \
                bf16x8 av[2], as_[4]; \
_Pragma("unroll") \
                for (int ks = 0; ks < 2; ++ks) av[ks] = *(const LAS bf16x8*)(VT + (16 * vt_ + col) * 72 + ks * 32 + quad * 8); \
_Pragma("unroll") \
                for (int kk = 0; kk < 4; ++kk) as_[kk] = *(const LAS bf16x8*)(ST + (16 * vt_ + col) * 136 + kk * 32 + quad * 8); \
                f32x4 acc0 = {0.f, 0.f, 0.f, 0.f}, acc1 = {0.f, 0.f, 0.f, 0.f}; \
_Pragma("unroll") \
                for (int ks = 0; ks < 2; ++ks) { const bf16x8 bp0 = *(const LAS bf16x8*)(PP + (16 * ct0 + col) * 72 + ks * 32 + quad * 8), bp1 = *(const LAS bf16x8*)(PP + (16 * (ct0 + 1) + col) * 72 + ks * 32 + quad * 8); \
                    acc0 = __builtin_amdgcn_mfma_f32_16x16x32_bf16(av[ks], bp0, acc0, 0, 0, 0); acc1 = __builtin_amdgcn_mfma_f32_16x16x32_bf16(av[ks], bp1, acc1, 0, 0, 0); } \
_Pragma("unroll") \
                for (int kk = 0; kk < 4; ++kk) { const bf16x8 bq0 = *(const LAS bf16x8*)(QE + (16 * ct0 + col) * 136 + kk * 32 + quad * 8), bq1 = *(const LAS bf16x8*)(QE + (16 * (ct0 + 1) + col) * 136 + kk * 32 + quad * 8); \
                    acc0 = __builtin_amdgcn_mfma_f32_16x16x32_bf16(as_[kk], bq0, acc0, 0, 0, 0); acc1 = __builtin_amdgcn_mfma_f32_16x16x32_bf16(as_[kk], bq1, acc1, 0, 0, 0); } \
                const int row0 = GROWP(p0, 16 * ct0 + col), row1 = GROWP(p0, 16 * (ct0 + 1) + col); \
                u32x2 w0, w1; w0.x = pk2(acc0[0], acc0[1]); w0.y = pk2(acc0[2], acc0[3]); w1.x = pk2(acc1[0], acc1[1]); w1.y = pk2(acc1[2], acc1[3]); \
                *(u32x2*)(Ob + (size_t)row0 * D + hd * 256 + sl * 64 + 16 * vt_ + quad * 4) = w0; *(u32x2*)(Ob + (size_t)row1 * D + hd * 256 + sl * 64 + 16 * vt_ + quad * 4) = w1; \
                bf16x8 ak[2]; \
_Pragma("unroll") \
                for (int ks = 0; ks < 2; ++ks) ak[ks] = *(const LAS bf16x8*)(KT + (16 * kt + col) * 72 + ks * 32 + quad * 8); \
                float dk[4]; \
_Pragma("unroll") \
                for (int j = 0; j < 4; ++j) dk[j] = DEC[16 * kt + quad * 4 + j]; \
_Pragma("unroll") \
                for (int vt = 0; vt < 4; ++vt) { \
_Pragma("unroll") \
                    for (int j = 0; j < 4; ++j) S[vt][j] *= dk[j]; \
_Pragma("unroll") \
                    for (int ks = 0; ks < 2; ++ks) { const bf16x8 bv = *(const LAS bf16x8*)(VT + (16 * vt + col) * 72 + ks * 32 + quad * 8); \
                        S[vt] = __builtin_amdgcn_mfma_f32_16x16x32_bf16(ak[ks], bv, S[vt], 0, 0, 0); } } \
            } \
        } while (0)
        GLA_FETCH(A, dir ? nch - 1 : 0); GLA_FETCH(B, dir ? nch - 2 : 1);
        for (int n = 0; n < nch; n += 2) { GLA_CHUNK(A, n); GLA_CHUNK(B, n + 1); }
#undef GLA_CHUNK
#undef GLA_FETCH
#undef GROWP
        if (!lat) {
#pragma unroll
            for (int vt = 0; vt < 4; ++vt)
#pragma unroll
                for (int j = 0; j < 4; ++j)
                    SG[((((size_t)(b * 2 + dir) * 4 + hd) * 128 + 16 * kt + quad * 4 + j) * 256) + sl * 64 + 16 * vt + col] = S[vt][j];
        }
    }
}

template <int MODE> __device__ __forceinline__ void ew_pass(bf16* dst, const bf16* a0, const bf16* b0, const bf16* a1, const bf16* b1, int tid) {
    const size_t nvec = (size_t)M * D / 8;
    for (size_t i = (size_t)blockIdx.x * 512 + tid; i < nvec; i += (size_t)gridDim.x * 512) {
        const u32x4 x0 = ((const u32x4*)a0)[i], y0 = ((const u32x4*)b0)[i], x1 = ((const u32x4*)a1)[i];
        u32x4 o;
        if (MODE == 0) {
#pragma unroll
            for (int e = 0; e < 4; ++e) o[e] = pk2((bflo(x0[e]) + bflo(x1[e])) * bflo(y0[e]), (bfhi(x0[e]) + bfhi(x1[e])) * bfhi(y0[e]));
        } else {
            const u32x4 y1 = ((const u32x4*)b1)[i];
#pragma unroll
            for (int e = 0; e < 4; ++e) o[e] = pk2(bflo(x0[e]) * bflo(y0[e]) + bflo(x1[e]) * bflo(y1[e]), bfhi(x0[e]) * bfhi(y0[e]) + bfhi(x1[e]) * bfhi(y1[e]));
        }
        ((u32x4*)dst)[i] = o;
    }
}
__device__ __forceinline__ void post_gla(const Args& a, int lane, int wave) {
    const bf16* OFb = (const bf16*)(a.ws + WS_S0 + 2 * SLOT); const bf16* OBb = (const bf16*)(a.ws + WS_S0);
    bf16* G = (bf16*)(a.ws + WS_S0 + 1 * SLOT);
    const f32x4 gn = *(const f32x4*)(a.in[20] + 4 * lane);
    const int stride = gridDim.x * 8; int m = blockIdx.x * 8 + wave;
    u32x2 cf[4], cb[4], cg[4];
    if (m < M) {
#pragma unroll
        for (int hh = 0; hh < 4; ++hh) { const size_t off = (size_t)m * D + hh * 256 + 4 * lane; cf[hh] = *(const u32x2*)(OFb + off); cb[hh] = *(const u32x2*)(OBb + off); cg[hh] = *(const u32x2*)(G + off); } }
    for (; m < M; m += stride) {
        u32x2 nf[4], nb[4], ng_[4]; const int mn = m + stride;
#pragma unroll
        for (int hh = 0; hh < 4; ++hh) { nf[hh] = cf[hh]; nb[hh] = cb[hh]; ng_[hh] = cg[hh]; }
        if (mn < M) {
#pragma unroll
            for (int hh = 0; hh < 4; ++hh) { const size_t off = (size_t)mn * D + hh * 256 + 4 * lane; nf[hh] = *(const u32x2*)(OFb + off); nb[hh] = *(const u32x2*)(OBb + off); ng_[hh] = *(const u32x2*)(G + off); } }
#pragma unroll
        for (int hh = 0; hh < 4; ++hh) { const size_t off = (size_t)m * D + hh * 256 + 4 * lane;
            const u32x2 f = cf[hh], bb = cb[hh], g = cg[hh];
            f32x4 o; o[0] = bflo(f.x) + bflo(bb.x); o[1] = bfhi(f.x) + bfhi(bb.x); o[2] = bflo(f.y) + bflo(bb.y); o[3] = bfhi(f.y) + bfhi(bb.y);
            const float ss = wave_sum((o[0] * o[0] + o[1] * o[1]) + (o[2] * o[2] + o[3] * o[3]));
            const float rstd = rsqrtf(ss * (1.f / 256.f) + EPS);
            u32x2 w; w.x = pk2(o[0] * rstd * gn[0] * bflo(g.x), o[1] * rstd * gn[1] * bfhi(g.x)); w.y = pk2(o[2] * rstd * gn[2] * bflo(g.y), o[3] * rstd * gn[3] * bfhi(g.y));
            *(u32x2*)(G + off) = w; }
#pragma unroll
        for (int hh = 0; hh < 4; ++hh) { cf[hh] = nf[hh]; cb[hh] = nb[hh]; cg[hh] = ng_[hh]; }
    }
}
struct SplitRow { u32x2 o[4]; u32x2 p[3][4]; };
__device__ __forceinline__ void split_row_load(SplitRow& r, const bf16* O, const bf16* P, int m, int lane) {
#pragma unroll
    for (int q = 0; q < 4; ++q) r.o[q] = *(const u32x2*)(O + (size_t)m * D + 4 * (lane + 64 * q));
    if (m >= 16384) {
#pragma unroll
        for (int k = 0; k < 3; ++k)
#pragma unroll
            for (int q = 0; q < 4; ++q) r.p[k][q] = *(const u32x2*)(P + ((size_t)k * 4096 + (m - 16384)) * D + 4 * (lane + 64 * q)); }
}
__device__ __forceinline__ f32x4 split_row_val(const SplitRow& r, int m, int q) {
    f32x4 v; v[0] = bflo(r.o[q].x); v[1] = bfhi(r.o[q].x); v[2] = bflo(r.o[q].y); v[3] = bfhi(r.o[q].y);
    if (m >= 16384) {
#pragma unroll
        for (int k = 0; k < 3; ++k) { v[0] += bflo(r.p[k][q].x); v[1] += bfhi(r.p[k][q].x); v[2] += bflo(r.p[k][q].y); v[3] += bfhi(r.p[k][q].y); } }
    return v;
}
__device__ __forceinline__ void x1_pass(const Args& a, int lane, int wave) {
    const float* MOD = (const float*)(a.ws + WS_MOD); const float* ng = a.in[8];
    const bf16* Mm = (const bf16*)(a.ws + WS_S0 + 2 * SLOT); const bf16* Pm = (const bf16*)(a.ws + WS_S0 + 4 * SLOT); bf16* H2 = (bf16*)(a.ws + WS_S0);
    const int stride = gridDim.x * 8; int m = blockIdx.x * 8 + wave;
    SplitRow cur; f32x4 xc[4];
    if (m < M) { split_row_load(cur, Mm, Pm, m, lane); const f32x4* xr = (const f32x4*)xrow(a, m) + lane;
#pragma unroll
        for (int q = 0; q < 4; ++q) xc[q] = xr[64 * q]; }
    for (; m < M; m += stride) {
        SplitRow nxt = cur; f32x4 xn[4]; const int mn = m + stride;
#pragma unroll
        for (int q = 0; q < 4; ++q) xn[q] = xc[q];
        if (mn < M) { split_row_load(nxt, Mm, Pm, mn, lane); const f32x4* xr = (const f32x4*)xrow(a, mn) + lane;
#pragma unroll
            for (int q = 0; q < 4; ++q) xn[q] = xr[64 * q]; }
        const float* md = MOD + modgrp(m) * 6144;
        f32x4 mv[4]; float s1 = 0.f;
#pragma unroll
        for (int q = 0; q < 4; ++q) { mv[q] = split_row_val(cur, m, q); s1 += (mv[q][0] * mv[q][0] + mv[q][1] * mv[q][1]) + (mv[q][2] * mv[q][2] + mv[q][3] * mv[q][3]); }
        const float rstd1 = rsqrtf(wave_sum(s1) * (1.f / D) + EPS);
        f32x4 v[4]; float s = 0.f;
#pragma unroll
        for (int q = 0; q < 4; ++q) { const int c = 4 * (lane + 64 * q);
            const f32x4 g1 = *(const f32x4*)(md + 2048 + c), n1 = *(const f32x4*)(ng + 1024 + c);
            v[q] = xc[q] + g1 * (mv[q] * rstd1 * n1);
            *(f32x4*)(a.out + (size_t)m * D + c) = v[q];
            s += (v[q][0] * v[q][0] + v[q][1] * v[q][1]) + (v[q][2] * v[q][2] + v[q][3] * v[q][3]); }
        const float rstd = rsqrtf(wave_sum(s) * (1.f / D) + EPS);
#pragma unroll
        for (int q = 0; q < 4; ++q) { const int c = 4 * (lane + 64 * q);
            const f32x4 g = *(const f32x4*)(ng + 2048 + c), sh = *(const f32x4*)(md + 3072 + c), sc = *(const f32x4*)(md + 4096 + c);
            const f32x4 r = v[q] * rstd * g * (sc + 1.0f) + sh;
            u32x2 w; w.x = pk2(r[0], r[1]); w.y = pk2(r[2], r[3]); *(u32x2*)(H2 + (size_t)m * D + c) = w; }
        cur = nxt;
#pragma unroll
        for (int q = 0; q < 4; ++q) xc[q] = xn[q];
    }
}
__device__ __forceinline__ void fin_pass(const Args& a, int lane, int wave) {
    const float* MOD = (const float*)(a.ws + WS_MOD); const float* ng = a.in[8];
    const bf16* F = (const bf16*)(a.ws + WS_S0); const bf16* Pf = (const bf16*)(a.ws + WS_WL);
    const int stride = gridDim.x * 8; int m = blockIdx.x * 8 + wave;
    SplitRow cur; f32x4 yc[4];
    if (m < M) { split_row_load(cur, F, Pf, m, lane);
#pragma unroll
        for (int q = 0; q < 4; ++q) yc[q] = *(const f32x4*)(a.out + (size_t)m * D + 4 * (lane + 64 * q)); }
    for (; m < M; m += stride) {
        SplitRow nxt = cur; f32x4 yn[4]; const int mn = m + stride;
#pragma unroll
        for (int q = 0; q < 4; ++q) yn[q] = yc[q];
        if (mn < M) { split_row_load(nxt, F, Pf, mn, lane);
#pragma unroll
            for (int q = 0; q < 4; ++q) yn[q] = *(const f32x4*)(a.out + (size_t)mn * D + 4 * (lane + 64 * q)); }
        const float* md = MOD + modgrp(m) * 6144;
        f32x4 fv[4]; float s = 0.f;
#pragma unroll
        for (int q = 0; q < 4; ++q) { fv[q] = split_row_val(cur, m, q); s += (fv[q][0] * fv[q][0] + fv[q][1] * fv[q][1]) + (fv[q][2] * fv[q][2] + fv[q][3] * fv[q][3]); }
        const float rstd = rsqrtf(wave_sum(s) * (1.f / D) + EPS);
#pragma unroll
        for (int q = 0; q < 4; ++q) { const int c = 4 * (lane + 64 * q);
            const f32x4 g2 = *(const f32x4*)(md + 5120 + c), n3 = *(const f32x4*)(ng + 3072 + c);
            *(f32x4*)(a.out + (size_t)m * D + c) = yc[q] + g2 * (fv[q] * rstd * n3); }
        cur = nxt;
#pragma unroll
        for (int q = 0; q < 4; ++q) yc[q] = yn[q];
    }
}

constexpr int NPHASE = 14;
__global__ void __launch_bounds__(512, 2) mk_fwd(Args a) {
    extern __shared__ __attribute__((aligned(16))) unsigned char lds_raw[];
    LAS unsigned char* lds = (LAS unsigned char*)lds_raw;
    cg::grid_group grid = cg::this_grid();
    const int tid = threadIdx.x, lane = tid & 63, wave = __builtin_amdgcn_readfirstlane(tid >> 6);
    const int lo = a.ph_lo, hi = a.ph_hi, G = gridDim.x;
    volatile LAS unsigned* MISC = (volatile LAS unsigned*)(lds + LDS_BYTES - 64);
    if (tid < 16) MISC[tid] = 0u;
    __syncthreads();
    const XcdBarrier bar = xcd_barrier_post((unsigned*)(a.ws + WS_BAR), MISC);
    unsigned char* ws = a.ws;
    bf16* S0 = (bf16*)(ws + WS_S0); bf16* S1 = (bf16*)(ws + WS_S0 + SLOT); bf16* S2 = (bf16*)(ws + WS_S0 + 2 * SLOT);
    bf16* S3 = (bf16*)(ws + WS_S0 + 3 * SLOT); bf16* S4 = (bf16*)(ws + WS_S0 + 4 * SLOT);
    bf16* D0 = (bf16*)a.out; bf16* D1 = D0 + (size_t)M * D;
#ifndef MK_MASK
#define MK_MASK 0x3fff
#endif
#define IN(k) (((MK_MASK >> (k)) & 1) && lo <= (k) && (k) < hi)
#define SEAM(k) do { if (IN(k) && IN((k) + 1)) xcd_barrier(bar); } while (0)
    if (lo < 0) grid.sync();
    if (IN(0)) { phase0(a, lds, tid, lane, wave); } SEAM(0);
    if (IN(1)) { phase1(a, S0, lane, wave); } SEAM(1);
    if (IN(2)) {
        pg8::Gemm g{S0, (const bf16*)(ws + WS_WL), M, 5376, 1024, S0, S0, 1 << 30, 1 << 30, 1024}; pg8::StaticOrder S; S.init(M, 5376, G, (int)blockIdx.x);
        EpiLG E{D0, D1, (float*)(ws + WS_LR), S3, S3 + (size_t)M * 512, S4, S1};
        pg8::gemm_phase<EpiLG, pg8::StaticOrder, true, true>(lds, g, S, E);
    } SEAM(2);
    if (IN(3)) { lru_phase(a, lds, tid, lane, wave); } SEAM(3);
    if (IN(4)) {
        gla_prep(a, lds, tid, D1, S2, S0);
    } SEAM(4);
    if (IN(5)) { gla_phase(a, lds, tid, lane, wave); } SEAM(5);
    if (IN(6)) { post_gla(a, lane, wave); phase1(a, S3, lane, wave); } SEAM(6);
    if (IN(7)) {
        pg8::Gemm g{D1, (const bf16*)(ws + WS_WY) + (size_t)2048 * 1024, M, 2048, 1024, S1, S1, 4, 1 << 30, 1024}; pg8::StaticOrder S; S.init(M, 2048, G, (int)blockIdx.x);
        EpiYY E{S4, D0};
        pg8::gemm_phase<EpiYY, pg8::StaticOrder, true, true>(lds, g, S, E);
    } SEAM(7);
    if (IN(8)) {
        pg8::Gemm g{S3, (const bf16*)(ws + WS_WY), M, 2048, 1024, S3, S3, 1 << 30, 1 << 30, 1024}; pg8::StaticOrder S; S.init(M, 2048, G, (int)blockIdx.x);
        EpiMM E{S4, D0, S0};
        pg8::gemm_phase<EpiMM, pg8::StaticOrder, true, true>(lds, g, S, E);
    } SEAM(8);
    if (IN(9)) {
        { pg8::Gemm g{S0, (const bf16*)(ws + WS_WO), 16384, 1024, 1024, S0, S0, 1 << 30, 1 << 30, 1024}; pg8::StaticOrder S; S.init(16384, 1024, G, (int)blockIdx.x);
          EpiS E{S2, S4, 64}; pg8::gemm_phase<EpiS, pg8::StaticOrder, true, true>(lds, g, S, E); }
        { pg8::Gemm g{S0, (const bf16*)(ws + WS_WO), M, 1024, 256, S0, S0, 1 << 30, 1 << 30, 1024}; SplitOrder S{64, G, (int)blockIdx.x};
          EpiS E{S2, S4, 64}; pg8::gemm_phase<EpiS, SplitOrder, true, true>(lds, g, S, E); }
    } SEAM(9);
    if (IN(10)) { x1_pass(a, lane, wave); } SEAM(10);
    if (IN(11)) {
        pg8::Gemm g{S0, (const bf16*)(ws + WS_W1), M, 4096, 1024, S0, S0, 1 << 30, 1 << 30, 1024}; pg8::StaticOrder S; S.init(M, 4096, G, (int)blockIdx.x);
        EpiH E{S1};
        pg8::gemm_phase<EpiH, pg8::StaticOrder, true, true>(lds, g, S, E);
    } SEAM(11);
    if (IN(12)) {
        { pg8::Gemm g{S1, (const bf16*)(ws + WS_W2), 16384, 1024, 4096, S1, S1, 1 << 30, 1 << 30, 4096}; pg8::StaticOrder S; S.init(16384, 1024, G, (int)blockIdx.x);
          EpiS E{S0, (bf16*)(ws + WS_WL), 64}; pg8::gemm_phase<EpiS, pg8::StaticOrder, true, true>(lds, g, S, E); }
        { pg8::Gemm g{S1, (const bf16*)(ws + WS_W2), M, 1024, 1024, S1, S1, 1 << 30, 1 << 30, 4096}; SplitOrder S{64, G, (int)blockIdx.x};
          EpiS E{S0, (bf16*)(ws + WS_WL), 64}; pg8::gemm_phase<EpiS, SplitOrder, true, true>(lds, g, S, E); }
    } SEAM(12);
    if (IN(13)) { fin_pass(a, lane, wave); }
#undef IN
#undef SEAM
}

extern "C" void kernel_launch(void* const* d_in, const int* in_sizes, int n_in, void* d_out, int out_size, void* d_ws, size_t ws_size, hipStream_t stream) {
    static int grid = 0;
    if (grid == 0) {
        if (n_in != 25 || ws_size < WS_END) { fprintf(stderr, "kernel_launch: unexpected n_in %d / ws %zu\n", n_in, ws_size); grid = -1; return; }
        int dev = 0, cus = 0, per_cu = 0;
        hipGetDevice(&dev); hipDeviceGetAttribute(&cus, hipDeviceAttributeMultiprocessorCount, dev);
        if (hipFuncSetAttribute((const void*)mk_fwd, hipFuncAttributeMaxDynamicSharedMemorySize, LDS_BYTES) != hipSuccess) { fprintf(stderr, "kernel_launch: hipFuncSetAttribute failed\n"); grid = -1; return; }
        if (hipOccupancyMaxActiveBlocksPerMultiprocessor(&per_cu, (const void*)mk_fwd, 512, LDS_BYTES) != hipSuccess || per_cu < 1) { fprintf(stderr, "kernel_launch: occupancy query says %d\n", per_cu); per_cu = 1; }
        (void)hipGetLastError();
        grid = cus * 1;
    }
    if (grid < 0) return;
    if (hipMemsetAsync((char*)d_ws + WS_BAR, 0, WS_BAR_BYTES, stream) != hipSuccess) { fprintf(stderr, "kernel_launch: memset failed\n"); return; }
    Args a{};
    for (int i = 0; i < 25; ++i) a.in[i] = (const float*)d_in[i];
    a.out = (float*)d_out; a.ws = (unsigned char*)d_ws;
    constexpr int NL = MK_N_LAUNCHES;
    for (int li = 0; li < NL; ++li) {
        a.ph_lo = (NL == 1) ? 0 : li; a.ph_hi = (NL == 1) ? NPHASE : li + 1;
        void* args[] = {&a};
        hipError_t e = hipLaunchCooperativeKernel((const void*)mk_fwd, dim3(grid), dim3(512), args, LDS_BYTES, stream);
        if (e != hipSuccess) { fprintf(stderr, "kernel_launch: cooperative launch %d failed: %s\n", li, hipGetErrorString(e)); break; }
    }
}
```

```cpp
#include <hip/hip_runtime.h>
#include <hip/hip_cooperative_groups.h>
#include <cstdio>
#include <cstdint>
namespace cg = cooperative_groups;
namespace pg8 {
#define PG8_LAS __attribute__((address_space(3)))
typedef unsigned short bf16_t;
typedef short bf16x8 __attribute__((ext_vector_type(8)));
typedef float f32x4 __attribute__((ext_vector_type(4)));
typedef unsigned u32x4 __attribute__((ext_vector_type(4)));
constexpr int BM = 256, BK = 64, HALF = 128, HTB = HALF * BK * 2  , STAGE_BYTES = 8 * HTB, NXCD = 8, WGM = 8;

__host__ __device__ __forceinline__ int lds_byte(int r, int c) { const int st = (r >> 4) * 2 + (c >> 5), rr = r & 15, cc = c & 31, ob = rr * 64 + cc * 2; return st * 1024 + (ob ^ (((ob >> 9) & 1) << 5)); }
__host__ __device__ __forceinline__ void stage_rc(int b, int& R, int& C) { const int st = b / 1024, sb = b % 1024, swz = sb ^ (((sb >> 9) & 1) << 5); R = (st >> 1) * 16 + swz / 64; C = (st & 1) * 32 + (swz % 64) / 2; }
__host__ __device__ __forceinline__ int perm32(int rho) { const int n = rho >> 4, i = rho & 15; return 8 * (i >> 2) + 4 * n + (i & 3); }

struct Unit { int pm, pn, kq; };
struct Gemm { const bf16_t* A; const bf16_t* Bt; int M, N, K; const bf16_t* A1; const bf16_t* A2; int pn1, pn2; int ld;
    __device__ __forceinline__ const char* abase(int pn) const { return (const char*)(pn < pn1 ? A : (pn < pn2 ? A1 : A2)); } };

struct StaticOrder {
    int nM, nN, nwg, G, c;
    __host__ __device__ void init(int M, int N, int G_, int c_) { nM = M / BM; nN = N / BM; nwg = nM * nN; G = G_; c = c_; }
    __host__ __device__ bool next(int i, Unit& u) const {
        const long L = (long)i * G + c; if (L >= nwg) return false;
        int wgid = (int)L; { const int q = nwg / NXCD, r = nwg % NXCD, xcd = wgid % NXCD, off = wgid / NXCD; wgid = (xcd < r ? xcd * (q + 1) : r * (q + 1) + (xcd - r) * q) + off; }
        const int nig = WGM * nN, gid = wgid / nig, fm = gid * WGM, gsz = (nM - fm) < WGM ? (nM - fm) : WGM;
        u.pm = fm + ((wgid % nig) % gsz); u.pn = (wgid % nig) / gsz; u.kq = 0; return true;
    }
    __device__ __forceinline__ void a_ready(const Unit&) const {}
    __device__ __forceinline__ void done(const Unit&) const {}
};

typedef float f32x2 __attribute__((ext_vector_type(2)));
typedef __bf16 bf16x2_t __attribute__((ext_vector_type(2)));
__device__ __forceinline__ unsigned cvt_pk_bf16(float lo, float hi) { const f32x2 v = {lo, hi}; return __builtin_bit_cast(unsigned, __builtin_convertvector(v, bf16x2_t)); }
template <class Epi, class Sched, bool ALIGN_EPI = false, bool SP2 = false>
__device__ __forceinline__ void gemm_phase(PG8_LAS unsigned char* lds, const Gemm g, const Sched& S, const Epi& E) {
    const int tid = threadIdx.x, wid = __builtin_amdgcn_readfirstlane(tid >> 6), lane = tid & 63, wr = wid >> 2, wc = wid & 3, fr = lane & 15, fq = lane >> 4;
    const int K = g.K, nt = K / BK;
    unsigned voffA[2], voffB[2];
#pragma unroll
    for (int i = 0; i < 2; ++i) { int R, C; stage_rc(tid * 16 + i * 8192, R, C); const int Rb = Epi::PERM ? ((R & ~31) + perm32(R & 31)) : R;
        voffA[i] = (unsigned)(R * g.ld + C) * 2u; voffB[i] = (unsigned)(Rb * g.ld + C) * 2u; }
    const size_t kstep = (size_t)(BK * 2);
    const size_t hstep = (size_t)HALF * g.ld * 2;
    const size_t tstep = 2 * hstep;
    const unsigned ldsw = (unsigned)wid * 1024u;
    const int aoff = lds_byte(wr * 64 + fr, fq * 8), boff = lds_byte(wc * 32 + fr, fq * 8);
#define PG8_SA(b, h) (((b) * 2 + (h)) * HTB)
#define PG8_SB(b, h) ((4 + (b) * 2 + (h)) * HTB)
#define PG8_STAGE(bufoff, gbase, voff) do { _Pragma("unroll") for (int _i = 0; _i < 2; ++_i) \
        __builtin_amdgcn_global_load_lds((const unsigned*)((const char*)(gbase) + (voff)[_i]), (PG8_LAS unsigned*)(lds + (bufoff) + ldsw + _i * 8192), 16, 0, 0); } while (0)
#define PG8_LDA(dst, b, h) do { _Pragma("unroll") for (int m = 0; m < 4; ++m) _Pragma("unroll") for (int k = 0; k < 2; ++k) dst[m][k] = *(const PG8_LAS bf16x8*)(lds + PG8_SA(b, h) + aoff + m * 2048 + k * 1024); } while (0)
#define PG8_LDB(dst, b, h) do { _Pragma("unroll") for (int n = 0; n < 2; ++n) _Pragma("unroll") for (int k = 0; k < 2; ++k) dst[n][k] = *(const PG8_LAS bf16x8*)(lds + PG8_SB(b, h) + boff + n * 2048 + k * 1024); } while (0)
#define PG8_MMA(ai, bj, At, Bt) do { __builtin_amdgcn_s_setprio(1); _Pragma("unroll") for (int m = 0; m < 4; ++m) _Pragma("unroll") for (int n = 0; n < 2; ++n) _Pragma("unroll") for (int k = 0; k < 2; ++k) \
        acc[ai][bj][m][n] = __builtin_amdgcn_mfma_f32_16x16x32_bf16(Bt[n][k], At[m][k], acc[ai][bj][m][n], 0, 0, 0); __builtin_amdgcn_s_setprio(0); } while (0)
#define PG8_WAIT_V(n) asm volatile("s_waitcnt vmcnt(" #n ")" ::: "memory")
#define PG8_WAIT_L(n) asm volatile("s_waitcnt lgkmcnt(" #n ")" ::: "memory")
#define PG8_BAR __builtin_amdgcn_s_barrier()
#define PG8_SCHED __builtin_amdgcn_sched_barrier(0)
    Unit cur, nxt; int ui = 0;
    if (!S.next(0, cur)) return;
    f32x4 acc[2][2][4][2];
#pragma unroll
    for (int a = 0; a < 2; ++a)
#pragma unroll
        for (int b = 0; b < 2; ++b)
#pragma unroll
            for (int m = 0; m < 4; ++m)
#pragma unroll
                for (int n = 0; n < 2; ++n) acc[a][b][m][n] = (f32x4){0.f, 0.f, 0.f, 0.f};
    bf16x8 At[4][2], B0[2][2], B1[2][2];
    const size_t qstep = (size_t)K * 2;
    const char* cA = g.abase(cur.pn) + (size_t)cur.pm * tstep + (size_t)cur.kq * qstep; const char* cB = (const char*)g.Bt + (size_t)cur.pn * tstep + (size_t)cur.kq * qstep;
    S.a_ready(cur);
    if constexpr (SP2) {
        PG8_STAGE(PG8_SB(0, 0), cB, voffB); PG8_STAGE(PG8_SB(0, 1), cB + hstep, voffB); PG8_STAGE(PG8_SA(0, 0), cA, voffA); PG8_STAGE(PG8_SA(0, 1), cA + hstep, voffA);
        if (wr == 1) PG8_BAR;
        PG8_WAIT_V(2); PG8_BAR;
        PG8_STAGE(PG8_SB(1, 0), cB + kstep, voffB); PG8_STAGE(PG8_SA(1, 0), cA + kstep, voffA); PG8_STAGE(PG8_SB(1, 1), cB + hstep + kstep, voffB);
        PG8_WAIT_V(6); PG8_BAR;
    } else {
        PG8_STAGE(PG8_SB(0, 0), cB, voffB); PG8_STAGE(PG8_SA(0, 0), cA, voffA); PG8_STAGE(PG8_SB(0, 1), cB + hstep, voffB); PG8_STAGE(PG8_SA(0, 1), cA + hstep, voffA);
        if (wr == 1) PG8_BAR;
        PG8_WAIT_V(4); PG8_BAR;
        PG8_STAGE(PG8_SB(1, 0), cB + kstep, voffB); PG8_STAGE(PG8_SA(1, 0), cA + kstep, voffA); PG8_STAGE(PG8_SB(1, 1), cB + hstep + kstep, voffB);
        PG8_WAIT_V(6); PG8_BAR;
    }
    for (;;) {
        const bool has_next = S.next(ui + 1, nxt);
        const char* nA = has_next ? g.abase(nxt.pn) + (size_t)nxt.pm * tstep + (size_t)nxt.kq * qstep : cA; const char* nB = has_next ? (const char*)g.Bt + (size_t)nxt.pn * tstep + (size_t)nxt.kq * qstep : cB;
        for (int t = 0; t < nt; t += 2) {
            const bool last = (t == nt - 2);
            const char* a1 = cA + (size_t)(t + 1) * kstep;
            const char* a2 = last ? nA : cA + (size_t)(t + 2) * kstep; const char* b2 = last ? nB : cB + (size_t)(t + 2) * kstep;
            const char* a3 = a2 + kstep; const char* b3 = b2 + kstep;
            if (last && has_next) S.a_ready(nxt);
            if constexpr (SP2) {
            PG8_LDB(B0, 0, 0); PG8_LDB(B1, 0, 1); PG8_SCHED; PG8_LDA(At, 0, 0); PG8_STAGE(PG8_SA(1, 1), a1 + hstep, voffA);
            PG8_WAIT_V(8); PG8_WAIT_L(0); PG8_BAR; PG8_MMA(0, 0, At, B0); PG8_MMA(0, 1, At, B1); PG8_BAR; PG8_SCHED;
            PG8_LDA(At, 0, 1); PG8_STAGE(PG8_SB(0, 0), b2, voffB); PG8_STAGE(PG8_SB(0, 1), b2 + hstep, voffB); PG8_STAGE(PG8_SA(0, 0), a2, voffA);
            PG8_WAIT_V(8); PG8_WAIT_L(0); PG8_BAR; PG8_MMA(1, 0, At, B0); PG8_MMA(1, 1, At, B1); PG8_BAR; PG8_SCHED;
            PG8_LDB(B0, 1, 0); PG8_LDB(B1, 1, 1); PG8_SCHED; PG8_LDA(At, 1, 0); PG8_STAGE(PG8_SA(0, 1), a2 + hstep, voffA);
            PG8_WAIT_V(8); PG8_WAIT_L(0); PG8_BAR; PG8_MMA(0, 0, At, B0); PG8_MMA(0, 1, At, B1); PG8_BAR; PG8_SCHED;
            PG8_LDA(At, 1, 1); PG8_STAGE(PG8_SB(1, 0), b3, voffB); PG8_STAGE(PG8_SB(1, 1), b3 + hstep, voffB); PG8_STAGE(PG8_SA(1, 0), a3, voffA);
            PG8_WAIT_V(8); PG8_WAIT_L(0); PG8_BAR; PG8_MMA(1, 0, At, B0); PG8_MMA(1, 1, At, B1); PG8_BAR; PG8_SCHED;
            } else {
            PG8_LDB(B0, 0, 0); PG8_SCHED; PG8_LDA(At, 0, 0); PG8_STAGE(PG8_SA(1, 1), a1 + hstep, voffA);
            PG8_WAIT_L(8); PG8_BAR; PG8_WAIT_L(0); PG8_MMA(0, 0, At, B0); PG8_BAR; PG8_SCHED;
            PG8_LDB(B1, 0, 1); PG8_STAGE(PG8_SB(0, 0), b2, voffB);
            PG8_BAR; PG8_WAIT_L(0); PG8_MMA(0, 1, At, B1); PG8_BAR;
            PG8_LDA(At, 0, 1); PG8_STAGE(PG8_SA(0, 0), a2, voffA);
            PG8_BAR; PG8_WAIT_L(0); PG8_MMA(1, 0, At, B0); PG8_BAR; PG8_SCHED;
            PG8_STAGE(PG8_SB(0, 1), b2 + hstep, voffB);
            PG8_WAIT_V(6); PG8_BAR; PG8_MMA(1, 1, At, B1); PG8_BAR;
            PG8_LDB(B0, 1, 0); PG8_SCHED; PG8_LDA(At, 1, 0); PG8_STAGE(PG8_SA(0, 1), a2 + hstep, voffA);
            PG8_WAIT_L(8); PG8_BAR; PG8_WAIT_L(0); PG8_MMA(0, 0, At, B0); PG8_BAR; PG8_SCHED;
            PG8_LDB(B1, 1, 1); PG8_STAGE(PG8_SB(1, 0), b3, voffB);
            PG8_BAR; PG8_WAIT_L(0); PG8_MMA(0, 1, At, B1); PG8_BAR;
            PG8_LDA(At, 1, 1); PG8_STAGE(PG8_SA(1, 0), a3, voffA);
            PG8_BAR; PG8_WAIT_L(0); PG8_MMA(1, 0, At, B0); PG8_BAR; PG8_SCHED;
            PG8_STAGE(PG8_SB(1, 1), b3 + hstep, voffB);
            PG8_WAIT_V(6); PG8_BAR; PG8_MMA(1, 1, At, B1); PG8_BAR;
            }
        }
        if constexpr (ALIGN_EPI) { if (wr == 0) PG8_BAR; }
        if constexpr (!Epi::AFTER_DRAIN) { E(acc, cur, wr, wc, fr, fq); S.done(cur); }
        if (!has_next) break;
#pragma unroll
        for (int a = 0; a < 2; ++a)
#pragma unroll
            for (int b = 0; b < 2; ++b)
#pragma unroll
                for (int m = 0; m < 4; ++m)
#pragma unroll
                    for (int n = 0; n < 2; ++n) acc[a][b][m][n] = (f32x4){0.f, 0.f, 0.f, 0.f};
        cur = nxt; cA = nA; cB = nB; ++ui;
        if constexpr (ALIGN_EPI) { if (wr == 1) PG8_BAR; }
    }
    PG8_WAIT_V(0);
    if constexpr (!ALIGN_EPI) { if (wr == 0) PG8_BAR; }
    PG8_BAR;
    if constexpr (Epi::AFTER_DRAIN) { E.fused(acc, cur, wr, wc, fr, fq, lds, wid, lane); S.done(cur); }
#undef PG8_SA
#undef PG8_SB
#undef PG8_STAGE
#undef PG8_LDA
#undef PG8_LDB
#undef PG8_MMA
#undef PG8_WAIT_V
#undef PG8_WAIT_L
#undef PG8_BAR
#undef PG8_SCHED
}
}

#ifndef MK_N_LAUNCHES
#define MK_N_LAUNCHES 1
#endif
#define LAS __attribute__((address_space(3)))
typedef unsigned short bf16;
typedef float f32x4 __attribute__((ext_vector_type(4)));
typedef float f32x2 __attribute__((ext_vector_type(2)));
typedef unsigned u32x4 __attribute__((ext_vector_type(4)));
typedef unsigned u32x2 __attribute__((ext_vector_type(2)));
typedef short bf16x8 __attribute__((ext_vector_type(8)));

constexpr int D = 1024, MP = 4096, ML = 16384, M = MP + ML, NIN = 7200, DFF = 4096;
constexpr float EPS = 1e-6f;
constexpr size_t MiB = 1u << 20;
constexpr size_t WS_MOD = 0;
constexpr size_t WS_BAR = 512 * 1024, WS_BAR_BYTES = 16384;
constexpr size_t WS_SSQ1 = 1 * MiB;
constexpr size_t WS_SSQ2 = 2560 * 1024;
constexpr size_t WS_LR = 4 * MiB;
constexpr size_t WS_WL = 8 * MiB;
constexpr size_t WS_WG = WS_WL + (size_t)2304 * 1024 * 2;
constexpr size_t WS_WY = WS_WG + (size_t)3072 * 1024 * 2;
constexpr size_t WS_WO = WS_WY + (size_t)4096 * 1024 * 2;
constexpr size_t WS_W1 = WS_WO + (size_t)1024 * 1024 * 2;
constexpr size_t WS_W2 = WS_W1 + (size_t)4096 * 1024 * 2;
constexpr size_t WS_S0 = 48 * MiB, SLOT = 40 * MiB;
static_assert(WS_W2 + (size_t)1024 * 4096 * 2 <= WS_S0, "ws map");
constexpr size_t WS_END = WS_S0 + 5 * SLOT;
constexpr int LDS_BYTES = 147456;

struct Args { const float* in[25]; float* out; unsigned char* ws; int ph_lo, ph_hi; };

__device__ __forceinline__ float bf2f(unsigned v) { return __uint_as_float(v << 16); }
__device__ __forceinline__ float bflo(unsigned w) { return __uint_as_float(w << 16); }
__device__ __forceinline__ float bfhi(unsigned w) { return __uint_as_float(w & 0xffff0000u); }
__device__ __forceinline__ unsigned pk2(float lo, float hi) { return pg8::cvt_pk_bf16(lo, hi); }
__device__ __forceinline__ float wave_sum(float v) {
#pragma unroll
    for (int o = 1; o < 64; o <<= 1) v += __shfl_xor(v, o);
    return v;
}
__device__ __forceinline__ float rcpf_(float x) { return __builtin_amdgcn_rcpf(x); }
__device__ __forceinline__ float expf_(float x) { return __builtin_amdgcn_exp2f(x * 1.4426950408889634f); }
__device__ __forceinline__ float logf_(float x) { return __builtin_amdgcn_logf(x) * 0.6931471805599453f; }
__device__ __forceinline__ float sigmoidf_(float x) { return rcpf_(1.0f + expf_(-x)); }
__device__ __forceinline__ float siluf_(float x) { return x * sigmoidf_(x); }
__device__ __forceinline__ float gelu_tanh(float x) { const float t = x * (1.5957691216f + 0.0713548163f * x * x); return x * rcpf_(1.0f + expf_(-t)); }
template <int ACT> __device__ __forceinline__ float actf(float x) {
    if (ACT == 1) return gelu_tanh(x);
    if (ACT == 2) return siluf_(x);
    if (ACT == 3) return sigmoidf_(x);
    if (ACT == 4) { const float m = fmaxf(x, 0.f); return m * m; }
    return x;
}
#define LDS_WAIT() asm volatile("s_waitcnt lgkmcnt(0)" ::: "memory")

#define XB_TMO      128
#define XB_XCNT(j)  (256  + 64 * (j))
#define XB_XSUB(j)  (1280 + 64 * (j))
#define XB_XGEN(j)  (2304 + 64 * (j))
#define XB_TOP      3328
#define XB_TOPGEN   3392
#define XCD_BAR_WORDS 3456
#define XB_SPIN_CAP (1u << 18)

__device__ __forceinline__ unsigned xb_ld(unsigned* p)              { return __hip_atomic_load(p, __ATOMIC_RELAXED, __HIP_MEMORY_SCOPE_AGENT); }
__device__ __forceinline__ unsigned xb_add(unsigned* p, unsigned v) { return __hip_atomic_fetch_add(p, v, __ATOMIC_RELAXED, __HIP_MEMORY_SCOPE_AGENT); }
__device__ __forceinline__ unsigned xb_xcc_id() { return (unsigned)__builtin_amdgcn_s_getreg((3 << 11) | 20) & 0xFu; }
#define XB_SPIN(cond, bar) do { unsigned _sp = 0; while (cond) { __builtin_amdgcn_s_sleep(1); \
    if ((++_sp & 255u) == 0u) { if (xb_ld(&(bar)[XB_TMO])) break; if (_sp > XB_SPIN_CAP) { atomicAdd(&(bar)[XB_TMO], 1u); break; } } } } while (0)

struct XcdBarrier {
    unsigned* bar; unsigned x;
    volatile LAS unsigned* st;
};

__device__ __forceinline__ XcdBarrier xcd_barrier_post(unsigned* bar, volatile LAS unsigned* st) {
    XcdBarrier b; b.bar = bar; b.x = xb_xcc_id(); b.st = st;
    if (threadIdx.x == 0) (void)xb_add(&bar[XB_XCNT(b.x)], 1u);
    return b;
}
__device__ __forceinline__ void xcd_barrier_complete(unsigned* bar, unsigned x, unsigned& nloc, unsigned& nx) {
    const unsigned G = gridDim.x * gridDim.y * gridDim.z;
    unsigned sum, cnt, mine, sp = 0u;
    for (;;) {
        sum = 0u; cnt = 0u; mine = 0u;
#pragma unroll
        for (unsigned j = 0; j < 16; ++j) { const unsigned c = xb_ld(&bar[XB_XCNT(j)]); sum += c; cnt += (c > 0u) ? 1u : 0u; mine = (j == x) ? c : mine; }
        if (sum == G) break;
        __builtin_amdgcn_s_sleep(1);
        if ((++sp & 255u) == 0u) { if (xb_ld(&bar[XB_TMO])) break; if (sp > XB_SPIN_CAP) { atomicAdd(&bar[XB_TMO], 1u); break; } }
    }
    nloc = mine > 0u ? mine : 1u; nx = cnt > 0u ? cnt : 1u;
}

__device__ __forceinline__ void xcd_barrier(const XcdBarrier& b) {
    asm volatile("s_waitcnt vmcnt(0)" ::: "memory");
    __syncthreads();
    if (threadIdx.x == 0) {
        unsigned* bar = b.bar;
        __builtin_amdgcn_s_waitcnt(0);
        unsigned nloc = b.st[0], nx = b.st[1];
        if (nloc == 0u) { xcd_barrier_complete(bar, b.x, nloc, nx); b.st[0] = nloc; b.st[1] = nx; }
        const unsigned old = xb_add(&bar[XB_XSUB(b.x)], 1u);
        const unsigned gen = old / nloc;
        if (old + 1u == (gen + 1u) * nloc) {
            __builtin_amdgcn_fence(__ATOMIC_RELEASE, "agent");
            asm volatile("s_waitcnt vmcnt(0)" ::: "memory");
            const unsigned og = xb_add(&bar[XB_TOP], 1u);
            const unsigned tg = og / nx;
            if (og + 1u == (tg + 1u) * nx) xb_add(&bar[XB_TOPGEN], 1u);
            else XB_SPIN(xb_ld(&bar[XB_TOPGEN]) == tg, bar);
            __builtin_amdgcn_fence(__ATOMIC_ACQUIRE, "agent");
            xb_add(&bar[XB_XGEN(b.x)], 1u);
            asm volatile("s_waitcnt vmcnt(0)" ::: "memory");
        } else {
            XB_SPIN(xb_ld(&bar[XB_XGEN(b.x)]) == gen, bar);
            __builtin_amdgcn_fence(__ATOMIC_ACQUIRE, "agent");
            asm volatile("s_waitcnt vmcnt(0)" ::: "memory");
        }
    }
    __syncthreads();
}

template <int ACT> __device__ __forceinline__ void store_tile(const f32x4 (&acc)[2][2][4][2], bf16* base, int ld, int row0, int col0) {
#pragma unroll
    for (int ai = 0; ai < 2; ++ai)
#pragma unroll
        for (int m = 0; m < 4; ++m) { bf16* rowp = base + (size_t)(row0 + ai * 128 + m * 16) * ld + col0;
#pragma unroll
            for (int bj = 0; bj < 2; ++bj) { const f32x4 v0 = acc[ai][bj][m][0], v1 = acc[ai][bj][m][1];
                u32x4 w; w.x = pk2(actf<ACT>(v0[0]), actf<ACT>(v0[1])); w.y = pk2(actf<ACT>(v0[2]), actf<ACT>(v0[3]));
                w.z = pk2(actf<ACT>(v1[0]), actf<ACT>(v1[1])); w.w = pk2(actf<ACT>(v1[2]), actf<ACT>(v1[3]));
                *(u32x4*)(rowp + bj * 128) = w; } }
}
struct EpiLG {
    static constexpr bool PERM = true, AFTER_DRAIN = false;
    bf16* ZX; bf16* ZG; float* LR; bf16* Q; bf16* K; bf16* V; bf16* G;
    __device__ __forceinline__ void operator()(const f32x4 (&acc)[2][2][4][2], const pg8::Unit& u, int wr, int wc, int fr, int fq) const {
        const int row0 = u.pm * 256 + wr * 64 + fr, cw = wc * 32 + 8 * fq;
        if (u.pn < 4) store_tile<0>(acc, ZX, D, row0, u.pn * 256 + cw);
        else if (u.pn < 8) store_tile<1>(acc, ZG, D, row0, (u.pn - 4) * 256 + cw);
        else if (u.pn == 8) { if (wc == 0) {
#pragma unroll
            for (int ai = 0; ai < 2; ++ai)
#pragma unroll
                for (int m = 0; m < 4; ++m) { float* rp = LR + (size_t)(row0 + ai * 128 + m * 16) * 32 + 8 * fq;
                    *(f32x4*)rp = acc[ai][0][m][0]; *(f32x4*)(rp + 4) = acc[ai][0][m][1]; } } }
        else if (u.pn < 11) store_tile<0>(acc, Q, 512, row0, (u.pn - 9) * 256 + cw);
        else if (u.pn < 13) store_tile<0>(acc, K, 512, row0, (u.pn - 11) * 256 + cw);
        else if (u.pn < 17) store_tile<0>(acc, V, D, row0, (u.pn - 13) * 256 + cw);
        else store_tile<2>(acc, G, D, row0, (u.pn - 17) * 256 + cw);
    }
};
struct EpiYY {
    static constexpr bool PERM = true, AFTER_DRAIN = false;
    bf16* YA; bf16* YB;
    __device__ __forceinline__ void operator()(const f32x4 (&acc)[2][2][4][2], const pg8::Unit& u, int wr, int wc, int fr, int fq) const {
        store_tile<0>(acc, u.pn < 4 ? YA : YB, D, u.pm * 256 + wr * 64 + fr, (u.pn & 3) * 256 + wc * 32 + 8 * fq);
    }
};
struct EpiMM {
    static constexpr bool PERM = true, AFTER_DRAIN = false;
    const bf16* YA; const bf16* YB; bf16* MM;
    __device__ __forceinline__ void operator()(const f32x4 (&acc)[2][2][4][2], const pg8::Unit& u, int wr, int wc, int fr, int fq) const {
        const int row0 = u.pm * 256 + wr * 64 + fr, c0 = u.pn * 128 + wc * 32 + 8 * fq;
#pragma unroll
        for (int ai = 0; ai < 2; ++ai)
#pragma unroll
            for (int m = 0; m < 4; ++m) { const size_t off = (size_t)(row0 + ai * 128 + m * 16) * D + c0;
                const u32x4 ya = *(const u32x4*)(YA + off), yb = *(const u32x4*)(YB + off);
                const f32x4 a0 = acc[ai][0][m][0], a1 = acc[ai][0][m][1], b0 = acc[ai][1][m][0], b1 = acc[ai][1][m][1];
#define MMV(av, bv, yv, zv) ({ const float ea_ = 1.0f + expf_(-(av)), eb_ = 1.0f + expf_(-(bv)); ((yv) * eb_ + (zv) * ea_) * rcpf_(ea_ * eb_); })
                u32x4 w;
                w.x = pk2(MMV(a0[0], b0[0], bflo(ya.x), bflo(yb.x)), MMV(a0[1], b0[1], bfhi(ya.x), bfhi(yb.x)));
                w.y = pk2(MMV(a0[2], b0[2], bflo(ya.y), bflo(yb.y)), MMV(a0[3], b0[3], bfhi(ya.y), bfhi(yb.y)));
                w.z = pk2(MMV(a1[0], b1[0], bflo(ya.z), bflo(yb.z)), MMV(a1[1], b1[1], bfhi(ya.z), bfhi(yb.z)));
                w.w = pk2(MMV(a1[2], b1[2], bflo(ya.w), bflo(yb.w)), MMV(a1[3], b1[3], bfhi(ya.w), bfhi(yb.w)));
#undef MMV
                *(u32x4*)(MM + off) = w; }
    }
};
struct EpiN {
    static constexpr bool PERM = true, AFTER_DRAIN = false;
    bf16* O; float* SSQ;
    __device__ __forceinline__ void operator()(const f32x4 (&acc)[2][2][4][2], const pg8::Unit& u, int wr, int wc, int fr, int fq) const {
        const int row0 = u.pm * 256 + wr * 64 + fr;
        store_tile<0>(acc, O, D, row0, u.pn * 256 + wc * 32 + 8 * fq);
#pragma unroll
        for (int ai = 0; ai < 2; ++ai)
#pragma unroll
            for (int m = 0; m < 4; ++m) { float ss = 0.f;
#pragma unroll
                for (int bj = 0; bj < 2; ++bj)
#pragma unroll
                    for (int n = 0; n < 2; ++n) { const f32x4 v = acc[ai][bj][m][n]; ss += (v[0] * v[0] + v[1] * v[1]) + (v[2] * v[2] + v[3] * v[3]); }
                ss += __shfl_xor(ss, 16); ss += __shfl_xor(ss, 32);
                if (fq == 0) SSQ[(size_t)(row0 + ai * 128 + m * 16) * 16 + u.pn * 4 + wc] = ss; }
    }
};
struct SplitOrder {
    int pm0, G, c;
    __device__ __forceinline__ bool next(int i, pg8::Unit& u) const { const int L = i * G + c; if (L >= 256) return false; u.kq = L & 3; u.pn = (L >> 2) & 3; u.pm = pm0 + (L >> 4); return true; }
    __device__ __forceinline__ void a_ready(const pg8::Unit&) const {}
    __device__ __forceinline__ void done(const pg8::Unit&) const {}
};
struct EpiS {
    static constexpr bool PERM = true, AFTER_DRAIN = false;
    bf16* O; bf16* P; int pm0;
    __device__ __forceinline__ void operator()(const f32x4 (&acc)[2][2][4][2], const pg8::Unit& u, int wr, int wc, int fr, int fq) const {
        const int cw = u.pn * 256 + wc * 32 + 8 * fq;
        if (u.kq == 0) store_tile<0>(acc, O, D, u.pm * 256 + wr * 64 + fr, cw);
        else store_tile<0>(acc, P + (size_t)(u.kq - 1) * 4096 * 1024, D, (u.pm - pm0) * 256 + wr * 64 + fr, cw);
    }
};
struct EpiH {
    static constexpr bool PERM = true, AFTER_DRAIN = false;
    bf16* Hd;
    __device__ __forceinline__ void operator()(const f32x4 (&acc)[2][2][4][2], const pg8::Unit& u, int wr, int wc, int fr, int fq) const {
        store_tile<4>(acc, Hd, DFF, u.pm * 256 + wr * 64 + fr, u.pn * 256 + wc * 32 + 8 * fq);
    }
};

template <bool ILV = false> __device__ __forceinline__ void tr_item(const float* W, int ld, int col0, int ncols, int K, bf16* WT, int row_off, LAS float* scr, int item, int lane) {
    const int nblk = ncols >> 5, kb = item / nblk, nb = item - kb * nblk, k0 = 64 * kb, n0 = 32 * nb;
    const int r0 = ILV ? ((n0 & 1023) >> 7) * 256 + (n0 & 127) + (n0 >> 10) * 128 : n0;
#pragma unroll 8
    for (int i = 0; i < 32; ++i) { const int kk = 2 * i + (lane >> 5); scr[kk * 33 + (lane & 31)] = W[(size_t)(k0 + kk) * ld + col0 + n0 + (lane & 31)]; }
    LDS_WAIT(); asm volatile("" ::: "memory");
    const int c = lane & 7;
#pragma unroll
    for (int j = 0; j < 4; ++j) { const int n = (lane >> 3) + 8 * j; const LAS float* s = scr + (8 * c) * 33 + n;
        u32x4 o; o.x = pk2(s[0 * 33], s[1 * 33]); o.y = pk2(s[2 * 33], s[3 * 33]); o.z = pk2(s[4 * 33], s[5 * 33]); o.w = pk2(s[6 * 33], s[7 * 33]);
        *(u32x4*)(WT + (size_t)(row_off + r0 + n) * K + k0 + 8 * c) = o; }
    LDS_WAIT(); asm volatile("" ::: "memory");
}
__device__ __forceinline__ void phase0(const Args& a, LAS unsigned char* lds, int tid, int lane, int wave) {
    LAS float* SIL = (LAS float*)lds;
    LAS float* RED = (LAS float*)(lds + 36864);
    LAS float* SCR = (LAS float*)(lds + 36864 + 18432 + wave * 8448);
    unsigned char* ws = a.ws;
    float* MOD = (float*)(ws + WS_MOD);
    for (int i = tid; i < 9 * 1024; i += 512) { const float c = i < 8192 ? a.in[4][i] : a.in[5][i - 8192]; SIL[i] = siluf_(c); }
    __syncthreads();
    for (int it = blockIdx.x; it < 96; it += gridDim.x) {
        const float* wp = a.in[6] + (size_t)(wave * 128) * 6144 + it * 64 + lane;
        float acc[9];
#pragma unroll
        for (int j = 0; j < 9; ++j) acc[j] = 0.f;
#pragma unroll 8
        for (int k = 0; k < 128; ++k) { const float w = wp[(size_t)k * 6144];
#pragma unroll
            for (int j = 0; j < 9; ++j) acc[j] += SIL[j * 1024 + wave * 128 + k] * w; }
#pragma unroll
        for (int j = 0; j < 9; ++j) RED[(wave * 9 + j) * 64 + lane] = acc[j];
        __syncthreads();
        for (int o = tid; o < 576; o += 512) { const int j = o >> 6, l = o & 63; float s = a.in[7][it * 64 + l];
#pragma unroll
            for (int w = 0; w < 8; ++w) s += RED[(w * 9 + j) * 64 + l];
            MOD[j * 6144 + it * 64 + l] = s; }
        __syncthreads();
    }
    bf16* WL = (bf16*)(ws + WS_WL); bf16* WG = (bf16*)(ws + WS_WG); bf16* WY = (bf16*)(ws + WS_WY);
    bf16* WO = (bf16*)(ws + WS_WO); bf16* W1 = (bf16*)(ws + WS_W1); bf16* W2 = (bf16*)(ws + WS_W2);
    const float* w_in = a.in[9];
    const bool split = gridDim.x >= 192;
    const int gw = split ? ((int)blockIdx.x - 96) * 8 + wave : (int)blockIdx.x * 8 + wave, NGW = split ? ((int)gridDim.x - 96) * 8 : (int)gridDim.x * 8;
    constexpr int NITEMS = 1024 + 16 + 1536 + 1024 + 512 + 512 + 512 + 2048 + 2048;
    for (int it = gw; it < NITEMS && gw >= 0; it += NGW) {
        int r = it;
        if (r < 1024) { tr_item(w_in, NIN, 0, 2048, 1024, WL, 0, SCR, r, lane); continue; } r -= 1024;
        if (r < 16) { tr_item(w_in, NIN, 5120, 32, 1024, WL, 2048, SCR, r, lane); continue; } r -= 16;
        if (r < 1536) { tr_item(w_in, NIN, 2048, 3072, 1024, WG, 0, SCR, r, lane); continue; } r -= 1536;
        if (r < 1024) { tr_item<true>(w_in, NIN, 5152, 2048, 1024, WY, 0, SCR, r, lane); continue; } r -= 1024;
        if (r < 512) { tr_item(a.in[17], 1024, 0, 1024, 1024, WY, 2048, SCR, r, lane); continue; } r -= 512;
        if (r < 512) { tr_item(a.in[21], 1024, 0, 1024, 1024, WY, 3072, SCR, r, lane); continue; } r -= 512;
        if (r < 512) { tr_item(a.in[22], 1024, 0, 1024, 1024, WO, 0, SCR, r, lane); continue; } r -= 512;
        if (r < 2048) { tr_item(a.in[23], 4096, 0, 4096, 1024, W1, 0, SCR, r, lane); continue; } r -= 2048;
        tr_item(a.in[24], 1024, 0, 1024, 4096, W2, 0, SCR, r, lane);
    }
    { u32x4* z = (u32x4*)(WL + (size_t)2080 * 1024); const u32x4 zz = {0u, 0u, 0u, 0u};
      for (int i = blockIdx.x * 512 + tid; i < 224 * 1024 / 8; i += gridDim.x * 512) z[i] = zz; }
}

__device__ __forceinline__ const float* xrow(const Args& a, int m) { return m < MP ? a.in[0] + (size_t)m * D : a.in[1] + (size_t)(m - MP) * D; }
__device__ __forceinline__ int modgrp(int m) { return m < MP ? 8 : ((m - MP) >> 11); }
__device__ __forceinline__ void phase1(const Args& a, bf16* H, int lane, int wave) {
    const float* MOD = (const float*)(a.ws + WS_MOD); const float* ng = a.in[8];
    const int stride = gridDim.x * 8; int m = blockIdx.x * 8 + wave;
    f32x4 v[4];
    if (m < M) { const f32x4* xr = (const f32x4*)xrow(a, m) + lane;
#pragma unroll
        for (int q = 0; q < 4; ++q) v[q] = xr[64 * q]; }
    for (; m < M; m += stride) {
        f32x4 vn[4]; const int mn = m + stride;
#pragma unroll
        for (int q = 0; q < 4; ++q) vn[q] = v[q];
        if (mn < M) { const f32x4* xr = (const f32x4*)xrow(a, mn) + lane;
#pragma unroll
            for (int q = 0; q < 4; ++q) vn[q] = xr[64 * q]; }
        const float* md = MOD + modgrp(m) * 6144;
        float s = 0.f;
#pragma unroll
        for (int q = 0; q < 4; ++q) s += (v[q][0] * v[q][0] + v[q][1] * v[q][1]) + (v[q][2] * v[q][2] + v[q][3] * v[q][3]);
        const float rstd = rsqrtf(wave_sum(s) * (1.f / D) + EPS);
        u32x2* o = (u32x2*)(H + (size_t)m * D) + lane;
#pragma unroll
        for (int q = 0; q < 4; ++q) { const int c = 4 * (lane + 64 * q);
            const f32x4 g = *(const f32x4*)(ng + c), sh = *(const f32x4*)(md + c), sc = *(const f32x4*)(md + 1024 + c);
            const f32x4 r = v[q] * rstd * g * (sc + 1.0f) + sh;
            u32x2 w; w.x = pk2(r[0], r[1]); w.y = pk2(r[2], r[3]); o[64 * q] = w; }
#pragma unroll
        for (int q = 0; q < 4; ++q) v[q] = vn[q];
    }
}

__device__ __forceinline__ void lru_phase(const Args& a, LAS unsigned char* lds, int tid, int lane, int wave) {
    LAS bf16* XC = (LAS bf16*)lds;
    LAS float* AU = (LAS float*)(lds + 18432);
    LAS float* SUBA = (LAS float*)(lds + 18432 + 69632);
    LAS float* HC = SUBA + 8 * 64 * 2;
    const bf16* ZX = (const bf16*)a.out;
    bf16* HF = (bf16*)(a.ws + WS_S0 + 2 * SLOT); bf16* HB = (bf16*)(a.ws + WS_S0);
    const float* conv_w = a.in[10]; const float* conv_b = a.in[11];
    const int col = lane & 15, quad = lane >> 4, mt = wave & 3, nh = wave >> 2;
    const int vcu = (gridDim.x % 8 == 0) ? (int)(blockIdx.x % 8) * (int)(gridDim.x / 8) + (int)(blockIdx.x / 8) : (int)blockIdx.x;
    for (int u = vcu; u < 768; u += gridDim.x) {
        const bool lat = u < 256; const int v = lat ? u : u - 256; const int b = v >> 5, blk = (v >> 1) & 15, dir = v & 1;
        const int row_base = lat ? MP + b * 2048 : b * 256, nseg = lat ? 32 : 4;
        bf16* HX = dir ? HB : HF;
        const float* wa = a.in[12] + (size_t)(dir * 16 + blk) * 4096; const float* wx = a.in[14] + (size_t)(dir * 16 + blk) * 4096;
        bf16x8 Bf[2][2][2];
#pragma unroll
        for (int nt = 0; nt < 2; ++nt)
#pragma unroll
            for (int kk = 0; kk < 2; ++kk)
#pragma unroll
                for (int i = 0; i < 8; i += 2) { const int k = kk * 32 + quad * 8 + i, n = nh * 32 + nt * 16 + col;
                    const unsigned pa = pk2(wa[k * 64 + n], wa[(k + 1) * 64 + n]), px = pk2(wx[k * 64 + n], wx[(k + 1) * 64 + n]);
                    Bf[0][nt][kk][i] = (short)(pa & 0xffffu); Bf[0][nt][kk][i + 1] = (short)(pa >> 16);
                    Bf[1][nt][kk][i] = (short)(px & 0xffffu); Bf[1][nt][kk][i + 1] = (short)(px >> 16); }
        float ba_[2], bx_[2], c8_[2];
#pragma unroll
        for (int nt = 0; nt < 2; ++nt) { const int ch = dir * 1024 + blk * 64 + nh * 32 + nt * 16 + col;
            ba_[nt] = -1.4426950408889634f * a.in[13][ch]; bx_[nt] = -1.4426950408889634f * a.in[15][ch]; c8_[nt] = -8.0f * 1.4426950408889634f * log1pf(expf(-a.in[16][ch])); }
        if (tid < 64) HC[tid] = lat ? a.in[2][(size_t)(b * 2 + dir) * 1024 + blk * 64 + tid] : 0.f;
        const int tokA = tid >> 3, c8A = (tid & 7) * 8, ch0A = blk * 64 + c8A;
        f32x4 cwv[4][2];
#pragma unroll
        for (int j = 0; j < 4; ++j) { cwv[j][0] = *(const f32x4*)(conv_w + j * 1024 + ch0A); cwv[j][1] = *(const f32x4*)(conv_w + j * 1024 + ch0A + 4); }
        const f32x4 cb0 = *(const f32x4*)(conv_b + ch0A), cb1 = *(const f32x4*)(conv_b + ch0A + 4);
        const int nst = nseg >> 1;
        u32x4 Zg[2][4];
#define LRU_FETCH(t0_) do { _Pragma("unroll") for (int hh_ = 0; hh_ < 2; ++hh_) { const int t0h_ = (t0_) + 64 * hh_; const int lo_ = lat ? t0h_ : 0, hi_ = lat ? t0h_ + 64 : 256; \
            _Pragma("unroll") for (int j_ = 0; j_ < 4; ++j_) { const int t_ = t0h_ + tokA + j_ - 1; \
                Zg[hh_][j_] = (t_ >= lo_ && t_ < hi_) ? *(const u32x4*)(ZX + (size_t)(row_base + t_) * D + ch0A) : (u32x4){0u, 0u, 0u, 0u}; } } } while (0)
        LRU_FETCH((dir ? nst - 1 : 0) * 128);
        for (int s = 0; s < nst; ++s) {
            const int st = dir ? nst - 1 - s : s, t0 = st * 128;
#pragma unroll
            for (int hh = 0; hh < 2; ++hh) {
                f32x4 x0 = cb0, x1 = cb1;
#pragma unroll
                for (int j = 0; j < 4; ++j) { const u32x4 z = Zg[hh][j]; const f32x4 w0 = cwv[j][0], w1 = cwv[j][1];
                    x0[0] += w0[0] * bflo(z.x); x0[1] += w0[1] * bfhi(z.x); x0[2] += w0[2] * bflo(z.y); x0[3] += w0[3] * bfhi(z.y);
                    x1[0] += w1[0] * bflo(z.z); x1[1] += w1[1] * bfhi(z.z); x1[2] += w1[2] * bflo(z.w); x1[3] += w1[3] * bfhi(z.w); }
                u32x4 w; w.x = pk2(x0[0], x0[1]); w.y = pk2(x0[2], x0[3]); w.z = pk2(x1[0], x1[1]); w.w = pk2(x1[2], x1[3]);
                *(LAS u32x4*)(XC + (64 * hh + tokA) * 72 + c8A) = w;
            }
            __syncthreads();
            if (s + 1 < nst) LRU_FETCH((dir ? nst - 2 - s : s + 1) * 128);
#pragma unroll
            for (int hh = 0; hh < 2; ++hh) {
                bf16x8 Af[2];
#pragma unroll
                for (int kk = 0; kk < 2; ++kk) Af[kk] = *(const LAS bf16x8*)(XC + (64 * hh + 16 * mt + col) * 72 + kk * 32 + quad * 8);
                f32x4 ar[2], ai[2];
#pragma unroll
                for (int nt = 0; nt < 2; ++nt) { ar[nt] = (f32x4){0.f, 0.f, 0.f, 0.f}; ai[nt] = (f32x4){0.f, 0.f, 0.f, 0.f};
#pragma unroll
                    for (int kk = 0; kk < 2; ++kk) { ar[nt] = __builtin_amdgcn_mfma_f32_16x16x32_bf16(Af[kk], Bf[0][nt][kk], ar[nt], 0, 0, 0);
                        ai[nt] = __builtin_amdgcn_mfma_f32_16x16x32_bf16(Af[kk], Bf[1][nt][kk], ai[nt], 0, 0, 0); } }
                float xv[2][4];
#pragma unroll
                for (int nt = 0; nt < 2; ++nt)
#pragma unroll
                    for (int j = 0; j < 4; ++j) xv[nt][j] = bf2f((unsigned)XC[(64 * hh + 16 * mt + quad * 4 + j) * 72 + nh * 32 + nt * 16 + col]);
#pragma unroll
                for (int nt = 0; nt < 2; ++nt)
#pragma unroll
                    for (int j = 0; j < 4; ++j) { const int tok = 64 * hh + 16 * mt + quad * 4 + j, chl = nh * 32 + nt * 16 + col;
                        const float er = 1.0f + __builtin_amdgcn_exp2f(fmaf(ar[nt][j], -1.4426950408889634f, ba_[nt])), ei = 1.0f + __builtin_amdgcn_exp2f(fmaf(ai[nt][j], -1.4426950408889634f, bx_[nt]));
                        const float inv = rcpf_(er * ei), r = inv * ei, ig = inv * er;
                        const float aa = __builtin_amdgcn_exp2f(c8_[nt] * r);
                        const float uu = __builtin_amdgcn_sqrtf(fmaxf(1.0f - aa * aa, 0.f)) * ig * xv[nt][j];
                        typedef float f32x2s __attribute__((ext_vector_type(2)));
                        *(LAS f32x2s*)(AU + (tok * 68 + chl) * 2) = (f32x2s){aa, uu}; }
            }
            __syncthreads();
            {
                typedef float f32x2l __attribute__((ext_vector_type(2)));
                f32x2l p[16];
#pragma unroll
                for (int e = 0; e < 16; ++e) { const int i = wave * 16 + e; const int tok = dir ? 127 - i : i; p[e] = *(const LAS f32x2l*)(AU + (tok * 68 + lane) * 2); }
                float hl = 0.f, cp = 1.f;
#pragma unroll
                for (int e = 0; e < 16; ++e) { hl = p[e].x * hl + p[e].y; cp *= p[e].x; p[e].y = hl; p[e].x = cp; }
                *(LAS f32x2l*)(SUBA + (wave * 64 + lane) * 2) = (f32x2l){cp, hl};
                __syncthreads();
                float c = HC[(s & 1) * 64 + lane];
#pragma unroll
                for (int s2 = 0; s2 < 7; ++s2) { const f32x2l q = *(const LAS f32x2l*)(SUBA + (s2 * 64 + lane) * 2); if (s2 < wave) c = q.x * c + q.y; }
#pragma unroll
                for (int e = 0; e < 16; ++e) { const int i = wave * 16 + e; const int tok = dir ? 127 - i : i; *(LAS f32x2l*)(AU + (tok * 68 + lane) * 2) = (f32x2l){p[e].x, p[e].y + p[e].x * c}; }
                if (wave == 7) HC[((s + 1) & 1) * 64 + lane] = p[15].y + p[15].x * c;
            }
            __syncthreads();
#pragma unroll
            for (int hh = 0; hh < 2; ++hh) {
                const LAS f32x4* hq = (const LAS f32x4*)(AU + ((64 * hh + tokA) * 68 + c8A) * 2);
                const f32x4 q0 = hq[0], q1 = hq[1], q2 = hq[2], q3 = hq[3];
                u32x4 w; w.x = pk2(q0[1], q0[3]); w.y = pk2(q1[1], q1[3]); w.z = pk2(q2[1], q2[3]); w.w = pk2(q3[1], q3[3]);
                *(u32x4*)(HX + (size_t)(row_base + t0 + 64 * hh + tokA) * D + blk * 64 + c8A) = w;
            }
        }
#undef LRU_FETCH
        if (!lat && tid < 64) a.out[(size_t)M * D + (size_t)(b * 2 + dir) * 1024 + blk * 64 + tid] = HC[(nst & 1) * 64 + tid];
        __syncthreads();
    }
}

constexpr size_t WS_DEC = 6656 * 1024;
__device__ __forceinline__ void gla_prep(const Args& a, LAS unsigned char* lds, int tid, bf16* ewd, const bf16* ewa, const bf16* ewb) {
    LAS float* LRS = (LAS float*)lds;
    const float* LR = (const float*)(a.ws + WS_LR);
    bf16* EFb = (bf16*)a.out; bf16* EBb = EFb + (size_t)M * 512;
    float* DECg = (float*)(a.ws + WS_DEC);
    const size_t ew_n = (size_t)M * D / 8, ew_stride = (size_t)gridDim.x * 512; size_t ew_i = (size_t)blockIdx.x * 512 + tid;
    for (int it = blockIdx.x; it < 640; it += gridDim.x) {
        const int gc = it >> 1, dir = it & 1; const bool lat = gc >= 64; const int g2 = lat ? gc - 64 : gc;
        const int b = lat ? (g2 >> 5) : (g2 >> 2), cn = lat ? (g2 & 31) : (g2 & 3), p0 = cn * 64;
        const int row_base = lat ? MP + b * 2048 : b * 256;
        bf16* Eb = dir ? EBb : EFb;
        float w2r[16];
#pragma unroll
        for (int r = 0; r < 16; ++r) w2r[r] = a.in[18][(size_t)(dir * 16 + r) * 512 + tid];
        const float b2v = a.in[19][dir * 512 + tid];
        __syncthreads();
        if (tid < 256) { const int i = tid >> 2; const int p_ = dir ? p0 + 63 - i : p0 + i; const int row = lat ? row_base + (p_ & 31) * 64 + (p_ >> 5) : row_base + p_;
            *(LAS f32x4*)(LRS + i * 16 + (tid & 3) * 4) = *(const f32x4*)(LR + (size_t)row * 32 + dir * 16 + (tid & 3) * 4); }
        __syncthreads();
        float run = 0.f;
#pragma unroll 1
        for (int i8 = 0; i8 < 64; i8 += 8) {
            const bool ew_on = ew_i < ew_n; u32x4 ex0 = {0u, 0u, 0u, 0u}, ex1 = ex0, ey0 = ex0;
            if (ew_on) { ex0 = ((const u32x4*)ewa)[ew_i]; ex1 = ((const u32x4*)ewb)[ew_i]; ey0 = ((const u32x4*)ewd)[ew_i]; }
#pragma unroll
            for (int i7 = 0; i7 < 8; ++i7) { const int i = i8 + i7; const int p_ = dir ? p0 + 63 - i : p0 + i; const int row = lat ? row_base + (p_ & 31) * 64 + (p_ >> 5) : row_base + p_;
                const LAS f32x4* lrp = (const LAS f32x4*)(LRS + i * 16);
                const f32x4 l0 = lrp[0], l1 = lrp[1], l2 = lrp[2], l3 = lrp[3];
                float x = b2v;
                x += l0[0] * w2r[0]; x += l0[1] * w2r[1]; x += l0[2] * w2r[2]; x += l0[3] * w2r[3];
                x += l1[0] * w2r[4]; x += l1[1] * w2r[5]; x += l1[2] * w2r[6]; x += l1[3] * w2r[7];
                x += l2[0] * w2r[8]; x += l2[1] * w2r[9]; x += l2[2] * w2r[10]; x += l2[3] * w2r[11];
                x += l3[0] * w2r[12]; x += l3[1] * w2r[13]; x += l3[2] * w2r[14]; x += l3[3] * w2r[15];
                run += (fminf(x, 0.f) - logf_(1.0f + expf_(-fabsf(x)))) * 0.0625f;
                Eb[(size_t)row * 512 + tid] = (bf16)(pk2(expf_(run), 0.f) & 0xffffu); }
            if (ew_on) { u32x4 o;
#pragma unroll
                for (int e = 0; e < 4; ++e) o[e] = pk2((bflo(ex0[e]) + bflo(ex1[e])) * bflo(ey0[e]), (bfhi(ex0[e]) + bfhi(ex1[e])) * bfhi(ey0[e]));
                ((u32x4*)ewd)[ew_i] = o; ew_i += ew_stride; }
        }
        DECg[((size_t)dir * 320 + gc) * 512 + tid] = expf_(run);
    }
    for (; ew_i < ew_n; ew_i += ew_stride) { const u32x4 ex0 = ((const u32x4*)ewa)[ew_i], ex1 = ((const u32x4*)ewb)[ew_i], ey0 = ((const u32x4*)ewd)[ew_i]; u32x4 o;
#pragma unroll
        for (int e = 0; e < 4; ++e) o[e] = pk2((bflo(ex0[e]) + bflo(ex1[e])) * bflo(ey0[e]), (bfhi(ex0[e]) + bfhi(ex1[e])) * bfhi(ey0[e]));
        ((u32x4*)ewd)[ew_i] = o; }
}

__device__ __forceinline__ void gla_phase(const Args& a, LAS unsigned char* lds, int tid, int lane, int wave) {
    LAS bf16* QE = (LAS bf16*)lds;
    LAS bf16* KE = QE + 64 * 136;
    LAS bf16* ST = KE + 64 * 136;
    LAS bf16* KT = ST + 64 * 136;
    LAS bf16* VT = KT + 128 * 72;
    LAS bf16* PP = VT + 64 * 72;
    LAS bf16* EE = PP + 64 * 72;
    LAS float* DEC = (LAS float*)(EE + 64 * 136);
    const unsigned char* ws = a.ws;
    const bf16* EFb = (const bf16*)a.out; const bf16* EBb = EFb + (size_t)M * 512;
    const float* DECg = (const float*)(ws + WS_DEC);
    const bf16* Qb = (const bf16*)(ws + WS_S0 + 3 * SLOT); const bf16* Kb = Qb + (size_t)M * 512;
    const bf16* Vb = (const bf16*)(ws + WS_S0 + 4 * SLOT);
    bf16* OFb = (bf16*)(a.ws + WS_S0 + 2 * SLOT); bf16* OBb = (bf16*)(a.ws + WS_S0);
    const int ch = tid & 127, sub = __builtin_amdgcn_readfirstlane(tid >> 7);
    const int col = lane & 15, quad = lane >> 4, kt = wave;
    float* SG = a.out + (size_t)M * D + 16 * 2 * 1024;
    const int vcu = (gridDim.x % 8 == 0) ? (int)(blockIdx.x % 8) * (int)(gridDim.x / 8) + (int)(blockIdx.x / 8) : (int)blockIdx.x;
    for (int u = vcu; u < 768; u += gridDim.x) {
        const bool lat = u < 256; const int v = lat ? u : u - 256; const int b = v >> 5, hd = (v >> 3) & 3, dir = (v >> 2) & 1, sl = v & 3;
        const int row_base = lat ? MP + b * 2048 : b * 256, nch = lat ? 32 : 4, gc0 = lat ? 64 + b * 32 : b * 4;
        bf16* Ob = dir ? OBb : OFb; const bf16* Eb = dir ? EBb : EFb;
        f32x4 S[4];
#pragma unroll
        for (int vt = 0; vt < 4; ++vt)
#pragma unroll
            for (int j = 0; j < 4; ++j)
                S[vt][j] = lat ? a.in[3][((((size_t)(b * 2 + dir) * 4 + hd) * 128 + 16 * kt + quad * 4 + j) * 256) + sl * 64 + 16 * vt + col] : 0.f;
#define GROWP(p0_, i) ({ const int p_ = dir ? (p0_) + 63 - (i) : (p0_) + (i); lat ? row_base + (p_ & 31) * 64 + (p_ >> 5) : row_base + p_; })
        u32x4 QgA[2], KgA[2], EgA[2], VgA, QgB[2], KgB[2], EgB[2], VgB; f32x2 etgA, etgB;
#define GLA_FETCH(X, cn_) do { const int p0_ = (cn_) * 64; \
            _Pragma("unroll") for (int e_ = 0; e_ < 2; ++e_) { const int pc_ = tid + e_ * 512; const size_t ro_ = (size_t)GROWP(p0_, pc_ >> 4) * 512 + hd * 128 + (pc_ & 15) * 8; \
                Qg##X[e_] = *(const u32x4*)(Qb + ro_); Kg##X[e_] = *(const u32x4*)(Kb + ro_); Eg##X[e_] = *(const u32x4*)(Eb + ro_); } \
            Vg##X = *(const u32x4*)(Vb + (size_t)GROWP(p0_, tid & 63) * D + hd * 256 + sl * 64 + (tid >> 6) * 8); \
            etg##X = *(const f32x2*)(DECg + ((size_t)dir * 320 + gc0 + (cn_)) * 512 + hd * 128 + 2 * lane); } while (0)
#define GLA_CHUNK(X, n) do { const int cn = dir ? nch - 1 - (n) : (n), p0 = cn * 64; \
            __syncthreads(); \
_Pragma("unroll") \
            for (int vt = 0; vt < 4; ++vt) { u32x2 w; w.x = pk2(S[vt][0], S[vt][1]); w.y = pk2(S[vt][2], S[vt][3]); \
                *(LAS u32x2*)(ST + (16 * vt + col) * 136 + 16 * kt + quad * 4) = w; } \
_Pragma("unroll") \
            for (int e = 0; e < 2; ++e) { const int pc = tid + e * 512, o_ = (pc >> 4) * 136 + (pc & 15) * 8; \
                *(LAS u32x4*)(QE + o_) = Qg##X[e]; *(LAS u32x4*)(KE + o_) = Kg##X[e]; *(LAS u32x4*)(EE + o_) = Eg##X[e]; } \
            {   const int i = tid & 63, v8 = (tid >> 6) * 8; const u32x4 z = Vg##X; \
                VT[(v8 + 0) * 72 + i] = (bf16)(z.x & 0xffffu); VT[(v8 + 1) * 72 + i] = (bf16)(z.x >> 16); \
                VT[(v8 + 2) * 72 + i] = (bf16)(z.y & 0xffffu); VT[(v8 + 3) * 72 + i] = (bf16)(z.y >> 16); \
                VT[(v8 + 4) * 72 + i] = (bf16)(z.z & 0xffffu); VT[(v8 + 5) * 72 + i] = (bf16)(z.z >> 16); \
                VT[(v8 + 6) * 72 + i] = (bf16)(z.w & 0xffffu); VT[(v8 + 7) * 72 + i] = (bf16)(z.w >> 16); } \
            const f32x2 etot = etg##X; \
            if (wave == 0) *(LAS f32x2*)(DEC + 2 * lane) = etot; \
            __syncthreads(); \
            if ((n) + 2 < nch) GLA_FETCH(X, dir ? nch - 3 - (n) : (n) + 2); \
            {     \
                unsigned qw[8], kw_[8], ew[8]; \
_Pragma("unroll") \
                for (int e = 0; e < 8; ++e) { const int o_ = (wave * 8 + e) * 136 + 2 * lane; qw[e] = *(const LAS unsigned*)(QE + o_); kw_[e] = *(const LAS unsigned*)(KE + o_); ew[e] = *(const LAS unsigned*)(EE + o_); } \
                float t0v[8], t1v[8]; \
_Pragma("unroll") \
                for (int e = 0; e < 8; ++e) { const float E0 = bflo(ew[e]), E1 = bfhi(ew[e]); const float R0 = rcpf_(E0), R1 = rcpf_(E1); \
                    const float q0 = bflo(qw[e]) * E0 * 0.08838834764831845f, q1 = bfhi(qw[e]) * E1 * 0.08838834764831845f; \
                    const float k0 = bflo(kw_[e]) * R0, k1 = bfhi(kw_[e]) * R1; t0v[e] = k0 * etot.x; t1v[e] = k1 * etot.y; \
                    qw[e] = pk2(q0, q1); kw_[e] = pk2(k0, k1); } \
_Pragma("unroll") \
                for (int e = 0; e < 8; ++e) { const int o_ = (wave * 8 + e) * 136 + 2 * lane; *(LAS unsigned*)(QE + o_) = qw[e]; *(LAS unsigned*)(KE + o_) = kw_[e]; } \
                u32x4 w0, w1; w0.x = pk2(t0v[0], t0v[1]); w0.y = pk2(t0v[2], t0v[3]); w0.z = pk2(t0v[4], t0v[5]); w0.w = pk2(t0v[6], t0v[7]); \
                w1.x = pk2(t1v[0], t1v[1]); w1.y = pk2(t1v[2], t1v[3]); w1.z = pk2(t1v[4], t1v[5]); w1.w = pk2(t1v[6], t1v[7]); \
                *(LAS u32x4*)(KT + (2 * lane) * 72 + wave * 8) = w0; *(LAS u32x4*)(KT + (2 * lane + 1) * 72 + wave * 8) = w1; } \
            __syncthreads(); \
            {     \
                const int st = wave >> 1, ct0 = 2 * (wave & 1); \
                f32x4 acc0 = {0.f, 0.f, 0.f, 0.f}, acc1 = {0.f, 0.f, 0.f, 0.f}; \
                if (st <= ct0 + 1) { \
_Pragma("unroll") \
                    for (int kk = 0; kk < 4; ++kk) { const bf16x8 ak = *(const LAS bf16x8*)(KE + (16 * st + col) * 136 + kk * 32 + quad * 8); \
                        if (st <= ct0) { const bf16x8 bq0 = *(const LAS bf16x8*)(QE + (16 * ct0 + col) * 136 + kk * 32 + quad * 8); acc0 = __builtin_amdgcn_mfma_f32_16x16x32_bf16(ak, bq0, acc0, 0, 0, 0); } \
                        const bf16x8 bq1 = *(const LAS bf16x8*)(QE + (16 * (ct0 + 1) + col) * 136 + kk * 32 + quad * 8); acc1 = __builtin_amdgcn_mfma_f32_16x16x32_bf16(ak, bq1, acc1, 0, 0, 0); } \
                } \
_Pragma("unroll") \
                for (int j = 0; j < 4; ++j) { if (16 * st + quad * 4 + j > 16 * ct0 + col) acc0[j] = 0.f; if (16 * st + quad * 4 + j > 16 * (ct0 + 1) + col) acc1[j] = 0.f; } \
                u32x2 w0, w1; w0.x = pk2(acc0[0], acc0[1]); w0.y = pk2(acc0[2], acc0[3]); w1.x = pk2(acc1[0], acc1[1]); w1.y = pk2(acc1[2], acc1[3]); \
                *(LAS u32x2*)(PP + (16 * ct0 + col) * 72 + 16 * st + quad * 4) = w0; *(LAS u32x2*)(PP + (16 * (ct0 + 1) + col) * 72 + 16 * st + quad * 4) = w1; \
            } \
            __syncthreads(); \
            {     \
                const int vt_ = wave >> 1, ct0 = 2 * (wave & 1); \
                bf16x8 av[2], as_[4]; \
_Pragma("unroll") \
                for (int ks = 0; ks < 2; ++ks) av[ks] = *(const LAS bf16x8*)(VT + (16 * vt_ + col) * 72 + ks * 32 + quad * 8); \
_Pragma("unroll") \
                for (int kk = 0; kk < 4; ++kk) as_[kk] = *(const LAS bf16x8*)(ST + (16 * vt_ + col) * 136 + kk * 32 + quad * 8); \
                f32x4 acc0 = {0.f, 0.f, 0.f, 0.f}, acc1 = {0.f, 0.f, 0.f, 0.f}; \
_Pragma("unroll") \
                for (int ks = 0; ks < 2; ++ks) { const bf16x8 bp0 = *(const LAS bf16x8*)(PP + (16 * ct0 + col) * 72 + ks * 32 + quad * 8), bp1 = *(const LAS bf16x8*)(PP + (16 * (ct0 + 1) + col) * 72 + ks * 32 + quad * 8); \
                    acc0 = __builtin_amdgcn_mfma_f32_16x16x32_bf16(av[ks], bp0, acc0, 0, 0, 0); acc1 = __builtin_amdgcn_mfma_f32_16x16x32_bf16(av[ks], bp1, acc1, 0, 0, 0); } \
_Pragma("unroll") \
                for (int kk = 0; kk < 4; ++kk) { const bf16x8 bq0 = *(const LAS bf16x8*)(QE + (16 * ct0 + col) * 136 + kk * 32 + quad * 8), bq1 = *(const LAS bf16x8*)(QE + (16 * (ct0 + 1) + col) * 136 + kk * 32 + quad * 8); \
                    acc0 = __builtin_amdgcn_mfma_f32_16x16x32_bf16(as_[kk], bq0, acc0, 0, 0, 0); acc1 = __builtin_amdgcn_mfma_f32_16x16x32_bf16(as_[kk], bq1, acc1, 0, 0, 0); } \
                const int row0 = GROWP(p0, 16 * ct0 + col), row1 = GROWP(p0, 16 * (ct0 + 1) + col); \
                u32x2 w0, w1; w0.x = pk2(acc0[0], acc0[1]); w0.y = pk2(acc0[2], acc0[3]); w1.x = pk2(acc1[0], acc1[1]); w1.y = pk2(acc1[2], acc1[3]); \
                *(u32x2*)(Ob + (size_t)row0 * D + hd * 256 + sl * 64 + 16 * vt_ + quad * 4) = w0; *(u32x2*)(Ob + (size_t)row1 * D + hd * 256 + sl * 64 + 16 * vt_ + quad * 4) = w1; \
                bf16x8 ak[2]; \
_Pragma("unroll") \
                for (int ks = 0; ks < 2; ++ks) ak[ks] = *(const LAS bf16x8*)(KT + (16 * kt + col) * 72 + ks * 32 + quad * 8); \
                float dk[4]; \
_Pragma("unroll") \
                for (int j = 0; j < 4; ++j) dk[j] = DEC[16 * kt + quad * 4 + j]; \
_Pragma("unroll") \
                for (int vt = 0; vt < 4; ++vt) { \
_Pragma("unroll") \
                    for (int j = 0; j < 4; ++j) S[vt][j] *= dk[j]; \
_Pragma("unroll") \
                    for (int ks = 0; ks < 2; ++ks) { const bf16x8 bv = *(const LAS bf16x8*)(VT + (16 * vt + col) * 72 + ks * 32 + quad * 8); \
                        S[vt] = __builtin_amdgcn_mfma_f32_16x16x32_bf16(ak[ks], bv, S[vt], 0, 0, 0); } } \
            } \
        } while (0)
        GLA_FETCH(A, dir ? nch - 1 : 0); GLA_FETCH(B, dir ? nch - 2 : 1);
        for (int n = 0; n < nch; n += 2) { GLA_CHUNK(A, n); GLA_CHUNK(B, n + 1); }
#undef GLA_CHUNK
#undef GLA_FETCH
#undef GROWP
        if (!lat) {
#pragma unroll
            for (int vt = 0; vt < 4; ++vt)
#pragma unroll
                for (int j = 0; j < 4; ++j)
                    SG[((((size_t)(b * 2 + dir) * 4 + hd) * 128 + 16 * kt + quad * 4 + j) * 256) + sl * 64 + 16 * vt + col] = S[vt][j];
        }
    }
}

template <int MODE> __device__ __forceinline__ void ew_pass(bf16* dst, const bf16* a0, const bf16* b0, const bf16* a1, const bf16* b1, int tid) {
    const size_t nvec = (size_t)M * D / 8;
    for (size_t i = (size_t)blockIdx.x * 512 + tid; i < nvec; i += (size_t)gridDim.x * 512) {
        const u32x4 x0 = ((const u32x4*)a0)[i], y0 = ((const u32x4*)b0)[i], x1 = ((const u32x4*)a1)[i];
        u32x4 o;
        if (MODE == 0) {
#pragma unroll
            for (int e = 0; e < 4; ++e) o[e] = pk2((bflo(x0[e]) + bflo(x1[e])) * bflo(y0[e]), (bfhi(x0[e]) + bfhi(x1[e])) * bfhi(y0[e]));
        } else {
            const u32x4 y1 = ((const u32x4*)b1)[i];
#pragma unroll
            for (int e = 0; e < 4; ++e) o[e] = pk2(bflo(x0[e]) * bflo(y0[e]) + bflo(x1[e]) * bflo(y1[e]), bfhi(x0[e]) * bfhi(y0[e]) + bfhi(x1[e]) * bfhi(y1[e]));
        }
        ((u32x4*)dst)[i] = o;
    }
}
__device__ __forceinline__ void post_gla(const Args& a, int lane, int wave) {
    const bf16* OFb = (const bf16*)(a.ws + WS_S0 + 2 * SLOT); const bf16* OBb = (const bf16*)(a.ws + WS_S0);
    bf16* G = (bf16*)(a.ws + WS_S0 + 1 * SLOT);
    const f32x4 gn = *(const f32x4*)(a.in[20] + 4 * lane);
    const int stride = gridDim.x * 8; int m = blockIdx.x * 8 + wave;
    u32x2 cf[4], cb[4], cg[4];
    if (m < M) {
#pragma unroll
        for (int hh = 0; hh < 4; ++hh) { const size_t off = (size_t)m * D + hh * 256 + 4 * lane; cf[hh] = *(const u32x2*)(OFb + off); cb[hh] = *(const u32x2*)(OBb + off); cg[hh] = *(const u32x2*)(G + off); } }
    for (; m < M; m += stride) {
        u32x2 nf[4], nb[4], ng_[4]; const int mn = m + stride;
#pragma unroll
        for (int hh = 0; hh < 4; ++hh) { nf[hh] = cf[hh]; nb[hh] = cb[hh]; ng_[hh] = cg[hh]; }
        if (mn < M) {
#pragma unroll
            for (int hh = 0; hh < 4; ++hh) { const size_t off = (size_t)mn * D + hh * 256 + 4 * lane; nf[hh] = *(const u32x2*)(OFb + off); nb[hh] = *(const u32x2*)(OBb + off); ng_[hh] = *(const u32x2*)(G + off); } }
#pragma unroll
        for (int hh = 0; hh < 4; ++hh) { const size_t off = (size_t)m * D + hh * 256 + 4 * lane;
            const u32x2 f = cf[hh], bb = cb[hh], g = cg[hh];
            f32x4 o; o[0] = bflo(f.x) + bflo(bb.x); o[1] = bfhi(f.x) + bfhi(bb.x); o[2] = bflo(f.y) + bflo(bb.y); o[3] = bfhi(f.y) + bfhi(bb.y);
            const float ss = wave_sum((o[0] * o[0] + o[1] * o[1]) + (o[2] * o[2] + o[3] * o[3]));
            const float rstd = rsqrtf(ss * (1.f / 256.f) + EPS);
            u32x2 w; w.x = pk2(o[0] * rstd * gn[0] * bflo(g.x), o[1] * rstd * gn[1] * bfhi(g.x)); w.y = pk2(o[2] * rstd * gn[2] * bflo(g.y), o[3] * rstd * gn[3] * bfhi(g.y));
            *(u32x2*)(G + off) = w; }
#pragma unroll
        for (int hh = 0; hh < 4; ++hh) { cf[hh] = nf[hh]; cb[hh] = nb[hh]; cg[hh] = ng_[hh]; }
    }
}
struct SplitRow { u32x2 o[4]; u32x2 p[3][4]; };
__device__ __forceinline__ void split_row_load(SplitRow& r, const bf16* O, const bf16* P, int m, int lane) {
#pragma unroll
    for (int q = 0; q < 4; ++q) r.o[q] = *(const u32x2*)(O + (size_t)m * D + 4 * (lane + 64 * q));
    if (m >= 16384) {
#pragma unroll
        for (int k = 0; k < 3; ++k)
#pragma unroll
            for (int q = 0; q < 4; ++q) r.p[k][q] = *(const u32x2*)(P + ((size_t)k * 4096 + (m - 16384)) * D + 4 * (lane + 64 * q)); }
}
__device__ __forceinline__ f32x4 split_row_val(const SplitRow& r, int m, int q) {
    f32x4 v; v[0] = bflo(r.o[q].x); v[1] = bfhi(r.o[q].x); v[2] = bflo(r.o[q].y); v[3] = bfhi(r.o[q].y);
    if (m >= 16384) {
#pragma unroll
        for (int k = 0; k < 3; ++k) { v[0] += bflo(r.p[k][q].x); v[1] += bfhi(r.p[k][q].x); v[2] += bflo(r.p[k][q].y); v[3] += bfhi(r.p[k][q].y); } }
    return v;
}
__device__ __forceinline__ void x1_pass(const Args& a, int lane, int wave) {
    const float* MOD = (const float*)(a.ws + WS_MOD); const float* ng = a.in[8];
    const bf16* Mm = (const bf16*)(a.ws + WS_S0 + 2 * SLOT); const bf16* Pm = (const bf16*)(a.ws + WS_S0 + 4 * SLOT); bf16* H2 = (bf16*)(a.ws + WS_S0);
    const int stride = gridDim.x * 8; int m = blockIdx.x * 8 + wave;
    SplitRow cur; f32x4 xc[4];
    if (m < M) { split_row_load(cur, Mm, Pm, m, lane); const f32x4* xr = (const f32x4*)xrow(a, m) + lane;
#pragma unroll
        for (int q = 0; q < 4; ++q) xc[q] = xr[64 * q]; }
    for (; m < M; m += stride) {
        SplitRow nxt = cur; f32x4 xn[4]; const int mn = m + stride;
#pragma unroll
        for (int q = 0; q < 4; ++q) xn[q] = xc[q];
        if (mn < M) { split_row_load(nxt, Mm, Pm, mn, lane); const f32x4* xr = (const f32x4*)xrow(a, mn) + lane;
#pragma unroll
            for (int q = 0; q < 4; ++q) xn[q] = xr[64 * q]; }
        const float* md = MOD + modgrp(m) * 6144;
        f32x4 mv[4]; float s1 = 0.f;
#pragma unroll
        for (int q = 0; q < 4; ++q) { mv[q] = split_row_val(cur, m, q); s1 += (mv[q][0] * mv[q][0] + mv[q][1] * mv[q][1]) + (mv[q][2] * mv[q][2] + mv[q][3] * mv[q][3]); }
        const float rstd1 = rsqrtf(wave_sum(s1) * (1.f / D) + EPS);
        f32x4 v[4]; float s = 0.f;
#pragma unroll
        for (int q = 0; q < 4; ++q) { const int c = 4 * (lane + 64 * q);
            const f32x4 g1 = *(const f32x4*)(md + 2048 + c), n1 = *(const f32x4*)(ng + 1024 + c);
            v[q] = xc[q] + g1 * (mv[q] * rstd1 * n1);
            *(f32x4*)(a.out + (size_t)m * D + c) = v[q];
            s += (v[q][0] * v[q][0] + v[q][1] * v[q][1]) + (v[q][2] * v[q][2] + v[q][3] * v[q][3]); }
        const float rstd = rsqrtf(wave_sum(s) * (1.f / D) + EPS);
#pragma unroll
        for (int q = 0; q < 4; ++q) { const int c = 4 * (lane + 64 * q);
            const f32x4 g = *(const f32x4*)(ng + 2048 + c), sh = *(const f32x4*)(md + 3072 + c), sc = *(const f32x4*)(md + 4096 + c);
            const f32x4 r = v[q] * rstd * g * (sc + 1.0f) + sh;
            u32x2 w; w.x = pk2(r[0], r[1]); w.y = pk2(r[2], r[3]); *(u32x2*)(H2 + (size_t)m * D + c) = w; }
        cur = nxt;
#pragma unroll
        for (int q = 0; q < 4; ++q) xc[q] = xn[q];
    }
}
__device__ __forceinline__ void fin_pass(const Args& a, int lane, int wave) {
    const float* MOD = (const float*)(a.ws + WS_MOD); const float* ng = a.in[8];
    const bf16* F = (const bf16*)(a.ws + WS_S0); const bf16* Pf = (const bf16*)(a.ws + WS_WL);
    const int stride = gridDim.x * 8; int m = blockIdx.x * 8 + wave;
    SplitRow cur; f32x4 yc[4];
    if (m < M) { split_row_load(cur, F, Pf, m, lane);
#pragma unroll
        for (int q = 0; q < 4; ++q) yc[q] = *(const f32x4*)(a.out + (size_t)m * D + 4 * (lane + 64 * q)); }
    for (; m < M; m += stride) {
        SplitRow nxt = cur; f32x4 yn[4]; const int mn = m + stride;
#pragma unroll
        for (int q = 0; q < 4; ++q) yn[q] = yc[q];
        if (mn < M) { split_row_load(nxt, F, Pf, mn, lane);
#pragma unroll
            for (int q = 0; q < 4; ++q) yn[q] = *(const f32x4*)(a.out + (size_t)mn * D + 4 * (lane + 64 * q)); }
        const float* md = MOD + modgrp(m) * 6144;
        f32x4 fv[4]; float s = 0.f;
#pragma unroll
        for (int q = 0; q < 4; ++q) { fv[q] = split_row_val(cur, m, q); s += (fv[q][0] * fv[q][0] + fv[q][1] * fv[q][1]) + (fv[q][2] * fv[q][2] + fv[q][3] * fv[q][3]); }
        const float rstd = rsqrtf(wave_sum(s) * (1.f / D) + EPS);
#pragma unroll
        for (int q = 0; q < 4; ++q) { const int c = 4 * (lane + 64 * q);
            const f32x4 g2 = *(const f32x4*)(md + 5120 + c), n3 = *(const f32x4*)(ng + 3072 + c);
            *(f32x4*)(a.out + (size_t)m * D + c) = yc[q] + g2 * (fv[q] * rstd * n3); }
        cur = nxt;
#pragma unroll
        for (int q = 0; q < 4; ++q) yc[q] = yn[q];
    }
}

constexpr int NPHASE = 14;
__global__ void __launch_bounds__(512, 2) mk_fwd(Args a) {
    extern __shared__ __attribute__((aligned(16))) unsigned char lds_raw[];
    LAS unsigned char* lds = (LAS unsigned char*)lds_raw;
    cg::grid_group grid = cg::this_grid();
    const int tid = threadIdx.x, lane = tid & 63, wave = __builtin_amdgcn_readfirstlane(tid >> 6);
    const int lo = a.ph_lo, hi = a.ph_hi, G = gridDim.x;
    volatile LAS unsigned* MISC = (volatile LAS unsigned*)(lds + LDS_BYTES - 64);
    if (tid < 16) MISC[tid] = 0u;
    __syncthreads();
    const XcdBarrier bar = xcd_barrier_post((unsigned*)(a.ws + WS_BAR), MISC);
    unsigned char* ws = a.ws;
    bf16* S0 = (bf16*)(ws + WS_S0); bf16* S1 = (bf16*)(ws + WS_S0 + SLOT); bf16* S2 = (bf16*)(ws + WS_S0 + 2 * SLOT);
    bf16* S3 = (bf16*)(ws + WS_S0 + 3 * SLOT); bf16* S4 = (bf16*)(ws + WS_S0 + 4 * SLOT);
    bf16* D0 = (bf16*)a.out; bf16* D1 = D0 + (size_t)M * D;
#ifndef MK_MASK
#define MK_MASK 0x3fff
#endif
#define IN(k) (((MK_MASK >> (k)) & 1) && lo <= (k) && (k) < hi)
#define SEAM(k) do { if (IN(k) && IN((k) + 1)) xcd_barrier(bar); } while (0)
    if (lo < 0) grid.sync();
    if (IN(0)) { phase0(a, lds, tid, lane, wave); } SEAM(0);
    if (IN(1)) { phase1(a, S0, lane, wave); } SEAM(1);
    if (IN(2)) {
        pg8::Gemm g{S0, (const bf16*)(ws + WS_WL), M, 5376, 1024, S0, S0, 1 << 30, 1 << 30, 1024}; pg8::StaticOrder S; S.init(M, 5376, G, (int)blockIdx.x);
        EpiLG E{D0, D1, (float*)(ws + WS_LR), S3, S3 + (size_t)M * 512, S4, S1};
        pg8::gemm_phase<EpiLG, pg8::StaticOrder, true, true>(lds, g, S, E);
    } SEAM(2);
    if (IN(3)) { lru_phase(a, lds, tid, lane, wave); } SEAM(3);
    if (IN(4)) {
        gla_prep(a, lds, tid, D1, S2, S0);
    } SEAM(4);
    if (IN(5)) { gla_phase(a, lds, tid, lane, wave); } SEAM(5);
    if (IN(6)) { post_gla(a, lane, wave); phase1(a, S3, lane, wave); } SEAM(6);
    if (IN(7)) {
        pg8::Gemm g{D1, (const bf16*)(ws + WS_WY) + (size_t)2048 * 1024, M, 2048, 1024, S1, S1, 4, 1 << 30, 1024}; pg8::StaticOrder S; S.init(M, 2048, G, (int)blockIdx.x);
        EpiYY E{S4, D0};
        pg8::gemm_phase<EpiYY, pg8::StaticOrder, true, true>(lds, g, S, E);
    } SEAM(7);
    if (IN(8)) {
        pg8::Gemm g{S3, (const bf16*)(ws + WS_WY), M, 2048, 1024, S3, S3, 1 << 30, 1 << 30, 1024}; pg8::StaticOrder S; S.init(M, 2048, G, (int)blockIdx.x);
        EpiMM E{S4, D0, S0};
        pg8::gemm_phase<EpiMM, pg8::StaticOrder, true, true>(lds, g, S, E);
    } SEAM(8);
    if (IN(9)) {
        { pg8::Gemm g{S0, (const bf16*)(ws + WS_WO), 16384, 1024, 1024, S0, S0, 1 << 30, 1 << 30, 1024}; pg8::StaticOrder S; S.init(16384, 1024, G, (int)blockIdx.x);
          EpiS E{S2, S4, 64}; pg8::gemm_phase<EpiS, pg8::StaticOrder, true, true>(lds, g, S, E); }
        { pg8::Gemm g{S0, (const bf16*)(ws + WS_WO), M, 1024, 256, S0, S0, 1 << 30, 1 << 30, 1024}; SplitOrder S{64, G, (int)blockIdx.x};
          EpiS E{S2, S4, 64}; pg8::gemm_phase<EpiS, SplitOrder, true, true>(lds, g, S, E); }
    } SEAM(9);
    if (IN(10)) { x1_pass(a, lane, wave); } SEAM(10);
    if (IN(11)) {
        pg8::Gemm g{S0, (const bf16*)(ws + WS_W1), M, 4096, 1024, S0, S0, 1 << 30, 1 << 30, 1024}; pg8::StaticOrder S; S.init(M, 4096, G, (int)blockIdx.x);
        EpiH E{S1};
        pg8::gemm_phase<EpiH, pg8::StaticOrder, true, true>(lds, g, S, E);
    } SEAM(11);
    if (IN(12)) {
        { pg8::Gemm g{S1, (const bf16*)(ws + WS_W2), 16384, 1024, 4096, S1, S1, 1 << 30, 1 << 30, 4096}; pg8::StaticOrder S; S.init(16384, 1024, G, (int)blockIdx.x);
          EpiS E{S0, (bf16*)(ws + WS_WL), 64}; pg8::gemm_phase<EpiS, pg8::StaticOrder, true, true>(lds, g, S, E); }
        { pg8::Gemm g{S1, (const bf16*)(ws + WS_W2), M, 1024, 1024, S1, S1, 1 << 30, 1 << 30, 4096}; SplitOrder S{64, G, (int)blockIdx.x};
          EpiS E{S0, (bf16*)(ws + WS_WL), 64}; pg8::gemm_phase<EpiS, SplitOrder, true, true>(lds, g, S, E); }
    } SEAM(12);
    if (IN(13)) { fin_pass(a, lane, wave); }
#undef IN
#undef SEAM
}

extern "C" void kernel_launch(void* const* d_in, const int* in_sizes, int n_in, void* d_out, int out_size, void* d_ws, size_t ws_size, hipStream_t stream) {
    static int grid = 0;
    if (grid == 0) {
        if (n_in != 25 || ws_size < WS_END) { fprintf(stderr, "kernel_launch: unexpected n_in %d / ws %zu\n", n_in, ws_size); grid = -1; return; }
        int dev = 0, cus = 0, per_cu = 0;
        hipGetDevice(&dev); hipDeviceGetAttribute(&cus, hipDeviceAttributeMultiprocessorCount, dev);
        if (hipFuncSetAttribute((const void*)mk_fwd, hipFuncAttributeMaxDynamicSharedMemorySize, LDS_BYTES) != hipSuccess) { fprintf(stderr, "kernel_launch: hipFuncSetAttribute failed\n"); grid = -1; return; }
        if (hipOccupancyMaxActiveBlocksPerMultiprocessor(&per_cu, (const void*)mk_fwd, 512, LDS_BYTES) != hipSuccess || per_cu < 1) { fprintf(stderr, "kernel_launch: occupancy query says %d\n", per_cu); per_cu = 1; }
        (void)hipGetLastError();
        grid = cus * 1;
    }
    if (grid < 0) return;
    if (hipMemsetAsync((char*)d_ws + WS_BAR, 0, WS_BAR_BYTES, stream) != hipSuccess) { fprintf(stderr, "kernel_launch: memset failed\n"); return; }
    Args a{};
    for (int i = 0; i < 25; ++i) a.in[i] = (const float*)d_in[i];
    a.out = (float*)d_out; a.ws = (unsigned char*)d_ws;
    constexpr int NL = MK_N_LAUNCHES;
    for (int li = 0; li < NL; ++li) {
        a.ph_lo = (NL == 1) ? 0 : li; a.ph_hi = (NL == 1) ? NPHASE : li + 1;
        void* args[] = {&a};
        hipError_t e = hipLaunchCooperativeKernel((const void*)mk_fwd, dim3(grid), dim3(512), args, LDS_BYTES, stream);
        if (e != hipSuccess) { fprintf(stderr, "kernel_launch: cooperative launch %d failed: %s\n", li, hipGetErrorString(e)); break; }
    }
}
```

```cpp
#include <hip/hip_runtime.h>
#include <hip/hip_cooperative_groups.h>
#include <cstdio>
#include <cstdint>
namespace cg = cooperative_groups;
namespace pg8 {
#define PG8_LAS __attribute__((address_space(3)))
typedef unsigned short bf16_t;
typedef short bf16x8 __attribute__((ext_vector_type(8)));
typedef float f32x4 __attribute__((ext_vector_type(4)));
typedef unsigned u32x4 __attribute__((ext_vector_type(4)));
constexpr int BM = 256, BK = 64, HALF = 128, HTB = HALF * BK * 2  , STAGE_BYTES = 8 * HTB, NXCD = 8, WGM = 8;

__host__ __device__ __forceinline__ int lds_byte(int r, int c) { const int st = (r >> 4) * 2 + (c >> 5), rr = r & 15, cc = c & 31, ob = rr * 64 + cc * 2; return st * 1024 + (ob ^ (((ob >> 9) & 1) << 5)); }
__host__ __device__ __forceinline__ void stage_rc(int b, int& R, int& C) { const int st = b / 1024, sb = b % 1024, swz = sb ^ (((sb >> 9) & 1) << 5); R = (st >> 1) * 16 + swz / 64; C = (st & 1) * 32 + (swz % 64) / 2; }
__host__ __device__ __forceinline__ int perm32(int rho) { const int n = rho >> 4, i = rho & 15; return 8 * (i >> 2) + 4 * n + (i & 3); }

struct Unit { int pm, pn, kq; };
struct Gemm { const bf16_t* A; const bf16_t* Bt; int M, N, K; const bf16_t* A1; const bf16_t* A2; int pn1, pn2; int ld;
    __device__ __forceinline__ const char* abase(int pn) const { return (const char*)(pn < pn1 ? A : (pn < pn2 ? A1 : A2)); } };

struct StaticOrder {
    int nM, nN, nwg, G, c;
    __host__ __device__ void init(int M, int N, int G_, int c_) { nM = M / BM; nN = N / BM; nwg = nM * nN; G = G_; c = c_; }
    __host__ __device__ bool next(int i, Unit& u) const {
        const long L = (long)i * G + c; if (L >= nwg) return false;
        int wgid = (int)L; { const int q = nwg / NXCD, r = nwg % NXCD, xcd = wgid % NXCD, off = wgid / NXCD; wgid = (xcd < r ? xcd * (q + 1) : r * (q + 1) + (xcd - r) * q) + off; }
        const int nig = WGM * nN, gid = wgid / nig, fm = gid * WGM, gsz = (nM - fm) < WGM ? (nM - fm) : WGM;
        u.pm = fm + ((wgid % nig) % gsz); u.pn = (wgid % nig) / gsz; u.kq = 0; return true;
    }
    __device__ __forceinline__ void a_ready(const Unit&) const {}
    __device__ __forceinline__ void done(const Unit&) const {}
};

typedef float f32x2 __attribute__((ext_vector_type(2)));
typedef __bf16 bf16x2_t __attribute__((ext_vector_type(2)));
__device__ __forceinline__ unsigned cvt_pk_bf16(float lo, float hi) { const f32x2 v = {lo, hi}; return __builtin_bit_cast(unsigned, __builtin_convertvector(v, bf16x2_t)); }
template <class Epi, class Sched, bool ALIGN_EPI = false, bool SP2 = false>
__device__ __forceinline__ void gemm_phase(PG8_LAS unsigned char* lds, const Gemm g, const Sched& S, const Epi& E) {
    const int tid = threadIdx.x, wid = __builtin_amdgcn_readfirstlane(tid >> 6), lane = tid & 63, wr = wid >> 2, wc = wid & 3, fr = lane & 15, fq = lane >> 4;
    const int K = g.K, nt = K / BK;
    unsigned voffA[2], voffB[2];
#pragma unroll
    for (int i = 0; i < 2; ++i) { int R, C; stage_rc(tid * 16 + i * 8192, R, C); const int Rb = Epi::PERM ? ((R & ~31) + perm32(R & 31)) : R;
        voffA[i] = (unsigned)(R * g.ld + C) * 2u; voffB[i] = (unsigned)(Rb * g.ld + C) * 2u; }
    const size_t kstep = (size_t)(BK * 2);
    const size_t hstep = (size_t)HALF * g.ld * 2;
    const size_t tstep = 2 * hstep;
    const unsigned ldsw = (unsigned)wid * 1024u;
    const int aoff = lds_byte(wr * 64 + fr, fq * 8), boff = lds_byte(wc * 32 + fr, fq * 8);
#define PG8_SA(b, h) (((b) * 2 + (h)) * HTB)
#define PG8_SB(b, h) ((4 + (b) * 2 + (h)) * HTB)
#define PG8_STAGE(bufoff, gbase, voff) do { _Pragma("unroll") for (int _i = 0; _i < 2; ++_i) \
        __builtin_amdgcn_global_load_lds((const unsigned*)((const char*)(gbase) + (voff)[_i]), (PG8_LAS unsigned*)(lds + (bufoff) + ldsw + _i * 8192), 16, 0, 0); } while (0)
#define PG8_LDA(dst, b, h) do { _Pragma("unroll") for (int m = 0; m < 4; ++m) _Pragma("unroll") for (int k = 0; k < 2; ++k) dst[m][k] = *(const PG8_LAS bf16x8*)(lds + PG8_SA(b, h) + aoff + m * 2048 + k * 1024); } while (0)
#define PG8_LDB(dst, b, h) do { _Pragma("unroll") for (int n = 0; n < 2; ++n) _Pragma("unroll") for (int k = 0; k < 2; ++k) dst[n][k] = *(const PG8_LAS bf16x8*)(lds + PG8_SB(b, h) + boff + n * 2048 + k * 1024); } while (0)
#define PG8_MMA(ai, bj, At, Bt) do { __builtin_amdgcn_s_setprio(1); _Pragma("unroll") for (int m = 0; m < 4; ++m) _Pragma("unroll") for (int n = 0; n < 2; ++n) _Pragma("unroll") for (int k = 0; k < 2; ++k) \
        acc[ai][bj][m][n] = __builtin_amdgcn_mfma_f32_16x16x32_bf16(Bt[n][k], At[m][k], acc[ai][bj][m][n], 0, 0, 0); __builtin_amdgcn_s_setprio(0); } while (0)
#define PG8_WAIT_V(n) asm volatile("s_waitcnt vmcnt(" #n ")" ::: "memory")
#define PG8_WAIT_L(n) asm volatile("s_waitcnt lgkmcnt(" #n ")" ::: "memory")
#define PG8_BAR __builtin_amdgcn_s_barrier()
#define PG8_SCHED __builtin_amdgcn_sched_barrier(0)
    Unit cur, nxt; int ui = 0;
    if (!S.next(0, cur)) return;
    f32x4 acc[2][2][4][2];
#pragma unroll
    for (int a = 0; a < 2; ++a)
#pragma unroll
        for (int b = 0; b < 2; ++b)
#pragma unroll
            for (int m = 0; m < 4; ++m)
#pragma unroll
                for (int n = 0; n < 2; ++n) acc[a][b][m][n] = (f32x4){0.f, 0.f, 0.f, 0.f};
    bf16x8 At[4][2], B0[2][2], B1[2][2];
    const size_t qstep = (size_t)K * 2;
    const char* cA = g.abase(cur.pn) + (size_t)cur.pm * tstep + (size_t)cur.kq * qstep; const char* cB = (const char*)g.Bt + (size_t)cur.pn * tstep + (size_t)cur.kq * qstep;
    S.a_ready(cur);
    if constexpr (SP2) {
        PG8_STAGE(PG8_SB(0, 0), cB, voffB); PG8_STAGE(PG8_SB(0, 1), cB + hstep, voffB); PG8_STAGE(PG8_SA(0, 0), cA, voffA); PG8_STAGE(PG8_SA(0, 1), cA + hstep, voffA);
        if (wr == 1) PG8_BAR;
        PG8_WAIT_V(2); PG8_BAR;
        PG8_STAGE(PG8_SB(1, 0), cB + kstep, voffB); PG8_STAGE(PG8_SA(1, 0), cA + kstep, voffA); PG8_STAGE(PG8_SB(1, 1), cB + hstep + kstep, voffB);
        PG8_WAIT_V(6); PG8_BAR;
    } else {
        PG8_STAGE(PG8_SB(0, 0), cB, voffB); PG8_STAGE(PG8_SA(0, 0), cA, voffA); PG8_STAGE(PG8_SB(0, 1), cB + hstep, voffB); PG8_STAGE(PG8_SA(0, 1), cA + hstep, voffA);
        if (wr == 1) PG8_BAR;
        PG8_WAIT_V(4); PG8_BAR;
        PG8_STAGE(PG8_SB(1, 0), cB + kstep, voffB); PG8_STAGE(PG8_SA(1, 0), cA + kstep, voffA); PG8_STAGE(PG8_SB(1, 1), cB + hstep + kstep, voffB);
        PG8_WAIT_V(6); PG8_BAR;
    }
    for (;;) {
        const bool has_next = S.next(ui + 1, nxt);
        const char* nA = has_next ? g.abase(nxt.pn) + (size_t)nxt.pm * tstep + (size_t)nxt.kq * qstep : cA; const char* nB = has_next ? (const char*)g.Bt + (size_t)nxt.pn * tstep + (size_t)nxt.kq * qstep : cB;
        for (int t = 0; t < nt; t += 2) {
            const bool last = (t == nt - 2);
            const char* a1 = cA + (size_t)(t + 1) * kstep;
            const char* a2 = last ? nA : cA + (size_t)(t + 2) * kstep; const char* b2 = last ? nB : cB + (size_t)(t + 2) * kstep;
            const char* a3 = a2 + kstep; const char* b3 = b2 + kstep;
            if (last && has_next) S.a_ready(nxt);
            if constexpr (SP2) {
            PG8_LDB(B0, 0, 0); PG8_LDB(B1, 0, 1); PG8_SCHED; PG8_LDA(At, 0, 0); PG8_STAGE(PG8_SA(1, 1), a1 + hstep, voffA);
            PG8_WAIT_V(8); PG8_WAIT_L(0); PG8_BAR; PG8_MMA(0, 0, At, B0); PG8_MMA(0, 1, At, B1); PG8_BAR; PG8_SCHED;
            PG8_LDA(At, 0, 1); PG8_STAGE(PG8_SB(0, 0), b2, voffB); PG8_STAGE(PG8_SB(0, 1), b2 + hstep, voffB); PG8_STAGE(PG8_SA(0, 0), a2, voffA);
            PG8_WAIT_V(8); PG8_WAIT_L(0); PG8_BAR; PG8_MMA(1, 0, At, B0); PG8_MMA(1, 1, At, B1); PG8_BAR; PG8_SCHED;
            PG8_LDB(B0, 1, 0); PG8_LDB(B1, 1, 1); PG8_SCHED; PG8_LDA(At, 1, 0); PG8_STAGE(PG8_SA(0, 1), a2 + hstep, voffA);
            PG8_WAIT_V(8); PG8_WAIT_L(0); PG8_BAR; PG8_MMA(0, 0, At, B0); PG8_MMA(0, 1, At, B1); PG8_BAR; PG8_SCHED;
            PG8_LDA(At, 1, 1); PG8_STAGE(PG8_SB(1, 0), b3, voffB); PG8_STAGE(PG8_SB(1, 1), b3 + hstep, voffB); PG8_STAGE(PG8_SA(1, 0), a3, voffA);
            PG8_WAIT_V(8); PG8_WAIT_L(0); PG8_BAR; PG8_MMA(1, 0, At, B0); PG8_MMA(1, 1, At, B1); PG8_BAR; PG8_SCHED;
            } else {
            PG8_LDB(B0, 0, 0); PG8_SCHED; PG8_LDA(At, 0, 0); PG8_STAGE(PG8_SA(1, 1), a1 + hstep, voffA);
            PG8_WAIT_L(8); PG8_BAR; PG8_WAIT_L(0); PG8_MMA(0, 0, At, B0); PG8_BAR; PG8_SCHED;
            PG8_LDB(B1, 0, 1); PG8_STAGE(PG8_SB(0, 0), b2, voffB);
            PG8_BAR; PG8_WAIT_L(0); PG8_MMA(0, 1, At, B1); PG8_BAR;
            PG8_LDA(At, 0, 1); PG8_STAGE(PG8_SA(0, 0), a2, voffA);
            PG8_BAR; PG8_WAIT_L(0); PG8_MMA(1, 0, At, B0); PG8_BAR; PG8_SCHED;
            PG8_STAGE(PG8_SB(0, 1), b2 + hstep, voffB);
            PG8_WAIT_V(6); PG8_BAR; PG8_MMA(1, 1, At, B1); PG8_BAR;
            PG8_LDB(B0, 1, 0); PG8_SCHED; PG8_LDA(At, 1, 0); PG8_STAGE(PG8_SA(0, 1), a2 + hstep, voffA);
            PG8_WAIT_L(8); PG8_BAR; PG8_WAIT_L(0); PG8_MMA(0, 0, At, B0); PG8_BAR; PG8_SCHED;
            PG8_LDB(B1, 1, 1); PG8_STAGE(PG8_SB(1, 0), b3, voffB);
            PG8_BAR; PG8_WAIT_L(0); PG8_MMA(0, 1, At, B1); PG8_BAR;
            PG8_LDA(At, 1, 1); PG8_STAGE(PG8_SA(1, 0), a3, voffA);
            PG8_BAR; PG8_WAIT_L(0); PG8_MMA(1, 0, At, B0); PG8_BAR; PG8_SCHED;
            PG8_STAGE(PG8_SB(1, 1), b3 + hstep, voffB);
            PG8_WAIT_V(6); PG8_BAR; PG8_MMA(1, 1, At, B1); PG8_BAR;
            }
        }
        if constexpr (ALIGN_EPI) { if (wr == 0) PG8_BAR; }
        if constexpr (!Epi::AFTER_DRAIN) { E(acc, cur, wr, wc, fr, fq); S.done(cur); }
        if (!has_next) break;
#pragma unroll
        for (int a = 0; a < 2; ++a)
#pragma unroll
            for (int b = 0; b < 2; ++b)
#pragma unroll
                for (int m = 0; m < 4; ++m)
#pragma unroll
                    for (int n = 0; n < 2; ++n) acc[a][b][m][n] = (f32x4){0.f, 0.f, 0.f, 0.f};
        cur = nxt; cA = nA; cB = nB; ++ui;
        if constexpr (ALIGN_EPI) { if (wr == 1) PG8_BAR; }
    }
    PG8_WAIT_V(0);
    if constexpr (!ALIGN_EPI) { if (wr == 0) PG8_BAR; }
    PG8_BAR;
    if constexpr (Epi::AFTER_DRAIN) { E.fused(acc, cur, wr, wc, fr, fq, lds, wid, lane); S.done(cur); }
#undef PG8_SA
#undef PG8_SB
#undef PG8_STAGE
#undef PG8_LDA
#undef PG8_LDB
#undef PG8_MMA
#undef PG8_WAIT_V
#undef PG8_WAIT_L
#undef PG8_BAR
#undef PG8_SCHED
}
}

#ifndef MK_N_LAUNCHES
#define MK_N_LAUNCHES 1
#endif
#define LAS __attribute__((address_space(3)))
typedef unsigned short bf16;
typedef float f32x4 __attribute__((ext_vector_type(4)));
typedef float f32x2 __attribute__((ext_vector_type(2)));
typedef unsigned u32x4 __attribute__((ext_vector_type(4)));
typedef unsigned u32x2 __attribute__((ext_vector_type(2)));
typedef short bf16x8 __attribute__((ext_vector_type(8)));

constexpr int D = 1024, MP = 4096, ML = 16384, M = MP + ML, NIN = 7200, DFF = 4096;
constexpr float EPS = 1e-6f;
constexpr size_t MiB = 1u << 20;
constexpr size_t WS_MOD = 0;
constexpr size_t WS_BAR = 512 * 1024, WS_BAR_BYTES = 16384;
constexpr size_t WS_SSQ1 = 1 * MiB;
constexpr size_t WS_SSQ2 = 2560 * 1024;
constexpr size_t WS_LR = 4 * MiB;
constexpr size_t WS_WL = 8 * MiB;
constexpr size_t WS_WG = WS_WL + (size_t)2304 * 1024 * 2;
constexpr size_t WS_WY = WS_WG + (size_t)3072 * 1024 * 2;
constexpr size_t WS_WO = WS_WY + (size_t)4096 * 1024 * 2;
constexpr size_t WS_W1 = WS_WO + (size_t)1024 * 1024 * 2;
constexpr size_t WS_W2 = WS_W1 + (size_t)4096 * 1024 * 2;
constexpr size_t WS_S0 = 48 * MiB, SLOT = 40 * MiB;
static_assert(WS_W2 + (size_t)1024 * 4096 * 2 <= WS_S0, "ws map");
constexpr size_t WS_END = WS_S0 + 5 * SLOT;
constexpr int LDS_BYTES = 147456;

struct Args { const float* in[25]; float* out; unsigned char* ws; int ph_lo, ph_hi; };

__device__ __forceinline__ float bf2f(unsigned v) { return __uint_as_float(v << 16); }
__device__ __forceinline__ float bflo(unsigned w) { return __uint_as_float(w << 16); }
__device__ __forceinline__ float bfhi(unsigned w) { return __uint_as_float(w & 0xffff0000u); }
__device__ __forceinline__ unsigned pk2(float lo, float hi) { return pg8::cvt_pk_bf16(lo, hi); }
__device__ __forceinline__ float wave_sum(float v) {
#pragma unroll
    for (int o = 1; o < 64; o <<= 1) v += __shfl_xor(v, o);
    return v;
}
__device__ __forceinline__ float rcpf_(float x) { return __builtin_amdgcn_rcpf(x); }
__device__ __forceinline__ float expf_(float x) { return __builtin_amdgcn_exp2f(x * 1.4426950408889634f); }
__device__ __forceinline__ float logf_(float x) { return __builtin_amdgcn_logf(x) * 0.6931471805599453f; }
__device__ __forceinline__ float sigmoidf_(float x) { return rcpf_(1.0f + expf_(-x)); }
__device__ __forceinline__ float siluf_(float x) { return x * sigmoidf_(x); }
__device__ __forceinline__ float gelu_tanh(float x) { const float t = x * (1.5957691216f + 0.0713548163f * x * x); return x * rcpf_(1.0f + expf_(-t)); }
template <int ACT> __device__ __forceinline__ float actf(float x) {
    if (ACT == 1) return gelu_tanh(x);
    if (ACT == 2) return siluf_(x);
    if (ACT == 3) return sigmoidf_(x);
    if (ACT == 4) { const float m = fmaxf(x, 0.f); return m * m; }
    return x;
}
#define LDS_WAIT() asm volatile("s_waitcnt lgkmcnt(0)" ::: "memory")

#define XB_TMO      128
#define XB_XCNT(j)  (256  + 64 * (j))
#define XB_XSUB(j)  (1280 + 64 * (j))
#define XB_XGEN(j)  (2304 + 64 * (j))
#define XB_TOP      3328
#define XB_TOPGEN   3392
#define XCD_BAR_WORDS 3456
#define XB_SPIN_CAP (1u << 18)

__device__ __forceinline__ unsigned xb_ld(unsigned* p)              { return __hip_atomic_load(p, __ATOMIC_RELAXED, __HIP_MEMORY_SCOPE_AGENT); }
__device__ __forceinline__ unsigned xb_add(unsigned* p, unsigned v) { return __hip_atomic_fetch_add(p, v, __ATOMIC_RELAXED, __HIP_MEMORY_SCOPE_AGENT); }
__device__ __forceinline__ unsigned xb_xcc_id() { return (unsigned)__builtin_amdgcn_s_getreg((3 << 11) | 20) & 0xFu; }
#define XB_SPIN(cond, bar) do { unsigned _sp = 0; while (cond) { __builtin_amdgcn_s_sleep(1); \
    if ((++_sp & 255u) == 0u) { if (xb_ld(&(bar)[XB_TMO])) break; if (_sp > XB_SPIN_CAP) { atomicAdd(&(bar)[XB_TMO], 1u); break; } } } } while (0)

struct XcdBarrier {
    unsigned* bar; unsigned x;
    volatile LAS unsigned* st;
};

__device__ __forceinline__ XcdBarrier xcd_barrier_post(unsigned* bar, volatile LAS unsigned* st) {
    XcdBarrier b; b.bar = bar; b.x = xb_xcc_id(); b.st = st;
    if (threadIdx.x == 0) (void)xb_add(&bar[XB_XCNT(b.x)], 1u);
    return b;
}
__device__ __forceinline__ void xcd_barrier_complete(unsigned* bar, unsigned x, unsigned& nloc, unsigned& nx) {
    const unsigned G = gridDim.x * gridDim.y * gridDim.z;
    unsigned sum, cnt, mine, sp = 0u;
    for (;;) {
        sum = 0u; cnt = 0u; mine = 0u;
#pragma unroll
        for (unsigned j = 0; j < 16; ++j) { const unsigned c = xb_ld(&bar[XB_XCNT(j)]); sum += c; cnt += (c > 0u) ? 1u : 0u; mine = (j == x) ? c : mine; }
        if (sum == G) break;
        __builtin_amdgcn_s_sleep(1);
        if ((++sp & 255u) == 0u) { if (xb_ld(&bar[XB_TMO])) break; if (sp > XB_SPIN_CAP) { atomicAdd(&bar[XB_TMO], 1u); break; } }
    }
    nloc = mine > 0u ? mine : 1u; nx = cnt > 0u ? cnt : 1u;
}

__device__ __forceinline__ void xcd_barrier(const XcdBarrier& b) {
    asm volatile("s_waitcnt vmcnt(0)" ::: "memory");
    __syncthreads();
    if (threadIdx.x == 0) {
        unsigned* bar = b.bar;
        __builtin_amdgcn_s_waitcnt(0);
        unsigned nloc = b.st[0], nx = b.st[1];
        if (nloc == 0u) { xcd_barrier_complete(bar, b.x, nloc, nx); b.st[0] = nloc; b.st[1] = nx; }
        const unsigned old = xb_add(&bar[XB_XSUB(b.x)], 1u);
        const unsigned gen = old / nloc;
        if (old + 1u == (gen + 1u) * nloc) {
            __builtin_amdgcn_fence(__ATOMIC_RELEASE, "agent");
            asm volatile("s_waitcnt vmcnt(0)" ::: "memory");
            const unsigned og = xb_add(&bar[XB_TOP], 1u);
            const unsigned tg = og / nx;
            if (og + 1u == (tg + 1u) * nx) xb_add(&bar[XB_TOPGEN], 1u);
            else XB_SPIN(xb_ld(&bar[XB_TOPGEN]) == tg, bar);
            __builtin_amdgcn_fence(__ATOMIC_ACQUIRE, "agent");
            xb_add(&bar[XB_XGEN(b.x)], 1u);
            asm volatile("s_waitcnt vmcnt(0)" ::: "memory");
        } else {
            XB_SPIN(xb_ld(&bar[XB_XGEN(b.x)]) == gen, bar);
            __builtin_amdgcn_fence(__ATOMIC_ACQUIRE, "agent");
            asm volatile("s_waitcnt vmcnt(0)" ::: "memory");
        }
    }
    __syncthreads();
}

template <int ACT> __device__ __forceinline__ void store_tile(const f32x4 (&acc)[2][2][4][2], bf16* base, int ld, int row0, int col0) {
#pragma unroll
    for (int ai = 0; ai < 2; ++ai)
#pragma unroll
        for (int m = 0; m < 4; ++m) { bf16* rowp = base + (size_t)(row0 + ai * 128 + m * 16) * ld + col0;
#pragma unroll
            for (int bj = 0; bj < 2; ++bj) { const f32x4 v0 = acc[ai][bj][m][0], v1 = acc[ai][bj][m][1];
                u32x4 w; w.x = pk2(actf<ACT>(v0[0]), actf<ACT>(v0[1])); w.y = pk2(actf<ACT>(v0[2]), actf<ACT>(v0[3]));
                w.z = pk2(actf<ACT>(v1[0]), actf<ACT>(v1[1])); w.w = pk2(actf<ACT>(v1[2]), actf<ACT>(v1[3]));
                *(u32x4*)(rowp + bj * 128) = w; } }
}
struct EpiLG {
    static constexpr bool PERM = true, AFTER_DRAIN = false;
    bf16* ZX; bf16* ZG; float* LR; bf16* Q; bf16* K; bf16* V; bf16* G;
    __device__ __forceinline__ void operator()(const f32x4 (&acc)[2][2][4][2], const pg8::Unit& u, int wr, int wc, int fr, int fq) const {
        const int row0 = u.pm * 256 + wr * 64 + fr, cw = wc * 32 + 8 * fq;
        if (u.pn < 4) store_tile<0>(acc, ZX, D, row0, u.pn * 256 + cw);
        else if (u.pn < 8) store_tile<1>(acc, ZG, D, row0, (u.pn - 4) * 256 + cw);
        else if (u.pn == 8) { if (wc == 0) {
#pragma unroll
            for (int ai = 0; ai < 2; ++ai)
#pragma unroll
                for (int m = 0; m < 4; ++m) { float* rp = LR + (size_t)(row0 + ai * 128 + m * 16) * 32 + 8 * fq;
                    *(f32x4*)rp = acc[ai][0][m][0]; *(f32x4*)(rp + 4) = acc[ai][0][m][1]; } } }
        else if (u.pn < 11) store_tile<0>(acc, Q, 512, row0, (u.pn - 9) * 256 + cw);
        else if (u.pn < 13) store_tile<0>(acc, K, 512, row0, (u.pn - 11) * 256 + cw);
        else if (u.pn < 17) store_tile<0>(acc, V, D, row0, (u.pn - 13) * 256 + cw);
        else store_tile<2>(acc, G, D, row0, (u.pn - 17) * 256 + cw);
    }
};
struct EpiYY {
    static constexpr bool PERM = true, AFTER_DRAIN = false;
    bf16* YA; bf16* YB;
    __device__ __forceinline__ void operator()(const f32x4 (&acc)[2][2][4][2], const pg8::Unit& u, int wr, int wc, int fr, int fq) const {
        store_tile<0>(acc, u.pn < 4 ? YA : YB, D, u.pm * 256 + wr * 64 + fr, (u.pn & 3) * 256 + wc * 32 + 8 * fq);
    }
};
struct EpiMM {
    static constexpr bool PERM = true, AFTER_DRAIN = false;
    const bf16* YA; const bf16* YB; bf16* MM;
    __device__ __forceinline__ void operator()(const f32x4 (&acc)[2][2][4][2], const pg8::Unit& u, int wr, int wc, int fr, int fq) const {
        const int row0 = u.pm * 256 + wr * 64 + fr, c0 = u.pn * 128 + wc * 32 + 8 * fq;
#pragma unroll
        for (int ai = 0; ai < 2; ++ai)
#pragma unroll
            for (int m = 0; m < 4; ++m) { const size_t off = (size_t)(row0 + ai * 128 + m * 16) * D + c0;
                const u32x4 ya = *(const u32x4*)(YA + off), yb = *(const u32x4*)(YB + off);
                const f32x4 a0 = acc[ai][0][m][0], a1 = acc[ai][0][m][1], b0 = acc[ai][1][m][0], b1 = acc[ai][1][m][1];
#define MMV(av, bv, yv, zv) ({ const float ea_ = 1.0f + expf_(-(av)), eb_ = 1.0f + expf_(-(bv)); ((yv) * eb_ + (zv) * ea_) * rcpf_(ea_ * eb_); })
                u32x4 w;
                w.x = pk2(MMV(a0[0], b0[0], bflo(ya.x), bflo(yb.x)), MMV(a0[1], b0[1], bfhi(ya.x), bfhi(yb.x)));
                w.y = pk2(MMV(a0[2], b0[2], bflo(ya.y), bflo(yb.y)), MMV(a0[3], b0[3], bfhi(ya.y), bfhi(yb.y)));
                w.z = pk2(MMV(a1[0], b1[0], bflo(ya.z), bflo(yb.z)), MMV(a1[1], b1[1], bfhi(ya.z), bfhi(yb.z)));
                w.w = pk2(MMV(a1[2], b1[2], bflo(ya.w), bflo(yb.w)), MMV(a1[3], b1[3], bfhi(ya.w), bfhi(yb.w)));
#undef MMV
                *(u32x4*)(MM + off) = w; }
    }
};
struct EpiN {
    static constexpr bool PERM = true, AFTER_DRAIN = false;
    bf16* O; float* SSQ;
    __device__ __forceinline__ void operator()(const f32x4 (&acc)[2][2][4][2], const pg8::Unit& u, int wr, int wc, int fr, int fq) const {
        const int row0 = u.pm * 256 + wr * 64 + fr;
        store_tile<0>(acc, O, D, row0, u.pn * 256 + wc * 32 + 8 * fq);
#pragma unroll
        for (int ai = 0; ai < 2; ++ai)
#pragma unroll
            for (int m = 0; m < 4; ++m) { float ss = 0.f;
#pragma unroll
                for (int bj = 0; bj < 2; ++bj)
#pragma unroll
                    for (int n = 0; n < 2; ++n) { const f32x4 v = acc[ai][bj][m][n]; ss += (v[0] * v[0] + v[1] * v[1]) + (v[2] * v[2] + v[3] * v[3]); }
                ss += __shfl_xor(ss, 16); ss += __shfl_xor(ss, 32);
                if (fq == 0) SSQ[(size_t)(row0 + ai * 128 + m * 16) * 16 + u.pn * 4 + wc] = ss; }
    }
};
struct SplitOrder {
    int pm0, G, c;
    __device__ __forceinline__ bool next(int i, pg8::Unit& u) const { const int L = i * G + c; if (L >= 256) return false; u.kq = L & 3; u.pn = (L >> 2) & 3; u.pm = pm0 + (L >> 4); return true; }
    __device__ __forceinline__ void a_ready(const pg8::Unit&) const {}
    __device__ __forceinline__ void done(const pg8::Unit&) const {}
};
struct EpiS {
    static constexpr bool PERM = true, AFTER_DRAIN = false;
    bf16* O; bf16* P; int pm0;
    __device__ __forceinline__ void operator()(const f32x4 (&acc)[2][2][4][2], const pg8::Unit& u, int wr, int wc, int fr, int fq) const {
        const int cw = u.pn * 256 + wc * 32 + 8 * fq;
        if (u.kq == 0) store_tile<0>(acc, O, D, u.pm * 256 + wr * 64 + fr, cw);
        else store_tile<0>(acc, P + (size_t)(u.kq - 1) * 4096 * 1024, D, (u.pm - pm0) * 256 + wr * 64 + fr, cw);
    }
};
struct EpiH {
    static constexpr bool PERM = true, AFTER_DRAIN = false;
    bf16* Hd;
    __device__ __forceinline__ void operator()(const f32x4 (&acc)[2][2][4][2], const pg8::Unit& u, int wr, int wc, int fr, int fq) const {
        store_tile<4>(acc, Hd, DFF, u.pm * 256 + wr * 64 + fr, u.pn * 256 + wc * 32 + 8 * fq);
    }
};

template <bool ILV = false> __device__ __forceinline__ void tr_item(const float* W, int ld, int col0, int ncols, int K, bf16* WT, int row_off, LAS float* scr, int item, int lane) {
    const int nblk = ncols >> 5, kb = item / nblk, nb = item - kb * nblk, k0 = 64 * kb, n0 = 32 * nb;
    const int r0 = ILV ? ((n0 & 1023) >> 7) * 256 + (n0 & 127) + (n0 >> 10) * 128 : n0;
#pragma unroll 8
    for (int i = 0; i < 32; ++i) { const int kk = 2 * i + (lane >> 5); scr[kk * 33 + (lane & 31)] = W[(size_t)(k0 + kk) * ld + col0 + n0 + (lane & 31)]; }
    LDS_WAIT(); asm volatile("" ::: "memory");
    const int c = lane & 7;
#pragma unroll
    for (int j = 0; j < 4; ++j) { const int n = (lane >> 3) + 8 * j; const LAS float* s = scr + (8 * c) * 33 + n;
        u32x4 o; o.x = pk2(s[0 * 33], s[1 * 33]); o.y = pk2(s[2 * 33], s[3 * 33]); o.z = pk2(s[4 * 33], s[5 * 33]); o.w = pk2(s[6 * 33], s[7 * 33]);
        *(u32x4*)(WT + (size_t)(row_off + r0 + n) * K + k0 + 8 * c) = o; }
    LDS_WAIT(); asm volatile("" ::: "memory");
}
__device__ __forceinline__ void phase0(const Args& a, LAS unsigned char* lds, int tid, int lane, int wave) {
    LAS float* SIL = (LAS float*)lds;
    LAS float* RED = (LAS float*)(lds + 36864);
    LAS float* SCR = (LAS float*)(lds + 36864 + 18432 + wave * 8448);
    unsigned char* ws = a.ws;
    float* MOD = (float*)(ws + WS_MOD);
    for (int i = tid; i < 9 * 1024; i += 512) { const float c = i < 8192 ? a.in[4][i] : a.in[5][i - 8192]; SIL[i] = siluf_(c); }
    __syncthreads();
    for (int it = blockIdx.x; it < 96; it += gridDim.x) {
        const float* wp = a.in[6] + (size_t)(wave * 128) * 6144 + it * 64 + lane;
        float acc[9];
#pragma unroll
        for (int j = 0; j < 9; ++j) acc[j] = 0.f;
#pragma unroll 8
        for (int k = 0; k < 128; ++k) { const float w = wp[(size_t)k * 6144];
#pragma unroll
            for (int j = 0; j < 9; ++j) acc[j] += SIL[j * 1024 + wave * 128 + k] * w; }
#pragma unroll
        for (int j = 0; j < 9; ++j) RED[(wave * 9 + j) * 64 + lane] = acc[j];
        __syncthreads();
        for (int o = tid; o < 576; o += 512) { const int j = o >> 6, l = o & 63; float s = a.in[7][it * 64 + l];
#pragma unroll
            for (int w = 0; w < 8; ++w) s += RED[(w * 9 + j) * 64 + l];
            MOD[j * 6144 + it * 64 + l] = s; }
        __syncthreads();
    }
    bf16* WL = (bf16*)(ws + WS_WL); bf16* WG = (bf16*)(ws + WS_WG); bf16* WY = (bf16*)(ws + WS_WY);
    bf16* WO = (bf16*)(ws + WS_WO); bf16* W1 = (bf16*)(ws + WS_W1); bf16* W2 = (bf16*)(ws + WS_W2);
    const float* w_in = a.in[9];
    const bool split = gridDim.x >= 192;
    const int gw = split ? ((int)blockIdx.x - 96) * 8 + wave : (int)blockIdx.x * 8 + wave, NGW = split ? ((int)gridDim.x - 96) * 8 : (int)gridDim.x * 8;
    constexpr int NITEMS = 1024 + 16 + 1536 + 1024 + 512 + 512 + 512 + 2048 + 2048;
    for (int it = gw; it < NITEMS && gw >= 0; it += NGW) {
        int r = it;
        if (r < 1024) { tr_item(w_in, NIN, 0, 2048, 1024, WL, 0, SCR, r, lane); continue; } r -= 1024;
        if (r < 16) { tr_item(w_in, NIN, 5120, 32, 1024, WL, 2048, SCR, r, lane); continue; } r -= 16;
        if (r < 1536) { tr_item(w_in, NIN, 2048, 3072, 1024, WG, 0, SCR, r, lane); continue; } r -= 1536;
        if (r < 1024) { tr_item<true>(w_in, NIN, 5152, 2048, 1024, WY, 0, SCR, r, lane); continue; } r -= 1024;
        if (r < 512) { tr_item(a.in[17], 1024, 0, 1024, 1024, WY, 2048, SCR, r, lane); continue; } r -= 512;
        if (r < 512) { tr_item(a.in[21], 1024, 0, 1024, 1024, WY, 3072, SCR, r, lane); continue; } r -= 512;
        if (r < 512) { tr_item(a.in[22], 1024, 0, 1024, 1024, WO, 0, SCR, r, lane); continue; } r -= 512;
        if (r < 2048) { tr_item(a.in[23], 4096, 0, 4096, 1024, W1, 0, SCR, r, lane); continue; } r -= 2048;
        tr_item(a.in[24], 1024, 0, 1024, 4096, W2, 0, SCR, r, lane);
    }
    { u32x4* z = (u32x4*)(WL + (size_t)2080 * 1024); const u32x4 zz = {0u, 0u, 0u, 0u};
      for (int i = blockIdx.x * 512 + tid; i < 224 * 1024 / 8; i += gridDim.x * 512) z[i] = zz; }
}

__device__ __forceinline__ const float* xrow(const Args& a, int m) { return m < MP ? a.in[0] + (size_t)m * D : a.in[1] + (size_t)(m - MP) * D; }
__device__ __forceinline__ int modgrp(int m) { return m < MP ? 8 : ((m - MP) >> 11); }
__device__ __forceinline__ void phase1(const Args& a, bf16* H, int lane, int wave) {
    const float* MOD = (const float*)(a.ws + WS_MOD); const float* ng = a.in[8];
    const int stride = gridDim.x * 8; int m = blockIdx.x * 8 + wave;
    f32x4 v[4];
    if (m < M) { const f32x4* xr = (const f32x4*)xrow(a, m) + lane;
#pragma unroll
        for (int q = 0; q < 4; ++q) v[q] = xr[64 * q]; }
    for (; m < M; m += stride) {
        f32x4 vn[4]; const int mn = m + stride;
#pragma unroll
        for (int q = 0; q < 4; ++q) vn[q] = v[q];
        if (mn < M) { const f32x4* xr = (const f32x4*)xrow(a, mn) + lane;
#pragma unroll
            for (int q = 0; q < 4; ++q) vn[q] = xr[64 * q]; }
        const float* md = MOD + modgrp(m) * 6144;
        float s = 0.f;
#pragma unroll
        for (int q = 0; q < 4; ++q) s += (v[q][0] * v[q][0] + v[q][1] * v[q][1]) + (v[q][2] * v[q][2] + v[q][3] * v[q][3]);
        const float rstd = rsqrtf(wave_sum(s) * (1.f / D) + EPS);
        u32x2* o = (u32x2*)(H + (size_t)m * D) + lane;
#pragma unroll
        for (int q = 0; q < 4; ++q) { const int c = 4 * (lane + 64 * q);
            const f32x4 g = *(const f32x4*)(ng + c), sh = *(const f32x4*)(md + c), sc = *(const f32x4*)(md + 1024 + c);
            const f32x4 r = v[q] * rstd * g * (sc + 1.0f) + sh;
            u32x2 w; w.x = pk2(r[0], r[1]); w.y = pk2(r[2], r[3]); o[64 * q] = w; }
#pragma unroll
        for (int q = 0; q < 4; ++q) v[q] = vn[q];
    }
}

__device__ __forceinline__ void lru_phase(const Args& a, LAS unsigned char* lds, int tid, int lane, int wave) {
    LAS bf16* XC = (LAS bf16*)lds;
    LAS float* AU = (LAS float*)(lds + 18432);
    LAS float* SUBA = (LAS float*)(lds + 18432 + 69632);
    LAS float* HC = SUBA + 8 * 64 * 2;
    const bf16* ZX = (const bf16*)a.out;
    bf16* HF = (bf16*)(a.ws + WS_S0 + 2 * SLOT); bf16* HB = (bf16*)(a.ws + WS_S0);
    const float* conv_w = a.in[10]; const float* conv_b = a.in[11];
    const int col = lane & 15, quad = lane >> 4, mt = wave & 3, nh = wave >> 2;
    const int vcu = (gridDim.x % 8 == 0) ? (int)(blockIdx.x % 8) * (int)(gridDim.x / 8) + (int)(blockIdx.x / 8) : (int)blockIdx.x;
    int cur_key = -1;
    bf16x8 Bf[2][2][2]; float ba_[2], bx_[2], c8_[2]; f32x4 cwv[4][2]; f32x4 cb0, cb1;
    const int tokA = tid >> 3, c8A = (tid & 7) * 8;
    for (int u = vcu; u < 768; u += gridDim.x) {
        const bool lat = u < 256; const int v = lat ? u : u - 256; const int b = v >> 5, blk = (v >> 1) & 15, dir = v & 1;
        const int row_base = lat ? MP + b * 2048 : b * 256, nseg = lat ? 32 : 4;
        bf16* HX = dir ? HB : HF;
        const int ch0A = blk * 64 + c8A;
        if ((blk * 2 + dir) != cur_key) { cur_key = blk * 2 + dir;
        const float* wa = a.in[12] + (size_t)(dir * 16 + blk) * 4096; const float* wx = a.in[14] + (size_t)(dir * 16 + blk) * 4096;
#pragma unroll
        for (int nt = 0; nt < 2; ++nt)
#pragma unroll
            for (int kk = 0; kk < 2; ++kk)
#pragma unroll
                for (int i = 0; i < 8; i += 2) { const int k = kk * 32 + quad * 8 + i, n = nh * 32 + nt * 16 + col;
                    const unsigned pa = pk2(wa[k * 64 + n], wa[(k + 1) * 64 + n]), px = pk2(wx[k * 64 + n], wx[(k + 1) * 64 + n]);
                    Bf[0][nt][kk][i] = (short)(pa & 0xffffu); Bf[0][nt][kk][i + 1] = (short)(pa >> 16);
                    Bf[1][nt][kk][i] = (short)(px & 0xffffu); Bf[1][nt][kk][i + 1] = (short)(px >> 16); }
#pragma unroll
        for (int nt = 0; nt < 2; ++nt) { const int ch = dir * 1024 + blk * 64 + nh * 32 + nt * 16 + col;
            ba_[nt] = -1.4426950408889634f * a.in[13][ch]; bx_[nt] = -1.4426950408889634f * a.in[15][ch]; c8_[nt] = -8.0f * 1.4426950408889634f * log1pf(expf(-a.in[16][ch])); }
#pragma unroll
        for (int j = 0; j < 4; ++j) { cwv[j][0] = *(const f32x4*)(conv_w + j * 1024 + ch0A); cwv[j][1] = *(const f32x4*)(conv_w + j * 1024 + ch0A + 4); }
        cb0 = *(const f32x4*)(conv_b + ch0A); cb1 = *(const f32x4*)(conv_b + ch0A + 4);
        }
        if (tid < 64) HC[tid] = lat ? a.in[2][(size_t)(b * 2 + dir) * 1024 + blk * 64 + tid] : 0.f;
        const int nst = nseg >> 1;
        u32x4 Zg[2][4];
#define LRU_FETCH(t0_) do { _Pragma("unroll") for (int hh_ = 0; hh_ < 2; ++hh_) { const int t0h_ = (t0_) + 64 * hh_; const int lo_ = lat ? t0h_ : 0, hi_ = lat ? t0h_ + 64 : 256; \
            _Pragma("unroll") for (int j_ = 0; j_ < 4; ++j_) { const int t_ = t0h_ + tokA + j_ - 1; \
                Zg[hh_][j_] = (t_ >= lo_ && t_ < hi_) ? *(const u32x4*)(ZX + (size_t)(row_base + t_) * D + ch0A) : (u32x4){0u, 0u, 0u, 0u}; } } } while (0)
        LRU_FETCH((dir ? nst - 1 : 0) * 128);
        for (int s = 0; s < nst; ++s) {
            const int st = dir ? nst - 1 - s : s, t0 = st * 128;
#pragma unroll
            for (int hh = 0; hh < 2; ++hh) {
                f32x4 x0 = cb0, x1 = cb1;
#pragma unroll
                for (int j = 0; j < 4; ++j) { const u32x4 z = Zg[hh][j]; const f32x4 w0 = cwv[j][0], w1 = cwv[j][1];
                    x0[0] += w0[0] * bflo(z.x); x0[1] += w0[1] * bfhi(z.x); x0[2] += w0[2] * bflo(z.y); x0[3] += w0[3] * bfhi(z.y);
                    x1[0] += w1[0] * bflo(z.z); x1[1] += w1[1] * bfhi(z.z); x1[2] += w1[2] * bflo(z.w); x1[3] += w1[3] * bfhi(z.w); }
                u32x4 w; w.x = pk2(x0[0], x0[1]); w.y = pk2(x0[2], x0[3]); w.z = pk2(x1[0], x1[1]); w.w = pk2(x1[2], x1[3]);
                *(LAS u32x4*)(XC + (64 * hh + tokA) * 72 + c8A) = w;
            }
            __syncthreads();
            if (s + 1 < nst) LRU_FETCH((dir ? nst - 2 - s : s + 1) * 128);
#pragma unroll
            for (int hh = 0; hh < 2; ++hh) {
                bf16x8 Af[2];
#pragma unroll
                for (int kk = 0; kk < 2; ++kk) Af[kk] = *(const LAS bf16x8*)(XC + (64 * hh + 16 * mt + col) * 72 + kk * 32 + quad * 8);
                f32x4 ar[2], ai[2];
#pragma unroll
                for (int nt = 0; nt < 2; ++nt) { ar[nt] = (f32x4){0.f, 0.f, 0.f, 0.f}; ai[nt] = (f32x4){0.f, 0.f, 0.f, 0.f};
#pragma unroll
                    for (int kk = 0; kk < 2; ++kk) { ar[nt] = __builtin_amdgcn_mfma_f32_16x16x32_bf16(Af[kk], Bf[0][nt][kk], ar[nt], 0, 0, 0);
                        ai[nt] = __builtin_amdgcn_mfma_f32_16x16x32_bf16(Af[kk], Bf[1][nt][kk], ai[nt], 0, 0, 0); } }
                float xv[2][4];
#pragma unroll
                for (int nt = 0; nt < 2; ++nt)
#pragma unroll
                    for (int j = 0; j < 4; ++j) xv[nt][j] = bf2f((unsigned)XC[(64 * hh + 16 * mt + quad * 4 + j) * 72 + nh * 32 + nt * 16 + col]);
#pragma unroll
                for (int nt = 0; nt < 2; ++nt)
#pragma unroll
                    for (int j = 0; j < 4; ++j) { const int tok = 64 * hh + 16 * mt + quad * 4 + j, chl = nh * 32 + nt * 16 + col;
                        const float er = 1.0f + __builtin_amdgcn_exp2f(fmaf(ar[nt][j], -1.4426950408889634f, ba_[nt])), ei = 1.0f + __builtin_amdgcn_exp2f(fmaf(ai[nt][j], -1.4426950408889634f, bx_[nt]));
                        const float inv = rcpf_(er * ei), r = inv * ei, ig = inv * er;
                        const float aa = __builtin_amdgcn_exp2f(c8_[nt] * r);
                        const float uu = __builtin_amdgcn_sqrtf(fmaxf(1.0f - aa * aa, 0.f)) * ig * xv[nt][j];
                        typedef float f32x2s __attribute__((ext_vector_type(2)));
                        *(LAS f32x2s*)(AU + (tok * 68 + chl) * 2) = (f32x2s){aa, uu}; }
            }
            __syncthreads();
            {
                typedef float f32x2l __attribute__((ext_vector_type(2)));
                f32x2l p[16];
#pragma unroll
                for (int e = 0; e < 16; ++e) { const int i = wave * 16 + e; const int tok = dir ? 127 - i : i; p[e] = *(const LAS f32x2l*)(AU + (tok * 68 + lane) * 2); }
                float hl = 0.f, cp = 1.f;
#pragma unroll
                for (int e = 0; e < 16; ++e) { hl = p[e].x * hl + p[e].y; cp *= p[e].x; p[e].y = hl; p[e].x = cp; }
                *(LAS f32x2l*)(SUBA + (wave * 64 + lane) * 2) = (f32x2l){cp, hl};
                __syncthreads();
                float c = HC[(s & 1) * 64 + lane];
#pragma unroll
                for (int s2 = 0; s2 < 7; ++s2) { const f32x2l q = *(const LAS f32x2l*)(SUBA + (s2 * 64 + lane) * 2); if (s2 < wave) c = q.x * c + q.y; }
#pragma unroll
                for (int e = 0; e < 16; ++e) { const int i = wave * 16 + e; const int tok = dir ? 127 - i : i; *(LAS f32x2l*)(AU + (tok * 68 + lane) * 2) = (f32x2l){p[e].x, p[e].y + p[e].x * c}; }
                if (wave == 7) HC[((s + 1) & 1) * 64 + lane] = p[15].y + p[15].x * c;
            }
            __syncthreads();
#pragma unroll
            for (int hh = 0; hh < 2; ++hh) {
                const LAS f32x4* hq = (const LAS f32x4*)(AU + ((64 * hh + tokA) * 68 + c8A) * 2);
                const f32x4 q0 = hq[0], q1 = hq[1], q2 = hq[2], q3 = hq[3];
                u32x4 w; w.x = pk2(q0[1], q0[3]); w.y = pk2(q1[1], q1[3]); w.z = pk2(q2[1], q2[3]); w.w = pk2(q3[1], q3[3]);
                *(u32x4*)(HX + (size_t)(row_base + t0 + 64 * hh + tokA) * D + blk * 64 + c8A) = w;
            }
        }
#undef LRU_FETCH
        if (!lat && tid < 64) a.out[(size_t)M * D + (size_t)(b * 2 + dir) * 1024 + blk * 64 + tid] = HC[(nst & 1) * 64 + tid];
        __syncthreads();
    }
}

constexpr size_t WS_DEC = 6656 * 1024;
__device__ __forceinline__ void gla_prep(const Args& a, LAS unsigned char* lds, int tid, bf16* ewd, const bf16* ewa, const bf16* ewb) {
    LAS float* LRS = (LAS float*)lds;
    const float* LR = (const float*)(a.ws + WS_LR);
    bf16* EFb = (bf16*)a.out; bf16* EBb = EFb + (size_t)M * 512;
    float* DECg = (float*)(a.ws + WS_DEC);
    const size_t ew_n = (size_t)M * D / 8, ew_stride = (size_t)gridDim.x * 512; size_t ew_i = (size_t)blockIdx.x * 512 + tid;
    for (int it = blockIdx.x; it < 640; it += gridDim.x) {
        const int gc = it >> 1, dir = it & 1; const bool lat = gc >= 64; const int g2 = lat ? gc - 64 : gc;
        const int b = lat ? (g2 >> 5) : (g2 >> 2), cn = lat ? (g2 & 31) : (g2 & 3), p0 = cn * 64;
        const int row_base = lat ? MP + b * 2048 : b * 256;
        bf16* Eb = dir ? EBb : EFb;
        float w2r[16];
#pragma unroll
        for (int r = 0; r < 16; ++r) w2r[r] = a.in[18][(size_t)(dir * 16 + r) * 512 + tid];
        const float b2v = a.in[19][dir * 512 + tid];
        __syncthreads();
        if (tid < 256) { const int i = tid >> 2; const int p_ = dir ? p0 + 63 - i : p0 + i; const int row = lat ? row_base + (p_ & 31) * 64 + (p_ >> 5) : row_base + p_;
            *(LAS f32x4*)(LRS + i * 16 + (tid & 3) * 4) = *(const f32x4*)(LR + (size_t)row * 32 + dir * 16 + (tid & 3) * 4); }
        __syncthreads();
        float run = 0.f;
#pragma unroll 1
        for (int i8 = 0; i8 < 64; i8 += 8) {
            const bool ew_on = ew_i < ew_n; u32x4 ex0 = {0u, 0u, 0u, 0u}, ex1 = ex0, ey0 = ex0;
            if (ew_on) { ex0 = ((const u32x4*)ewa)[ew_i]; ex1 = ((const u32x4*)ewb)[ew_i]; ey0 = ((const u32x4*)ewd)[ew_i]; }
#pragma unroll
            for (int i7 = 0; i7 < 8; ++i7) { const int i = i8 + i7; const int p_ = dir ? p0 + 63 - i : p0 + i; const int row = lat ? row_base + (p_ & 31) * 64 + (p_ >> 5) : row_base + p_;
                const LAS f32x4* lrp = (const LAS f32x4*)(LRS + i * 16);
                const f32x4 l0 = lrp[0], l1 = lrp[1], l2 = lrp[2], l3 = lrp[3];
                float x = b2v;
                x += l0[0] * w2r[0]; x += l0[1] * w2r[1]; x += l0[2] * w2r[2]; x += l0[3] * w2r[3];
                x += l1[0] * w2r[4]; x += l1[1] * w2r[5]; x += l1[2] * w2r[6]; x += l1[3] * w2r[7];
                x += l2[0] * w2r[8]; x += l2[1] * w2r[9]; x += l2[2] * w2r[10]; x += l2[3] * w2r[11];
                x += l3[0] * w2r[12]; x += l3[1] * w2r[13]; x += l3[2] * w2r[14]; x += l3[3] * w2r[15];
                run += (fminf(x, 0.f) - logf_(1.0f + expf_(-fabsf(x)))) * 0.0625f;
                Eb[(size_t)row * 512 + tid] = (bf16)(pk2(expf_(run), 0.f) & 0xffffu); }
            if (ew_on) { u32x4 o;
#pragma unroll
                for (int e = 0; e < 4; ++e) o[e] = pk2((bflo(ex0[e]) + bflo(ex1[e])) * bflo(ey0[e]), (bfhi(ex0[e]) + bfhi(ex1[e])) * bfhi(ey0[e]));
                ((u32x4*)ewd)[ew_i] = o; ew_i += ew_stride; }
        }
        DECg[((size_t)dir * 320 + gc) * 512 + tid] = expf_(run);
    }
    for (; ew_i < ew_n; ew_i += ew_stride) { const u32x4 ex0 = ((const u32x4*)ewa)[ew_i], ex1 = ((const u32x4*)ewb)[ew_i], ey0 = ((const u32x4*)ewd)[ew_i]; u32x4 o;
#pragma unroll
        for (int e = 0; e < 4; ++e) o[e] = pk2((bflo(ex0[e]) + bflo(ex1[e])) * bflo(ey0[e]), (bfhi(ex0[e]) + bfhi(ex1[e])) * bfhi(ey0[e]));
        ((u32x4*)ewd)[ew_i] = o; }
}

__device__ __forceinline__ void gla_phase(const Args& a, LAS unsigned char* lds, int tid, int lane, int wave) {
    LAS bf16* QE = (LAS bf16*)lds;
    LAS bf16* KE = QE + 64 * 136;
    LAS bf16* ST = KE + 64 * 136;
    LAS bf16* KT = ST + 64 * 136;
    LAS bf16* VT = KT + 128 * 72;
    LAS bf16* PP = VT + 64 * 72;
    LAS bf16* EE = PP + 64 * 72;
    LAS float* DEC = (LAS float*)(EE + 64 * 136);
    const unsigned char* ws = a.ws;
    const bf16* EFb = (const bf16*)a.out; const bf16* EBb = EFb + (size_t)M * 512;
    const float* DECg = (const float*)(ws + WS_DEC);
    const bf16* Qb = (const bf16*)(ws + WS_S0 + 3 * SLOT); const bf16* Kb = Qb + (size_t)M * 512;
    const bf16* Vb = (const bf16*)(ws + WS_S0 + 4 * SLOT);
    bf16* OFb = (bf16*)(a.ws + WS_S0 + 2 * SLOT); bf16* OBb = (bf16*)(a.ws + WS_S0);
    const int ch = tid & 127, sub = __builtin_amdgcn_readfirstlane(tid >> 7);
    const int col = lane & 15, quad = lane >> 4, kt = wave;
    float* SG = a.out + (size_t)M * D + 16 * 2 * 1024;
    const int vcu = (gridDim.x % 8 == 0) ? (int)(blockIdx.x % 8) * (int)(gridDim.x / 8) + (int)(blockIdx.x / 8) : (int)blockIdx.x;
    for (int u = vcu; u < 768; u += gridDim.x) {
        const bool lat = u < 256; const int v = lat ? u : u - 256; const int b = v >> 5, hd = (v >> 3) & 3, dir = (v >> 2) & 1, sl = v & 3;
        const int row_base = lat ? MP + b * 2048 : b * 256, nch = lat ? 32 : 4, gc0 = lat ? 64 + b * 32 : b * 4;
        bf16* Ob = dir ? OBb : OFb; const bf16* Eb = dir ? EBb : EFb;
        f32x4 S[4];
#pragma unroll
        for (int vt = 0; vt < 4; ++vt)
#pragma unroll
            for (int j = 0; j < 4; ++j)
                S[vt][j] = lat ? a.in[3][((((size_t)(b * 2 + dir) * 4 + hd) * 128 + 16 * kt + quad * 4 + j) * 256) + sl * 64 + 16 * vt + col] : 0.f;
#define GROWP(p0_, i) ({ const int p_ = dir ? (p0_) + 63 - (i) : (p0_) + (i); lat ? row_base + (p_ & 31) * 64 + (p_ >> 5) : row_base + p_; })
        u32x4 QgA[2], KgA[2], EgA[2], VgA, QgB[2], KgB[2], EgB[2], VgB; f32x2 etgA, etgB;
#define GLA_FETCH(X, cn_) do { const int p0_ = (cn_) * 64; \
            _Pragma("unroll") for (int e_ = 0; e_ < 2; ++e_) { const int pc_ = tid + e_ * 512; const size_t ro_ = (size_t)GROWP(p0_, pc_ >> 4) * 512 + hd * 128 + (pc_ & 15) * 8; \
                Qg##X[e_] = *(const u32x4*)(Qb + ro_); Kg##X[e_] = *(const u32x4*)(Kb + ro_); Eg##X[e_] = *(const u32x4*)(Eb + ro_); } \
            Vg##X = *(const u32x4*)(Vb + (size_t)GROWP(p0_, tid & 63) * D + hd * 256 + sl * 64 + (tid >> 6) * 8); \
            etg##X = *(const f32x2*)(DECg + ((size_t)dir * 320 + gc0 + (cn_)) * 512 + hd * 128 + 2 * lane); } while (0)
#define GLA_CHUNK(X, n) do { const int cn = dir ? nch - 1 - (n) : (n), p0 = cn * 64; \
            __syncthreads(); \
_Pragma("unroll") \
            for (int vt = 0; vt < 4; ++vt) { u32x2 w; w.x = pk2(S[vt][0], S[vt][1]); w.y = pk2(S[vt][2], S[vt][3]); \
                *(LAS u32x2*)(ST + (16 * vt + col) * 136 + 16 * kt + quad * 4) = w; } \
_Pragma("unroll") \
            for (int e = 0; e < 2; ++e) { const int pc = tid + e * 512, o_ = (pc >> 4) * 136 + (pc & 15) * 8; \
                *(LAS u32x4*)(QE + o_) = Qg##X[e]; *(LAS u32x4*)(KE + o_) = Kg##X[e]; *(LAS u32x4*)(EE + o_) = Eg##X[e]; } \
            {   const int i = tid & 63, v8 = (tid >> 6) * 8; const u32x4 z = Vg##X; \
                VT[(v8 + 0) * 72 + i] = (bf16)(z.x & 0xffffu); VT[(v8 + 1) * 72 + i] = (bf16)(z.x >> 16); \
                VT[(v8 + 2) * 72 + i] = (bf16)(z.y & 0xffffu); VT[(v8 + 3) * 72 + i] = (bf16)(z.y >> 16); \
                VT[(v8 + 4) * 72 + i] = (bf16)(z.z & 0xffffu); VT[(v8 + 5) * 72 + i] = (bf16)(z.z >> 16); \
                VT[(v8 + 6) * 72 + i] = (bf16)(z.w & 0xffffu); VT[(v8 + 7) * 72 + i] = (bf16)(z.w >> 16); } \
            const f32x2 etot = etg##X; \
            if (wave == 0) *(LAS f32x2*)(DEC + 2 * lane) = etot; \
            __syncthreads(); \
            if ((n) + 2 < nch) GLA_FETCH(X, dir ? nch - 3 - (n) : (n) + 2); \
            {     \
                unsigned qw[8], kw_[8], ew[8]; \
_Pragma("unroll") \
                for (int e = 0; e < 8; ++e) { const int o_ = (wave * 8 + e) * 136 + 2 * lane; qw[e] = *(const LAS unsigned*)(QE + o_); kw_[e] = *(const LAS unsigned*)(KE + o_); ew[e] = *(const LAS unsigned*)(EE + o_); } \
                float t0v[8], t1v[8]; \
_Pragma("unroll") \
                for (int e = 0; e < 8; ++e) { const float E0 = bflo(ew[e]), E1 = bfhi(ew[e]); const float R0 = rcpf_(E0), R1 = rcpf_(E1); \
                    const float q0 = bflo(qw[e]) * E0 * 0.08838834764831845f, q1 = bfhi(qw[e]) * E1 * 0.08838834764831845f; \
                    const float k0 = bflo(kw_[e]) * R0, k1 = bfhi(kw_[e]) * R1; t0v[e] = k0 * etot.x; t1v[e] = k1 * etot.y; \
                    qw[e] = pk2(q0, q1); kw_[e] = pk2(k0, k1); } \
_Pragma("unroll") \
                for (int e = 0; e < 8; ++e) { const int o_ = (wave * 8 + e) * 136 + 2 * lane; *(LAS unsigned*)(QE + o_) = qw[e]; *(LAS unsigned*)(KE + o_) = kw_[e]; } \
                u32x4 w0, w1; w0.x = pk2(t0v[0], t0v[1]); w0.y = pk2(t0v[2], t0v[3]); w0.z = pk2(t0v[4], t0v[5]); w0.w = pk2(t0v[6], t0v[7]); \
                w1.x = pk2(t1v[0], t1v[1]); w1.y = pk2(t1v[2], t1v[3]); w1.z = pk2(t1v[4], t1v[5]); w1.w = pk2(t1v[6], t1v[7]); \
                *(LAS u32x4*)(KT + (2 * lane) * 72 + wave * 8) = w0; *(LAS u32x4*)(KT + (2 * lane + 1) * 72 + wave * 8) = w1; } \
            __syncthreads(); \
            {     \
                const int st = wave >> 1, ct0 = 2 * (wave & 1); \
                f32x4 acc0 = {0.f, 0.f, 0.f, 0.f}, acc1 = {0.f, 0.f, 0.f, 0.f}; \
                if (st <= ct0 + 1) { \
_Pragma("unroll") \
                    for (int kk = 0; kk < 4; ++kk) { const bf16x8 ak = *(const LAS bf16x8*)(KE + (16 * st + col) * 136 + kk * 32 + quad * 8); \
                        if (st <= ct0) { const bf16x8 bq0 = *(const LAS bf16x8*)(QE + (16 * ct0 + col) * 136 + kk * 32 + quad * 8); acc0 = __builtin_amdgcn_mfma_f32_16x16x32_bf16(ak, bq0, acc0, 0, 0, 0); } \
                        const bf16x8 bq1 = *(const LAS bf16x8*)(QE + (16 * (ct0 + 1) + col) * 136 + kk * 32 + quad * 8); acc1 = __builtin_amdgcn_mfma_f32_16x16x32_bf16(ak, bq1, acc1, 0, 0, 0); } \
                } \
_Pragma("unroll") \
                for (int j = 0; j < 4; ++j) { if (16 * st + quad * 4 + j > 16 * ct0 + col) acc0[j] = 0.f; if (16 * st + quad * 4 + j > 16 * (ct0 + 1) + col) acc1[j] = 0.f; } \
                u32x2 w0, w1; w0.x = pk2(acc0[0], acc0[1]); w0.y = pk2(acc0[2], acc0[3]); w1.x = pk2(acc1[0], acc1[1]); w1.y = pk2(acc1[2], acc1[3]); \
                *(LAS u32x2*)(PP + (16 * ct0 + col) * 72 + 16 * st + quad * 4) = w0; *(LAS u32x2*)(PP + (16 * (ct0 + 1) + col) * 72 + 16 * st + quad * 4) = w1; \
            } \
            __syncthreads(); \
            {     \
                const int vt_ = wave >> 1, ct0 = 2 * (wave & 1); \
                bf16x8 av[2], as_[4]; \
_Pragma("unroll") \
                for (int ks = 0; ks < 2; ++ks) av[ks] = *(const LAS bf16x8*)(VT + (16 * vt_ + col) * 72 + ks * 32 + quad * 8); \
_Pragma("unroll") \
                for (int kk = 0; kk < 4; ++kk) as_[kk] = *(const LAS bf16x8*)(ST + (16 * vt_ + col) * 136 + kk * 32 + quad * 8); \
                f32x4 acc0 = {0.f, 0.f, 0.f, 0.f}, acc1 = {0.f, 0.f, 0.f, 0.f}; \
_Pragma("unroll") \
                for (int ks = 0; ks < 2; ++ks) { const bf16x8 bp0 = *(const LAS bf16x8*)(PP + (16 * ct0 + col) * 72 + ks * 32 + quad * 8), bp1 = *(const LAS bf16x8*)(PP + (16 * (ct0 + 1) + col) * 72 + ks * 32 + quad * 8); \
                    acc0 = __builtin_amdgcn_mfma_f32_16x16x32_bf16(av[ks], bp0, acc0, 0, 0, 0); acc1 = __builtin_amdgcn_mfma_f32_16x16x32_bf16(av[ks], bp1, acc1, 0, 0, 0); } \
_Pragma("unroll") \
                for (int kk = 0; kk < 4; ++kk) { const bf16x8 bq0 = *(const LAS bf16x8*)(QE + (16 * ct0 + col) * 136 + kk * 32 + quad * 8), bq1 = *(const LAS bf16x8*)(QE + (16 * (ct0 + 1) + col) * 136 + kk * 32 + quad * 8); \
                    acc0 = __builtin_amdgcn_mfma_f32_16x16x32_bf16(as_[kk], bq0, acc0, 0, 0, 0); acc1 = __builtin_amdgcn_mfma_f32_16x16x32_bf16(as_[kk], bq1, acc1, 0, 0, 0); } \
                const int row0 = GROWP(p0, 16 * ct0 + col), row1 = GROWP(p0, 16 * (ct0 + 1) + col); \
                u32x2 w0, w1; w0.x = pk2(acc0[0], acc0[1]); w0.y = pk2(acc0[2], acc0[3]); w1.x = pk2(acc1[0], acc1[1]); w1.y = pk2(acc1[2], acc1[3]); \
                *(u32x2*)(Ob + (size_t)row0 * D + hd * 256 + sl * 64 + 16 * vt_ + quad * 4) = w0; *(u32x2*)(Ob + (size_t)row1 * D + hd * 256 + sl * 64 + 16 * vt_ + quad * 4) = w1; \
                bf16x8 ak[2]; \
_Pragma("unroll") \
                for (int ks = 0; ks < 2; ++ks) ak[ks] = *(const LAS bf16x8*)(KT + (16 * kt + col) * 72 + ks * 32 + quad * 8); \
                float dk[4]; \
_Pragma("unroll") \
                for (int j = 0; j < 4; ++j) dk[j] = DEC[16 * kt + quad * 4 + j]; \
_Pragma("unroll") \
                for (int vt = 0; vt < 4; ++vt) { \
_Pragma("unroll") \
                    for (int j = 0; j < 4; ++j) S[vt][j] *= dk[j]; \
_Pragma("unroll") \
                    for (int ks = 0; ks < 2; ++ks) { const bf16x8 bv = *(const LAS bf16x8*)(VT + (16 * vt + col) * 72 + ks * 32 + quad * 8); \
                        S[vt] = __builtin_amdgcn_mfma_f32_16x16x32_bf16(ak[ks], bv, S[vt], 0, 0, 0); } } \
            } \
        } while (0)
        GLA_FETCH(A, dir ? nch - 1 : 0); GLA_FETCH(B, dir ? nch - 2 : 1);
        for (int n = 0; n < nch; n += 2) { GLA_CHUNK(A, n); GLA_CHUNK(B, n + 1); }
#undef GLA_CHUNK
#undef GLA_FETCH
#undef GROWP
        if (!lat) {
#pragma unroll
            for (int vt = 0; vt < 4; ++vt)
#pragma unroll
                for (int j = 0; j < 4; ++j)
                    SG[((((size_t)(b * 2 + dir) * 4 + hd) * 128 + 16 * kt + quad * 4 + j) * 256) + sl * 64 + 16 * vt + col] = S[vt][j];
        }
    }
}

template <int MODE> __device__ __forceinline__ void ew_pass(bf16* dst, const bf16* a0, const bf16* b0, const bf16* a1, const bf16* b1, int tid) {
    const size_t nvec = (size_t)M * D / 8;
    for (size_t i = (size_t)blockIdx.x * 512 + tid; i < nvec; i += (size_t)gridDim.x * 512) {
        const u32x4 x0 = ((const u32x4*)a0)[i], y0 = ((const u32x4*)b0)[i], x1 = ((const u32x4*)a1)[i];
        u32x4 o;
        if (MODE == 0) {
#pragma unroll
            for (int e = 0; e < 4; ++e) o[e] = pk2((bflo(x0[e]) + bflo(x1[e])) * bflo(y0[e]), (bfhi(x0[e]) + bfhi(x1[e])) * bfhi(y0[e]));
        } else {
            const u32x4 y1 = ((const u32x4*)b1)[i];
#pragma unroll
            for (int e = 0; e < 4; ++e) o[e] = pk2(bflo(x0[e]) * bflo(y0[e]) + bflo(x1[e]) * bflo(y1[e]), bfhi(x0[e]) * bfhi(y0[e]) + bfhi(x1[e]) * bfhi(y1[e]));
        }
        ((u32x4*)dst)[i] = o;
    }
}
__device__ __forceinline__ void post_gla(const Args& a, int lane, int wave) {
    const bf16* OFb = (const bf16*)(a.ws + WS_S0 + 2 * SLOT); const bf16* OBb = (const bf16*)(a.ws + WS_S0);
    bf16* G = (bf16*)(a.ws + WS_S0 + 1 * SLOT);
    const f32x4 gn = *(const f32x4*)(a.in[20] + 4 * lane);
    const int stride = gridDim.x * 8; int m = blockIdx.x * 8 + wave;
    u32x2 cf[4], cb[4], cg[4];
    if (m < M) {
#pragma unroll
        for (int hh = 0; hh < 4; ++hh) { const size_t off = (size_t)m * D + hh * 256 + 4 * lane; cf[hh] = *(const u32x2*)(OFb + off); cb[hh] = *(const u32x2*)(OBb + off); cg[hh] = *(const u32x2*)(G + off); } }
    for (; m < M; m += stride) {
        u32x2 nf[4], nb[4], ng_[4]; const int mn = m + stride;
#pragma unroll
        for (int hh = 0; hh < 4; ++hh) { nf[hh] = cf[hh]; nb[hh] = cb[hh]; ng_[hh] = cg[hh]; }
        if (mn < M) {
#pragma unroll
            for (int hh = 0; hh < 4; ++hh) { const size_t off = (size_t)mn * D + hh * 256 + 4 * lane; nf[hh] = *(const u32x2*)(OFb + off); nb[hh] = *(const u32x2*)(OBb + off); ng_[hh] = *(const u32x2*)(G + off); } }
#pragma unroll
        for (int hh = 0; hh < 4; ++hh) { const size_t off = (size_t)m * D + hh * 256 + 4 * lane;
            const u32x2 f = cf[hh], bb = cb[hh], g = cg[hh];
            f32x4 o; o[0] = bflo(f.x) + bflo(bb.x); o[1] = bfhi(f.x) + bfhi(bb.x); o[2] = bflo(f.y) + bflo(bb.y); o[3] = bfhi(f.y) + bfhi(bb.y);
            const float ss = wave_sum((o[0] * o[0] + o[1] * o[1]) + (o[2] * o[2] + o[3] * o[3]));
            const float rstd = rsqrtf(ss * (1.f / 256.f) + EPS);
            u32x2 w; w.x = pk2(o[0] * rstd * gn[0] * bflo(g.x), o[1] * rstd * gn[1] * bfhi(g.x)); w.y = pk2(o[2] * rstd * gn[2] * bflo(g.y), o[3] * rstd * gn[3] * bfhi(g.y));
            *(u32x2*)(G + off) = w; }
#pragma unroll
        for (int hh = 0; hh < 4; ++hh) { cf[hh] = nf[hh]; cb[hh] = nb[hh]; cg[hh] = ng_[hh]; }
    }
}
struct SplitRow { u32x2 o[4]; u32x2 p[3][4]; };
__device__ __forceinline__ void split_row_load(SplitRow& r, const bf16* O, const bf16* P, int m, int lane) {
#pragma unroll
    for (int q = 0; q < 4; ++q) r.o[q] = *(const u32x2*)(O + (size_t)m * D + 4 * (lane + 64 * q));
    if (m >= 16384) {
#pragma unroll
        for (int k = 0; k < 3; ++k)
#pragma unroll
            for (int q = 0; q < 4; ++q) r.p[k][q] = *(const u32x2*)(P + ((size_t)k * 4096 + (m - 16384)) * D + 4 * (lane + 64 * q)); }
}
__device__ __forceinline__ f32x4 split_row_val(const SplitRow& r, int m, int q) {
    f32x4 v; v[0] = bflo(r.o[q].x); v[1] = bfhi(r.o[q].x); v[2] = bflo(r.o[q].y); v[3] = bfhi(r.o[q].y);
    if (m >= 16384) {
#pragma unroll
        for (int k = 0; k < 3; ++k) { v[0] += bflo(r.p[k][q].x); v[1] += bfhi(r.p[k][q].x); v[2] += bflo(r.p[k][q].y); v[3] += bfhi(r.p[k][q].y); } }
    return v;
}
__device__ __forceinline__ void x1_pass(const Args& a, int lane, int wave) {
    const float* MOD = (const float*)(a.ws + WS_MOD); const float* ng = a.in[8];
    const bf16* Mm = (const bf16*)(a.ws + WS_S0 + 2 * SLOT); const bf16* Pm = (const bf16*)(a.ws + WS_S0 + 4 * SLOT); bf16* H2 = (bf16*)(a.ws + WS_S0);
    const int stride = gridDim.x * 8; int m = blockIdx.x * 8 + wave;
    SplitRow cur; f32x4 xc[4];
    if (m < M) { split_row_load(cur, Mm, Pm, m, lane); const f32x4* xr = (const f32x4*)xrow(a, m) + lane;
#pragma unroll
        for (int q = 0; q < 4; ++q) xc[q] = xr[64 * q]; }
    for (; m < M; m += stride) {
        SplitRow nxt = cur; f32x4 xn[4]; const int mn = m + stride;
#pragma unroll
        for (int q = 0; q < 4; ++q) xn[q] = xc[q];
        if (mn < M) { split_row_load(nxt, Mm, Pm, mn, lane); const f32x4* xr = (const f32x4*)xrow(a, mn) + lane;
#pragma unroll
            for (int q = 0; q < 4; ++q) xn[q] = xr[64 * q]; }
        const float* md = MOD + modgrp(m) * 6144;
        f32x4 mv[4]; float s1 = 0.f;
#pragma unroll
        for (int q = 0; q < 4; ++q) { mv[q] = split_row_val(cur, m, q); s1 += (mv[q][0] * mv[q][0] + mv[q][1] * mv[q][1]) + (mv[q][2] * mv[q][2] + mv[q][3] * mv[q][3]); }
        const float rstd1 = rsqrtf(wave_sum(s1) * (1.f / D) + EPS);
        f32x4 v[4]; float s = 0.f;
#pragma unroll
        for (int q = 0; q < 4; ++q) { const int c = 4 * (lane + 64 * q);
            const f32x4 g1 = *(const f32x4*)(md + 2048 + c), n1 = *(const f32x4*)(ng + 1024 + c);
            v[q] = xc[q] + g1 * (mv[q] * rstd1 * n1);
            *(f32x4*)(a.out + (size_t)m * D + c) = v[q];
            s += (v[q][0] * v[q][0] + v[q][1] * v[q][1]) + (v[q][2] * v[q][2] + v[q][3] * v[q][3]); }
        const float rstd = rsqrtf(wave_sum(s) * (1.f / D) + EPS);
#pragma unroll
        for (int q = 0; q < 4; ++q) { const int c = 4 * (lane + 64 * q);
            const f32x4 g = *(const f32x4*)(ng + 2048 + c), sh = *(const f32x4*)(md + 3072 + c), sc = *(const f32x4*)(md + 4096 + c);
            const f32x4 r = v[q] * rstd * g * (sc + 1.0f) + sh;
            u32x2 w; w.x = pk2(r[0], r[1]); w.y = pk2(r[2], r[3]); *(u32x2*)(H2 + (size_t)m * D + c) = w; }
        cur = nxt;
#pragma unroll
        for (int q = 0; q < 4; ++q) xc[q] = xn[q];
    }
}
__device__ __forceinline__ void fin_pass(const Args& a, int lane, int wave) {
    const float* MOD = (const float*)(a.ws + WS_MOD); const float* ng = a.in[8];
    const bf16* F = (const bf16*)(a.ws + WS_S0); const bf16* Pf = (const bf16*)(a.ws + WS_WL);
    const int stride = gridDim.x * 8; int m = blockIdx.x * 8 + wave;
    SplitRow cur; f32x4 yc[4];
    if (m < M) { split_row_load(cur, F, Pf, m, lane);
#pragma unroll
        for (int q = 0; q < 4; ++q) yc[q] = *(const f32x4*)(a.out + (size_t)m * D + 4 * (lane + 64 * q)); }
    for (; m < M; m += stride) {
        SplitRow nxt = cur; f32x4 yn[4]; const int mn = m + stride;
#pragma unroll
        for (int q = 0; q < 4; ++q) yn[q] = yc[q];
        if (mn < M) { split_row_load(nxt, F, Pf, mn, lane);
#pragma unroll
            for (int q = 0; q < 4; ++q) yn[q] = *(const f32x4*)(a.out + (size_t)mn * D + 4 * (lane + 64 * q)); }
        const float* md = MOD + modgrp(m) * 6144;
        f32x4 fv[4]; float s = 0.f;
#pragma unroll
        for (int q = 0; q < 4; ++q) { fv[q] = split_row_val(cur, m, q); s += (fv[q][0] * fv[q][0] + fv[q][1] * fv[q][1]) + (fv[q][2] * fv[q][2] + fv[q][3] * fv[q][3]); }
        const float rstd = rsqrtf(wave_sum(s) * (1.f / D) + EPS);
#pragma unroll
        for (int q = 0; q < 4; ++q) { const int c = 4 * (lane + 64 * q);
            const f32x4 g2 = *(const f32x4*)(md + 5120 + c), n3 = *(const f32x4*)(ng + 3072 + c);
            *(f32x4*)(a.out + (size_t)m * D + c) = yc[q] + g2 * (fv[q] * rstd * n3); }
        cur = nxt;
#pragma unroll
        for (int q = 0; q < 4; ++q) yc[q] = yn[q];
    }
}

constexpr int NPHASE = 14;
__global__ void __launch_bounds__(512, 2) mk_fwd(Args a) {
    extern __shared__ __attribute__((aligned(16))) unsigned char lds_raw[];
    LAS unsigned char* lds = (LAS unsigned char*)lds_raw;
    cg::grid_group grid = cg::this_grid();
    const int tid = threadIdx.x, lane = tid & 63, wave = __builtin_amdgcn_readfirstlane(tid >> 6);
    const int lo = a.ph_lo, hi = a.ph_hi, G = gridDim.x;
    volatile LAS unsigned* MISC = (volatile LAS unsigned*)(lds + LDS_BYTES - 64);
    if (tid < 16) MISC[tid] = 0u;
    __syncthreads();
    const XcdBarrier bar = xcd_barrier_post((unsigned*)(a.ws + WS_BAR), MISC);
    unsigned char* ws = a.ws;
    bf16* S0 = (bf16*)(ws + WS_S0); bf16* S1 = (bf16*)(ws + WS_S0 + SLOT); bf16* S2 = (bf16*)(ws + WS_S0 + 2 * SLOT);
    bf16* S3 = (bf16*)(ws + WS_S0 + 3 * SLOT); bf16* S4 = (bf16*)(ws + WS_S0 + 4 * SLOT);
    bf16* D0 = (bf16*)a.out; bf16* D1 = D0 + (size_t)M * D;
#ifndef MK_MASK
#define MK_MASK 0x3fff
#endif
#define IN(k) (((MK_MASK >> (k)) & 1) && lo <= (k) && (k) < hi)
#define SEAM(k) do { if (IN(k) && IN((k) + 1)) xcd_barrier(bar); } while (0)
    if (lo < 0) grid.sync();
    if (IN(0)) { phase0(a, lds, tid, lane, wave); } SEAM(0);
    if (IN(1)) { phase1(a, S0, lane, wave); } SEAM(1);
    if (IN(2)) {
        pg8::Gemm g{S0, (const bf16*)(ws + WS_WL), M, 5376, 1024, S0, S0, 1 << 30, 1 << 30, 1024}; pg8::StaticOrder S; S.init(M, 5376, G, (int)blockIdx.x);
        EpiLG E{D0, D1, (float*)(ws + WS_LR), S3, S3 + (size_t)M * 512, S4, S1};
        pg8::gemm_phase<EpiLG, pg8::StaticOrder, true, true>(lds, g, S, E);
    } SEAM(2);
    if (IN(3)) { lru_phase(a, lds, tid, lane, wave); } SEAM(3);
    if (IN(4)) {
        gla_prep(a, lds, tid, D1, S2, S0);
    } SEAM(4);
    if (IN(5)) { gla_phase(a, lds, tid, lane, wave); } SEAM(5);
    if (IN(6)) { post_gla(a, lane, wave); phase1(a, S3, lane, wave); } SEAM(6);
    if (IN(7)) {
        pg8::Gemm g{D1, (const bf16*)(ws + WS_WY) + (size_t)2048 * 1024, M, 2048, 1024, S1, S1, 4, 1 << 30, 1024}; pg8::StaticOrder S; S.init(M, 2048, G, (int)blockIdx.x);
        EpiYY E{S4, D0};
        pg8::gemm_phase<EpiYY, pg8::StaticOrder, true, true>(lds, g, S, E);
    } SEAM(7);
    if (IN(8)) {
        pg8::Gemm g{S3, (const bf16*)(ws + WS_WY), M, 2048, 1024, S3, S3, 1 << 30, 1 << 30, 1024}; pg8::StaticOrder S; S.init(M, 2048, G, (int)blockIdx.x);
        EpiMM E{S4, D0, S0};
        pg8::gemm_phase<EpiMM, pg8::StaticOrder, true, true>(lds, g, S, E);
    } SEAM(8);
    if (IN(9)) {
        { pg8::Gemm g{S0, (const bf16*)(ws + WS_WO), 16384, 1024, 1024, S0, S0, 1 << 30, 1 << 30, 1024}; pg8::StaticOrder S; S.init(16384, 1024, G, (int)blockIdx.x);
          EpiS E{S2, S4, 64}; pg8::gemm_phase<EpiS, pg8::StaticOrder, true, true>(lds, g, S, E); }
        { pg8::Gemm g{S0, (const bf16*)(ws + WS_WO), M, 1024, 256, S0, S0, 1 << 30, 1 << 30, 1024}; SplitOrder S{64, G, (int)blockIdx.x};
          EpiS E{S2, S4, 64}; pg8::gemm_phase<EpiS, SplitOrder, true, true>(lds, g, S, E); }
    } SEAM(9);
    if (IN(10)) { x1_pass(a, lane, wave); } SEAM(10);
    if (IN(11)) {
        pg8::Gemm g{S0, (const bf16*)(ws + WS_W1), M, 4096, 1024, S0, S0, 1 << 30, 1 << 30, 1024}; pg8::StaticOrder S; S.init(M, 4096, G, (int)blockIdx.x);
        EpiH E{S1};
        pg8::gemm_phase<EpiH, pg8::StaticOrder, true, true>(lds, g, S, E);
    } SEAM(11);
    if (IN(12)) {
        { pg8::Gemm g{S1, (const bf16*)(ws + WS_W2), 16384, 1024, 4096, S1, S1, 1 << 30, 1 << 30, 4096}; pg8::StaticOrder S; S.init(16384, 1024, G, (int)blockIdx.x);
          EpiS E{S0, (bf16*)(ws + WS_WL), 64}; pg8::gemm_phase<EpiS, pg8::StaticOrder, true, true>(lds, g, S, E); }
        { pg8::Gemm g{S1, (const bf16*)(ws + WS_W2), M, 1024, 1024, S1, S1, 1 << 30, 1 << 30, 4096}; SplitOrder S{64, G, (int)blockIdx.x};
          EpiS E{S0, (bf16*)(ws + WS_WL), 64}; pg8::gemm_phase<EpiS, SplitOrder, true, true>(lds, g, S, E); }
    } SEAM(12);
    if (IN(13)) { fin_pass(a, lane, wave); }
#undef IN
#undef SEAM
}

extern "C" void kernel_launch(void* const* d_in, const int* in_sizes, int n_in, void* d_out, int out_size, void* d_ws, size_t ws_size, hipStream_t stream) {
    static int grid = 0;
    if (grid == 0) {
        if (n_in != 25 || ws_size < WS_END) { fprintf(stderr, "kernel_launch: unexpected n_in %d / ws %zu\n", n_in, ws_size); grid = -1; return; }
        int dev = 0, cus = 0, per_cu = 0;
        hipGetDevice(&dev); hipDeviceGetAttribute(&cus, hipDeviceAttributeMultiprocessorCount, dev);
        if (hipFuncSetAttribute((const void*)mk_fwd, hipFuncAttributeMaxDynamicSharedMemorySize, LDS_BYTES) != hipSuccess) { fprintf(stderr, "kernel_launch: hipFuncSetAttribute failed\n"); grid = -1; return; }
        if (hipOccupancyMaxActiveBlocksPerMultiprocessor(&per_cu, (const void*)mk_fwd, 512, LDS_BYTES) != hipSuccess || per_cu < 1) { fprintf(stderr, "kernel_launch: occupancy query says %d\n", per_cu); per_cu = 1; }
        (void)hipGetLastError();
        grid = cus * 1;
    }
    if (grid < 0) return;
    if (hipMemsetAsync((char*)d_ws + WS_BAR, 0, WS_BAR_BYTES, stream) != hipSuccess) { fprintf(stderr, "kernel_launch: memset failed\n"); return; }
    Args a{};
    for (int i = 0; i < 25; ++i) a.in[i] = (const float*)d_in[i];
    a.out = (float*)d_out; a.ws = (unsigned char*)d_ws;
    constexpr int NL = MK_N_LAUNCHES;
    for (int li = 0; li < NL; ++li) {
        a.ph_lo = (NL == 1) ? 0 : li; a.ph_hi = (NL == 1) ? NPHASE : li + 1;
        void* args[] = {&a};
        hipError_t e = hipLaunchCooperativeKernel((const void*)mk_fwd, dim3(grid), dim3(512), args, LDS_BYTES, stream);
        if (e != hipSuccess) { fprintf(stderr, "kernel_launch: cooperative launch %d failed: %s\n", li, hipGetErrorString(e)); break; }
    }
}
```

```cpp
#include <hip/hip_runtime.h>
#include <hip/hip_cooperative_groups.h>
#include <cstdio>
#include <cstdint>
namespace cg = cooperative_groups;
namespace pg8 {
#define PG8_LAS __attribute__((address_space(3)))
typedef unsigned short bf16_t;
typedef short bf16x8 __attribute__((ext_vector_type(8)));
typedef float f32x4 __attribute__((ext_vector_type(4)));
typedef unsigned u32x4 __attribute__((ext_vector_type(4)));
constexpr int BM = 256, BK = 64, HALF = 128, HTB = HALF * BK * 2  , STAGE_BYTES = 8 * HTB, NXCD = 8, WGM = 8;

__host__ __device__ __forceinline__ int lds_byte(int r, int c) { const int st = (r >> 4) * 2 + (c >> 5), rr = r & 15, cc = c & 31, ob = rr * 64 + cc * 2; return st * 1024 + (ob ^ (((ob >> 9) & 1) << 5)); }
__host__ __device__ __forceinline__ void stage_rc(int b, int& R, int& C) { const int st = b / 1024, sb = b % 1024, swz = sb ^ (((sb >> 9) & 1) << 5); R = (st >> 1) * 16 + swz / 64; C = (st & 1) * 32 + (swz % 64) / 2; }
__host__ __device__ __forceinline__ int perm32(int rho) { const int n = rho >> 4, i = rho & 15; return 8 * (i >> 2) + 4 * n + (i & 3); }

struct Unit { int pm, pn, kq; };
struct Gemm { const bf16_t* A; const bf16_t* Bt; int M, N, K; const bf16_t* A1; const bf16_t* A2; int pn1, pn2; int ld;
    __device__ __forceinline__ const char* abase(int pn) const { return (const char*)(pn < pn1 ? A : (pn < pn2 ? A1 : A2)); } };

struct StaticOrder {
    int nM, nN, nwg, G, c;
    __host__ __device__ void init(int M, int N, int G_, int c_) { nM = M / BM; nN = N / BM; nwg = nM * nN; G = G_; c = c_; }
    __host__ __device__ bool next(int i, Unit& u) const {
        const long L = (long)i * G + c; if (L >= nwg) return false;
        int wgid = (int)L; { const int q = nwg / NXCD, r = nwg % NXCD, xcd = wgid % NXCD, off = wgid / NXCD; wgid = (xcd < r ? xcd * (q + 1) : r * (q + 1) + (xcd - r) * q) + off; }
        const int nig = WGM * nN, gid = wgid / nig, fm = gid * WGM, gsz = (nM - fm) < WGM ? (nM - fm) : WGM;
        u.pm = fm + ((wgid % nig) % gsz); u.pn = (wgid % nig) / gsz; u.kq = 0; return true;
    }
    __device__ __forceinline__ void a_ready(const Unit&) const {}
    __device__ __forceinline__ void done(const Unit&) const {}
};

typedef float f32x2 __attribute__((ext_vector_type(2)));
typedef __bf16 bf16x2_t __attribute__((ext_vector_type(2)));
__device__ __forceinline__ unsigned cvt_pk_bf16(float lo, float hi) { const f32x2 v = {lo, hi}; return __builtin_bit_cast(unsigned, __builtin_convertvector(v, bf16x2_t)); }
template <class Epi, class Sched, bool ALIGN_EPI = false, bool SP2 = false>
__device__ __forceinline__ void gemm_phase(PG8_LAS unsigned char* lds, const Gemm g, const Sched& S, const Epi& E) {
    const int tid = threadIdx.x, wid = __builtin_amdgcn_readfirstlane(tid >> 6), lane = tid & 63, wr = wid >> 2, wc = wid & 3, fr = lane & 15, fq = lane >> 4;
    const int K = g.K, nt = K / BK;
    unsigned voffA[2], voffB[2];
#pragma unroll
    for (int i = 0; i < 2; ++i) { int R, C; stage_rc(tid * 16 + i * 8192, R, C); const int Rb = Epi::PERM ? ((R & ~31) + perm32(R & 31)) : R;
        voffA[i] = (unsigned)(R * g.ld + C) * 2u; voffB[i] = (unsigned)(Rb * g.ld + C) * 2u; }
    const size_t kstep = (size_t)(BK * 2);
    const size_t hstep = (size_t)HALF * g.ld * 2;
    const size_t tstep = 2 * hstep;
    const unsigned ldsw = (unsigned)wid * 1024u;
    const int aoff = lds_byte(wr * 64 + fr, fq * 8), boff = lds_byte(wc * 32 + fr, fq * 8);
#define PG8_SA(b, h) (((b) * 2 + (h)) * HTB)
#define PG8_SB(b, h) ((4 + (b) * 2 + (h)) * HTB)
#define PG8_STAGE(bufoff, gbase, voff) do { _Pragma("unroll") for (int _i = 0; _i < 2; ++_i) \
        __builtin_amdgcn_global_load_lds((const unsigned*)((const char*)(gbase) + (voff)[_i]), (PG8_LAS unsigned*)(lds + (bufoff) + ldsw + _i * 8192), 16, 0, 0); } while (0)
#define PG8_LDA(dst, b, h) do { _Pragma("unroll") for (int m = 0; m < 4; ++m) _Pragma("unroll") for (int k = 0; k < 2; ++k) dst[m][k] = *(const PG8_LAS bf16x8*)(lds + PG8_SA(b, h) + aoff + m * 2048 + k * 1024); } while (0)
#define PG8_LDB(dst, b, h) do { _Pragma("unroll") for (int n = 0; n < 2; ++n) _Pragma("unroll") for (int k = 0; k < 2; ++k) dst[n][k] = *(const PG8_LAS bf16x8*)(lds + PG8_SB(b, h) + boff + n * 2048 + k * 1024); } while (0)
#define PG8_MMA(ai, bj, At, Bt) do { __builtin_amdgcn_s_setprio(1); _Pragma("unroll") for (int m = 0; m < 4; ++m) _Pragma("unroll") for (int n = 0; n < 2; ++n) _Pragma("unroll") for (int k = 0; k < 2; ++k) \
        acc[ai][bj][m][n] = __builtin_amdgcn_mfma_f32_16x16x32_bf16(Bt[n][k], At[m][k], acc[ai][bj][m][n], 0, 0, 0); __builtin_amdgcn_s_setprio(0); } while (0)
#define PG8_WAIT_V(n) asm volatile("s_waitcnt vmcnt(" #n ")" ::: "memory")
#define PG8_WAIT_L(n) asm volatile("s_waitcnt lgkmcnt(" #n ")" ::: "memory")
#define PG8_BAR __builtin_amdgcn_s_barrier()
#define PG8_SCHED __builtin_amdgcn_sched_barrier(0)
    Unit cur, nxt; int ui = 0;
    if (!S.next(0, cur)) return;
    f32x4 acc[2][2][4][2];
#pragma unroll
    for (int a = 0; a < 2; ++a)
#pragma unroll
        for (int b = 0; b < 2; ++b)
#pragma unroll
            for (int m = 0; m < 4; ++m)
#pragma unroll
                for (int n = 0; n < 2; ++n) acc[a][b][m][n] = (f32x4){0.f, 0.f, 0.f, 0.f};
    bf16x8 At[4][2], B0[2][2], B1[2][2];
    const size_t qstep = (size_t)K * 2;
    const char* cA = g.abase(cur.pn) + (size_t)cur.pm * tstep + (size_t)cur.kq * qstep; const char* cB = (const char*)g.Bt + (size_t)cur.pn * tstep + (size_t)cur.kq * qstep;
    S.a_ready(cur);
    if constexpr (SP2) {
        PG8_STAGE(PG8_SB(0, 0), cB, voffB); PG8_STAGE(PG8_SB(0, 1), cB + hstep, voffB); PG8_STAGE(PG8_SA(0, 0), cA, voffA); PG8_STAGE(PG8_SA(0, 1), cA + hstep, voffA);
        if (wr == 1) PG8_BAR;
        PG8_WAIT_V(2); PG8_BAR;
        PG8_STAGE(PG8_SB(1, 0), cB + kstep, voffB); PG8_STAGE(PG8_SA(1, 0), cA + kstep, voffA); PG8_STAGE(PG8_SB(1, 1), cB + hstep + kstep, voffB);
        PG8_WAIT_V(6); PG8_BAR;
    } else {
        PG8_STAGE(PG8_SB(0, 0), cB, voffB); PG8_STAGE(PG8_SA(0, 0), cA, voffA); PG8_STAGE(PG8_SB(0, 1), cB + hstep, voffB); PG8_STAGE(PG8_SA(0, 1), cA + hstep, voffA);
        if (wr == 1) PG8_BAR;
        PG8_WAIT_V(4); PG8_BAR;
        PG8_STAGE(PG8_SB(1, 0), cB + kstep, voffB); PG8_STAGE(PG8_SA(1, 0), cA + kstep, voffA); PG8_STAGE(PG8_SB(1, 1), cB + hstep + kstep, voffB);
        PG8_WAIT_V(6); PG8_BAR;
    }
    for (;;) {
        const bool has_next = S.next(ui + 1, nxt);
        const char* nA = has_next ? g.abase(nxt.pn) + (size_t)nxt.pm * tstep + (size_t)nxt.kq * qstep : cA; const char* nB = has_next ? (const char*)g.Bt + (size_t)nxt.pn * tstep + (size_t)nxt.kq * qstep : cB;
        for (int t = 0; t < nt; t += 2) {
            const bool last = (t == nt - 2);
            const char* a1 = cA + (size_t)(t + 1) * kstep;
            const char* a2 = last ? nA : cA + (size_t)(t + 2) * kstep; const char* b2 = last ? nB : cB + (size_t)(t + 2) * kstep;
            const char* a3 = a2 + kstep; const char* b3 = b2 + kstep;
            if (last && has_next) S.a_ready(nxt);
            if constexpr (SP2) {
            PG8_LDB(B0, 0, 0); PG8_LDB(B1, 0, 1); PG8_SCHED; PG8_LDA(At, 0, 0); PG8_STAGE(PG8_SA(1, 1), a1 + hstep, voffA);
            PG8_WAIT_V(8); PG8_WAIT_L(0); PG8_BAR; PG8_MMA(0, 0, At, B0); PG8_MMA(0, 1, At, B1); PG8_BAR; PG8_SCHED;
            PG8_LDA(At, 0, 1); PG8_STAGE(PG8_SB(0, 0), b2, voffB); PG8_STAGE(PG8_SB(0, 1), b2 + hstep, voffB); PG8_STAGE(PG8_SA(0, 0), a2, voffA);
            PG8_WAIT_V(8); PG8_WAIT_L(0); PG8_BAR; PG8_MMA(1, 0, At, B0); PG8_MMA(1, 1, At, B1); PG8_BAR; PG8_SCHED;
            PG8_LDB(B0, 1, 0); PG8_LDB(B1, 1, 1); PG8_SCHED; PG8_LDA(At, 1, 0); PG8_STAGE(PG8_SA(0, 1), a2 + hstep, voffA);
            PG8_WAIT_V(8); PG8_WAIT_L(0); PG8_BAR; PG8_MMA(0, 0, At, B0); PG8_MMA(0, 1, At, B1); PG8_BAR; PG8_SCHED;
            PG8_LDA(At, 1, 1); PG8_STAGE(PG8_SB(1, 0), b3, voffB); PG8_STAGE(PG8_SB(1, 1), b3 + hstep, voffB); PG8_STAGE(PG8_SA(1, 0), a3, voffA);
            PG8_WAIT_V(8); PG8_WAIT_L(0); PG8_BAR; PG8_MMA(1, 0, At, B0); PG8_MMA(1, 1, At, B1); PG8_BAR; PG8_SCHED;
            } else {
            PG8_LDB(B0, 0, 0); PG8_SCHED; PG8_LDA(At, 0, 0); PG8_STAGE(PG8_SA(1, 1), a1 + hstep, voffA);
            PG8_WAIT_L(8); PG8_BAR; PG8_WAIT_L(0); PG8_MMA(0, 0, At, B0); PG8_BAR; PG8_SCHED;
            PG8_LDB(B1, 0, 1); PG8_STAGE(PG8_SB(0, 0), b2, voffB);
            PG8_BAR; PG8_WAIT_L(0); PG8_MMA(0, 1, At, B1); PG8_BAR;
            PG8_LDA(At, 0, 1); PG8_STAGE(PG8_SA(0, 0), a2, voffA);
            PG8_BAR; PG8_WAIT_L(0); PG8_MMA(1, 0, At, B0); PG8_BAR; PG8_SCHED;
            PG8_STAGE(PG8_SB(0, 1), b2 + hstep, voffB);
            PG8_WAIT_V(6); PG8_BAR; PG8_MMA(1, 1, At, B1); PG8_BAR;
            PG8_LDB(B0, 1, 0); PG8_SCHED; PG8_LDA(At, 1, 0); PG8_STAGE(PG8_SA(0, 1), a2 + hstep, voffA);
            PG8_WAIT_L(8); PG8_BAR; PG8_WAIT_L(0); PG8_MMA(0, 0, At, B0); PG8_BAR; PG8_SCHED;
            PG8_LDB(B1, 1, 1); PG8_STAGE(PG8_SB(1, 0), b3, voffB);
            PG8_BAR; PG8_WAIT_L(0); PG8_MMA(0, 1, At, B1); PG8_BAR;
            PG8_LDA(At, 1, 1); PG8_STAGE(PG8_SA(1, 0), a3, voffA);
            PG8_BAR; PG8_WAIT_L(0); PG8_MMA(1, 0, At, B0); PG8_BAR; PG8_SCHED;
            PG8_STAGE(PG8_SB(1, 1), b3 + hstep, voffB);
            PG8_WAIT_V(6); PG8_BAR; PG8_MMA(1, 1, At, B1); PG8_BAR;
            }
        }
        if constexpr (ALIGN_EPI) { if (wr == 0) PG8_BAR; }
        if constexpr (!Epi::AFTER_DRAIN) { E(acc, cur, wr, wc, fr, fq); S.done(cur); }
        if (!has_next) break;
#pragma unroll
        for (int a = 0; a < 2; ++a)
#pragma unroll
            for (int b = 0; b < 2; ++b)
#pragma unroll
                for (int m = 0; m < 4; ++m)
#pragma unroll
                    for (int n = 0; n < 2; ++n) acc[a][b][m][n] = (f32x4){0.f, 0.f, 0.f, 0.f};
        cur = nxt; cA = nA; cB = nB; ++ui;
        if constexpr (ALIGN_EPI) { if (wr == 1) PG8_BAR; }
    }
    PG8_WAIT_V(0);
    if constexpr (!ALIGN_EPI) { if (wr == 0) PG8_BAR; }
    PG8_BAR;
    if constexpr (Epi::AFTER_DRAIN) { E.fused(acc, cur, wr, wc, fr, fq, lds, wid, lane); S.done(cur); }
#undef PG8_SA
#undef PG8_SB
#undef PG8_STAGE
#undef PG8_LDA
#undef PG8_LDB
#undef PG8_MMA
#undef PG8_WAIT_V
#undef PG8_WAIT_L
#undef PG8_BAR
#undef PG8_SCHED
}
}

#ifndef MK_N_LAUNCHES
#define MK_N_LAUNCHES 1
#endif
#define LAS __attribute__((address_space(3)))
typedef unsigned short bf16;
typedef float f32x4 __attribute__((ext_vector_type(4)));
typedef float f32x2 __attribute__((ext_vector_type(2)));
typedef unsigned u32x4 __attribute__((ext_vector_type(4)));
typedef unsigned u32x2 __attribute__((ext_vector_type(2)));
typedef short bf16x8 __attribute__((ext_vector_type(8)));

constexpr int D = 1024, MP = 4096, ML = 16384, M = MP + ML, NIN = 7200, DFF = 4096;
constexpr float EPS = 1e-6f;
constexpr size_t MiB = 1u << 20;
constexpr size_t WS_MOD = 0;
constexpr size_t WS_BAR = 512 * 1024, WS_BAR_BYTES = 16384;
constexpr size_t WS_SSQ1 = 1 * MiB;
constexpr size_t WS_SSQ2 = 2560 * 1024;
constexpr size_t WS_LR = 4 * MiB;
constexpr size_t WS_WL = 8 * MiB;
constexpr size_t WS_WG = WS_WL + (size_t)2304 * 1024 * 2;
constexpr size_t WS_WY = WS_WG + (size_t)3072 * 1024 * 2;
constexpr size_t WS_WO = WS_WY + (size_t)4096 * 1024 * 2;
constexpr size_t WS_W1 = WS_WO + (size_t)1024 * 1024 * 2;
constexpr size_t WS_W2 = WS_W1 + (size_t)4096 * 1024 * 2;
constexpr size_t WS_S0 = 48 * MiB, SLOT = 40 * MiB;
static_assert(WS_W2 + (size_t)1024 * 4096 * 2 <= WS_S0, "ws map");
constexpr size_t WS_END = WS_S0 + 5 * SLOT;
constexpr int LDS_BYTES = 147456;

struct Args { const float* in[25]; float* out; unsigned char* ws; int ph_lo, ph_hi; };

__device__ __forceinline__ float bf2f(unsigned v) { return __uint_as_float(v << 16); }
__device__ __forceinline__ float bflo(unsigned w) { return __uint_as_float(w << 16); }
__device__ __forceinline__ float bfhi(unsigned w) { return __uint_as_float(w & 0xffff0000u); }
__device__ __forceinline__ unsigned pk2(float lo, float hi) { return pg8::cvt_pk_bf16(lo, hi); }
__device__ __forceinline__ float wave_sum(float v) {
#pragma unroll
    for (int o = 1; o < 64; o <<= 1) v += __shfl_xor(v, o);
    return v;
}
__device__ __forceinline__ float rcpf_(float x) { return __builtin_amdgcn_rcpf(x); }
__device__ __forceinline__ float expf_(float x) { return __builtin_amdgcn_exp2f(x * 1.4426950408889634f); }
__device__ __forceinline__ float logf_(float x) { return __builtin_amdgcn_logf(x) * 0.6931471805599453f; }
__device__ __forceinline__ float sigmoidf_(float x) { return rcpf_(1.0f + expf_(-x)); }
__device__ __forceinline__ float siluf_(float x) { return x * sigmoidf_(x); }
__device__ __forceinline__ float gelu_tanh(float x) { const float t = x * (1.5957691216f + 0.0713548163f * x * x); return x * rcpf_(1.0f + expf_(-t)); }
template <int ACT> __device__ __forceinline__ float actf(float x) {
    if (ACT == 1) return gelu_tanh(x);
    if (ACT == 2) return siluf_(x);
    if (ACT == 3) return sigmoidf_(x);
    if (ACT == 4) { const float m = fmaxf(x, 0.f); return m * m; }
    return x;
}
#define LDS_WAIT() asm volatile("s_waitcnt lgkmcnt(0)" ::: "memory")

#define XB_TMO      128
#define XB_XCNT(j)  (256  + 64 * (j))
#define XB_XSUB(j)  (1280 + 64 * (j))
#define XB_XGEN(j)  (2304 + 64 * (j))
#define XB_TOP      3328
#define XB_TOPGEN   3392
#define XCD_BAR_WORDS 3456
#define XB_SPIN_CAP (1u << 18)

__device__ __forceinline__ unsigned xb_ld(unsigned* p)              { return __hip_atomic_load(p, __ATOMIC_RELAXED, __HIP_MEMORY_SCOPE_AGENT); }
__device__ __forceinline__ unsigned xb_add(unsigned* p, unsigned v) { return __hip_atomic_fetch_add(p, v, __ATOMIC_RELAXED, __HIP_MEMORY_SCOPE_AGENT); }
__device__ __forceinline__ unsigned xb_xcc_id() { return (unsigned)__builtin_amdgcn_s_getreg((3 << 11) | 20) & 0xFu; }
#define XB_SPIN(cond, bar) do { unsigned _sp = 0; while (cond) { __builtin_amdgcn_s_sleep(1); \
    if ((++_sp & 255u) == 0u) { if (xb_ld(&(bar)[XB_TMO])) break; if (_sp > XB_SPIN_CAP) { atomicAdd(&(bar)[XB_TMO], 1u); break; } } } } while (0)

struct XcdBarrier {
    unsigned* bar; unsigned x;
    volatile LAS unsigned* st;
};

__device__ __forceinline__ XcdBarrier xcd_barrier_post(unsigned* bar, volatile LAS unsigned* st) {
    XcdBarrier b; b.bar = bar; b.x = xb_xcc_id(); b.st = st;
    if (threadIdx.x == 0) (void)xb_add(&bar[XB_XCNT(b.x)], 1u);
    return b;
}
__device__ __forceinline__ void xcd_barrier_complete(unsigned* bar, unsigned x, unsigned& nloc, unsigned& nx) {
    const unsigned G = gridDim.x * gridDim.y * gridDim.z;
    unsigned sum, cnt, mine, sp = 0u;
    for (;;) {
        sum = 0u; cnt = 0u; mine = 0u;
#pragma unroll
        for (unsigned j = 0; j < 16; ++j) { const unsigned c = xb_ld(&bar[XB_XCNT(j)]); sum += c; cnt += (c > 0u) ? 1u : 0u; mine = (j == x) ? c : mine; }
        if (sum == G) break;
        __builtin_amdgcn_s_sleep(1);
        if ((++sp & 255u) == 0u) { if (xb_ld(&bar[XB_TMO])) break; if (sp > XB_SPIN_CAP) { atomicAdd(&bar[XB_TMO], 1u); break; } }
    }
    nloc = mine > 0u ? mine : 1u; nx = cnt > 0u ? cnt : 1u;
}

__device__ __forceinline__ void xcd_barrier(const XcdBarrier& b) {
    asm volatile("s_waitcnt vmcnt(0)" ::: "memory");
    __syncthreads();
    if (threadIdx.x == 0) {
        unsigned* bar = b.bar;
        __builtin_amdgcn_s_waitcnt(0);
        unsigned nloc = b.st[0], nx = b.st[1];
        if (nloc == 0u) { xcd_barrier_complete(bar, b.x, nloc, nx); b.st[0] = nloc; b.st[1] = nx; }
        const unsigned old = xb_add(&bar[XB_XSUB(b.x)], 1u);
        const unsigned gen = old / nloc;
        if (old + 1u == (gen + 1u) * nloc) {
            __builtin_amdgcn_fence(__ATOMIC_RELEASE, "agent");
            asm volatile("s_waitcnt vmcnt(0)" ::: "memory");
            const unsigned og = xb_add(&bar[XB_TOP], 1u);
            const unsigned tg = og / nx;
            if (og + 1u == (tg + 1u) * nx) xb_add(&bar[XB_TOPGEN], 1u);
            else XB_SPIN(xb_ld(&bar[XB_TOPGEN]) == tg, bar);
            __builtin_amdgcn_fence(__ATOMIC_ACQUIRE, "agent");
            xb_add(&bar[XB_XGEN(b.x)], 1u);
            asm volatile("s_waitcnt vmcnt(0)" ::: "memory");
        } else {
            XB_SPIN(xb_ld(&bar[XB_XGEN(b.x)]) == gen, bar);
            __builtin_amdgcn_fence(__ATOMIC_ACQUIRE, "agent");
            asm volatile("s_waitcnt vmcnt(0)" ::: "memory");
        }
    }
    __syncthreads();
}

template <int ACT> __device__ __forceinline__ void store_tile(const f32x4 (&acc)[2][2][4][2], bf16* base, int ld, int row0, int col0) {
#pragma unroll
    for (int ai = 0; ai < 2; ++ai)
#pragma unroll
        for (int m = 0; m < 4; ++m) { bf16* rowp = base + (size_t)(row0 + ai * 128 + m * 16) * ld + col0;
#pragma unroll
            for (int bj = 0; bj < 2; ++bj) { const f32x4 v0 = acc[ai][bj][m][0], v1 = acc[ai][bj][m][1];
                u32x4 w; w.x = pk2(actf<ACT>(v0[0]), actf<ACT>(v0[1])); w.y = pk2(actf<ACT>(v0[2]), actf<ACT>(v0[3]));
                w.z = pk2(actf<ACT>(v1[0]), actf<ACT>(v1[1])); w.w = pk2(actf<ACT>(v1[2]), actf<ACT>(v1[3]));
                *(u32x4*)(rowp + bj * 128) = w; } }
}
struct EpiLG {
    static constexpr bool PERM = true, AFTER_DRAIN = false;
    bf16* ZX; bf16* ZG; float* LR; bf16* Q; bf16* K; bf16* V; bf16* G;
    __device__ __forceinline__ void operator()(const f32x4 (&acc)[2][2][4][2], const pg8::Unit& u, int wr, int wc, int fr, int fq) const {
        const int row0 = u.pm * 256 + wr * 64 + fr, cw = wc * 32 + 8 * fq;
        if (u.pn < 4) store_tile<0>(acc, ZX, D, row0, u.pn * 256 + cw);
        else if (u.pn < 8) store_tile<1>(acc, ZG, D, row0, (u.pn - 4) * 256 + cw);
        else if (u.pn == 8) { if (wc == 0) {
#pragma unroll
            for (int ai = 0; ai < 2; ++ai)
#pragma unroll
                for (int m = 0; m < 4; ++m) { float* rp = LR + (size_t)(row0 + ai * 128 + m * 16) * 32 + 8 * fq;
                    *(f32x4*)rp = acc[ai][0][m][0]; *(f32x4*)(rp + 4) = acc[ai][0][m][1]; } } }
        else if (u.pn < 11) store_tile<0>(acc, Q, 512, row0, (u.pn - 9) * 256 + cw);
        else if (u.pn < 13) store_tile<0>(acc, K, 512, row0, (u.pn - 11) * 256 + cw);
        else if (u.pn < 17) store_tile<0>(acc, V, D, row0, (u.pn - 13) * 256 + cw);
        else store_tile<2>(acc, G, D, row0, (u.pn - 17) * 256 + cw);
    }
};
struct EpiYY {
    static constexpr bool PERM = true, AFTER_DRAIN = false;
    bf16* YA; bf16* YB;
    __device__ __forceinline__ void operator()(const f32x4 (&acc)[2][2][4][2], const pg8::Unit& u, int wr, int wc, int fr, int fq) const {
        store_tile<0>(acc, u.pn < 4 ? YA : YB, D, u.pm * 256 + wr * 64 + fr, (u.pn & 3) * 256 + wc * 32 + 8 * fq);
    }
};
struct EpiMM {
    static constexpr bool PERM = true, AFTER_DRAIN = false;
    const bf16* YA; const bf16* YB; bf16* MM;
    __device__ __forceinline__ void operator()(const f32x4 (&acc)[2][2][4][2], const pg8::Unit& u, int wr, int wc, int fr, int fq) const {
        const int row0 = u.pm * 256 + wr * 64 + fr, c0 = u.pn * 128 + wc * 32 + 8 * fq;
#pragma unroll
        for (int ai = 0; ai < 2; ++ai)
#pragma unroll
            for (int m = 0; m < 4; ++m) { const size_t off = (size_t)(row0 + ai * 128 + m * 16) * D + c0;
                const u32x4 ya = *(const u32x4*)(YA + off), yb = *(const u32x4*)(YB + off);
                const f32x4 a0 = acc[ai][0][m][0], a1 = acc[ai][0][m][1], b0 = acc[ai][1][m][0], b1 = acc[ai][1][m][1];
#define MMV(av, bv, yv, zv) ({ const float ea_ = 1.0f + expf_(-(av)), eb_ = 1.0f + expf_(-(bv)); ((yv) * eb_ + (zv) * ea_) * rcpf_(ea_ * eb_); })
                u32x4 w;
                w.x = pk2(MMV(a0[0], b0[0], bflo(ya.x), bflo(yb.x)), MMV(a0[1], b0[1], bfhi(ya.x), bfhi(yb.x)));
                w.y = pk2(MMV(a0[2], b0[2], bflo(ya.y), bflo(yb.y)), MMV(a0[3], b0[3], bfhi(ya.y), bfhi(yb.y)));
                w.z = pk2(MMV(a1[0], b1[0], bflo(ya.z), bflo(yb.z)), MMV(a1[1], b1[1], bfhi(ya.z), bfhi(yb.z)));
                w.w = pk2(MMV(a1[2], b1[2], bflo(ya.w), bflo(yb.w)), MMV(a1[3], b1[3], bfhi(ya.w), bfhi(yb.w)));
#undef MMV
                *(u32x4*)(MM + off) = w; }
    }
};
struct EpiN {
    static constexpr bool PERM = true, AFTER_DRAIN = false;
    bf16* O; float* SSQ;
    __device__ __forceinline__ void operator()(const f32x4 (&acc)[2][2][4][2], const pg8::Unit& u, int wr, int wc, int fr, int fq) const {
        const int row0 = u.pm * 256 + wr * 64 + fr;
        store_tile<0>(acc, O, D, row0, u.pn * 256 + wc * 32 + 8 * fq);
#pragma unroll
        for (int ai = 0; ai < 2; ++ai)
#pragma unroll
            for (int m = 0; m < 4; ++m) { float ss = 0.f;
#pragma unroll
                for (int bj = 0; bj < 2; ++bj)
#pragma unroll
                    for (int n = 0; n < 2; ++n) { const f32x4 v = acc[ai][bj][m][n]; ss += (v[0] * v[0] + v[1] * v[1]) + (v[2] * v[2] + v[3] * v[3]); }
                ss += __shfl_xor(ss, 16); ss += __shfl_xor(ss, 32);
                if (fq == 0) SSQ[(size_t)(row0 + ai * 128 + m * 16) * 16 + u.pn * 4 + wc] = ss; }
    }
};
struct SplitOrder {
    int pm0, G, c;
    __device__ __forceinline__ bool next(int i, pg8::Unit& u) const { const int L = i * G + c; if (L >= 256) return false; u.kq = L & 3; u.pn = (L >> 2) & 3; u.pm = pm0 + (L >> 4); return true; }
    __device__ __forceinline__ void a_ready(const pg8::Unit&) const {}
    __device__ __forceinline__ void done(const pg8::Unit&) const {}
};
struct EpiS {
    static constexpr bool PERM = true, AFTER_DRAIN = false;
    bf16* O; bf16* P; int pm0;
    __device__ __forceinline__ void operator()(const f32x4 (&acc)[2][2][4][2], const pg8::Unit& u, int wr, int wc, int fr, int fq) const {
        const int cw = u.pn * 256 + wc * 32 + 8 * fq;
        if (u.kq == 0) store_tile<0>(acc, O, D, u.pm * 256 + wr * 64 + fr, cw);
        else store_tile<0>(acc, P + (size_t)(u.kq - 1) * 4096 * 1024, D, (u.pm - pm0) * 256 + wr * 64 + fr, cw);
    }
};
struct EpiH {
    static constexpr bool PERM = true, AFTER_DRAIN = false;
    bf16* Hd;
    __device__ __forceinline__ void operator()(const f32x4 (&acc)[2][2][4][2], const pg8::Unit& u, int wr, int wc, int fr, int fq) const {
        store_tile<4>(acc, Hd, DFF, u.pm * 256 + wr * 64 + fr, u.pn * 256 + wc * 32 + 8 * fq);
    }
};

template <bool ILV = false> __device__ __forceinline__ void tr_item(const float* W, int ld, int col0, int ncols, int K, bf16* WT, int row_off, LAS float* scr, int item, int lane) {
    const int nblk = ncols >> 5, kb = item / nblk, nb = item - kb * nblk, k0 = 64 * kb, n0 = 32 * nb;
    const int r0 = ILV ? ((n0 & 1023) >> 7) * 256 + (n0 & 127) + (n0 >> 10) * 128 : n0;
#pragma unroll 8
    for (int i = 0; i < 32; ++i) { const int kk = 2 * i + (lane >> 5); scr[kk * 33 + (lane & 31)] = W[(size_t)(k0 + kk) * ld + col0 + n0 + (lane & 31)]; }
    LDS_WAIT(); asm volatile("" ::: "memory");
    const int c = lane & 7;
#pragma unroll
    for (int j = 0; j < 4; ++j) { const int n = (lane >> 3) + 8 * j; const LAS float* s = scr + (8 * c) * 33 + n;
        u32x4 o; o.x = pk2(s[0 * 33], s[1 * 33]); o.y = pk2(s[2 * 33], s[3 * 33]); o.z = pk2(s[4 * 33], s[5 * 33]); o.w = pk2(s[6 * 33], s[7 * 33]);
        *(u32x4*)(WT + (size_t)(row_off + r0 + n) * K + k0 + 8 * c) = o; }
    LDS_WAIT(); asm volatile("" ::: "memory");
}
__device__ __forceinline__ void phase0(const Args& a, LAS unsigned char* lds, int tid, int lane, int wave) {
    LAS float* SIL = (LAS float*)lds;
    LAS float* RED = (LAS float*)(lds + 36864);
    LAS float* SCR = (LAS float*)(lds + 36864 + 18432 + wave * 8448);
    unsigned char* ws = a.ws;
    float* MOD = (float*)(ws + WS_MOD);
    for (int i = tid; i < 9 * 1024; i += 512) { const float c = i < 8192 ? a.in[4][i] : a.in[5][i - 8192]; SIL[i] = siluf_(c); }
    __syncthreads();
    for (int it = blockIdx.x; it < 96; it += gridDim.x) {
        const float* wp = a.in[6] + (size_t)(wave * 128) * 6144 + it * 64 + lane;
        float acc[9];
#pragma unroll
        for (int j = 0; j < 9; ++j) acc[j] = 0.f;
#pragma unroll 8
        for (int k = 0; k < 128; ++k) { const float w = wp[(size_t)k * 6144];
#pragma unroll
            for (int j = 0; j < 9; ++j) acc[j] += SIL[j * 1024 + wave * 128 + k] * w; }
#pragma unroll
        for (int j = 0; j < 9; ++j) RED[(wave * 9 + j) * 64 + lane] = acc[j];
        __syncthreads();
        for (int o = tid; o < 576; o += 512) { const int j = o >> 6, l = o & 63; float s = a.in[7][it * 64 + l];
#pragma unroll
            for (int w = 0; w < 8; ++w) s += RED[(w * 9 + j) * 64 + l];
            MOD[j * 6144 + it * 64 + l] = s; }
        __syncthreads();
    }
    bf16* WL = (bf16*)(ws + WS_WL); bf16* WG = (bf16*)(ws + WS_WG); bf16* WY = (bf16*)(ws + WS_WY);
    bf16* WO = (bf16*)(ws + WS_WO); bf16* W1 = (bf16*)(ws + WS_W1); bf16* W2 = (bf16*)(ws + WS_W2);
    const float* w_in = a.in[9];
    const bool split = gridDim.x >= 192;
    const int gw = split ? ((int)blockIdx.x - 96) * 8 + wave : (int)blockIdx.x * 8 + wave, NGW = split ? ((int)gridDim.x - 96) * 8 : (int)gridDim.x * 8;
    constexpr int NITEMS = 1024 + 16 + 1536 + 1024 + 512 + 512 + 512 + 2048 + 2048;
    for (int it = gw; it < NITEMS && gw >= 0; it += NGW) {
        int r = it;
        if (r < 1024) { tr_item(w_in, NIN, 0, 2048, 1024, WL, 0, SCR, r, lane); continue; } r -= 1024;
        if (r < 16) { tr_item(w_in, NIN, 5120, 32, 1024, WL, 2048, SCR, r, lane); continue; } r -= 16;
        if (r < 1536) { tr_item(w_in, NIN, 2048, 3072, 1024, WG, 0, SCR, r, lane); continue; } r -= 1536;
        if (r < 1024) { tr_item<true>(w_in, NIN, 5152, 2048, 1024, WY, 0, SCR, r, lane); continue; } r -= 1024;
        if (r < 512) { tr_item(a.in[17], 1024, 0, 1024, 1024, WY, 2048, SCR, r, lane); continue; } r -= 512;
        if (r < 512) { tr_item(a.in[21], 1024, 0, 1024, 1024, WY, 3072, SCR, r, lane); continue; } r -= 512;
        if (r < 512) { tr_item(a.in[22], 1024, 0, 1024, 1024, WO, 0, SCR, r, lane); continue; } r -= 512;
        if (r < 2048) { tr_item(a.in[23], 4096, 0, 4096, 1024, W1, 0, SCR, r, lane); continue; } r -= 2048;
        tr_item(a.in[24], 1024, 0, 1024, 4096, W2, 0, SCR, r, lane);
    }
    { u32x4* z = (u32x4*)(WL + (size_t)2080 * 1024); const u32x4 zz = {0u, 0u, 0u, 0u};
      for (int i = blockIdx.x * 512 + tid; i < 224 * 1024 / 8; i += gridDim.x * 512) z[i] = zz; }
}

__device__ __forceinline__ const float* xrow(const Args& a, int m) { return m < MP ? a.in[0] + (size_t)m * D : a.in[1] + (size_t)(m - MP) * D; }
__device__ __forceinline__ int modgrp(int m) { return m < MP ? 8 : ((m - MP) >> 11); }
__device__ __forceinline__ void phase1(const Args& a, bf16* H, int lane, int wave) {
    const float* MOD = (const float*)(a.ws + WS_MOD); const float* ng = a.in[8];
    const int stride = gridDim.x * 8; int m = blockIdx.x * 8 + wave;
    f32x4 v[4];
    if (m < M) { const f32x4* xr = (const f32x4*)xrow(a, m) + lane;
#pragma unroll
        for (int q = 0; q < 4; ++q) v[q] = xr[64 * q]; }
    for (; m < M; m += stride) {
        f32x4 vn[4]; const int mn = m + stride;
#pragma unroll
        for (int q = 0; q < 4; ++q) vn[q] = v[q];
        if (mn < M) { const f32x4* xr = (const f32x4*)xrow(a, mn) + lane;
#pragma unroll
            for (int q = 0; q < 4; ++q) vn[q] = xr[64 * q]; }
        const float* md = MOD + modgrp(m) * 6144;
        float s = 0.f;
#pragma unroll
        for (int q = 0; q < 4; ++q) s += (v[q][0] * v[q][0] + v[q][1] * v[q][1]) + (v[q][2] * v[q][2] + v[q][3] * v[q][3]);
        const float rstd = rsqrtf(wave_sum(s) * (1.f / D) + EPS);
        u32x2* o = (u32x2*)(H + (size_t)m * D) + lane;
#pragma unroll
        for (int q = 0; q < 4; ++q) { const int c = 4 * (lane + 64 * q);
            const f32x4 g = *(const f32x4*)(ng + c), sh = *(const f32x4*)(md + c), sc = *(const f32x4*)(md + 1024 + c);
            const f32x4 r = v[q] * rstd * g * (sc + 1.0f) + sh;
            u32x2 w; w.x = pk2(r[0], r[1]); w.y = pk2(r[2], r[3]); o[64 * q] = w; }
#pragma unroll
        for (int q = 0; q < 4; ++q) v[q] = vn[q];
    }
}

__device__ __forceinline__ void lru_phase(const Args& a, LAS unsigned char* lds, int tid, int lane, int wave) {
    LAS bf16* XC = (LAS bf16*)lds;
    LAS float* AU = (LAS float*)(lds + 18432);
    LAS float* SUBA = (LAS float*)(lds + 18432 + 69632);
    LAS float* HC = SUBA + 8 * 64 * 2;
    const bf16* ZX = (const bf16*)a.out;
    bf16* HF = (bf16*)(a.ws + WS_S0 + 2 * SLOT); bf16* HB = (bf16*)(a.ws + WS_S0);
    const float* conv_w = a.in[10]; const float* conv_b = a.in[11];
    const int col = lane & 15, quad = lane >> 4, mt = wave & 3, nh = wave >> 2;
    const int vcu = (gridDim.x % 8 == 0) ? (int)(blockIdx.x % 8) * (int)(gridDim.x / 8) + (int)(blockIdx.x / 8) : (int)blockIdx.x;
    int cur_key = -1;
    bf16x8 Bf[2][2][2]; float ba_[2], bx_[2], c8_[2]; f32x4 cwv[4][2]; f32x4 cb0, cb1;
    const int tokA = tid >> 3, c8A = (tid & 7) * 8;
    for (int u = vcu; u < 768; u += gridDim.x) {
        const bool lat = u < 256; const int v = lat ? u : u - 256; const int b = v >> 5, blk = (v >> 1) & 15, dir = v & 1;
        const int row_base = lat ? MP + b * 2048 : b * 256, nseg = lat ? 32 : 4;
        bf16* HX = dir ? HB : HF;
        const int ch0A = blk * 64 + c8A;
        if ((blk * 2 + dir) != cur_key) { cur_key = blk * 2 + dir;
        const float* wa = a.in[12] + (size_t)(dir * 16 + blk) * 4096; const float* wx = a.in[14] + (size_t)(dir * 16 + blk) * 4096;
#pragma unroll
        for (int nt = 0; nt < 2; ++nt)
#pragma unroll
            for (int kk = 0; kk < 2; ++kk)
#pragma unroll
                for (int i = 0; i < 8; i += 2) { const int k = kk * 32 + quad * 8 + i, n = nh * 32 + nt * 16 + col;
                    const unsigned pa = pk2(wa[k * 64 + n], wa[(k + 1) * 64 + n]), px = pk2(wx[k * 64 + n], wx[(k + 1) * 64 + n]);
                    Bf[0][nt][kk][i] = (short)(pa & 0xffffu); Bf[0][nt][kk][i + 1] = (short)(pa >> 16);
                    Bf[1][nt][kk][i] = (short)(px & 0xffffu); Bf[1][nt][kk][i + 1] = (short)(px >> 16); }
#pragma unroll
        for (int nt = 0; nt < 2; ++nt) { const int ch = dir * 1024 + blk * 64 + nh * 32 + nt * 16 + col;
            ba_[nt] = -1.4426950408889634f * a.in[13][ch]; bx_[nt] = -1.4426950408889634f * a.in[15][ch]; c8_[nt] = -8.0f * 1.4426950408889634f * log1pf(expf(-a.in[16][ch])); }
#pragma unroll
        for (int j = 0; j < 4; ++j) { cwv[j][0] = *(const f32x4*)(conv_w + j * 1024 + ch0A); cwv[j][1] = *(const f32x4*)(conv_w + j * 1024 + ch0A + 4); }
        cb0 = *(const f32x4*)(conv_b + ch0A); cb1 = *(const f32x4*)(conv_b + ch0A + 4);
        }
        if (tid < 64) HC[tid] = lat ? a.in[2][(size_t)(b * 2 + dir) * 1024 + blk * 64 + tid] : 0.f;
        const int nst = nseg >> 1;
        u32x4 Zg[2][4];
#define LRU_FETCH(t0_) do { _Pragma("unroll") for (int hh_ = 0; hh_ < 2; ++hh_) { const int t0h_ = (t0_) + 64 * hh_; const int lo_ = lat ? t0h_ : 0, hi_ = lat ? t0h_ + 64 : 256; \
            _Pragma("unroll") for (int j_ = 0; j_ < 4; ++j_) { const int t_ = t0h_ + tokA + j_ - 1; \
                Zg[hh_][j_] = (t_ >= lo_ && t_ < hi_) ? *(const u32x4*)(ZX + (size_t)(row_base + t_) * D + ch0A) : (u32x4){0u, 0u, 0u, 0u}; } } } while (0)
        LRU_FETCH((dir ? nst - 1 : 0) * 128);
        for (int s = 0; s < nst; ++s) {
            const int st = dir ? nst - 1 - s : s, t0 = st * 128;
#pragma unroll
            for (int hh = 0; hh < 2; ++hh) {
                f32x4 x0 = cb0, x1 = cb1;
#pragma unroll
                for (int j = 0; j < 4; ++j) { const u32x4 z = Zg[hh][j]; const f32x4 w0 = cwv[j][0], w1 = cwv[j][1];
                    x0[0] += w0[0] * bflo(z.x); x0[1] += w0[1] * bfhi(z.x); x0[2] += w0[2] * bflo(z.y); x0[3] += w0[3] * bfhi(z.y);
                    x1[0] += w1[0] * bflo(z.z); x1[1] += w1[1] * bfhi(z.z); x1[2] += w1[2] * bflo(z.w); x1[3] += w1[3] * bfhi(z.w); }
                u32x4 w; w.x = pk2(x0[0], x0[1]); w.y = pk2(x0[2], x0[3]); w.z = pk2(x1[0], x1[1]); w.w = pk2(x1[2], x1[3]);
                *(LAS u32x4*)(XC + (64 * hh + tokA) * 72 + c8A) = w;
            }
            __syncthreads();
            if (s + 1 < nst) LRU_FETCH((dir ? nst - 2 - s : s + 1) * 128);
#pragma unroll
            for (int hh = 0; hh < 2; ++hh) {
                bf16x8 Af[2];
#pragma unroll
                for (int kk = 0; kk < 2; ++kk) Af[kk] = *(const LAS bf16x8*)(XC + (64 * hh + 16 * mt + col) * 72 + kk * 32 + quad * 8);
                f32x4 ar[2], ai[2];
#pragma unroll
                for (int nt = 0; nt < 2; ++nt) { ar[nt] = (f32x4){0.f, 0.f, 0.f, 0.f}; ai[nt] = (f32x4){0.f, 0.f, 0.f, 0.f};
#pragma unroll
                    for (int kk = 0; kk < 2; ++kk) { ar[nt] = __builtin_amdgcn_mfma_f32_16x16x32_bf16(Af[kk], Bf[0][nt][kk], ar[nt], 0, 0, 0);
                        ai[nt] = __builtin_amdgcn_mfma_f32_16x16x32_bf16(Af[kk], Bf[1][nt][kk], ai[nt], 0, 0, 0); } }
                float xv[2][4];
#pragma unroll
                for (int nt = 0; nt < 2; ++nt)
#pragma unroll
                    for (int j = 0; j < 4; ++j) xv[nt][j] = bf2f((unsigned)XC[(64 * hh + 16 * mt + quad * 4 + j) * 72 + nh * 32 + nt * 16 + col]);
#pragma unroll
                for (int nt = 0; nt < 2; ++nt)
#pragma unroll
                    for (int j = 0; j < 4; ++j) { const int tok = 64 * hh + 16 * mt + quad * 4 + j, chl = nh * 32 + nt * 16 + col;
                        const float er = 1.0f + __builtin_amdgcn_exp2f(fmaf(ar[nt][j], -1.4426950408889634f, ba_[nt])), ei = 1.0f + __builtin_amdgcn_exp2f(fmaf(ai[nt][j], -1.4426950408889634f, bx_[nt]));
                        const float inv = rcpf_(er * ei), r = inv * ei, ig = inv * er;
                        const float aa = __builtin_amdgcn_exp2f(c8_[nt] * r);
                        const float uu = __builtin_amdgcn_sqrtf(fmaxf(1.0f - aa * aa, 0.f)) * ig * xv[nt][j];
                        typedef float f32x2s __attribute__((ext_vector_type(2)));
                        *(LAS f32x2s*)(AU + (tok * 68 + chl) * 2) = (f32x2s){aa, uu}; }
            }
            __syncthreads();
            {
                typedef float f32x2l __attribute__((ext_vector_type(2)));
                f32x2l p[16];
#pragma unroll
                for (int e = 0; e < 16; ++e) { const int i = wave * 16 + e; const int tok = dir ? 127 - i : i; p[e] = *(const LAS f32x2l*)(AU + (tok * 68 + lane) * 2); }
                float hl = 0.f, cp = 1.f;
#pragma unroll
                for (int e = 0; e < 16; ++e) { hl = p[e].x * hl + p[e].y; cp *= p[e].x; p[e].y = hl; p[e].x = cp; }
                *(LAS f32x2l*)(SUBA + (wave * 64 + lane) * 2) = (f32x2l){cp, hl};
                __syncthreads();
                float c = HC[(s & 1) * 64 + lane];
#pragma unroll
                for (int s2 = 0; s2 < 7; ++s2) { const f32x2l q = *(const LAS f32x2l*)(SUBA + (s2 * 64 + lane) * 2); if (s2 < wave) c = q.x * c + q.y; }
#pragma unroll
                for (int e = 0; e < 16; ++e) { const int i = wave * 16 + e; const int tok = dir ? 127 - i : i; *(LAS f32x2l*)(AU + (tok * 68 + lane) * 2) = (f32x2l){p[e].x, p[e].y + p[e].x * c}; }
                if (wave == 7) HC[((s + 1) & 1) * 64 + lane] = p[15].y + p[15].x * c;
            }
            __syncthreads();
#pragma unroll
            for (int hh = 0; hh < 2; ++hh) {
                const LAS f32x4* hq = (const LAS f32x4*)(AU + ((64 * hh + tokA) * 68 + c8A) * 2);
                const f32x4 q0 = hq[0], q1 = hq[1], q2 = hq[2], q3 = hq[3];
                u32x4 w; w.x = pk2(q0[1], q0[3]); w.y = pk2(q1[1], q1[3]); w.z = pk2(q2[1], q2[3]); w.w = pk2(q3[1], q3[3]);
                *(u32x4*)(HX + (size_t)(row_base + t0 + 64 * hh + tokA) * D + blk * 64 + c8A) = w;
            }
        }
#undef LRU_FETCH
        if (!lat && tid < 64) a.out[(size_t)M * D + (size_t)(b * 2 + dir) * 1024 + blk * 64 + tid] = HC[(nst & 1) * 64 + tid];
        __syncthreads();
    }
}

constexpr size_t WS_DEC = 6656 * 1024;
__device__ __forceinline__ void gla_prep(const Args& a, LAS unsigned char* lds, int tid, bf16* ewd, const bf16* ewa, const bf16* ewb) {
    LAS float* LRS = (LAS float*)lds;
    const float* LR = (const float*)(a.ws + WS_LR);
    bf16* EFb = (bf16*)a.out; bf16* EBb = EFb + (size_t)M * 512;
    float* DECg = (float*)(a.ws + WS_DEC);
    const size_t ew_n = (size_t)M * D / 8, ew_stride = (size_t)gridDim.x * 512; size_t ew_i = (size_t)blockIdx.x * 512 + tid;
    for (int it = blockIdx.x; it < 640; it += gridDim.x) {
        const int gc = it >> 1, dir = it & 1; const bool lat = gc >= 64; const int g2 = lat ? gc - 64 : gc;
        const int b = lat ? (g2 >> 5) : (g2 >> 2), cn = lat ? (g2 & 31) : (g2 & 3), p0 = cn * 64;
        const int row_base = lat ? MP + b * 2048 : b * 256;
        bf16* Eb = dir ? EBb : EFb;
        float w2r[16];
#pragma unroll
        for (int r = 0; r < 16; ++r) w2r[r] = a.in[18][(size_t)(dir * 16 + r) * 512 + tid];
        const float b2v = a.in[19][dir * 512 + tid];
        __syncthreads();
        if (tid < 256) { const int i = tid >> 2; const int p_ = dir ? p0 + 63 - i : p0 + i; const int row = lat ? row_base + (p_ & 31) * 64 + (p_ >> 5) : row_base + p_;
            *(LAS f32x4*)(LRS + i * 16 + (tid & 3) * 4) = *(const f32x4*)(LR + (size_t)row * 32 + dir * 16 + (tid & 3) * 4); }
        __syncthreads();
        float run = 0.f;
#pragma unroll 1
        for (int i8 = 0; i8 < 64; i8 += 8) {
            const bool ew_on = ew_i < ew_n; u32x4 ex0 = {0u, 0u, 0u, 0u}, ex1 = ex0, ey0 = ex0;
            if (ew_on) { ex0 = ((const u32x4*)ewa)[ew_i]; ex1 = ((const u32x4*)ewb)[ew_i]; ey0 = ((const u32x4*)ewd)[ew_i]; }
#pragma unroll
            for (int i7 = 0; i7 < 8; ++i7) { const int i = i8 + i7; const int p_ = dir ? p0 + 63 - i : p0 + i; const int row = lat ? row_base + (p_ & 31) * 64 + (p_ >> 5) : row_base + p_;
                const LAS f32x4* lrp = (const LAS f32x4*)(LRS + i * 16);
                const f32x4 l0 = lrp[0], l1 = lrp[1], l2 = lrp[2], l3 = lrp[3];
                float x = b2v;
                x += l0[0] * w2r[0]; x += l0[1] * w2r[1]; x += l0[2] * w2r[2]; x += l0[3] * w2r[3];
                x += l1[0] * w2r[4]; x += l1[1] * w2r[5]; x += l1[2] * w2r[6]; x += l1[3] * w2r[7];
                x += l2[0] * w2r[8]; x += l2[1] * w2r[9]; x += l2[2] * w2r[10]; x += l2[3] * w2r[11];
                x += l3[0] * w2r[12]; x += l3[1] * w2r[13]; x += l3[2] * w2r[14]; x += l3[3] * w2r[15];
                run += (fminf(x, 0.f) - logf_(1.0f + expf_(-fabsf(x)))) * 0.0625f;
                Eb[(size_t)row * 512 + tid] = (bf16)(pk2(expf_(run), 0.f) & 0xffffu); }
            if (ew_on) { u32x4 o;
#pragma unroll
                for (int e = 0; e < 4; ++e) o[e] = pk2((bflo(ex0[e]) + bflo(ex1[e])) * bflo(ey0[e]), (bfhi(ex0[e]) + bfhi(ex1[e])) * bfhi(ey0[e]));
                ((u32x4*)ewd)[ew_i] = o; ew_i += ew_stride; }
        }
        DECg[((size_t)dir * 320 + gc) * 512 + tid] = expf_(run);
    }
    for (; ew_i < ew_n; ew_i += ew_stride) { const u32x4 ex0 = ((const u32x4*)ewa)[ew_i], ex1 = ((const u32x4*)ewb)[ew_i], ey0 = ((const u32x4*)ewd)[ew_i]; u32x4 o;
#pragma unroll
        for (int e = 0; e < 4; ++e) o[e] = pk2((bflo(ex0[e]) + bflo(ex1[e])) * bflo(ey0[e]), (bfhi(ex0[e]) + bfhi(ex1[e])) * bfhi(ey0[e]));
        ((u32x4*)ewd)[ew_i] = o; }
}

__device__ __forceinline__ void gla_phase(const Args& a, LAS unsigned char* lds, int tid, int lane, int wave) {
    LAS bf16* QE = (LAS bf16*)lds;
    LAS bf16* KE = QE + 64 * 136;
    LAS bf16* ST = KE + 64 * 136;
    LAS bf16* KT = ST + 64 * 136;
    LAS bf16* VT = KT + 128 * 72;
    LAS bf16* PP = VT + 64 * 72;
    LAS bf16* EE = PP + 64 * 72;
    LAS float* DEC = (LAS float*)(EE + 64 * 136);
    const unsigned char* ws = a.ws;
    const bf16* EFb = (const bf16*)a.out; const bf16* EBb = EFb + (size_t)M * 512;
    const float* DECg = (const float*)(ws + WS_DEC);
    const bf16* Qb = (const bf16*)(ws + WS_S0 + 3 * SLOT); const bf16* Kb = Qb + (size_t)M * 512;
    const bf16* Vb = (const bf16*)(ws + WS_S0 + 4 * SLOT);
    bf16* OFb = (bf16*)(a.ws + WS_S0 + 2 * SLOT); bf16* OBb = (bf16*)(a.ws + WS_S0);
    const int ch = tid & 127, sub = __builtin_amdgcn_readfirstlane(tid >> 7);
    const int col = lane & 15, quad = lane >> 4, kt = wave;
    float* SG = a.out + (size_t)M * D + 16 * 2 * 1024;
    const int vcu = (gridDim.x % 8 == 0) ? (int)(blockIdx.x % 8) * (int)(gridDim.x / 8) + (int)(blockIdx.x / 8) : (int)blockIdx.x;
    for (int u = vcu; u < 768; u += gridDim.x) {
        const bool lat = u < 256; const int v = lat ? u : u - 256; const int b = v >> 5, hd = (v >> 3) & 3, dir = (v >> 2) & 1, sl = v & 3;
        const int row_base = lat ? MP + b * 2048 : b * 256, nch = lat ? 32 : 4, gc0 = lat ? 64 + b * 32 : b * 4;
        bf16* Ob = dir ? OBb : OFb; const bf16* Eb = dir ? EBb : EFb;
        f32x4 S[4];
#pragma unroll
        for (int vt = 0; vt < 4; ++vt)
#pragma unroll
            for (int j = 0; j < 4; ++j)
                S[vt][j] = lat ? a.in[3][((((size_t)(b * 2 + dir) * 4 + hd) * 128 + 16 * kt + quad * 4 + j) * 256) + sl * 64 + 16 * vt + col] : 0.f;
#define GROWP(p0_, i) ({ const int p_ = dir ? (p0_) + 63 - (i) : (p0_) + (i); lat ? row_base + (p_ & 31) * 64 + (p_ >> 5) : row_base + p_; })
        u32x4 QgA[2], KgA[2], EgA[2], VgA, QgB[2], KgB[2], EgB[2], VgB; f32x2 etgA, etgB;
#define GLA_FETCH(X, cn_) do { const int p0_ = (cn_) * 64; \
            _Pragma("unroll") for (int e_ = 0; e_ < 2; ++e_) { const int pc_ = tid + e_ * 512; const size_t ro_ = (size_t)GROWP(p0_, pc_ >> 4) * 512 + hd * 128 + (pc_ & 15) * 8; \
                Qg##X[e_] = *(const u32x4*)(Qb + ro_); Kg##X[e_] = *(const u32x4*)(Kb + ro_); Eg##X[e_] = *(const u32x4*)(Eb + ro_); } \
            Vg##X = *(const u32x4*)(Vb + (size_t)GROWP(p0_, tid & 63) * D + hd * 256 + sl * 64 + (tid >> 6) * 8); \
            etg##X = *(const f32x2*)(DECg + ((size_t)dir * 320 + gc0 + (cn_)) * 512 + hd * 128 + 2 * lane); } while (0)
#define GLA_CHUNK(X, n) do { const int cn = dir ? nch - 1 - (n) : (n), p0 = cn * 64; \
            __syncthreads(); \
_Pragma("unroll") \
            for (int vt = 0; vt < 4; ++vt) { u32x2 w; w.x = pk2(S[vt][0], S[vt][1]); w.y = pk2(S[vt][2], S[vt][3]); \
                *(LAS u32x2*)(ST + (16 * vt + col) * 136 + 16 * kt + quad * 4) = w; } \
_Pragma("unroll") \
            for (int e = 0; e < 2; ++e) { const int pc = tid + e * 512, o_ = (pc >> 4) * 136 + (pc & 15) * 8; \
                  \
                const u32x4 qr = Qg##X[e], kr = Kg##X[e], er = Eg##X[e]; u32x4 qo, ko; \
_Pragma("unroll") \
                for (int d_ = 0; d_ < 4; ++d_) { const float E0 = bflo(er[d_]), E1 = bfhi(er[d_]); const float R0 = rcpf_(E0), R1 = rcpf_(E1); \
                    qo[d_] = pk2(bflo(qr[d_]) * E0 * 0.08838834764831845f, bfhi(qr[d_]) * E1 * 0.08838834764831845f); \
                    ko[d_] = pk2(bflo(kr[d_]) * R0, bfhi(kr[d_]) * R1); } \
                *(LAS u32x4*)(QE + o_) = qo; *(LAS u32x4*)(KE + o_) = ko; } \
            {   const int i = tid & 63, v8 = (tid >> 6) * 8; const u32x4 z = Vg##X; \
                VT[(v8 + 0) * 72 + i] = (bf16)(z.x & 0xffffu); VT[(v8 + 1) * 72 + i] = (bf16)(z.x >> 16); \
                VT[(v8 + 2) * 72 + i] = (bf16)(z.y & 0xffffu); VT[(v8 + 3) * 72 + i] = (bf16)(z.y >> 16); \
                VT[(v8 + 4) * 72 + i] = (bf16)(z.z & 0xffffu); VT[(v8 + 5) * 72 + i] = (bf16)(z.z >> 16); \
                VT[(v8 + 6) * 72 + i] = (bf16)(z.w & 0xffffu); VT[(v8 + 7) * 72 + i] = (bf16)(z.w >> 16); } \
            const f32x2 etot = etg##X; \
            if (wave == 0) *(LAS f32x2*)(DEC + 2 * lane) = etot; \
            __syncthreads(); \
            if ((n) + 2 < nch) GLA_FETCH(X, dir ? nch - 3 - (n) : (n) + 2); \
            {     \
                unsigned kw_[8]; \
_Pragma("unroll") \
                for (int e = 0; e < 8; ++e) kw_[e] = *(const LAS unsigned*)(KE + (wave * 8 + e) * 136 + 2 * lane); \
                u32x4 w0, w1; \
                w0.x = pk2(bflo(kw_[0]) * etot.x, bflo(kw_[1]) * etot.x); w0.y = pk2(bflo(kw_[2]) * etot.x, bflo(kw_[3]) * etot.x); w0.z = pk2(bflo(kw_[4]) * etot.x, bflo(kw_[5]) * etot.x); w0.w = pk2(bflo(kw_[6]) * etot.x, bflo(kw_[7]) * etot.x); \
                w1.x = pk2(bfhi(kw_[0]) * etot.y, bfhi(kw_[1]) * etot.y); w1.y = pk2(bfhi(kw_[2]) * etot.y, bfhi(kw_[3]) * etot.y); w1.z = pk2(bfhi(kw_[4]) * etot.y, bfhi(kw_[5]) * etot.y); w1.w = pk2(bfhi(kw_[6]) * etot.y, bfhi(kw_[7]) * etot.y); \
                *(LAS u32x4*)(KT + (2 * lane) * 72 + wave * 8) = w0; *(LAS u32x4*)(KT + (2 * lane + 1) * 72 + wave * 8) = w1; } \
            __syncthreads(); \
            {     \
                const int st = wave >> 1, ct0 = 2 * (wave & 1); \
                f32x4 acc0 = {0.f, 0.f, 0.f, 0.f}, acc1 = {0.f, 0.f, 0.f, 0.f}; \
                if (st <= ct0 + 1) { \
_Pragma("unroll") \
                    for (int kk = 0; kk < 4; ++kk) { const bf16x8 ak = *(const LAS bf16x8*)(KE + (16 * st + col) * 136 + kk * 32 + quad * 8); \
                        if (st <= ct0) { const bf16x8 bq0 = *(const LAS bf16x8*)(QE + (16 * ct0 + col) * 136 + kk * 32 + quad * 8); acc0 = __builtin_amdgcn_mfma_f32_16x16x32_bf16(ak, bq0, acc0, 0, 0, 0); } \
                        const bf16x8 bq1 = *(const LAS bf16x8*)(QE + (16 * (ct0 + 1) + col) * 136 + kk * 32 + quad * 8); acc1 = __builtin_amdgcn_mfma_f32_16x16x32_bf16(ak, bq1, acc1, 0, 0, 0); } \
                } \
_Pragma("unroll") \
                for (int j = 0; j < 4; ++j) { if (16 * st + quad * 4 + j > 16 * ct0 + col) acc0[j] = 0.f; if (16 * st + quad * 4 + j > 16 * (ct0 + 1) + col) acc1[j] = 0.f; } \
                u32x2 w0, w1; w0.x = pk2(acc0[0], acc0[1]); w0.y = pk2(acc0[2], acc0[3]); w1.x = pk2(acc1[0], acc1[1]); w1.y = pk2(acc1[2], acc1[3]); \
                *(LAS u32x2*)(PP + (16 * ct0 + col) * 72 + 16 * st + quad * 4) = w0; *(LAS u32x2*)(PP + (16 * (ct0 + 1) + col) * 72 + 16 * st + quad * 4) = w1; \
            } \
            __syncthreads(); \
            {     \
                const int vt_ = wave >> 1, ct0 = 2 * (wave & 1); \
                bf16x8 av[2], as_[4]; \
_Pragma("unroll") \
                for (int ks = 0; ks < 2; ++ks) av[ks] = *(const LAS bf16x8*)(VT + (16 * vt_ + col) * 72 + ks * 32 + quad * 8); \
_Pragma("unroll") \
                for (int kk = 0; kk < 4; ++kk) as_[kk] = *(const LAS bf16x8*)(ST + (16 * vt_ + col) * 136 + kk * 32 + quad * 8); \
                f32x4 acc0 = {0.f, 0.f, 0.f, 0.f}, acc1 = {0.f, 0.f, 0.f, 0.f}; \
_Pragma("unroll") \
                for (int ks = 0; ks < 2; ++ks) { const bf16x8 bp0 = *(const LAS bf16x8*)(PP + (16 * ct0 + col) * 72 + ks * 32 + quad * 8), bp1 = *(const LAS bf16x8*)(PP + (16 * (ct0 + 1) + col) * 72 + ks * 32 + quad * 8); \
                    acc0 = __builtin_amdgcn_mfma_f32_16x16x32_bf16(av[ks], bp0, acc0, 0, 0, 0); acc1 = __builtin_amdgcn_mfma_f32_16x16x32_bf16(av[ks], bp1, acc1, 0, 0, 0); } \
_Pragma("unroll") \
                for (int kk = 0; kk < 4; ++kk) { const bf16x8 bq0 = *(const LAS bf16x8*)(QE + (16 * ct0 + col) * 136 + kk * 32 + quad * 8), bq1 = *(const LAS bf16x8*)(QE + (16 * (ct0 + 1) + col) * 136 + kk * 32 + quad * 8); \
                    acc0 = __builtin_amdgcn_mfma_f32_16x16x32_bf16(as_[kk], bq0, acc0, 0, 0, 0); acc1 = __builtin_amdgcn_mfma_f32_16x16x32_bf16(as_[kk], bq1, acc1, 0, 0, 0); } \
                const int row0 = GROWP(p0, 16 * ct0 + col), row1 = GROWP(p0, 16 * (ct0 + 1) + col); \
                u32x2 w0, w1; w0.x = pk2(acc0[0], acc0[1]); w0.y = pk2(acc0[2], acc0[3]); w1.x = pk2(acc1[0], acc1[1]); w1.y = pk2(acc1[2], acc1[3]); \
                *(u32x2*)(Ob + (size_t)row0 * D + hd * 256 + sl * 64 + 16 * vt_ + quad * 4) = w0; *(u32x2*)(Ob + (size_t)row1 * D + hd * 256 + sl * 64 + 16 * vt_ + quad * 4) = w1; \
                bf16x8 ak[2]; \
_Pragma("unroll") \
                for (int ks = 0; ks < 2; ++ks) ak[ks] = *(const LAS bf16x8*)(KT + (16 * kt + col) * 72 + ks * 32 + quad * 8); \
                float dk[4]; \
_Pragma("unroll") \
                for (int j = 0; j < 4; ++j) dk[j] = DEC[16 * kt + quad * 4 + j]; \
_Pragma("unroll") \
                for (int vt = 0; vt < 4; ++vt) { \
_Pragma("unroll") \
                    for (int j = 0; j < 4; ++j) S[vt][j] *= dk[j]; \
_Pragma("unroll") \
                    for (int ks = 0; ks < 2; ++ks) { const bf16x8 bv = *(const LAS bf16x8*)(VT + (16 * vt + col) * 72 + ks * 32 + quad * 8); \
                        S[vt] = __builtin_amdgcn_mfma_f32_16x16x32_bf16(ak[ks], bv, S[vt], 0, 0, 0); } } \
            } \
        } while (0)
        GLA_FETCH(A, dir ? nch - 1 : 0); GLA_FETCH(B, dir ? nch - 2 : 1);
        for (int n = 0; n < nch; n += 2) { GLA_CHUNK(A, n); GLA_CHUNK(B, n + 1); }
#undef GLA_CHUNK
#undef GLA_FETCH
#undef GROWP
        if (!lat) {
#pragma unroll
            for (int vt = 0; vt < 4; ++vt)
#pragma unroll
                for (int j = 0; j < 4; ++j)
                    SG[((((size_t)(b * 2 + dir) * 4 + hd) * 128 + 16 * kt + quad * 4 + j) * 256) + sl * 64 + 16 * vt + col] = S[vt][j];
        }
    }
}

template <int MODE> __device__ __forceinline__ void ew_pass(bf16* dst, const bf16* a0, const bf16* b0, const bf16* a1, const bf16* b1, int tid) {
    const size_t nvec = (size_t)M * D / 8;
    for (size_t i = (size_t)blockIdx.x * 512 + tid; i < nvec; i += (size_t)gridDim.x * 512) {
        const u32x4 x0 = ((const u32x4*)a0)[i], y0 = ((const u32x4*)b0)[i], x1 = ((const u32x4*)a1)[i];
        u32x4 o;
        if (MODE == 0) {
#pragma unroll
            for (int e = 0; e < 4; ++e) o[e] = pk2((bflo(x0[e]) + bflo(x1[e])) * bflo(y0[e]), (bfhi(x0[e]) + bfhi(x1[e])) * bfhi(y0[e]));
        } else {
            const u32x4 y1 = ((const u32x4*)b1)[i];
#pragma unroll
            for (int e = 0; e < 4; ++e) o[e] = pk2(bflo(x0[e]) * bflo(y0[e]) + bflo(x1[e]) * bflo(y1[e]), bfhi(x0[e]) * bfhi(y0[e]) + bfhi(x1[e]) * bfhi(y1[e]));
        }
        ((u32x4*)dst)[i] = o;
    }
}
__device__ __forceinline__ void post_gla(const Args& a, int lane, int wave) {
    const bf16* OFb = (const bf16*)(a.ws + WS_S0 + 2 * SLOT); const bf16* OBb = (const bf16*)(a.ws + WS_S0);
    bf16* G = (bf16*)(a.ws + WS_S0 + 1 * SLOT);
    const f32x4 gn = *(const f32x4*)(a.in[20] + 4 * lane);
    const int stride = gridDim.x * 8; int m = blockIdx.x * 8 + wave;
    u32x2 cf[4], cb[4], cg[4];
    if (m < M) {
#pragma unroll
        for (int hh = 0; hh < 4; ++hh) { const size_t off = (size_t)m * D + hh * 256 + 4 * lane; cf[hh] = *(const u32x2*)(OFb + off); cb[hh] = *(const u32x2*)(OBb + off); cg[hh] = *(const u32x2*)(G + off); } }
    for (; m < M; m += stride) {
        u32x2 nf[4], nb[4], ng_[4]; const int mn = m + stride;
#pragma unroll
        for (int hh = 0; hh < 4; ++hh) { nf[hh] = cf[hh]; nb[hh] = cb[hh]; ng_[hh] = cg[hh]; }
        if (mn < M) {
#pragma unroll
            for (int hh = 0; hh < 4; ++hh) { const size_t off = (size_t)mn * D + hh * 256 + 4 * lane; nf[hh] = *(const u32x2*)(OFb + off); nb[hh] = *(const u32x2*)(OBb + off); ng_[hh] = *(const u32x2*)(G + off); } }
#pragma unroll
        for (int hh = 0; hh < 4; ++hh) { const size_t off = (size_t)m * D + hh * 256 + 4 * lane;
            const u32x2 f = cf[hh], bb = cb[hh], g = cg[hh];
            f32x4 o; o[0] = bflo(f.x) + bflo(bb.x); o[1] = bfhi(f.x) + bfhi(bb.x); o[2] = bflo(f.y) + bflo(bb.y); o[3] = bfhi(f.y) + bfhi(bb.y);
            const float ss = wave_sum((o[0] * o[0] + o[1] * o[1]) + (o[2] * o[2] + o[3] * o[3]));
            const float rstd = rsqrtf(ss * (1.f / 256.f) + EPS);
            u32x2 w; w.x = pk2(o[0] * rstd * gn[0] * bflo(g.x), o[1] * rstd * gn[1] * bfhi(g.x)); w.y = pk2(o[2] * rstd * gn[2] * bflo(g.y), o[3] * rstd * gn[3] * bfhi(g.y));
            *(u32x2*)(G + off) = w; }
#pragma unroll
        for (int hh = 0; hh < 4; ++hh) { cf[hh] = nf[hh]; cb[hh] = nb[hh]; cg[hh] = ng_[hh]; }
    }
}
struct SplitRow { u32x2 o[4]; u32x2 p[3][4]; };
__device__ __forceinline__ void split_row_load(SplitRow& r, const bf16* O, const bf16* P, int m, int lane) {
#pragma unroll
    for (int q = 0; q < 4; ++q) r.o[q] = *(const u32x2*)(O + (size_t)m * D + 4 * (lane + 64 * q));
    if (m >= 16384) {
#pragma unroll
        for (int k = 0; k < 3; ++k)
#pragma unroll
            for (int q = 0; q < 4; ++q) r.p[k][q] = *(const u32x2*)(P + ((size_t)k * 4096 + (m - 16384)) * D + 4 * (lane + 64 * q)); }
}
__device__ __forceinline__ f32x4 split_row_val(const SplitRow& r, int m, int q) {
    f32x4 v; v[0] = bflo(r.o[q].x); v[1] = bfhi(r.o[q].x); v[2] = bflo(r.o[q].y); v[3] = bfhi(r.o[q].y);
    if (m >= 16384) {
#pragma unroll
        for (int k = 0; k < 3; ++k) { v[0] += bflo(r.p[k][q].x); v[1] += bfhi(r.p[k][q].x); v[2] += bflo(r.p[k][q].y); v[3] += bfhi(r.p[k][q].y); } }
    return v;
}
__device__ __forceinline__ void x1_pass(const Args& a, int lane, int wave) {
    const float* MOD = (const float*)(a.ws + WS_MOD); const float* ng = a.in[8];
    const bf16* Mm = (const bf16*)(a.ws + WS_S0 + 2 * SLOT); const bf16* Pm = (const bf16*)(a.ws + WS_S0 + 4 * SLOT); bf16* H2 = (bf16*)(a.ws + WS_S0);
    const int stride = gridDim.x * 8; int m = blockIdx.x * 8 + wave;
    SplitRow cur; f32x4 xc[4];
    if (m < M) { split_row_load(cur, Mm, Pm, m, lane); const f32x4* xr = (const f32x4*)xrow(a, m) + lane;
#pragma unroll
        for (int q = 0; q < 4; ++q) xc[q] = xr[64 * q]; }
    for (; m < M; m += stride) {
        SplitRow nxt = cur; f32x4 xn[4]; const int mn = m + stride;
#pragma unroll
        for (int q = 0; q < 4; ++q) xn[q] = xc[q];
        if (mn < M) { split_row_load(nxt, Mm, Pm, mn, lane); const f32x4* xr = (const f32x4*)xrow(a, mn) + lane;
#pragma unroll
            for (int q = 0; q < 4; ++q) xn[q] = xr[64 * q]; }
        const float* md = MOD + modgrp(m) * 6144;
        f32x4 mv[4]; float s1 = 0.f;
#pragma unroll
        for (int q = 0; q < 4; ++q) { mv[q] = split_row_val(cur, m, q); s1 += (mv[q][0] * mv[q][0] + mv[q][1] * mv[q][1]) + (mv[q][2] * mv[q][2] + mv[q][3] * mv[q][3]); }
        const float rstd1 = rsqrtf(wave_sum(s1) * (1.f / D) + EPS);
        f32x4 v[4]; float s = 0.f;
#pragma unroll
        for (int q = 0; q < 4; ++q) { const int c = 4 * (lane + 64 * q);
            const f32x4 g1 = *(const f32x4*)(md + 2048 + c), n1 = *(const f32x4*)(ng + 1024 + c);
            v[q] = xc[q] + g1 * (mv[q] * rstd1 * n1);
            *(f32x4*)(a.out + (size_t)m * D + c) = v[q];
            s += (v[q][0] * v[q][0] + v[q][1] * v[q][1]) + (v[q][2] * v[q][2] + v[q][3] * v[q][3]); }
        const float rstd = rsqrtf(wave_sum(s) * (1.f / D) + EPS);
#pragma unroll
        for (int q = 0; q < 4; ++q) { const int c = 4 * (lane + 64 * q);
            const f32x4 g = *(const f32x4*)(ng + 2048 + c), sh = *(const f32x4*)(md + 3072 + c), sc = *(const f32x4*)(md + 4096 + c);
            const f32x4 r = v[q] * rstd * g * (sc + 1.0f) + sh;
            u32x2 w; w.x = pk2(r[0], r[1]); w.y = pk2(r[2], r[3]); *(u32x2*)(H2 + (size_t)m * D + c) = w; }
        cur = nxt;
#pragma unroll
        for (int q = 0; q < 4; ++q) xc[q] = xn[q];
    }
}
__device__ __forceinline__ void fin_pass(const Args& a, int lane, int wave) {
    const float* MOD = (const float*)(a.ws + WS_MOD); const float* ng = a.in[8];
    const bf16* F = (const bf16*)(a.ws + WS_S0); const bf16* Pf = (const bf16*)(a.ws + WS_WL);
    const int stride = gridDim.x * 8; int m = blockIdx.x * 8 + wave;
    SplitRow cur; f32x4 yc[4];
    if (m < M) { split_row_load(cur, F, Pf, m, lane);
#pragma unroll
        for (int q = 0; q < 4; ++q) yc[q] = *(const f32x4*)(a.out + (size_t)m * D + 4 * (lane + 64 * q)); }
    for (; m < M; m += stride) {
        SplitRow nxt = cur; f32x4 yn[4]; const int mn = m + stride;
#pragma unroll
        for (int q = 0; q < 4; ++q) yn[q] = yc[q];
        if (mn < M) { split_row_load(nxt, F, Pf, mn, lane);
#pragma unroll
            for (int q = 0; q < 4; ++q) yn[q] = *(const f32x4*)(a.out + (size_t)mn * D + 4 * (lane + 64 * q)); }
        const float* md = MOD + modgrp(m) * 6144;
        f32x4 fv[4]; float s = 0.f;
#pragma unroll
        for (int q = 0; q < 4; ++q) { fv[q] = split_row_val(cur, m, q); s += (fv[q][0] * fv[q][0] + fv[q][1] * fv[q][1]) + (fv[q][2] * fv[q][2] + fv[q][3] * fv[q][3]); }
        const float rstd = rsqrtf(wave_sum(s) * (1.f / D) + EPS);
#pragma unroll
        for (int q = 0; q < 4; ++q) { const int c = 4 * (lane + 64 * q);
            const f32x4 g2 = *(const f32x4*)(md + 5120 + c), n3 = *(const f32x4*)(ng + 3072 + c);
            *(f32x4*)(a.out + (size_t)m * D + c) = yc[q] + g2 * (fv[q] * rstd * n3); }
        cur = nxt;
#pragma unroll
        for (int q = 0; q < 4; ++q) yc[q] = yn[q];
    }
}

constexpr int NPHASE = 14;
__global__ void __launch_bounds__(512, 2) mk_fwd(Args a) {
    extern __shared__ __attribute__((aligned(16))) unsigned char lds_raw[];
    LAS unsigned char* lds = (LAS unsigned char*)lds_raw;
    cg::grid_group grid = cg::this_grid();
    const int tid = threadIdx.x, lane = tid & 63, wave = __builtin_amdgcn_readfirstlane(tid >> 6);
    const int lo = a.ph_lo, hi = a.ph_hi, G = gridDim.x;
    volatile LAS unsigned* MISC = (volatile LAS unsigned*)(lds + LDS_BYTES - 64);
    if (tid < 16) MISC[tid] = 0u;
    __syncthreads();
    const XcdBarrier bar = xcd_barrier_post((unsigned*)(a.ws + WS_BAR), MISC);
    unsigned char* ws = a.ws;
    bf16* S0 = (bf16*)(ws + WS_S0); bf16* S1 = (bf16*)(ws + WS_S0 + SLOT); bf16* S2 = (bf16*)(ws + WS_S0 + 2 * SLOT);
    bf16* S3 = (bf16*)(ws + WS_S0 + 3 * SLOT); bf16* S4 = (bf16*)(ws + WS_S0 + 4 * SLOT);
    bf16* D0 = (bf16*)a.out; bf16* D1 = D0 + (size_t)M * D;
#ifndef MK_MASK
#define MK_MASK 0x3fff
#endif
#define IN(k) (((MK_MASK >> (k)) & 1) && lo <= (k) && (k) < hi)
#define SEAM(k) do { if (IN(k) && IN((k) + 1)) xcd_barrier(bar); } while (0)
    if (lo < 0) grid.sync();
    if (IN(0)) { phase0(a, lds, tid, lane, wave); } SEAM(0);
    if (IN(1)) { phase1(a, S0, lane, wave); } SEAM(1);
    if (IN(2)) {
        pg8::Gemm g{S0, (const bf16*)(ws + WS_WL), M, 5376, 1024, S0, S0, 1 << 30, 1 << 30, 1024}; pg8::StaticOrder S; S.init(M, 5376, G, (int)blockIdx.x);
        EpiLG E{D0, D1, (float*)(ws + WS_LR), S3, S3 + (size_t)M * 512, S4, S1};
        pg8::gemm_phase<EpiLG, pg8::StaticOrder, true, true>(lds, g, S, E);
    } SEAM(2);
    if (IN(3)) { lru_phase(a, lds, tid, lane, wave); } SEAM(3);
    if (IN(4)) {
        gla_prep(a, lds, tid, D1, S2, S0);
    } SEAM(4);
    if (IN(5)) { gla_phase(a, lds, tid, lane, wave); } SEAM(5);
    if (IN(6)) { post_gla(a, lane, wave); phase1(a, S3, lane, wave); } SEAM(6);
    if (IN(7)) {
        pg8::Gemm g{D1, (const bf16*)(ws + WS_WY) + (size_t)2048 * 1024, M, 2048, 1024, S1, S1, 4, 1 << 30, 1024}; pg8::StaticOrder S; S.init(M, 2048, G, (int)blockIdx.x);
        EpiYY E{S4, D0};
        pg8::gemm_phase<EpiYY, pg8::StaticOrder, true, true>(lds, g, S, E);
    } SEAM(7);
    if (IN(8)) {
        pg8::Gemm g{S3, (const bf16*)(ws + WS_WY), M, 2048, 1024, S3, S3, 1 << 30, 1 << 30, 1024}; pg8::StaticOrder S; S.init(M, 2048, G, (int)blockIdx.x);
        EpiMM E{S4, D0, S0};
        pg8::gemm_phase<EpiMM, pg8::StaticOrder, true, true>(lds, g, S, E);
    } SEAM(8);
    if (IN(9)) {
        { pg8::Gemm g{S0, (const bf16*)(ws + WS_WO), 16384, 1024, 1024, S0, S0, 1 << 30, 1 << 30, 1024}; pg8::StaticOrder S; S.init(16384, 1024, G, (int)blockIdx.x);
          EpiS E{S2, S4, 64}; pg8::gemm_phase<EpiS, pg8::StaticOrder, true, true>(lds, g, S, E); }
        { pg8::Gemm g{S0, (const bf16*)(ws + WS_WO), M, 1024, 256, S0, S0, 1 << 30, 1 << 30, 1024}; SplitOrder S{64, G, (int)blockIdx.x};
          EpiS E{S2, S4, 64}; pg8::gemm_phase<EpiS, SplitOrder, true, true>(lds, g, S, E); }
    } SEAM(9);
    if (IN(10)) { x1_pass(a, lane, wave); } SEAM(10);
    if (IN(11)) {
        pg8::Gemm g{S0, (const bf16*)(ws + WS_W1), M, 4096, 1024, S0, S0, 1 << 30, 1 << 30, 1024}; pg8::StaticOrder S; S.init(M, 4096, G, (int)blockIdx.x);
        EpiH E{S1};
        pg8::gemm_phase<EpiH, pg8::StaticOrder, true, true>(lds, g, S, E);
    } SEAM(11);
    if (IN(12)) {
        { pg8::Gemm g{S1, (const bf16*)(ws + WS_W2), 16384, 1024, 4096, S1, S1, 1 << 30, 1 << 30, 4096}; pg8::StaticOrder S; S.init(16384, 1024, G, (int)blockIdx.x);
          EpiS E{S0, (bf16*)(ws + WS_WL), 64}; pg8::gemm_phase<EpiS, pg8::StaticOrder, true, true>(lds, g, S, E); }
        { pg8::Gemm g{S1, (const bf16*)(ws + WS_W2), M, 1024, 1024, S1, S1, 1 << 30, 1 << 30, 4096}; SplitOrder S{64, G, (int)blockIdx.x};
          EpiS E{S0, (bf16*)(ws + WS_WL), 64}; pg8::gemm_phase<EpiS, SplitOrder, true, true>(lds, g, S, E); }
    } SEAM(12);
    if (IN(13)) { fin_pass(a, lane, wave); }
#undef IN
#undef SEAM
}

extern "C" void kernel_launch(void* const* d_in, const int* in_sizes, int n_in, void* d_out, int out_size, void* d_ws, size_t ws_size, hipStream_t stream) {
    static int grid = 0;
    if (grid == 0) {
        if (n_in != 25 || ws_size < WS_END) { fprintf(stderr, "kernel_launch: unexpected n_in %d / ws %zu\n", n_in, ws_size); grid = -1; return; }
        int dev = 0, cus = 0, per_cu = 0;
        hipGetDevice(&dev); hipDeviceGetAttribute(&cus, hipDeviceAttributeMultiprocessorCount, dev);
        if (hipFuncSetAttribute((const void*)mk_fwd, hipFuncAttributeMaxDynamicSharedMemorySize, LDS_BYTES) != hipSuccess) { fprintf(stderr, "kernel_launch: hipFuncSetAttribute failed\n"); grid = -1; return; }
        if (hipOccupancyMaxActiveBlocksPerMultiprocessor(&per_cu, (const void*)mk_fwd, 512, LDS_BYTES) != hipSuccess || per_cu < 1) { fprintf(stderr, "kernel_launch: occupancy query says %d\n", per_cu); per_cu = 1; }
        (void)hipGetLastError();
        grid = cus * 1;
    }
    if (grid < 0) return;
    if (hipMemsetAsync((char*)d_ws + WS_BAR, 0, WS_BAR_BYTES, stream) != hipSuccess) { fprintf(stderr, "kernel_launch: memset failed\n"); return; }
    Args a{};
    for (int i = 0; i < 25; ++i) a.in[i] = (const float*)d_in[i];
    a.out = (float*)d_out; a.ws = (unsigned char*)d_ws;
    constexpr int NL = MK_N_LAUNCHES;
    for (int li = 0; li < NL; ++li) {
        a.ph_lo = (NL == 1) ? 0 : li; a.ph_hi = (NL == 1) ? NPHASE : li + 1;
        void* args[] = {&a};
        hipError_t e = hipLaunchCooperativeKernel((const void*)mk_fwd, dim3(grid), dim3(512), args, LDS_BYTES, stream);
        if (e != hipSuccess) { fprintf(stderr, "kernel_launch: cooperative launch %d failed: %s\n", li, hipGetErrorString(e)); break; }
    }
}
```

```cpp
#include <hip/hip_runtime.h>
#include <hip/hip_cooperative_groups.h>
#include <cstdio>
#include <cstdint>
namespace cg = cooperative_groups;
namespace pg8 {
#define PG8_LAS __attribute__((address_space(3)))
typedef unsigned short bf16_t;
typedef short bf16x8 __attribute__((ext_vector_type(8)));
typedef float f32x4 __attribute__((ext_vector_type(4)));
typedef unsigned u32x4 __attribute__((ext_vector_type(4)));
constexpr int BM = 256, BK = 64, HALF = 128, HTB = HALF * BK * 2  , STAGE_BYTES = 8 * HTB, NXCD = 8, WGM = 8;

__host__ __device__ __forceinline__ int lds_byte(int r, int c) { const int st = (r >> 4) * 2 + (c >> 5), rr = r & 15, cc = c & 31, ob = rr * 64 + cc * 2; return st * 1024 + (ob ^ (((ob >> 9) & 1) << 5)); }
__host__ __device__ __forceinline__ void stage_rc(int b, int& R, int& C) { const int st = b / 1024, sb = b % 1024, swz = sb ^ (((sb >> 9) & 1) << 5); R = (st >> 1) * 16 + swz / 64; C = (st & 1) * 32 + (swz % 64) / 2; }
__host__ __device__ __forceinline__ int perm32(int rho) { const int n = rho >> 4, i = rho & 15; return 8 * (i >> 2) + 4 * n + (i & 3); }

struct Unit { int pm, pn, kq; };
struct Gemm { const bf16_t* A; const bf16_t* Bt; int M, N, K; const bf16_t* A1; const bf16_t* A2; int pn1, pn2; int ld;
    __device__ __forceinline__ const char* abase(int pn) const { return (const char*)(pn < pn1 ? A : (pn < pn2 ? A1 : A2)); } };

struct StaticOrder {
    int nM, nN, nwg, G, c;
    __host__ __device__ void init(int M, int N, int G_, int c_) { nM = M / BM; nN = N / BM; nwg = nM * nN; G = G_; c = c_; }
    __host__ __device__ bool next(int i, Unit& u) const {
        const long L = (long)i * G + c; if (L >= nwg) return false;
        int wgid = (int)L; { const int q = nwg / NXCD, r = nwg % NXCD, xcd = wgid % NXCD, off = wgid / NXCD; wgid = (xcd < r ? xcd * (q + 1) : r * (q + 1) + (xcd - r) * q) + off; }
        const int nig = WGM * nN, gid = wgid / nig, fm = gid * WGM, gsz = (nM - fm) < WGM ? (nM - fm) : WGM;
        u.pm = fm + ((wgid % nig) % gsz); u.pn = (wgid % nig) / gsz; u.kq = 0; return true;
    }
    __device__ __forceinline__ void a_ready(const Unit&) const {}
    __device__ __forceinline__ void done(const Unit&) const {}
};

typedef float f32x2 __attribute__((ext_vector_type(2)));
typedef __bf16 bf16x2_t __attribute__((ext_vector_type(2)));
__device__ __forceinline__ unsigned cvt_pk_bf16(float lo, float hi) { const f32x2 v = {lo, hi}; return __builtin_bit_cast(unsigned, __builtin_convertvector(v, bf16x2_t)); }
template <class Epi, class Sched, bool ALIGN_EPI = false, bool SP2 = false>
__device__ __forceinline__ void gemm_phase(PG8_LAS unsigned char* lds, const Gemm g, const Sched& S, const Epi& E) {
    const int tid = threadIdx.x, wid = __builtin_amdgcn_readfirstlane(tid >> 6), lane = tid & 63, wr = wid >> 2, wc = wid & 3, fr = lane & 15, fq = lane >> 4;
    const int K = g.K, nt = K / BK;
    unsigned voffA[2], voffB[2];
#pragma unroll
    for (int i = 0; i < 2; ++i) { int R, C; stage_rc(tid * 16 + i * 8192, R, C); const int Rb = Epi::PERM ? ((R & ~31) + perm32(R & 31)) : R;
        voffA[i] = (unsigned)(R * g.ld + C) * 2u; voffB[i] = (unsigned)(Rb * g.ld + C) * 2u; }
    const size_t kstep = (size_t)(BK * 2);
    const size_t hstep = (size_t)HALF * g.ld * 2;
    const size_t tstep = 2 * hstep;
    const unsigned ldsw = (unsigned)wid * 1024u;
    const int aoff = lds_byte(wr * 64 + fr, fq * 8), boff = lds_byte(wc * 32 + fr, fq * 8);
#define PG8_SA(b, h) (((b) * 2 + (h)) * HTB)
#define PG8_SB(b, h) ((4 + (b) * 2 + (h)) * HTB)
#define PG8_STAGE(bufoff, gbase, voff) do { _Pragma("unroll") for (int _i = 0; _i < 2; ++_i) \
        __builtin_amdgcn_global_load_lds((const unsigned*)((const char*)(gbase) + (voff)[_i]), (PG8_LAS unsigned*)(lds + (bufoff) + ldsw + _i * 8192), 16, 0, 0); } while (0)
#define PG8_LDA(dst, b, h) do { _Pragma("unroll") for (int m = 0; m < 4; ++m) _Pragma("unroll") for (int k = 0; k < 2; ++k) dst[m][k] = *(const PG8_LAS bf16x8*)(lds + PG8_SA(b, h) + aoff + m * 2048 + k * 1024); } while (0)
#define PG8_LDB(dst, b, h) do { _Pragma("unroll") for (int n = 0; n < 2; ++n) _Pragma("unroll") for (int k = 0; k < 2; ++k) dst[n][k] = *(const PG8_LAS bf16x8*)(lds + PG8_SB(b, h) + boff + n * 2048 + k * 1024); } while (0)
#define PG8_MMA(ai, bj, At, Bt) do { __builtin_amdgcn_s_setprio(1); _Pragma("unroll") for (int m = 0; m < 4; ++m) _Pragma("unroll") for (int n = 0; n < 2; ++n) _Pragma("unroll") for (int k = 0; k < 2; ++k) \
        acc[ai][bj][m][n] = __builtin_amdgcn_mfma_f32_16x16x32_bf16(Bt[n][k], At[m][k], acc[ai][bj][m][n], 0, 0, 0); __builtin_amdgcn_s_setprio(0); } while (0)
#define PG8_WAIT_V(n) asm volatile("s_waitcnt vmcnt(" #n ")" ::: "memory")
#define PG8_WAIT_L(n) asm volatile("s_waitcnt lgkmcnt(" #n ")" ::: "memory")
#define PG8_BAR __builtin_amdgcn_s_barrier()
#define PG8_SCHED __builtin_amdgcn_sched_barrier(0)
    Unit cur, nxt; int ui = 0;
    if (!S.next(0, cur)) return;
    f32x4 acc[2][2][4][2];
#pragma unroll
    for (int a = 0; a < 2; ++a)
#pragma unroll
        for (int b = 0; b < 2; ++b)
#pragma unroll
            for (int m = 0; m < 4; ++m)
#pragma unroll
                for (int n = 0; n < 2; ++n) acc[a][b][m][n] = (f32x4){0.f, 0.f, 0.f, 0.f};
    bf16x8 At[4][2], B0[2][2], B1[2][2];
    const size_t qstep = (size_t)K * 2;
    const char* cA = g.abase(cur.pn) + (size_t)cur.pm * tstep + (size_t)cur.kq * qstep; const char* cB = (const char*)g.Bt + (size_t)cur.pn * tstep + (size_t)cur.kq * qstep;
    S.a_ready(cur);
    if constexpr (SP2) {
        PG8_STAGE(PG8_SB(0, 0), cB, voffB); PG8_STAGE(PG8_SB(0, 1), cB + hstep, voffB); PG8_STAGE(PG8_SA(0, 0), cA, voffA); PG8_STAGE(PG8_SA(0, 1), cA + hstep, voffA);
        if (wr == 1) PG8_BAR;
        PG8_WAIT_V(2); PG8_BAR;
        PG8_STAGE(PG8_SB(1, 0), cB + kstep, voffB); PG8_STAGE(PG8_SA(1, 0), cA + kstep, voffA); PG8_STAGE(PG8_SB(1, 1), cB + hstep + kstep, voffB);
        PG8_WAIT_V(6); PG8_BAR;
    } else {
        PG8_STAGE(PG8_SB(0, 0), cB, voffB); PG8_STAGE(PG8_SA(0, 0), cA, voffA); PG8_STAGE(PG8_SB(0, 1), cB + hstep, voffB); PG8_STAGE(PG8_SA(0, 1), cA + hstep, voffA);
        if (wr == 1) PG8_BAR;
        PG8_WAIT_V(4); PG8_BAR;
        PG8_STAGE(PG8_SB(1, 0), cB + kstep, voffB); PG8_STAGE(PG8_SA(1, 0), cA + kstep, voffA); PG8_STAGE(PG8_SB(1, 1), cB + hstep + kstep, voffB);
        PG8_WAIT_V(6); PG8_BAR;
    }
    for (;;) {
        const bool has_next = S.next(ui + 1, nxt);
        const char* nA = has_next ? g.abase(nxt.pn) + (size_t)nxt.pm * tstep + (size_t)nxt.kq * qstep : cA; const char* nB = has_next ? (const char*)g.Bt + (size_t)nxt.pn * tstep + (size_t)nxt.kq * qstep : cB;
        for (int t = 0; t < nt; t += 2) {
            const bool last = (t == nt - 2);
            const char* a1 = cA + (size_t)(t + 1) * kstep;
            const char* a2 = last ? nA : cA + (size_t)(t + 2) * kstep; const char* b2 = last ? nB : cB + (size_t)(t + 2) * kstep;
            const char* a3 = a2 + kstep; const char* b3 = b2 + kstep;
            if (last && has_next) S.a_ready(nxt);
            if constexpr (SP2) {
            PG8_LDB(B0, 0, 0); PG8_LDB(B1, 0, 1); PG8_SCHED; PG8_LDA(At, 0, 0); PG8_STAGE(PG8_SA(1, 1), a1 + hstep, voffA);
            PG8_WAIT_V(8); PG8_WAIT_L(0); PG8_BAR; PG8_MMA(0, 0, At, B0); PG8_MMA(0, 1, At, B1); PG8_BAR; PG8_SCHED;
            PG8_LDA(At, 0, 1); PG8_STAGE(PG8_SB(0, 0), b2, voffB); PG8_STAGE(PG8_SB(0, 1), b2 + hstep, voffB); PG8_STAGE(PG8_SA(0, 0), a2, voffA);
            PG8_WAIT_V(8); PG8_WAIT_L(0); PG8_BAR; PG8_MMA(1, 0, At, B0); PG8_MMA(1, 1, At, B1); PG8_BAR; PG8_SCHED;
            PG8_LDB(B0, 1, 0); PG8_LDB(B1, 1, 1); PG8_SCHED; PG8_LDA(At, 1, 0); PG8_STAGE(PG8_SA(0, 1), a2 + hstep, voffA);
            PG8_WAIT_V(8); PG8_WAIT_L(0); PG8_BAR; PG8_MMA(0, 0, At, B0); PG8_MMA(0, 1, At, B1); PG8_BAR; PG8_SCHED;
            PG8_LDA(At, 1, 1); PG8_STAGE(PG8_SB(1, 0), b3, voffB); PG8_STAGE(PG8_SB(1, 1), b3 + hstep, voffB); PG8_STAGE(PG8_SA(1, 0), a3, voffA);
            PG8_WAIT_V(8); PG8_WAIT_L(0); PG8_BAR; PG8_MMA(1, 0, At, B0); PG8_MMA(1, 1, At, B1); PG8_BAR; PG8_SCHED;
            } else {
            PG8_LDB(B0, 0, 0); PG8_SCHED; PG8_LDA(At, 0, 0); PG8_STAGE(PG8_SA(1, 1), a1 + hstep, voffA);
            PG8_WAIT_L(8); PG8_BAR; PG8_WAIT_L(0); PG8_MMA(0, 0, At, B0); PG8_BAR; PG8_SCHED;
            PG8_LDB(B1, 0, 1); PG8_STAGE(PG8_SB(0, 0), b2, voffB);
            PG8_BAR; PG8_WAIT_L(0); PG8_MMA(0, 1, At, B1); PG8_BAR;
            PG8_LDA(At, 0, 1); PG8_STAGE(PG8_SA(0, 0), a2, voffA);
            PG8_BAR; PG8_WAIT_L(0); PG8_MMA(1, 0, At, B0); PG8_BAR; PG8_SCHED;
            PG8_STAGE(PG8_SB(0, 1), b2 + hstep, voffB);
            PG8_WAIT_V(6); PG8_BAR; PG8_MMA(1, 1, At, B1); PG8_BAR;
            PG8_LDB(B0, 1, 0); PG8_SCHED; PG8_LDA(At, 1, 0); PG8_STAGE(PG8_SA(0, 1), a2 + hstep, voffA);
            PG8_WAIT_L(8); PG8_BAR; PG8_WAIT_L(0); PG8_MMA(0, 0, At, B0); PG8_BAR; PG8_SCHED;
            PG8_LDB(B1, 1, 1); PG8_STAGE(PG8_SB(1, 0), b3, voffB);
            PG8_BAR; PG8_WAIT_L(0); PG8_MMA(0, 1, At, B1); PG8_BAR;
            PG8_LDA(At, 1, 1); PG8_STAGE(PG8_SA(1, 0), a3, voffA);
            PG8_BAR; PG8_WAIT_L(0); PG8_MMA(1, 0, At, B0); PG8_BAR; PG8_SCHED;
            PG8_STAGE(PG8_SB(1, 1), b3 + hstep, voffB);
            PG8_WAIT_V(6); PG8_BAR; PG8_MMA(1, 1, At, B1); PG8_BAR;
            }
        }
        if constexpr (ALIGN_EPI) { if (wr == 0) PG8_BAR; }
        if constexpr (!Epi::AFTER_DRAIN) { E(acc, cur, wr, wc, fr, fq); S.done(cur); }
        if (!has_next) break;
#pragma unroll
        for (int a = 0; a < 2; ++a)
#pragma unroll
            for (int b = 0; b < 2; ++b)
#pragma unroll
                for (int m = 0; m < 4; ++m)
#pragma unroll
                    for (int n = 0; n < 2; ++n) acc[a][b][m][n] = (f32x4){0.f, 0.f, 0.f, 0.f};
        cur = nxt; cA = nA; cB = nB; ++ui;
        if constexpr (ALIGN_EPI) { if (wr == 1) PG8_BAR; }
    }
    PG8_WAIT_V(0);
    if constexpr (!ALIGN_EPI) { if (wr == 0) PG8_BAR; }
    PG8_BAR;
    if constexpr (Epi::AFTER_DRAIN) { E.fused(acc, cur, wr, wc, fr, fq, lds, wid, lane); S.done(cur); }
#undef PG8_SA
#undef PG8_SB
#undef PG8_STAGE
#undef PG8_LDA
#undef PG8_LDB
#undef PG8_MMA
#undef PG8_WAIT_V
#undef PG8_WAIT_L
#undef PG8_BAR
#undef PG8_SCHED
}
}

#ifndef MK_N_LAUNCHES
#define MK_N_LAUNCHES 1
#endif
#define LAS __attribute__((address_space(3)))
typedef unsigned short bf16;
typedef float f32x4 __attribute__((ext_vector_type(4)));
typedef float f32x2 __attribute__((ext_vector_type(2)));
typedef unsigned u32x4 __attribute__((ext_vector_type(4)));
typedef unsigned u32x2 __attribute__((ext_vector_type(2)));
typedef short bf16x8 __attribute__((ext_vector_type(8)));

constexpr int D = 1024, MP = 4096, ML = 16384, M = MP + ML, NIN = 7200, DFF = 4096;
constexpr float EPS = 1e-6f;
constexpr size_t MiB = 1u << 20;
constexpr size_t WS_MOD = 0;
constexpr size_t WS_BAR = 512 * 1024, WS_BAR_BYTES = 16384;
constexpr size_t WS_SSQ1 = 1 * MiB;
constexpr size_t WS_SSQ2 = 2560 * 1024;
constexpr size_t WS_LR = 4 * MiB;
constexpr size_t WS_WL = 8 * MiB;
constexpr size_t WS_WG = WS_WL + (size_t)2304 * 1024 * 2;
constexpr size_t WS_WY = WS_WG + (size_t)3072 * 1024 * 2;
constexpr size_t WS_WO = WS_WY + (size_t)4096 * 1024 * 2;
constexpr size_t WS_W1 = WS_WO + (size_t)1024 * 1024 * 2;
constexpr size_t WS_W2 = WS_W1 + (size_t)4096 * 1024 * 2;
constexpr size_t WS_S0 = 48 * MiB, SLOT = 40 * MiB;
static_assert(WS_W2 + (size_t)1024 * 4096 * 2 <= WS_S0, "ws map");
constexpr size_t WS_END = WS_S0 + 5 * SLOT;
constexpr int LDS_BYTES = 147456;

struct Args { const float* in[25]; float* out; unsigned char* ws; int ph_lo, ph_hi; };

__device__ __forceinline__ float bf2f(unsigned v) { return __uint_as_float(v << 16); }
__device__ __forceinline__ float bflo(unsigned w) { return __uint_as_float(w << 16); }
__device__ __forceinline__ float bfhi(unsigned w) { return __uint_as_float(w & 0xffff0000u); }
__device__ __forceinline__ unsigned pk2(float lo, float hi) { return pg8::cvt_pk_bf16(lo, hi); }
__device__ __forceinline__ float wave_sum(float v) {
#pragma unroll
    for (int o = 1; o < 64; o <<= 1) v += __shfl_xor(v, o);
    return v;
}
__device__ __forceinline__ float rcpf_(float x) { return __builtin_amdgcn_rcpf(x); }
__device__ __forceinline__ float expf_(float x) { return __builtin_amdgcn_exp2f(x * 1.4426950408889634f); }
__device__ __forceinline__ float logf_(float x) { return __builtin_amdgcn_logf(x) * 0.6931471805599453f; }
__device__ __forceinline__ float sigmoidf_(float x) { return rcpf_(1.0f + expf_(-x)); }
__device__ __forceinline__ float siluf_(float x) { return x * sigmoidf_(x); }
__device__ __forceinline__ float gelu_tanh(float x) { const float t = x * (1.5957691216f + 0.0713548163f * x * x); return x * rcpf_(1.0f + expf_(-t)); }
template <int ACT> __device__ __forceinline__ float actf(float x) {
    if (ACT == 1) return gelu_tanh(x);
    if (ACT == 2) return siluf_(x);
    if (ACT == 3) return sigmoidf_(x);
    if (ACT == 4) { const float m = fmaxf(x, 0.f); return m * m; }
    return x;
}
#define LDS_WAIT() asm volatile("s_waitcnt lgkmcnt(0)" ::: "memory")

#define XB_TMO      128
#define XB_XCNT(j)  (256  + 64 * (j))
#define XB_XSUB(j)  (1280 + 64 * (j))
#define XB_XGEN(j)  (2304 + 64 * (j))
#define XB_TOP      3328
#define XB_TOPGEN   3392
#define XCD_BAR_WORDS 3456
#define XB_SPIN_CAP (1u << 18)

__device__ __forceinline__ unsigned xb_ld(unsigned* p)              { return __hip_atomic_load(p, __ATOMIC_RELAXED, __HIP_MEMORY_SCOPE_AGENT); }
__device__ __forceinline__ unsigned xb_add(unsigned* p, unsigned v) { return __hip_atomic_fetch_add(p, v, __ATOMIC_RELAXED, __HIP_MEMORY_SCOPE_AGENT); }
__device__ __forceinline__ unsigned xb_xcc_id() { return (unsigned)__builtin_amdgcn_s_getreg((3 << 11) | 20) & 0xFu; }
#define XB_SPIN(cond, bar) do { unsigned _sp = 0; while (cond) { __builtin_amdgcn_s_sleep(1); \
    if ((++_sp & 255u) == 0u) { if (xb_ld(&(bar)[XB_TMO])) break; if (_sp > XB_SPIN_CAP) { atomicAdd(&(bar)[XB_TMO], 1u); break; } } } } while (0)

struct XcdBarrier {
    unsigned* bar; unsigned x;
    volatile LAS unsigned* st;
};

__device__ __forceinline__ XcdBarrier xcd_barrier_post(unsigned* bar, volatile LAS unsigned* st) {
    XcdBarrier b; b.bar = bar; b.x = xb_xcc_id(); b.st = st;
    if (threadIdx.x == 0) (void)xb_add(&bar[XB_XCNT(b.x)], 1u);
    return b;
}
__device__ __forceinline__ void xcd_barrier_complete(unsigned* bar, unsigned x, unsigned& nloc, unsigned& nx) {
    const unsigned G = gridDim.x * gridDim.y * gridDim.z;
    unsigned sum, cnt, mine, sp = 0u;
    for (;;) {
        sum = 0u; cnt = 0u; mine = 0u;
#pragma unroll
        for (unsigned j = 0; j < 16; ++j) { const unsigned c = xb_ld(&bar[XB_XCNT(j)]); sum += c; cnt += (c > 0u) ? 1u : 0u; mine = (j == x) ? c : mine; }
        if (sum == G) break;
        __builtin_amdgcn_s_sleep(1);
        if ((++sp & 255u) == 0u) { if (xb_ld(&bar[XB_TMO])) break; if (sp > XB_SPIN_CAP) { atomicAdd(&bar[XB_TMO], 1u); break; } }
    }
    nloc = mine > 0u ? mine : 1u; nx = cnt > 0u ? cnt : 1u;
}

__device__ __forceinline__ void xcd_barrier(const XcdBarrier& b) {
    asm volatile("s_waitcnt vmcnt(0)" ::: "memory");
    __syncthreads();
    if (threadIdx.x == 0) {
        unsigned* bar = b.bar;
        __builtin_amdgcn_s_waitcnt(0);
        unsigned nloc = b.st[0], nx = b.st[1];
        if (nloc == 0u) { xcd_barrier_complete(bar, b.x, nloc, nx); b.st[0] = nloc; b.st[1] = nx; }
        const unsigned old = xb_add(&bar[XB_XSUB(b.x)], 1u);
        const unsigned gen = old / nloc;
        if (old + 1u == (gen + 1u) * nloc) {
            __builtin_amdgcn_fence(__ATOMIC_RELEASE, "agent");
            asm volatile("s_waitcnt vmcnt(0)" ::: "memory");
            const unsigned og = xb_add(&bar[XB_TOP], 1u);
            const unsigned tg = og / nx;
            if (og + 1u == (tg + 1u) * nx) xb_add(&bar[XB_TOPGEN], 1u);
            else XB_SPIN(xb_ld(&bar[XB_TOPGEN]) == tg, bar);
            __builtin_amdgcn_fence(__ATOMIC_ACQUIRE, "agent");
            xb_add(&bar[XB_XGEN(b.x)], 1u);
            asm volatile("s_waitcnt vmcnt(0)" ::: "memory");
        } else {
            XB_SPIN(xb_ld(&bar[XB_XGEN(b.x)]) == gen, bar);
            __builtin_amdgcn_fence(__ATOMIC_ACQUIRE, "agent");
            asm volatile("s_waitcnt vmcnt(0)" ::: "memory");
        }
    }
    __syncthreads();
}

template <int ACT> __device__ __forceinline__ void store_tile(const f32x4 (&acc)[2][2][4][2], bf16* base, int ld, int row0, int col0) {
#pragma unroll
    for (int ai = 0; ai < 2; ++ai)
#pragma unroll
        for (int m = 0; m < 4; ++m) { bf16* rowp = base + (size_t)(row0 + ai * 128 + m * 16) * ld + col0;
#pragma unroll
            for (int bj = 0; bj < 2; ++bj) { const f32x4 v0 = acc[ai][bj][m][0], v1 = acc[ai][bj][m][1];
                u32x4 w; w.x = pk2(actf<ACT>(v0[0]), actf<ACT>(v0[1])); w.y = pk2(actf<ACT>(v0[2]), actf<ACT>(v0[3]));
                w.z = pk2(actf<ACT>(v1[0]), actf<ACT>(v1[1])); w.w = pk2(actf<ACT>(v1[2]), actf<ACT>(v1[3]));
                *(u32x4*)(rowp + bj * 128) = w; } }
}
struct EpiLG {
    static constexpr bool PERM = true, AFTER_DRAIN = false;
    bf16* ZX; bf16* ZG; float* LR; bf16* Q; bf16* K; bf16* V; bf16* G;
    __device__ __forceinline__ void operator()(const f32x4 (&acc)[2][2][4][2], const pg8::Unit& u, int wr, int wc, int fr, int fq) const {
        const int row0 = u.pm * 256 + wr * 64 + fr, cw = wc * 32 + 8 * fq;
        if (u.pn < 4) store_tile<0>(acc, ZX, D, row0, u.pn * 256 + cw);
        else if (u.pn < 8) store_tile<1>(acc, ZG, D, row0, (u.pn - 4) * 256 + cw);
        else if (u.pn == 8) { if (wc == 0) {
#pragma unroll
            for (int ai = 0; ai < 2; ++ai)
#pragma unroll
                for (int m = 0; m < 4; ++m) { float* rp = LR + (size_t)(row0 + ai * 128 + m * 16) * 32 + 8 * fq;
                    *(f32x4*)rp = acc[ai][0][m][0]; *(f32x4*)(rp + 4) = acc[ai][0][m][1]; } } }
        else if (u.pn < 11) store_tile<0>(acc, Q, 512, row0, (u.pn - 9) * 256 + cw);
        else if (u.pn < 13) store_tile<0>(acc, K, 512, row0, (u.pn - 11) * 256 + cw);
        else if (u.pn < 17) store_tile<0>(acc, V, D, row0, (u.pn - 13) * 256 + cw);
        else store_tile<2>(acc, G, D, row0, (u.pn - 17) * 256 + cw);
    }
};
struct EpiYY {
    static constexpr bool PERM = true, AFTER_DRAIN = false;
    bf16* YA; bf16* YB;
    __device__ __forceinline__ void operator()(const f32x4 (&acc)[2][2][4][2], const pg8::Unit& u, int wr, int wc, int fr, int fq) const {
        store_tile<0>(acc, u.pn < 4 ? YA : YB, D, u.pm * 256 + wr * 64 + fr, (u.pn & 3) * 256 + wc * 32 + 8 * fq);
    }
};
struct EpiMM {
    static constexpr bool PERM = true, AFTER_DRAIN = false;
    const bf16* YA; const bf16* YB; bf16* MM;
    __device__ __forceinline__ void operator()(const f32x4 (&acc)[2][2][4][2], const pg8::Unit& u, int wr, int wc, int fr, int fq) const {
        const int row0 = u.pm * 256 + wr * 64 + fr, c0 = u.pn * 128 + wc * 32 + 8 * fq;
#pragma unroll
        for (int ai = 0; ai < 2; ++ai)
#pragma unroll
            for (int m = 0; m < 4; ++m) { const size_t off = (size_t)(row0 + ai * 128 + m * 16) * D + c0;
                const u32x4 ya = *(const u32x4*)(YA + off), yb = *(const u32x4*)(YB + off);
                const f32x4 a0 = acc[ai][0][m][0], a1 = acc[ai][0][m][1], b0 = acc[ai][1][m][0], b1 = acc[ai][1][m][1];
#define MMV(av, bv, yv, zv) ({ const float ea_ = 1.0f + expf_(-(av)), eb_ = 1.0f + expf_(-(bv)); ((yv) * eb_ + (zv) * ea_) * rcpf_(ea_ * eb_); })
                u32x4 w;
                w.x = pk2(MMV(a0[0], b0[0], bflo(ya.x), bflo(yb.x)), MMV(a0[1], b0[1], bfhi(ya.x), bfhi(yb.x)));
                w.y = pk2(MMV(a0[2], b0[2], bflo(ya.y), bflo(yb.y)), MMV(a0[3], b0[3], bfhi(ya.y), bfhi(yb.y)));
                w.z = pk2(MMV(a1[0], b1[0], bflo(ya.z), bflo(yb.z)), MMV(a1[1], b1[1], bfhi(ya.z), bfhi(yb.z)));
                w.w = pk2(MMV(a1[2], b1[2], bflo(ya.w), bflo(yb.w)), MMV(a1[3], b1[3], bfhi(ya.w), bfhi(yb.w)));
#undef MMV
                *(u32x4*)(MM + off) = w; }
    }
};
struct EpiN {
    static constexpr bool PERM = true, AFTER_DRAIN = false;
    bf16* O; float* SSQ;
    __device__ __forceinline__ void operator()(const f32x4 (&acc)[2][2][4][2], const pg8::Unit& u, int wr, int wc, int fr, int fq) const {
        const int row0 = u.pm * 256 + wr * 64 + fr;
        store_tile<0>(acc, O, D, row0, u.pn * 256 + wc * 32 + 8 * fq);
#pragma unroll
        for (int ai = 0; ai < 2; ++ai)
#pragma unroll
            for (int m = 0; m < 4; ++m) { float ss = 0.f;
#pragma unroll
                for (int bj = 0; bj < 2; ++bj)
#pragma unroll
                    for (int n = 0; n < 2; ++n) { const f32x4 v = acc[ai][bj][m][n]; ss += (v[0] * v[0] + v[1] * v[1]) + (v[2] * v[2] + v[3] * v[3]); }
                ss += __shfl_xor(ss, 16); ss += __shfl_xor(ss, 32);
                if (fq == 0) SSQ[(size_t)(row0 + ai * 128 + m * 16) * 16 + u.pn * 4 + wc] = ss; }
    }
};
struct SplitOrder {
    int pm0, G, c;
    __device__ __forceinline__ bool next(int i, pg8::Unit& u) const { const int L = i * G + c; if (L >= 256) return false; u.kq = L & 3; u.pn = (L >> 2) & 3; u.pm = pm0 + (L >> 4); return true; }
    __device__ __forceinline__ void a_ready(const pg8::Unit&) const {}
    __device__ __forceinline__ void done(const pg8::Unit&) const {}
};
struct EpiS {
    static constexpr bool PERM = true, AFTER_DRAIN = false;
    bf16* O; bf16* P; int pm0;
    __device__ __forceinline__ void operator()(const f32x4 (&acc)[2][2][4][2], const pg8::Unit& u, int wr, int wc, int fr, int fq) const {
        const int cw = u.pn * 256 + wc * 32 + 8 * fq;
        if (u.kq == 0) store_tile<0>(acc, O, D, u.pm * 256 + wr * 64 + fr, cw);
        else store_tile<0>(acc, P + (size_t)(u.kq - 1) * 4096 * 1024, D, (u.pm - pm0) * 256 + wr * 64 + fr, cw);
    }
};
struct EpiH {
    static constexpr bool PERM = true, AFTER_DRAIN = false;
    bf16* Hd;
    __device__ __forceinline__ void operator()(const f32x4 (&acc)[2][2][4][2], const pg8::Unit& u, int wr, int wc, int fr, int fq) const {
        store_tile<4>(acc, Hd, DFF, u.pm * 256 + wr * 64 + fr, u.pn * 256 + wc * 32 + 8 * fq);
    }
};

template <bool ILV = false> __device__ __forceinline__ void tr_item(const float* W, int ld, int col0, int ncols, int K, bf16* WT, int row_off, LAS float* scr, int item, int lane) {
    const int nblk = ncols >> 5, kb = item / nblk, nb = item - kb * nblk, k0 = 64 * kb, n0 = 32 * nb;
    const int r0 = ILV ? ((n0 & 1023) >> 7) * 256 + (n0 & 127) + (n0 >> 10) * 128 : n0;
#pragma unroll 8
    for (int i = 0; i < 32; ++i) { const int kk = 2 * i + (lane >> 5); scr[kk * 33 + (lane & 31)] = W[(size_t)(k0 + kk) * ld + col0 + n0 + (lane & 31)]; }
    LDS_WAIT(); asm volatile("" ::: "memory");
    const int c = lane & 7;
#pragma unroll
    for (int j = 0; j < 4; ++j) { const int n = (lane >> 3) + 8 * j; const LAS float* s = scr + (8 * c) * 33 + n;
        u32x4 o; o.x = pk2(s[0 * 33], s[1 * 33]); o.y = pk2(s[2 * 33], s[3 * 33]); o.z = pk2(s[4 * 33], s[5 * 33]); o.w = pk2(s[6 * 33], s[7 * 33]);
        *(u32x4*)(WT + (size_t)(row_off + r0 + n) * K + k0 + 8 * c) = o; }
    LDS_WAIT(); asm volatile("" ::: "memory");
}
__device__ __forceinline__ void phase0(const Args& a, LAS unsigned char* lds, int tid, int lane, int wave) {
    LAS float* SIL = (LAS float*)lds;
    LAS float* RED = (LAS float*)(lds + 36864);
    LAS float* SCR = (LAS float*)(lds + 36864 + 18432 + wave * 8448);
    unsigned char* ws = a.ws;
    float* MOD = (float*)(ws + WS_MOD);
    for (int i = tid; i < 9 * 1024; i += 512) { const float c = i < 8192 ? a.in[4][i] : a.in[5][i - 8192]; SIL[i] = siluf_(c); }
    __syncthreads();
    for (int it = blockIdx.x; it < 96; it += gridDim.x) {
        const float* wp = a.in[6] + (size_t)(wave * 128) * 6144 + it * 64 + lane;
        float acc[9];
#pragma unroll
        for (int j = 0; j < 9; ++j) acc[j] = 0.f;
#pragma unroll 8
        for (int k = 0; k < 128; ++k) { const float w = wp[(size_t)k * 6144];
#pragma unroll
            for (int j = 0; j < 9; ++j) acc[j] += SIL[j * 1024 + wave * 128 + k] * w; }
#pragma unroll
        for (int j = 0; j < 9; ++j) RED[(wave * 9 + j) * 64 + lane] = acc[j];
        __syncthreads();
        for (int o = tid; o < 576; o += 512) { const int j = o >> 6, l = o & 63; float s = a.in[7][it * 64 + l];
#pragma unroll
            for (int w = 0; w < 8; ++w) s += RED[(w * 9 + j) * 64 + l];
            MOD[j * 6144 + it * 64 + l] = s; }
        __syncthreads();
    }
    bf16* WL = (bf16*)(ws + WS_WL); bf16* WG = (bf16*)(ws + WS_WG); bf16* WY = (bf16*)(ws + WS_WY);
    bf16* WO = (bf16*)(ws + WS_WO); bf16* W1 = (bf16*)(ws + WS_W1); bf16* W2 = (bf16*)(ws + WS_W2);
    const float* w_in = a.in[9];
    const bool split = gridDim.x >= 192;
    const int gw = split ? ((int)blockIdx.x - 96) * 8 + wave : (int)blockIdx.x * 8 + wave, NGW = split ? ((int)gridDim.x - 96) * 8 : (int)gridDim.x * 8;
    constexpr int NITEMS = 1024 + 16 + 1536 + 1024 + 512 + 512 + 512 + 2048 + 2048;
    for (int it = gw; it < NITEMS && gw >= 0; it += NGW) {
        int r = it;
        if (r < 1024) { tr_item(w_in, NIN, 0, 2048, 1024, WL, 0, SCR, r, lane); continue; } r -= 1024;
        if (r < 16) { tr_item(w_in, NIN, 5120, 32, 1024, WL, 2048, SCR, r, lane); continue; } r -= 16;
        if (r < 1536) { tr_item(w_in, NIN, 2048, 3072, 1024, WG, 0, SCR, r, lane); continue; } r -= 1536;
        if (r < 1024) { tr_item<true>(w_in, NIN, 5152, 2048, 1024, WY, 0, SCR, r, lane); continue; } r -= 1024;
        if (r < 512) { tr_item(a.in[17], 1024, 0, 1024, 1024, WY, 2048, SCR, r, lane); continue; } r -= 512;
        if (r < 512) { tr_item(a.in[21], 1024, 0, 1024, 1024, WY, 3072, SCR, r, lane); continue; } r -= 512;
        if (r < 512) { tr_item(a.in[22], 1024, 0, 1024, 1024, WO, 0, SCR, r, lane); continue; } r -= 512;
        if (r < 2048) { tr_item(a.in[23], 4096, 0, 4096, 1024, W1, 0, SCR, r, lane); continue; } r -= 2048;
        tr_item(a.in[24], 1024, 0, 1024, 4096, W2, 0, SCR, r, lane);
    }
    { u32x4* z = (u32x4*)(WL + (size_t)2080 * 1024); const u32x4 zz = {0u, 0u, 0u, 0u};
      for (int i = blockIdx.x * 512 + tid; i < 224 * 1024 / 8; i += gridDim.x * 512) z[i] = zz; }
}

__device__ __forceinline__ const float* xrow(const Args& a, int m) { return m < MP ? a.in[0] + (size_t)m * D : a.in[1] + (size_t)(m - MP) * D; }
__device__ __forceinline__ int modgrp(int m) { return m < MP ? 8 : ((m - MP) >> 11); }
__device__ __forceinline__ void phase1(const Args& a, bf16* H, int lane, int wave) {
    const float* MOD = (const float*)(a.ws + WS_MOD); const float* ng = a.in[8];
    const int stride = gridDim.x * 8; int m = blockIdx.x * 8 + wave;
    f32x4 v[4];
    if (m < M) { const f32x4* xr = (const f32x4*)xrow(a, m) + lane;
#pragma unroll
        for (int q = 0; q < 4; ++q) v[q] = xr[64 * q]; }
    for (; m < M; m += stride) {
        f32x4 vn[4]; const int mn = m + stride;
#pragma unroll
        for (int q = 0; q < 4; ++q) vn[q] = v[q];
        if (mn < M) { const f32x4* xr = (const f32x4*)xrow(a, mn) + lane;
#pragma unroll
            for (int q = 0; q < 4; ++q) vn[q] = xr[64 * q]; }
        const float* md = MOD + modgrp(m) * 6144;
        float s = 0.f;
#pragma unroll
        for (int q = 0; q < 4; ++q) s += (v[q][0] * v[q][0] + v[q][1] * v[q][1]) + (v[q][2] * v[q][2] + v[q][3] * v[q][3]);
        const float rstd = rsqrtf(wave_sum(s) * (1.f / D) + EPS);
        u32x2* o = (u32x2*)(H + (size_t)m * D) + lane;
#pragma unroll
        for (int q = 0; q < 4; ++q) { const int c = 4 * (lane + 64 * q);
            const f32x4 g = *(const f32x4*)(ng + c), sh = *(const f32x4*)(md + c), sc = *(const f32x4*)(md + 1024 + c);
            const f32x4 r = v[q] * rstd * g * (sc + 1.0f) + sh;
            u32x2 w; w.x = pk2(r[0], r[1]); w.y = pk2(r[2], r[3]); o[64 * q] = w; }
#pragma unroll
        for (int q = 0; q < 4; ++q) v[q] = vn[q];
    }
}

__device__ __forceinline__ void lru_phase(const Args& a, LAS unsigned char* lds, int tid, int lane, int wave) {
    LAS bf16* XC = (LAS bf16*)lds;
    LAS float* AU = (LAS float*)(lds + 18432);
    LAS float* SUBA = (LAS float*)(lds + 18432 + 69632);
    LAS float* HC = SUBA + 8 * 64 * 2;
    const bf16* ZX = (const bf16*)a.out;
    bf16* HF = (bf16*)(a.ws + WS_S0 + 2 * SLOT); bf16* HB = (bf16*)(a.ws + WS_S0);
    const float* conv_w = a.in[10]; const float* conv_b = a.in[11];
    const int col = lane & 15, quad = lane >> 4, mt = wave & 3, nh = wave >> 2;
    const int vcu = (gridDim.x % 8 == 0) ? (int)(blockIdx.x % 8) * (int)(gridDim.x / 8) + (int)(blockIdx.x / 8) : (int)blockIdx.x;
    int cur_key = -1;
    bf16x8 Bf[2][2][2]; float ba_[2], bx_[2], c8_[2]; f32x4 cwv[4][2]; f32x4 cb0, cb1;
    const int tokA = tid >> 3, c8A = (tid & 7) * 8;
    for (int u = vcu; u < 768; u += gridDim.x) {
        const bool lat = u < 256; const int v = lat ? u : u - 256; const int b = v >> 5, blk = (v >> 1) & 15, dir = v & 1;
        const int row_base = lat ? MP + b * 2048 : b * 256, nseg = lat ? 32 : 4;
        bf16* HX = dir ? HB : HF;
        const int ch0A = blk * 64 + c8A;
        if ((blk * 2 + dir) != cur_key) { cur_key = blk * 2 + dir;
        const float* wa = a.in[12] + (size_t)(dir * 16 + blk) * 4096; const float* wx = a.in[14] + (size_t)(dir * 16 + blk) * 4096;
#pragma unroll
        for (int nt = 0; nt < 2; ++nt)
#pragma unroll
            for (int kk = 0; kk < 2; ++kk)
#pragma unroll
                for (int i = 0; i < 8; i += 2) { const int k = kk * 32 + quad * 8 + i, n = nh * 32 + nt * 16 + col;
                    const unsigned pa = pk2(wa[k * 64 + n], wa[(k + 1) * 64 + n]), px = pk2(wx[k * 64 + n], wx[(k + 1) * 64 + n]);
                    Bf[0][nt][kk][i] = (short)(pa & 0xffffu); Bf[0][nt][kk][i + 1] = (short)(pa >> 16);
                    Bf[1][nt][kk][i] = (short)(px & 0xffffu); Bf[1][nt][kk][i + 1] = (short)(px >> 16); }
#pragma unroll
        for (int nt = 0; nt < 2; ++nt) { const int ch = dir * 1024 + blk * 64 + nh * 32 + nt * 16 + col;
            ba_[nt] = -1.4426950408889634f * a.in[13][ch]; bx_[nt] = -1.4426950408889634f * a.in[15][ch]; c8_[nt] = -8.0f * 1.4426950408889634f * log1pf(expf(-a.in[16][ch])); }
#pragma unroll
        for (int j = 0; j < 4; ++j) { cwv[j][0] = *(const f32x4*)(conv_w + j * 1024 + ch0A); cwv[j][1] = *(const f32x4*)(conv_w + j * 1024 + ch0A + 4); }
        cb0 = *(const f32x4*)(conv_b + ch0A); cb1 = *(const f32x4*)(conv_b + ch0A + 4);
        }
        if (tid < 64) HC[tid] = lat ? a.in[2][(size_t)(b * 2 + dir) * 1024 + blk * 64 + tid] : 0.f;
        const int nst = nseg >> 1;
        u32x4 Zg[2][4];
#define LRU_FETCH(t0_) do { _Pragma("unroll") for (int hh_ = 0; hh_ < 2; ++hh_) { const int t0h_ = (t0_) + 64 * hh_; const int lo_ = lat ? t0h_ : 0, hi_ = lat ? t0h_ + 64 : 256; \
            _Pragma("unroll") for (int j_ = 0; j_ < 4; ++j_) { const int t_ = t0h_ + tokA + j_ - 1; \
                Zg[hh_][j_] = (t_ >= lo_ && t_ < hi_) ? *(const u32x4*)(ZX + (size_t)(row_base + t_) * D + ch0A) : (u32x4){0u, 0u, 0u, 0u}; } } } while (0)
        LRU_FETCH((dir ? nst - 1 : 0) * 128);
        for (int s = 0; s < nst; ++s) {
            const int st = dir ? nst - 1 - s : s, t0 = st * 128;
#pragma unroll
            for (int hh = 0; hh < 2; ++hh) {
                f32x4 x0 = cb0, x1 = cb1;
#pragma unroll
                for (int j = 0; j < 4; ++j) { const u32x4 z = Zg[hh][j]; const f32x4 w0 = cwv[j][0], w1 = cwv[j][1];
                    x0[0] += w0[0] * bflo(z.x); x0[1] += w0[1] * bfhi(z.x); x0[2] += w0[2] * bflo(z.y); x0[3] += w0[3] * bfhi(z.y);
                    x1[0] += w1[0] * bflo(z.z); x1[1] += w1[1] * bfhi(z.z); x1[2] += w1[2] * bflo(z.w); x1[3] += w1[3] * bfhi(z.w); }
                u32x4 w; w.x = pk2(x0[0], x0[1]); w.y = pk2(x0[2], x0[3]); w.z = pk2(x1[0], x1[1]); w.w = pk2(x1[2], x1[3]);
                *(LAS u32x4*)(XC + (64 * hh + tokA) * 72 + c8A) = w;
            }
            __syncthreads();
            if (s + 1 < nst) LRU_FETCH((dir ? nst - 2 - s : s + 1) * 128);
#pragma unroll
            for (int hh = 0; hh < 2; ++hh) {
                bf16x8 Af[2];
#pragma unroll
                for (int kk = 0; kk < 2; ++kk) Af[kk] = *(const LAS bf16x8*)(XC + (64 * hh + 16 * mt + col) * 72 + kk * 32 + quad * 8);
                f32x4 ar[2], ai[2];
#pragma unroll
                for (int nt = 0; nt < 2; ++nt) { ar[nt] = (f32x4){0.f, 0.f, 0.f, 0.f}; ai[nt] = (f32x4){0.f, 0.f, 0.f, 0.f};
#pragma unroll
                    for (int kk = 0; kk < 2; ++kk) { ar[nt] = __builtin_amdgcn_mfma_f32_16x16x32_bf16(Af[kk], Bf[0][nt][kk], ar[nt], 0, 0, 0);
                        ai[nt] = __builtin_amdgcn_mfma_f32_16x16x32_bf16(Af[kk], Bf[1][nt][kk], ai[nt], 0, 0, 0); } }
                float xv[2][4];
#pragma unroll
                for (int nt = 0; nt < 2; ++nt)
#pragma unroll
                    for (int j = 0; j < 4; ++j) xv[nt][j] = bf2f((unsigned)XC[(64 * hh + 16 * mt + quad * 4 + j) * 72 + nh * 32 + nt * 16 + col]);
#pragma unroll
                for (int nt = 0; nt < 2; ++nt)
#pragma unroll
                    for (int j = 0; j < 4; ++j) { const int tok = 64 * hh + 16 * mt + quad * 4 + j, chl = nh * 32 + nt * 16 + col;
                        const float er = 1.0f + __builtin_amdgcn_exp2f(fmaf(ar[nt][j], -1.4426950408889634f, ba_[nt])), ei = 1.0f + __builtin_amdgcn_exp2f(fmaf(ai[nt][j], -1.4426950408889634f, bx_[nt]));
                        const float inv = rcpf_(er * ei), r = inv * ei, ig = inv * er;
                        const float aa = __builtin_amdgcn_exp2f(c8_[nt] * r);
                        const float uu = __builtin_amdgcn_sqrtf(fmaxf(1.0f - aa * aa, 0.f)) * ig * xv[nt][j];
                        typedef float f32x2s __attribute__((ext_vector_type(2)));
                        *(LAS f32x2s*)(AU + (tok * 68 + chl) * 2) = (f32x2s){aa, uu}; }
            }
            __syncthreads();
            {
                typedef float f32x2l __attribute__((ext_vector_type(2)));
                f32x2l p[16];
#pragma unroll
                for (int e = 0; e < 16; ++e) { const int i = wave * 16 + e; const int tok = dir ? 127 - i : i; p[e] = *(const LAS f32x2l*)(AU + (tok * 68 + lane) * 2); }
                float hl = 0.f, cp = 1.f;
#pragma unroll
                for (int e = 0; e < 16; ++e) { hl = p[e].x * hl + p[e].y; cp *= p[e].x; p[e].y = hl; p[e].x = cp; }
                *(LAS f32x2l*)(SUBA + (wave * 64 + lane) * 2) = (f32x2l){cp, hl};
                __syncthreads();
                float c = HC[(s & 1) * 64 + lane];
#pragma unroll
                for (int s2 = 0; s2 < 7; ++s2) { const f32x2l q = *(const LAS f32x2l*)(SUBA + (s2 * 64 + lane) * 2); if (s2 < wave) c = q.x * c + q.y; }
#pragma unroll
                for (int e = 0; e < 16; ++e) { const int i = wave * 16 + e; const int tok = dir ? 127 - i : i; *(LAS f32x2l*)(AU + (tok * 68 + lane) * 2) = (f32x2l){p[e].x, p[e].y + p[e].x * c}; }
                if (wave == 7) HC[((s + 1) & 1) * 64 + lane] = p[15].y + p[15].x * c;
            }
            __syncthreads();
#pragma unroll
            for (int hh = 0; hh < 2; ++hh) {
                const LAS f32x4* hq = (const LAS f32x4*)(AU + ((64 * hh + tokA) * 68 + c8A) * 2);
                const f32x4 q0 = hq[0], q1 = hq[1], q2 = hq[2], q3 = hq[3];
                u32x4 w; w.x = pk2(q0[1], q0[3]); w.y = pk2(q1[1], q1[3]); w.z = pk2(q2[1], q2[3]); w.w = pk2(q3[1], q3[3]);
                *(u32x4*)(HX + (size_t)(row_base + t0 + 64 * hh + tokA) * D + blk * 64 + c8A) = w;
            }
        }
#undef LRU_FETCH
        if (!lat && tid < 64) a.out[(size_t)M * D + (size_t)(b * 2 + dir) * 1024 + blk * 64 + tid] = HC[(nst & 1) * 64 + tid];
        __syncthreads();
    }
}

constexpr size_t WS_DEC = 6656 * 1024;
__device__ __forceinline__ void gla_prep(const Args& a, LAS unsigned char* lds, int tid, bf16* ewd, const bf16* ewa, const bf16* ewb) {
    LAS float* LRS = (LAS float*)lds;
    const float* LR = (const float*)(a.ws + WS_LR);
    bf16* EFb = (bf16*)a.out; bf16* EBb = EFb + (size_t)M * 512;
    float* DECg = (float*)(a.ws + WS_DEC);
    const size_t ew_n = (size_t)M * D / 8, ew_stride = (size_t)gridDim.x * 512; size_t ew_i = (size_t)blockIdx.x * 512 + tid;
    for (int it = blockIdx.x; it < 640; it += gridDim.x) {
        const int gc = it >> 1, dir = it & 1; const bool lat = gc >= 64; const int g2 = lat ? gc - 64 : gc;
        const int b = lat ? (g2 >> 5) : (g2 >> 2), cn = lat ? (g2 & 31) : (g2 & 3), p0 = cn * 64;
        const int row_base = lat ? MP + b * 2048 : b * 256;
        bf16* Eb = dir ? EBb : EFb;
        float w2r[16];
#pragma unroll
        for (int r = 0; r < 16; ++r) w2r[r] = a.in[18][(size_t)(dir * 16 + r) * 512 + tid];
        const float b2v = a.in[19][dir * 512 + tid];
        __syncthreads();
        if (tid < 256) { const int i = tid >> 2; const int p_ = dir ? p0 + 63 - i : p0 + i; const int row = lat ? row_base + (p_ & 31) * 64 + (p_ >> 5) : row_base + p_;
            *(LAS f32x4*)(LRS + i * 16 + (tid & 3) * 4) = *(const f32x4*)(LR + (size_t)row * 32 + dir * 16 + (tid & 3) * 4); }
        __syncthreads();
        float run = 0.f;
#pragma unroll 1
        for (int i8 = 0; i8 < 64; i8 += 8) {
            const bool ew_on = ew_i < ew_n; u32x4 ex0 = {0u, 0u, 0u, 0u}, ex1 = ex0, ey0 = ex0;
            if (ew_on) { ex0 = ((const u32x4*)ewa)[ew_i]; ex1 = ((const u32x4*)ewb)[ew_i]; ey0 = ((const u32x4*)ewd)[ew_i]; }
#pragma unroll
            for (int i7 = 0; i7 < 8; ++i7) { const int i = i8 + i7; const int p_ = dir ? p0 + 63 - i : p0 + i; const int row = lat ? row_base + (p_ & 31) * 64 + (p_ >> 5) : row_base + p_;
                const LAS f32x4* lrp = (const LAS f32x4*)(LRS + i * 16);
                const f32x4 l0 = lrp[0], l1 = lrp[1], l2 = lrp[2], l3 = lrp[3];
                float x = b2v;
                x += l0[0] * w2r[0]; x += l0[1] * w2r[1]; x += l0[2] * w2r[2]; x += l0[3] * w2r[3];
                x += l1[0] * w2r[4]; x += l1[1] * w2r[5]; x += l1[2] * w2r[6]; x += l1[3] * w2r[7];
                x += l2[0] * w2r[8]; x += l2[1] * w2r[9]; x += l2[2] * w2r[10]; x += l2[3] * w2r[11];
                x += l3[0] * w2r[12]; x += l3[1] * w2r[13]; x += l3[2] * w2r[14]; x += l3[3] * w2r[15];
                run += (fminf(x, 0.f) - logf_(1.0f + expf_(-fabsf(x)))) * 0.0625f;
                Eb[(size_t)row * 512 + tid] = (bf16)(pk2(expf_(run), 0.f) & 0xffffu); }
            if (ew_on) { u32x4 o;
#pragma unroll
                for (int e = 0; e < 4; ++e) o[e] = pk2((bflo(ex0[e]) + bflo(ex1[e])) * bflo(ey0[e]), (bfhi(ex0[e]) + bfhi(ex1[e])) * bfhi(ey0[e]));
                ((u32x4*)ewd)[ew_i] = o; ew_i += ew_stride; }
        }
        DECg[((size_t)dir * 320 + gc) * 512 + tid] = expf_(run);
    }
    for (; ew_i < ew_n; ew_i += ew_stride) { const u32x4 ex0 = ((const u32x4*)ewa)[ew_i], ex1 = ((const u32x4*)ewb)[ew_i], ey0 = ((const u32x4*)ewd)[ew_i]; u32x4 o;
#pragma unroll
        for (int e = 0; e < 4; ++e) o[e] = pk2((bflo(ex0[e]) + bflo(ex1[e])) * bflo(ey0[e]), (bfhi(ex0[e]) + bfhi(ex1[e])) * bfhi(ey0[e]));
        ((u32x4*)ewd)[ew_i] = o; }
}

__device__ __forceinline__ void gla_phase(const Args& a, LAS unsigned char* lds, int tid, int lane, int wave) {
    LAS bf16* QE = (LAS bf16*)lds;
    LAS bf16* KE = QE + 64 * 136;
    LAS bf16* ST = KE + 64 * 136;
    LAS bf16* KT = ST + 64 * 136;
    LAS bf16* VT = KT + 128 * 72;
    LAS bf16* PP = VT + 64 * 72;
    LAS bf16* EE = PP + 64 * 72;
    LAS float* DEC = (LAS float*)(EE + 64 * 136);
    const unsigned char* ws = a.ws;
    const bf16* EFb = (const bf16*)a.out; const bf16* EBb = EFb + (size_t)M * 512;
    const float* DECg = (const float*)(ws + WS_DEC);
    const bf16* Qb = (const bf16*)(ws + WS_S0 + 3 * SLOT); const bf16* Kb = Qb + (size_t)M * 512;
    const bf16* Vb = (const bf16*)(ws + WS_S0 + 4 * SLOT);
    bf16* OFb = (bf16*)(a.ws + WS_S0 + 2 * SLOT); bf16* OBb = (bf16*)(a.ws + WS_S0);
    const int ch = tid & 127, sub = __builtin_amdgcn_readfirstlane(tid >> 7);
    const int col = lane & 15, quad = lane >> 4, kt = wave;
    float* SG = a.out + (size_t)M * D + 16 * 2 * 1024;
    const int vcu = (gridDim.x % 8 == 0) ? (int)(blockIdx.x % 8) * (int)(gridDim.x / 8) + (int)(blockIdx.x / 8) : (int)blockIdx.x;
    for (int u = vcu; u < 768; u += gridDim.x) {
        const bool lat = u < 256; const int v = lat ? u : u - 256; const int b = v >> 5, hd = (v >> 3) & 3, dir = (v >> 2) & 1, sl = v & 3;
        const int row_base = lat ? MP + b * 2048 : b * 256, nch = lat ? 32 : 4, gc0 = lat ? 64 + b * 32 : b * 4;
        bf16* Ob = dir ? OBb : OFb; const bf16* Eb = dir ? EBb : EFb;
        f32x4 S[4];
#pragma unroll
        for (int vt = 0; vt < 4; ++vt)
#pragma unroll
            for (int j = 0; j < 4; ++j)
                S[vt][j] = lat ? a.in[3][((((size_t)(b * 2 + dir) * 4 + hd) * 128 + 16 * kt + quad * 4 + j) * 256) + sl * 64 + 16 * vt + col] : 0.f;
#define GROWP(p0_, i) ({ const int p_ = dir ? (p0_) + 63 - (i) : (p0_) + (i); lat ? row_base + (p_ & 31) * 64 + (p_ >> 5) : row_base + p_; })
        u32x4 QgA[2], KgA[2], EgA[2], VgA, QgB[2], KgB[2], EgB[2], VgB; f32x2 etgA, etgB;
#define GLA_FETCH(X, cn_) do { const int p0_ = (cn_) * 64; \
            _Pragma("unroll") for (int e_ = 0; e_ < 2; ++e_) { const int pc_ = tid + e_ * 512; const size_t ro_ = (size_t)GROWP(p0_, pc_ >> 4) * 512 + hd * 128 + (pc_ & 15) * 8; \
                Qg##X[e_] = *(const u32x4*)(Qb + ro_); Kg##X[e_] = *(const u32x4*)(Kb + ro_); Eg##X[e_] = *(const u32x4*)(Eb + ro_); } \
            Vg##X = *(const u32x4*)(Vb + (size_t)GROWP(p0_, tid & 63) * D + hd * 256 + sl * 64 + (tid >> 6) * 8); \
            etg##X = *(const f32x2*)(DECg + ((size_t)dir * 320 + gc0 + (cn_)) * 512 + hd * 128 + 2 * lane); } while (0)
#define GLA_CHUNK(X, n) do { const int cn = dir ? nch - 1 - (n) : (n), p0 = cn * 64; \
            __syncthreads(); \
_Pragma("unroll") \
            for (int vt = 0; vt < 4; ++vt) { u32x2 w; w.x = pk2(S[vt][0], S[vt][1]); w.y = pk2(S[vt][2], S[vt][3]); \
                *(LAS u32x2*)(ST + (16 * vt + col) * 136 + 16 * kt + quad * 4) = w; } \
_Pragma("unroll") \
            for (int e = 0; e < 2; ++e) { const int pc = tid + e * 512, o_ = (pc >> 4) * 136 + (pc & 15) * 8; \
                  \
                const u32x4 qr = Qg##X[e], kr = Kg##X[e], er = Eg##X[e]; u32x4 qo, ko; \
_Pragma("unroll") \
                for (int d_ = 0; d_ < 4; ++d_) { const float E0 = bflo(er[d_]), E1 = bfhi(er[d_]); const float R0 = rcpf_(E0), R1 = rcpf_(E1); \
                    qo[d_] = pk2(bflo(qr[d_]) * E0 * 0.08838834764831845f, bfhi(qr[d_]) * E1 * 0.08838834764831845f); \
                    ko[d_] = pk2(bflo(kr[d_]) * R0, bfhi(kr[d_]) * R1); } \
                *(LAS u32x4*)(QE + o_) = qo; *(LAS u32x4*)(KE + o_) = ko; } \
            {   const int i = tid & 63, v8 = (tid >> 6) * 8; const u32x4 z = Vg##X; \
                VT[(v8 + 0) * 72 + i] = (bf16)(z.x & 0xffffu); VT[(v8 + 1) * 72 + i] = (bf16)(z.x >> 16); \
                VT[(v8 + 2) * 72 + i] = (bf16)(z.y & 0xffffu); VT[(v8 + 3) * 72 + i] = (bf16)(z.y >> 16); \
                VT[(v8 + 4) * 72 + i] = (bf16)(z.z & 0xffffu); VT[(v8 + 5) * 72 + i] = (bf16)(z.z >> 16); \
                VT[(v8 + 6) * 72 + i] = (bf16)(z.w & 0xffffu); VT[(v8 + 7) * 72 + i] = (bf16)(z.w >> 16); } \
            const f32x2 etot = etg##X; \
            if (wave == 0) *(LAS f32x2*)(DEC + 2 * lane) = etot; \
            __syncthreads(); \
            if ((n) + 2 < nch) GLA_FETCH(X, dir ? nch - 3 - (n) : (n) + 2); \
            {     \
                unsigned kw_[8]; \
_Pragma("unroll") \
                for (int e = 0; e < 8; ++e) kw_[e] = *(const LAS unsigned*)(KE + (wave * 8 + e) * 136 + 2 * lane); \
                u32x4 w0, w1; \
                w0.x = pk2(bflo(kw_[0]) * etot.x, bflo(kw_[1]) * etot.x); w0.y = pk2(bflo(kw_[2]) * etot.x, bflo(kw_[3]) * etot.x); w0.z = pk2(bflo(kw_[4]) * etot.x, bflo(kw_[5]) * etot.x); w0.w = pk2(bflo(kw_[6]) * etot.x, bflo(kw_[7]) * etot.x); \
                w1.x = pk2(bfhi(kw_[0]) * etot.y, bfhi(kw_[1]) * etot.y); w1.y = pk2(bfhi(kw_[2]) * etot.y, bfhi(kw_[3]) * etot.y); w1.z = pk2(bfhi(kw_[4]) * etot.y, bfhi(kw_[5]) * etot.y); w1.w = pk2(bfhi(kw_[6]) * etot.y, bfhi(kw_[7]) * etot.y); \
                *(LAS u32x4*)(KT + (2 * lane) * 72 + wave * 8) = w0; *(LAS u32x4*)(KT + (2 * lane + 1) * 72 + wave * 8) = w1; } \
              \
            {     \
                const int st = wave >> 1, ct0 = 2 * (wave & 1); \
                f32x4 acc0 = {0.f, 0.f, 0.f, 0.f}, acc1 = {0.f, 0.f, 0.f, 0.f}; \
                if (st <= ct0 + 1) { \
_Pragma("unroll") \
                    for (int kk = 0; kk < 4; ++kk) { const bf16x8 ak = *(const LAS bf16x8*)(KE + (16 * st + col) * 136 + kk * 32 + quad * 8); \
                        if (st <= ct0) { const bf16x8 bq0 = *(const LAS bf16x8*)(QE + (16 * ct0 + col) * 136 + kk * 32 + quad * 8); acc0 = __builtin_amdgcn_mfma_f32_16x16x32_bf16(ak, bq0, acc0, 0, 0, 0); } \
                        const bf16x8 bq1 = *(const LAS bf16x8*)(QE + (16 * (ct0 + 1) + col) * 136 + kk * 32 + quad * 8); acc1 = __builtin_amdgcn_mfma_f32_16x16x32_bf16(ak, bq1, acc1, 0, 0, 0); } \
                } \
_Pragma("unroll") \
                for (int j = 0; j < 4; ++j) { if (16 * st + quad * 4 + j > 16 * ct0 + col) acc0[j] = 0.f; if (16 * st + quad * 4 + j > 16 * (ct0 + 1) + col) acc1[j] = 0.f; } \
                u32x2 w0, w1; w0.x = pk2(acc0[0], acc0[1]); w0.y = pk2(acc0[2], acc0[3]); w1.x = pk2(acc1[0], acc1[1]); w1.y = pk2(acc1[2], acc1[3]); \
                *(LAS u32x2*)(PP + (16 * ct0 + col) * 72 + 16 * st + quad * 4) = w0; *(LAS u32x2*)(PP + (16 * (ct0 + 1) + col) * 72 + 16 * st + quad * 4) = w1; \
            } \
            __syncthreads(); \
            {     \
                const int vt_ = wave >> 1, ct0 = 2 * (wave & 1); \
                bf16x8 av[2], as_[4]; \
_Pragma("unroll") \
                for (int ks = 0; ks < 2; ++ks) av[ks] = *(const LAS bf16x8*)(VT + (16 * vt_ + col) * 72 + ks * 32 + quad * 8); \
_Pragma("unroll") \
                for (int kk = 0; kk < 4; ++kk) as_[kk] = *(const LAS bf16x8*)(ST + (16 * vt_ + col) * 136 + kk * 32 + quad * 8); \
                f32x4 acc0 = {0.f, 0.f, 0.f, 0.f}, acc1 = {0.f, 0.f, 0.f, 0.f}; \
_Pragma("unroll") \
                for (int ks = 0; ks < 2; ++ks) { const bf16x8 bp0 = *(const LAS bf16x8*)(PP + (16 * ct0 + col) * 72 + ks * 32 + quad * 8), bp1 = *(const LAS bf16x8*)(PP + (16 * (ct0 + 1) + col) * 72 + ks * 32 + quad * 8); \
                    acc0 = __builtin_amdgcn_mfma_f32_16x16x32_bf16(av[ks], bp0, acc0, 0, 0, 0); acc1 = __builtin_amdgcn_mfma_f32_16x16x32_bf16(av[ks], bp1, acc1, 0, 0, 0); } \
_Pragma("unroll") \
                for (int kk = 0; kk < 4; ++kk) { const bf16x8 bq0 = *(const LAS bf16x8*)(QE + (16 * ct0 + col) * 136 + kk * 32 + quad * 8), bq1 = *(const LAS bf16x8*)(QE + (16 * (ct0 + 1) + col) * 136 + kk * 32 + quad * 8); \
                    acc0 = __builtin_amdgcn_mfma_f32_16x16x32_bf16(as_[kk], bq0, acc0, 0, 0, 0); acc1 = __builtin_amdgcn_mfma_f32_16x16x32_bf16(as_[kk], bq1, acc1, 0, 0, 0); } \
                const int row0 = GROWP(p0, 16 * ct0 + col), row1 = GROWP(p0, 16 * (ct0 + 1) + col); \
                u32x2 w0, w1; w0.x = pk2(acc0[0], acc0[1]); w0.y = pk2(acc0[2], acc0[3]); w1.x = pk2(acc1[0], acc1[1]); w1.y = pk2(acc1[2], acc1[3]); \
                *(u32x2*)(Ob + (size_t)row0 * D + hd * 256 + sl * 64 + 16 * vt_ + quad * 4) = w0; *(u32x2*)(Ob + (size_t)row1 * D + hd * 256 + sl * 64 + 16 * vt_ + quad * 4) = w1; \
                bf16x8 ak[2]; \
_Pragma("unroll") \
                for (int ks = 0; ks < 2; ++ks) ak[ks] = *(const LAS bf16x8*)(KT + (16 * kt + col) * 72 + ks * 32 + quad * 8); \
                float dk[4]; \
_Pragma("unroll") \
                for (int j = 0; j < 4; ++j) dk[j] = DEC[16 * kt + quad * 4 + j]; \
_Pragma("unroll") \
                for (int vt = 0; vt < 4; ++vt) { \
_Pragma("unroll") \
                    for (int j = 0; j < 4; ++j) S[vt][j] *= dk[j]; \
_Pragma("unroll") \
                    for (int ks = 0; ks < 2; ++ks) { const bf16x8 bv = *(const LAS bf16x8*)(VT + (16 * vt + col) * 72 + ks * 32 + quad * 8); \
                        S[vt] = __builtin_amdgcn_mfma_f32_16x16x32_bf16(ak[ks], bv, S[vt], 0, 0, 0); } } \
            } \
        } while (0)
        GLA_FETCH(A, dir ? nch - 1 : 0); GLA_FETCH(B, dir ? nch - 2 : 1);
        for (int n = 0; n < nch; n += 2) { GLA_CHUNK(A, n); GLA_CHUNK(B, n + 1); }
#undef GLA_CHUNK
#undef GLA_FETCH
#undef GROWP
        if (!lat) {
#pragma unroll
            for (int vt = 0; vt < 4; ++vt)
#pragma unroll
                for (int j = 0; j < 4; ++j)
                    SG[((((size_t)(b * 2 + dir) * 4 + hd) * 128 + 16 * kt + quad * 4 + j) * 256) + sl * 64 + 16 * vt + col] = S[vt][j];
        }
    }
}

template <int MODE> __device__ __forceinline__ void ew_pass(bf16* dst, const bf16* a0, const bf16* b0, const bf16* a1, const bf16* b1, int tid) {
    const size_t nvec = (size_t)M * D / 8;
    for (size_t i = (size_t)blockIdx.x * 512 + tid; i < nvec; i += (size_t)gridDim.x * 512) {
        const u32x4 x0 = ((const u32x4*)a0)[i], y0 = ((const u32x4*)b0)[i], x1 = ((const u32x4*)a1)[i];
        u32x4 o;
        if (MODE == 0) {
#pragma unroll
            for (int e = 0; e < 4; ++e) o[e] = pk2((bflo(x0[e]) + bflo(x1[e])) * bflo(y0[e]), (bfhi(x0[e]) + bfhi(x1[e])) * bfhi(y0[e]));
        } else {
            const u32x4 y1 = ((const u32x4*)b1)[i];
#pragma unroll
            for (int e = 0; e < 4; ++e) o[e] = pk2(bflo(x0[e]) * bflo(y0[e]) + bflo(x1[e]) * bflo(y1[e]), bfhi(x0[e]) * bfhi(y0[e]) + bfhi(x1[e]) * bfhi(y1[e]));
        }
        ((u32x4*)dst)[i] = o;
    }
}
__device__ __forceinline__ void post_gla(const Args& a, int lane, int wave) {
    const bf16* OFb = (const bf16*)(a.ws + WS_S0 + 2 * SLOT); const bf16* OBb = (const bf16*)(a.ws + WS_S0);
    bf16* G = (bf16*)(a.ws + WS_S0 + 1 * SLOT);
    const f32x4 gn = *(const f32x4*)(a.in[20] + 4 * lane);
    const int stride = gridDim.x * 8; int m = blockIdx.x * 8 + wave;
    u32x2 cf[4], cb[4], cg[4];
    if (m < M) {
#pragma unroll
        for (int hh = 0; hh < 4; ++hh) { const size_t off = (size_t)m * D + hh * 256 + 4 * lane; cf[hh] = *(const u32x2*)(OFb + off); cb[hh] = *(const u32x2*)(OBb + off); cg[hh] = *(const u32x2*)(G + off); } }
    for (; m < M; m += stride) {
        u32x2 nf[4], nb[4], ng_[4]; const int mn = m + stride;
#pragma unroll
        for (int hh = 0; hh < 4; ++hh) { nf[hh] = cf[hh]; nb[hh] = cb[hh]; ng_[hh] = cg[hh]; }
        if (mn < M) {
#pragma unroll
            for (int hh = 0; hh < 4; ++hh) { const size_t off = (size_t)mn * D + hh * 256 + 4 * lane; nf[hh] = *(const u32x2*)(OFb + off); nb[hh] = *(const u32x2*)(OBb + off); ng_[hh] = *(const u32x2*)(G + off); } }
#pragma unroll
        for (int hh = 0; hh < 4; ++hh) { const size_t off = (size_t)m * D + hh * 256 + 4 * lane;
            const u32x2 f = cf[hh], bb = cb[hh], g = cg[hh];
            f32x4 o; o[0] = bflo(f.x) + bflo(bb.x); o[1] = bfhi(f.x) + bfhi(bb.x); o[2] = bflo(f.y) + bflo(bb.y); o[3] = bfhi(f.y) + bfhi(bb.y);
            const float ss = wave_sum((o[0] * o[0] + o[1] * o[1]) + (o[2] * o[2] + o[3] * o[3]));
            const float rstd = rsqrtf(ss * (1.f / 256.f) + EPS);
            u32x2 w; w.x = pk2(o[0] * rstd * gn[0] * bflo(g.x), o[1] * rstd * gn[1] * bfhi(g.x)); w.y = pk2(o[2] * rstd * gn[2] * bflo(g.y), o[3] * rstd * gn[3] * bfhi(g.y));
            *(u32x2*)(G + off) = w; }
#pragma unroll
        for (int hh = 0; hh < 4; ++hh) { cf[hh] = nf[hh]; cb[hh] = nb[hh]; cg[hh] = ng_[hh]; }
    }
}
struct SplitRow { u32x2 o[4]; u32x2 p[3][4]; };
__device__ __forceinline__ void split_row_load(SplitRow& r, const bf16* O, const bf16* P, int m, int lane) {
#pragma unroll
    for (int q = 0; q < 4; ++q) r.o[q] = *(const u32x2*)(O + (size_t)m * D + 4 * (lane + 64 * q));
    if (m >= 16384) {
#pragma unroll
        for (int k = 0; k < 3; ++k)
#pragma unroll
            for (int q = 0; q < 4; ++q) r.p[k][q] = *(const u32x2*)(P + ((size_t)k * 4096 + (m - 16384)) * D + 4 * (lane + 64 * q)); }
}
__device__ __forceinline__ f32x4 split_row_val(const SplitRow& r, int m, int q) {
    f32x4 v; v[0] = bflo(r.o[q].x); v[1] = bfhi(r.o[q].x); v[2] = bflo(r.o[q].y); v[3] = bfhi(r.o[q].y);
    if (m >= 16384) {
#pragma unroll
        for (int k = 0; k < 3; ++k) { v[0] += bflo(r.p[k][q].x); v[1] += bfhi(r.p[k][q].x); v[2] += bflo(r.p[k][q].y); v[3] += bfhi(r.p[k][q].y); } }
    return v;
}
__device__ __forceinline__ void x1_pass(const Args& a, int lane, int wave) {
    const float* MOD = (const float*)(a.ws + WS_MOD); const float* ng = a.in[8];
    const bf16* Mm = (const bf16*)(a.ws + WS_S0 + 2 * SLOT); const bf16* Pm = (const bf16*)(a.ws + WS_S0 + 4 * SLOT); bf16* H2 = (bf16*)(a.ws + WS_S0);
    const int stride = gridDim.x * 8; int m = blockIdx.x * 8 + wave;
    SplitRow cur; f32x4 xc[4];
    if (m < M) { split_row_load(cur, Mm, Pm, m, lane); const f32x4* xr = (const f32x4*)xrow(a, m) + lane;
#pragma unroll
        for (int q = 0; q < 4; ++q) xc[q] = xr[64 * q]; }
    for (; m < M; m += stride) {
        SplitRow nxt = cur; f32x4 xn[4]; const int mn = m + stride;
#pragma unroll
        for (int q = 0; q < 4; ++q) xn[q] = xc[q];
        if (mn < M) { split_row_load(nxt, Mm, Pm, mn, lane); const f32x4* xr = (const f32x4*)xrow(a, mn) + lane;
#pragma unroll
            for (int q = 0; q < 4; ++q) xn[q] = xr[64 * q]; }
        const float* md = MOD + modgrp(m) * 6144;
        f32x4 mv[4]; float s1 = 0.f;
#pragma unroll
        for (int q = 0; q < 4; ++q) { mv[q] = split_row_val(cur, m, q); s1 += (mv[q][0] * mv[q][0] + mv[q][1] * mv[q][1]) + (mv[q][2] * mv[q][2] + mv[q][3] * mv[q][3]); }
        const float rstd1 = rsqrtf(wave_sum(s1) * (1.f / D) + EPS);
        f32x4 v[4]; float s = 0.f;
#pragma unroll
        for (int q = 0; q < 4; ++q) { const int c = 4 * (lane + 64 * q);
            const f32x4 g1 = *(const f32x4*)(md + 2048 + c), n1 = *(const f32x4*)(ng + 1024 + c);
            v[q] = xc[q] + g1 * (mv[q] * rstd1 * n1);
            *(f32x4*)(a.out + (size_t)m * D + c) = v[q];
            s += (v[q][0] * v[q][0] + v[q][1] * v[q][1]) + (v[q][2] * v[q][2] + v[q][3] * v[q][3]); }
        const float rstd = rsqrtf(wave_sum(s) * (1.f / D) + EPS);
#pragma unroll
        for (int q = 0; q < 4; ++q) { const int c = 4 * (lane + 64 * q);
            const f32x4 g = *(const f32x4*)(ng + 2048 + c), sh = *(const f32x4*)(md + 3072 + c), sc = *(const f32x4*)(md + 4096 + c);
            const f32x4 r = v[q] * rstd * g * (sc + 1.0f) + sh;
            u32x2 w; w.x = pk2(r[0], r[1]); w.y = pk2(r[2], r[3]); *(u32x2*)(H2 + (size_t)m * D + c) = w; }
        cur = nxt;
#pragma unroll
        for (int q = 0; q < 4; ++q) xc[q] = xn[q];
    }
}
__device__ __forceinline__ void fin_pass(const Args& a, int lane, int wave) {
    const float* MOD = (const float*)(a.ws + WS_MOD); const float* ng = a.in[8];
    const bf16* F = (const bf16*)(a.ws + WS_S0); const bf16* Pf = (const bf16*)(a.ws + WS_WL);
    const int stride = gridDim.x * 8; int m = blockIdx.x * 8 + wave;
    SplitRow cur; f32x4 yc[4];
    if (m < M) { split_row_load(cur, F, Pf, m, lane);
#pragma unroll
        for (int q = 0; q < 4; ++q) yc[q] = *(const f32x4*)(a.out + (size_t)m * D + 4 * (lane + 64 * q)); }
    for (; m < M; m += stride) {
        SplitRow nxt = cur; f32x4 yn[4]; const int mn = m + stride;
#pragma unroll
        for (int q = 0; q < 4; ++q) yn[q] = yc[q];
        if (mn < M) { split_row_load(nxt, F, Pf, mn, lane);
#pragma unroll
            for (int q = 0; q < 4; ++q) yn[q] = *(const f32x4*)(a.out + (size_t)mn * D + 4 * (lane + 64 * q)); }
        const float* md = MOD + modgrp(m) * 6144;
        f32x4 fv[4]; float s = 0.f;
#pragma unroll
        for (int q = 0; q < 4; ++q) { fv[q] = split_row_val(cur, m, q); s += (fv[q][0] * fv[q][0] + fv[q][1] * fv[q][1]) + (fv[q][2] * fv[q][2] + fv[q][3] * fv[q][3]); }
        const float rstd = rsqrtf(wave_sum(s) * (1.f / D) + EPS);
#pragma unroll
        for (int q = 0; q < 4; ++q) { const int c = 4 * (lane + 64 * q);
            const f32x4 g2 = *(const f32x4*)(md + 5120 + c), n3 = *(const f32x4*)(ng + 3072 + c);
            *(f32x4*)(a.out + (size_t)m * D + c) = yc[q] + g2 * (fv[q] * rstd * n3); }
        cur = nxt;
#pragma unroll
        for (int q = 0; q < 4; ++q) yc[q] = yn[q];
    }
}

constexpr int NPHASE = 14;
__global__ void __launch_bounds__(512, 2) mk_fwd(Args a) {
    extern __shared__ __attribute__((aligned(16))) unsigned char lds_raw[];
    LAS unsigned char* lds = (LAS unsigned char*)lds_raw;
    cg::grid_group grid = cg::this_grid();
    const int tid = threadIdx.x, lane = tid & 63, wave = __builtin_amdgcn_readfirstlane(tid >> 6);
    const int lo = a.ph_lo, hi = a.ph_hi, G = gridDim.x;
    volatile LAS unsigned* MISC = (volatile LAS unsigned*)(lds + LDS_BYTES - 64);
    if (tid < 16) MISC[tid] = 0u;
    __syncthreads();
    const XcdBarrier bar = xcd_barrier_post((unsigned*)(a.ws + WS_BAR), MISC);
    unsigned char* ws = a.ws;
    bf16* S0 = (bf16*)(ws + WS_S0); bf16* S1 = (bf16*)(ws + WS_S0 + SLOT); bf16* S2 = (bf16*)(ws + WS_S0 + 2 * SLOT);
    bf16* S3 = (bf16*)(ws + WS_S0 + 3 * SLOT); bf16* S4 = (bf16*)(ws + WS_S0 + 4 * SLOT);
    bf16* D0 = (bf16*)a.out; bf16* D1 = D0 + (size_t)M * D;
#ifndef MK_MASK
#define MK_MASK 0x3fff
#endif
#define IN(k) (((MK_MASK >> (k)) & 1) && lo <= (k) && (k) < hi)
#define SEAM(k) do { if (IN(k) && IN((k) + 1)) xcd_barrier(bar); } while (0)
    if (lo < 0) grid.sync();
    if (IN(0)) { phase0(a, lds, tid, lane, wave); } SEAM(0);
    if (IN(1)) { phase1(a, S0, lane, wave); } SEAM(1);
    if (IN(2)) {
        pg8::Gemm g{S0, (const bf16*)(ws + WS_WL), M, 5376, 1024, S0, S0, 1 << 30, 1 << 30, 1024}; pg8::StaticOrder S; S.init(M, 5376, G, (int)blockIdx.x);
        EpiLG E{D0, D1, (float*)(ws + WS_LR), S3, S3 + (size_t)M * 512, S4, S1};
        pg8::gemm_phase<EpiLG, pg8::StaticOrder, true, true>(lds, g, S, E);
    } SEAM(2);
    if (IN(3)) { lru_phase(a, lds, tid, lane, wave); } SEAM(3);
    if (IN(4)) {
        gla_prep(a, lds, tid, D1, S2, S0);
    } SEAM(4);
    if (IN(5)) { gla_phase(a, lds, tid, lane, wave); } SEAM(5);
    if (IN(6)) { post_gla(a, lane, wave); phase1(a, S3, lane, wave); } SEAM(6);
    if (IN(7)) {
        pg8::Gemm g{D1, (const bf16*)(ws + WS_WY) + (size_t)2048 * 1024, M, 2048, 1024, S1, S1, 4, 1 << 30, 1024}; pg8::StaticOrder S; S.init(M, 2048, G, (int)blockIdx.x);
        EpiYY E{S4, D0};
        pg8::gemm_phase<EpiYY, pg8::StaticOrder, true, true>(lds, g, S, E);
    } SEAM(7);
    if (IN(8)) {
        pg8::Gemm g{S3, (const bf16*)(ws + WS_WY), M, 2048, 1024, S3, S3, 1 << 30, 1 << 30, 1024}; pg8::StaticOrder S; S.init(M, 2048, G, (int)blockIdx.x);
        EpiMM E{S4, D0, S0};
        pg8::gemm_phase<EpiMM, pg8::StaticOrder, true, true>(lds, g, S, E);
    } SEAM(8);
    if (IN(9)) {
        { pg8::Gemm g{S0, (const bf16*)(ws + WS_WO), 16384, 1024, 1024, S0, S0, 1 << 30, 1 << 30, 1024}; pg8::StaticOrder S; S.init(16384, 1024, G, (int)blockIdx.x);
          EpiS E{S2, S4, 64}; pg8::gemm_phase<EpiS, pg8::StaticOrder, true, true>(lds, g, S, E); }
        { pg8::Gemm g{S0, (const bf16*)(ws + WS_WO), M, 1024, 256, S0, S0, 1 << 30, 1 << 30, 1024}; SplitOrder S{64, G, (int)blockIdx.x};
          EpiS E{S2, S4, 64}; pg8::gemm_phase<EpiS, SplitOrder, true, true>(lds, g, S, E); }
    } SEAM(9);
    if (IN(10)) { x1_pass(a, lane, wave); } SEAM(10);
    if (IN(11)) {
        pg8::Gemm g{S0, (const bf16*)(ws + WS_W1), M, 4096, 1024, S0, S0, 1 << 30, 1 << 30, 1024}; pg8::StaticOrder S; S.init(M, 4096, G, (int)blockIdx.x);
        EpiH E{S1};
        pg8::gemm_phase<EpiH, pg8::StaticOrder, true, true>(lds, g, S, E);
    } SEAM(11);
    if (IN(12)) {
        { pg8::Gemm g{S1, (const bf16*)(ws + WS_W2), 16384, 1024, 4096, S1, S1, 1 << 30, 1 << 30, 4096}; pg8::StaticOrder S; S.init(16384, 1024, G, (int)blockIdx.x);
          EpiS E{S0, (bf16*)(ws + WS_WL), 64}; pg8::gemm_phase<EpiS, pg8::StaticOrder, true, true>(lds, g, S, E); }
        { pg8::Gemm g{S1, (const bf16*)(ws + WS_W2), M, 1024, 1024, S1, S1, 1 << 30, 1 << 30, 4096}; SplitOrder S{64, G, (int)blockIdx.x};
          EpiS E{S0, (bf16*)(ws + WS_WL), 64}; pg8::gemm_phase<EpiS, SplitOrder, true, true>(lds, g, S, E); }
    } SEAM(12);
    if (IN(13)) { fin_pass(a, lane, wave); }
#undef IN
#undef SEAM
}

extern "C" void kernel_launch(void* const* d_in, const int* in_sizes, int n_in, void* d_out, int out_size, void* d_ws, size_t ws_size, hipStream_t stream) {
    static int grid = 0;
    if (grid == 0) {
        if (n_in != 25 || ws_size < WS_END) { fprintf(stderr, "kernel_launch: unexpected n_in %d / ws %zu\n", n_in, ws_size); grid = -1; return; }
        int dev = 0, cus = 0, per_cu = 0;
        hipGetDevice(&dev); hipDeviceGetAttribute(&cus, hipDeviceAttributeMultiprocessorCount, dev);
        if (hipFuncSetAttribute((const void*)mk_fwd, hipFuncAttributeMaxDynamicSharedMemorySize, LDS_BYTES) != hipSuccess) { fprintf(stderr, "kernel_launch: hipFuncSetAttribute failed\n"); grid = -1; return; }
        if (hipOccupancyMaxActiveBlocksPerMultiprocessor(&per_cu, (const void*)mk_fwd, 512, LDS_BYTES) != hipSuccess || per_cu < 1) { fprintf(stderr, "kernel_launch: occupancy query says %d\n", per_cu); per_cu = 1; }
        (void)hipGetLastError();
        grid = cus * 1;
    }
    if (grid < 0) return;
    if (hipMemsetAsync((char*)d_ws + WS_BAR, 0, WS_BAR_BYTES, stream) != hipSuccess) { fprintf(stderr, "kernel_launch: memset failed\n"); return; }
    Args a{};
    for (int i = 0; i < 25; ++i) a.in[i] = (const float*)d_in[i];
    a.out = (float*)d_out; a.ws = (unsigned char*)d_ws;
    constexpr int NL = MK_N_LAUNCHES;
    for (int li = 0; li < NL; ++li) {
        a.ph_lo = (NL == 1) ? 0 : li; a.ph_hi = (NL == 1) ? NPHASE : li + 1;
        void* args[] = {&a};
        hipError_t e = hipLaunchCooperativeKernel((const void*)mk_fwd, dim3(grid), dim3(512), args, LDS_BYTES, stream);
        if (e != hipSuccess) { fprintf(stderr, "kernel_launch: cooperative launch %d failed: %s\n", li, hipGetErrorString(e)); break; }
    }
}
```

```cpp
#include <hip/hip_runtime.h>
#include <hip/hip_cooperative_groups.h>
#include <cstdio>
#include <cstdint>
namespace cg = cooperative_groups;
namespace pg8 {
#define PG8_LAS __attribute__((address_space(3)))
typedef unsigned short bf16_t;
typedef short bf16x8 __attribute__((ext_vector_type(8)));
typedef float f32x4 __attribute__((ext_vector_type(4)));
typedef unsigned u32x4 __attribute__((ext_vector_type(4)));
constexpr int BM = 256, BK = 64, HALF = 128, HTB = HALF * BK * 2  , STAGE_BYTES = 8 * HTB, NXCD = 8, WGM = 8;

__host__ __device__ __forceinline__ int lds_byte(int r, int c) { const int st = (r >> 4) * 2 + (c >> 5), rr = r & 15, cc = c & 31, ob = rr * 64 + cc * 2; return st * 1024 + (ob ^ (((ob >> 9) & 1) << 5)); }
__host__ __device__ __forceinline__ void stage_rc(int b, int& R, int& C) { const int st = b / 1024, sb = b % 1024, swz = sb ^ (((sb >> 9) & 1) << 5); R = (st >> 1) * 16 + swz / 64; C = (st & 1) * 32 + (swz % 64) / 2; }
__host__ __device__ __forceinline__ int perm32(int rho) { const int n = rho >> 4, i = rho & 15; return 8 * (i >> 2) + 4 * n + (i & 3); }

struct Unit { int pm, pn, kq; };
struct Gemm { const bf16_t* A; const bf16_t* Bt; int M, N, K; const bf16_t* A1; const bf16_t* A2; int pn1, pn2; int ld;
    __device__ __forceinline__ const char* abase(int pn) const { return (const char*)(pn < pn1 ? A : (pn < pn2 ? A1 : A2)); } };

struct StaticOrder {
    int nM, nN, nwg, G, c;
    __host__ __device__ void init(int M, int N, int G_, int c_) { nM = M / BM; nN = N / BM; nwg = nM * nN; G = G_; c = c_; }
    __host__ __device__ bool next(int i, Unit& u) const {
        const long L = (long)i * G + c; if (L >= nwg) return false;
        int wgid = (int)L; { const int q = nwg / NXCD, r = nwg % NXCD, xcd = wgid % NXCD, off = wgid / NXCD; wgid = (xcd < r ? xcd * (q + 1) : r * (q + 1) + (xcd - r) * q) + off; }
        const int nig = WGM * nN, gid = wgid / nig, fm = gid * WGM, gsz = (nM - fm) < WGM ? (nM - fm) : WGM;
        u.pm = fm + ((wgid % nig) % gsz); u.pn = (wgid % nig) / gsz; u.kq = 0; return true;
    }
    __device__ __forceinline__ void a_ready(const Unit&) const {}
    __device__ __forceinline__ void done(const Unit&) const {}
};

typedef float f32x2 __attribute__((ext_vector_type(2)));
typedef __bf16 bf16x2_t __attribute__((ext_vector_type(2)));
__device__ __forceinline__ unsigned cvt_pk_bf16(float lo, float hi) { const f32x2 v = {lo, hi}; return __builtin_bit_cast(unsigned, __builtin_convertvector(v, bf16x2_t)); }
template <class Epi, class Sched, bool ALIGN_EPI = false, bool SP2 = false>
__device__ __forceinline__ void gemm_phase(PG8_LAS unsigned char* lds, const Gemm g, const Sched& S, const Epi& E) {
    const int tid = threadIdx.x, wid = __builtin_amdgcn_readfirstlane(tid >> 6), lane = tid & 63, wr = wid >> 2, wc = wid & 3, fr = lane & 15, fq = lane >> 4;
    const int K = g.K, nt = K / BK;
    unsigned voffA[2], voffB[2];
#pragma unroll
    for (int i = 0; i < 2; ++i) { int R, C; stage_rc(tid * 16 + i * 8192, R, C); const int Rb = Epi::PERM ? ((R & ~31) + perm32(R & 31)) : R;
        voffA[i] = (unsigned)(R * g.ld + C) * 2u; voffB[i] = (unsigned)(Rb * g.ld + C) * 2u; }
    const size_t kstep = (size_t)(BK * 2);
    const size_t hstep = (size_t)HALF * g.ld * 2;
    const size_t tstep = 2 * hstep;
    const unsigned ldsw = (unsigned)wid * 1024u;
    const int aoff = lds_byte(wr * 64 + fr, fq * 8), boff = lds_byte(wc * 32 + fr, fq * 8);
#define PG8_SA(b, h) (((b) * 2 + (h)) * HTB)
#define PG8_SB(b, h) ((4 + (b) * 2 + (h)) * HTB)
#define PG8_STAGE(bufoff, gbase, voff) do { _Pragma("unroll") for (int _i = 0; _i < 2; ++_i) \
        __builtin_amdgcn_global_load_lds((const unsigned*)((const char*)(gbase) + (voff)[_i]), (PG8_LAS unsigned*)(lds + (bufoff) + ldsw + _i * 8192), 16, 0, 0); } while (0)
#define PG8_LDA(dst, b, h) do { _Pragma("unroll") for (int m = 0; m < 4; ++m) _Pragma("unroll") for (int k = 0; k < 2; ++k) dst[m][k] = *(const PG8_LAS bf16x8*)(lds + PG8_SA(b, h) + aoff + m * 2048 + k * 1024); } while (0)
#define PG8_LDB(dst, b, h) do { _Pragma("unroll") for (int n = 0; n < 2; ++n) _Pragma("unroll") for (int k = 0; k < 2; ++k) dst[n][k] = *(const PG8_LAS bf16x8*)(lds + PG8_SB(b, h) + boff + n * 2048 + k * 1024); } while (0)
#define PG8_MMA(ai, bj, At, Bt) do { __builtin_amdgcn_s_setprio(1); _Pragma("unroll") for (int m = 0; m < 4; ++m) _Pragma("unroll") for (int n = 0; n < 2; ++n) _Pragma("unroll") for (int k = 0; k < 2; ++k) \
        acc[ai][bj][m][n] = __builtin_amdgcn_mfma_f32_16x16x32_bf16(Bt[n][k], At[m][k], acc[ai][bj][m][n], 0, 0, 0); __builtin_amdgcn_s_setprio(0); } while (0)
#define PG8_WAIT_V(n) asm volatile("s_waitcnt vmcnt(" #n ")" ::: "memory")
#define PG8_WAIT_L(n) asm volatile("s_waitcnt lgkmcnt(" #n ")" ::: "memory")
#define PG8_BAR __builtin_amdgcn_s_barrier()
#define PG8_SCHED __builtin_amdgcn_sched_barrier(0)
    Unit cur, nxt; int ui = 0;
    if (!S.next(0, cur)) return;
    f32x4 acc[2][2][4][2];
#pragma unroll
    for (int a = 0; a < 2; ++a)
#pragma unroll
        for (int b = 0; b < 2; ++b)
#pragma unroll
            for (int m = 0; m < 4; ++m)
#pragma unroll
                for (int n = 0; n < 2; ++n) acc[a][b][m][n] = (f32x4){0.f, 0.f, 0.f, 0.f};
    bf16x8 At[4][2], B0[2][2], B1[2][2];
    const size_t qstep = (size_t)K * 2;
    const char* cA = g.abase(cur.pn) + (size_t)cur.pm * tstep + (size_t)cur.kq * qstep; const char* cB = (const char*)g.Bt + (size_t)cur.pn * tstep + (size_t)cur.kq * qstep;
    S.a_ready(cur);
    if constexpr (SP2) {
        PG8_STAGE(PG8_SB(0, 0), cB, voffB); PG8_STAGE(PG8_SB(0, 1), cB + hstep, voffB); PG8_STAGE(PG8_SA(0, 0), cA, voffA); PG8_STAGE(PG8_SA(0, 1), cA + hstep, voffA);
        if (wr == 1) PG8_BAR;
        PG8_WAIT_V(2); PG8_BAR;
        PG8_STAGE(PG8_SB(1, 0), cB + kstep, voffB); PG8_STAGE(PG8_SA(1, 0), cA + kstep, voffA); PG8_STAGE(PG8_SB(1, 1), cB + hstep + kstep, voffB);
        PG8_WAIT_V(6); PG8_BAR;
    } else {
        PG8_STAGE(PG8_SB(0, 0), cB, voffB); PG8_STAGE(PG8_SA(0, 0), cA, voffA); PG8_STAGE(PG8_SB(0, 1), cB + hstep, voffB); PG8_STAGE(PG8_SA(0, 1), cA + hstep, voffA);
        if (wr == 1) PG8_BAR;
        PG8_WAIT_V(4); PG8_BAR;
        PG8_STAGE(PG8_SB(1, 0), cB + kstep, voffB); PG8_STAGE(PG8_SA(1, 0), cA + kstep, voffA); PG8_STAGE(PG8_SB(1, 1), cB + hstep + kstep, voffB);
        PG8_WAIT_V(6); PG8_BAR;
    }
    for (;;) {
        const bool has_next = S.next(ui + 1, nxt);
        const char* nA = has_next ? g.abase(nxt.pn) + (size_t)nxt.pm * tstep + (size_t)nxt.kq * qstep : cA; const char* nB = has_next ? (const char*)g.Bt + (size_t)nxt.pn * tstep + (size_t)nxt.kq * qstep : cB;
        for (int t = 0; t < nt; t += 2) {
            const bool last = (t == nt - 2);
            const char* a1 = cA + (size_t)(t + 1) * kstep;
            const char* a2 = last ? nA : cA + (size_t)(t + 2) * kstep; const char* b2 = last ? nB : cB + (size_t)(t + 2) * kstep;
            const char* a3 = a2 + kstep; const char* b3 = b2 + kstep;
            if (last && has_next) S.a_ready(nxt);
            if constexpr (SP2) {
            PG8_LDB(B0, 0, 0); PG8_LDB(B1, 0, 1); PG8_SCHED; PG8_LDA(At, 0, 0); PG8_STAGE(PG8_SA(1, 1), a1 + hstep, voffA);
            PG8_WAIT_V(8); PG8_WAIT_L(0); PG8_BAR; PG8_MMA(0, 0, At, B0); PG8_MMA(0, 1, At, B1); PG8_BAR; PG8_SCHED;
            PG8_LDA(At, 0, 1); PG8_STAGE(PG8_SB(0, 0), b2, voffB); PG8_STAGE(PG8_SB(0, 1), b2 + hstep, voffB); PG8_STAGE(PG8_SA(0, 0), a2, voffA);
            PG8_WAIT_V(8); PG8_WAIT_L(0); PG8_BAR; PG8_MMA(1, 0, At, B0); PG8_MMA(1, 1, At, B1); PG8_BAR; PG8_SCHED;
            PG8_LDB(B0, 1, 0); PG8_LDB(B1, 1, 1); PG8_SCHED; PG8_LDA(At, 1, 0); PG8_STAGE(PG8_SA(0, 1), a2 + hstep, voffA);
            PG8_WAIT_V(8); PG8_WAIT_L(0); PG8_BAR; PG8_MMA(0, 0, At, B0); PG8_MMA(0, 1, At, B1); PG8_BAR; PG8_SCHED;
            PG8_LDA(At, 1, 1); PG8_STAGE(PG8_SB(1, 0), b3, voffB); PG8_STAGE(PG8_SB(1, 1), b3 + hstep, voffB); PG8_STAGE(PG8_SA(1, 0), a3, voffA);
            PG8_WAIT_V(8); PG8_WAIT_L(0); PG8_BAR; PG8_MMA(1, 0, At, B0); PG8_MMA(1, 1, At, B1); PG8_BAR; PG8_SCHED;
            } else {
            PG8_LDB(B0, 0, 0); PG8_SCHED; PG8_LDA(At, 0, 0); PG8_STAGE(PG8_SA(1, 1), a1 + hstep, voffA);
            PG8_WAIT_L(8); PG8_BAR; PG8_WAIT_L(0); PG8_MMA(0, 0, At, B0); PG8_BAR; PG8_SCHED;
            PG8_LDB(B1, 0, 1); PG8_STAGE(PG8_SB(0, 0), b2, voffB);
            PG8_BAR; PG8_WAIT_L(0); PG8_MMA(0, 1, At, B1); PG8_BAR;
            PG8_LDA(At, 0, 1); PG8_STAGE(PG8_SA(0, 0), a2, voffA);
            PG8_BAR; PG8_WAIT_L(0); PG8_MMA(1, 0, At, B0); PG8_BAR; PG8_SCHED;
            PG8_STAGE(PG8_SB(0, 1), b2 + hstep, voffB);
            PG8_WAIT_V(6); PG8_BAR; PG8_MMA(1, 1, At, B1); PG8_BAR;
            PG8_LDB(B0, 1, 0); PG8_SCHED; PG8_LDA(At, 1, 0); PG8_STAGE(PG8_SA(0, 1), a2 + hstep, voffA);
            PG8_WAIT_L(8); PG8_BAR; PG8_WAIT_L(0); PG8_MMA(0, 0, At, B0); PG8_BAR; PG8_SCHED;
            PG8_LDB(B1, 1, 1); PG8_STAGE(PG8_SB(1, 0), b3, voffB);
            PG8_BAR; PG8_WAIT_L(0); PG8_MMA(0, 1, At, B1); PG8_BAR;
            PG8_LDA(At, 1, 1); PG8_STAGE(PG8_SA(1, 0), a3, voffA);
            PG8_BAR; PG8_WAIT_L(0); PG8_MMA(1, 0, At, B0); PG8_BAR; PG8_SCHED;
            PG8_STAGE(PG8_SB(1, 1), b3 + hstep, voffB);
            PG8_WAIT_V(6); PG8_BAR; PG8_MMA(1, 1, At, B1); PG8_BAR;
            }
        }
        if constexpr (ALIGN_EPI) { if (wr == 0) PG8_BAR; }
        if constexpr (!Epi::AFTER_DRAIN) { E(acc, cur, wr, wc, fr, fq); S.done(cur); }
        if (!has_next) break;
#pragma unroll
        for (int a = 0; a < 2; ++a)
#pragma unroll
            for (int b = 0; b < 2; ++b)
#pragma unroll
                for (int m = 0; m < 4; ++m)
#pragma unroll
                    for (int n = 0; n < 2; ++n) acc[a][b][m][n] = (f32x4){0.f, 0.f, 0.f, 0.f};
        cur = nxt; cA = nA; cB = nB; ++ui;
        if constexpr (ALIGN_EPI) { if (wr == 1) PG8_BAR; }
    }
    PG8_WAIT_V(0);
    if constexpr (!ALIGN_EPI) { if (wr == 0) PG8_BAR; }
    PG8_BAR;
    if constexpr (Epi::AFTER_DRAIN) { E.fused(acc, cur, wr, wc, fr, fq, lds, wid, lane); S.done(cur); }
#undef PG8_SA
#undef PG8_SB
#undef PG8_STAGE
#undef PG8_LDA
#undef PG8_LDB
#undef PG8_MMA
#undef PG8_WAIT_V
#undef PG8_WAIT_L
#undef PG8_BAR
#undef PG8_SCHED
}
}

#ifndef MK_N_LAUNCHES
#define MK_N_LAUNCHES 1
#endif
#define LAS __attribute__((address_space(3)))
typedef unsigned short bf16;
typedef float f32x4 __attribute__((ext_vector_type(4)));
typedef float f32x2 __attribute__((ext_vector_type(2)));
typedef unsigned u32x4 __attribute__((ext_vector_type(4)));
typedef unsigned u32x2 __attribute__((ext_vector_type(2)));
typedef short bf16x8 __attribute__((ext_vector_type(8)));

constexpr int D = 1024, MP = 4096, ML = 16384, M = MP + ML, NIN = 7200, DFF = 4096;
constexpr float EPS = 1e-6f;
constexpr size_t MiB = 1u << 20;
constexpr size_t WS_MOD = 0;
constexpr size_t WS_BAR = 512 * 1024, WS_BAR_BYTES = 16384;
constexpr size_t WS_SSQ1 = 1 * MiB;
constexpr size_t WS_SSQ2 = 2560 * 1024;
constexpr size_t WS_LR = 4 * MiB;
constexpr size_t WS_WL = 8 * MiB;
constexpr size_t WS_WG = WS_WL + (size_t)2304 * 1024 * 2;
constexpr size_t WS_WY = WS_WG + (size_t)3072 * 1024 * 2;
constexpr size_t WS_WO = WS_WY + (size_t)4096 * 1024 * 2;
constexpr size_t WS_W1 = WS_WO + (size_t)1024 * 1024 * 2;
constexpr size_t WS_W2 = WS_W1 + (size_t)4096 * 1024 * 2;
constexpr size_t WS_S0 = 48 * MiB, SLOT = 40 * MiB;
static_assert(WS_W2 + (size_t)1024 * 4096 * 2 <= WS_S0, "ws map");
constexpr size_t WS_END = WS_S0 + 5 * SLOT;
constexpr int LDS_BYTES = 147456;

struct Args { const float* in[25]; float* out; unsigned char* ws; int ph_lo, ph_hi; };

__device__ __forceinline__ float bf2f(unsigned v) { return __uint_as_float(v << 16); }
__device__ __forceinline__ float bflo(unsigned w) { return __uint_as_float(w << 16); }
__device__ __forceinline__ float bfhi(unsigned w) { return __uint_as_float(w & 0xffff0000u); }
__device__ __forceinline__ unsigned pk2(float lo, float hi) { return pg8::cvt_pk_bf16(lo, hi); }
__device__ __forceinline__ float wave_sum(float v) {
#pragma unroll
    for (int o = 1; o < 64; o <<= 1) v += __shfl_xor(v, o);
    return v;
}
__device__ __forceinline__ float rcpf_(float x) { return __builtin_amdgcn_rcpf(x); }
__device__ __forceinline__ float expf_(float x) { return __builtin_amdgcn_exp2f(x * 1.4426950408889634f); }
__device__ __forceinline__ float logf_(float x) { return __builtin_amdgcn_logf(x) * 0.6931471805599453f; }
__device__ __forceinline__ float sigmoidf_(float x) { return rcpf_(1.0f + expf_(-x)); }
__device__ __forceinline__ float siluf_(float x) { return x * sigmoidf_(x); }
__device__ __forceinline__ float gelu_tanh(float x) { const float t = x * (1.5957691216f + 0.0713548163f * x * x); return x * rcpf_(1.0f + expf_(-t)); }
template <int ACT> __device__ __forceinline__ float actf(float x) {
    if (ACT == 1) return gelu_tanh(x);
    if (ACT == 2) return siluf_(x);
    if (ACT == 3) return sigmoidf_(x);
    if (ACT == 4) { const float m = fmaxf(x, 0.f); return m * m; }
    return x;
}
#define LDS_WAIT() asm volatile("s_waitcnt lgkmcnt(0)" ::: "memory")

#define XB_TMO      128
#define XB_XCNT(j)  (256  + 64 * (j))
#define XB_XSUB(j)  (1280 + 64 * (j))
#define XB_XGEN(j)  (2304 + 64 * (j))
#define XB_TOP      3328
#define XB_TOPGEN   3392
#define XCD_BAR_WORDS 3456
#define XB_SPIN_CAP (1u << 18)

__device__ __forceinline__ unsigned xb_ld(unsigned* p)              { return __hip_atomic_load(p, __ATOMIC_RELAXED, __HIP_MEMORY_SCOPE_AGENT); }
__device__ __forceinline__ unsigned xb_add(unsigned* p, unsigned v) { return __hip_atomic_fetch_add(p, v, __ATOMIC_RELAXED, __HIP_MEMORY_SCOPE_AGENT); }
__device__ __forceinline__ unsigned xb_xcc_id() { return (unsigned)__builtin_amdgcn_s_getreg((3 << 11) | 20) & 0xFu; }
#define XB_SPIN(cond, bar) do { unsigned _sp = 0; while (cond) { __builtin_amdgcn_s_sleep(1); \
    if ((++_sp & 255u) == 0u) { if (xb_ld(&(bar)[XB_TMO])) break; if (_sp > XB_SPIN_CAP) { atomicAdd(&(bar)[XB_TMO], 1u); break; } } } } while (0)

struct XcdBarrier {
    unsigned* bar; unsigned x;
    volatile LAS unsigned* st;
};

__device__ __forceinline__ XcdBarrier xcd_barrier_post(unsigned* bar, volatile LAS unsigned* st) {
    XcdBarrier b; b.bar = bar; b.x = xb_xcc_id(); b.st = st;
    if (threadIdx.x == 0) (void)xb_add(&bar[XB_XCNT(b.x)], 1u);
    return b;
}
__device__ __forceinline__ void xcd_barrier_complete(unsigned* bar, unsigned x, unsigned& nloc, unsigned& nx) {
    const unsigned G = gridDim.x * gridDim.y * gridDim.z;
    unsigned sum, cnt, mine, sp = 0u;
    for (;;) {
        sum = 0u; cnt = 0u; mine = 0u;
#pragma unroll
        for (unsigned j = 0; j < 16; ++j) { const unsigned c = xb_ld(&bar[XB_XCNT(j)]); sum += c; cnt += (c > 0u) ? 1u : 0u; mine = (j == x) ? c : mine; }
        if (sum == G) break;
        __builtin_amdgcn_s_sleep(1);
        if ((++sp & 255u) == 0u) { if (xb_ld(&bar[XB_TMO])) break; if (sp > XB_SPIN_CAP) { atomicAdd(&bar[XB_TMO], 1u); break; } }
    }
    nloc = mine > 0u ? mine : 1u; nx = cnt > 0u ? cnt : 1u;
}

__device__ __forceinline__ void xcd_barrier(const XcdBarrier& b) {
    asm volatile("s_waitcnt vmcnt(0)" ::: "memory");
    __syncthreads();
    if (threadIdx.x == 0) {
        unsigned* bar = b.bar;
        __builtin_amdgcn_s_waitcnt(0);
        unsigned nloc = b.st[0], nx = b.st[1];
        if (nloc == 0u) { xcd_barrier_complete(bar, b.x, nloc, nx); b.st[0] = nloc; b.st[1] = nx; }
        const unsigned old = xb_add(&bar[XB_XSUB(b.x)], 1u);
        const unsigned gen = old / nloc;
        if (old + 1u == (gen + 1u) * nloc) {
            __builtin_amdgcn_fence(__ATOMIC_RELEASE, "agent");
            asm volatile("s_waitcnt vmcnt(0)" ::: "memory");
            const unsigned og = xb_add(&bar[XB_TOP], 1u);
            const unsigned tg = og / nx;
            if (og + 1u == (tg + 1u) * nx) xb_add(&bar[XB_TOPGEN], 1u);
            else XB_SPIN(xb_ld(&bar[XB_TOPGEN]) == tg, bar);
            __builtin_amdgcn_fence(__ATOMIC_ACQUIRE, "agent");
            xb_add(&bar[XB_XGEN(b.x)], 1u);
            asm volatile("s_waitcnt vmcnt(0)" ::: "memory");
        } else {
            XB_SPIN(xb_ld(&bar[XB_XGEN(b.x)]) == gen, bar);
            __builtin_amdgcn_fence(__ATOMIC_ACQUIRE, "agent");
            asm volatile("s_waitcnt vmcnt(0)" ::: "memory");
        }
    }
    __syncthreads();
}

template <int ACT> __device__ __forceinline__ void store_tile(const f32x4 (&acc)[2][2][4][2], bf16* base, int ld, int row0, int col0) {
#pragma unroll
    for (int ai = 0; ai < 2; ++ai)
#pragma unroll
        for (int m = 0; m < 4; ++m) { bf16* rowp = base + (size_t)(row0 + ai * 128 + m * 16) * ld + col0;
#pragma unroll
            for (int bj = 0; bj < 2; ++bj) { const f32x4 v0 = acc[ai][bj][m][0], v1 = acc[ai][bj][m][1];
                u32x4 w; w.x = pk2(actf<ACT>(v0[0]), actf<ACT>(v0[1])); w.y = pk2(actf<ACT>(v0[2]), actf<ACT>(v0[3]));
                w.z = pk2(actf<ACT>(v1[0]), actf<ACT>(v1[1])); w.w = pk2(actf<ACT>(v1[2]), actf<ACT>(v1[3]));
                *(u32x4*)(rowp + bj * 128) = w; } }
}
struct EpiLG {
    static constexpr bool PERM = true, AFTER_DRAIN = false;
    bf16* ZX; bf16* ZG; float* LR; bf16* Q; bf16* K; bf16* V; bf16* G;
    __device__ __forceinline__ void operator()(const f32x4 (&acc)[2][2][4][2], const pg8::Unit& u, int wr, int wc, int fr, int fq) const {
        const int row0 = u.pm * 256 + wr * 64 + fr, cw = wc * 32 + 8 * fq;
        if (u.pn < 4) store_tile<0>(acc, ZX, D, row0, u.pn * 256 + cw);
        else if (u.pn < 8) store_tile<1>(acc, ZG, D, row0, (u.pn - 4) * 256 + cw);
        else if (u.pn == 8) { if (wc == 0) {
#pragma unroll
            for (int ai = 0; ai < 2; ++ai)
#pragma unroll
                for (int m = 0; m < 4; ++m) { float* rp = LR + (size_t)(row0 + ai * 128 + m * 16) * 32 + 8 * fq;
                    *(f32x4*)rp = acc[ai][0][m][0]; *(f32x4*)(rp + 4) = acc[ai][0][m][1]; } } }
        else if (u.pn < 11) store_tile<0>(acc, Q, 512, row0, (u.pn - 9) * 256 + cw);
        else if (u.pn < 13) store_tile<0>(acc, K, 512, row0, (u.pn - 11) * 256 + cw);
        else if (u.pn < 17) store_tile<0>(acc, V, D, row0, (u.pn - 13) * 256 + cw);
        else store_tile<2>(acc, G, D, row0, (u.pn - 17) * 256 + cw);
    }
};
struct EpiYY {
    static constexpr bool PERM = true, AFTER_DRAIN = false;
    bf16* YA; bf16* YB;
    __device__ __forceinline__ void operator()(const f32x4 (&acc)[2][2][4][2], const pg8::Unit& u, int wr, int wc, int fr, int fq) const {
        store_tile<0>(acc, u.pn < 4 ? YA : YB, D, u.pm * 256 + wr * 64 + fr, (u.pn & 3) * 256 + wc * 32 + 8 * fq);
    }
};
struct EpiMM {
    static constexpr bool PERM = true, AFTER_DRAIN = false;
    const bf16* YA; const bf16* YB; bf16* MM;
    __device__ __forceinline__ void operator()(const f32x4 (&acc)[2][2][4][2], const pg8::Unit& u, int wr, int wc, int fr, int fq) const {
        const int row0 = u.pm * 256 + wr * 64 + fr, c0 = u.pn * 128 + wc * 32 + 8 * fq;
#pragma unroll
        for (int ai = 0; ai < 2; ++ai)
#pragma unroll
            for (int m = 0; m < 4; ++m) { const size_t off = (size_t)(row0 + ai * 128 + m * 16) * D + c0;
                const u32x4 ya = *(const u32x4*)(YA + off), yb = *(const u32x4*)(YB + off);
                const f32x4 a0 = acc[ai][0][m][0], a1 = acc[ai][0][m][1], b0 = acc[ai][1][m][0], b1 = acc[ai][1][m][1];
#define MMV(av, bv, yv, zv) ({ const float ea_ = 1.0f + expf_(-(av)), eb_ = 1.0f + expf_(-(bv)); ((yv) * eb_ + (zv) * ea_) * rcpf_(ea_ * eb_); })
                u32x4 w;
                w.x = pk2(MMV(a0[0], b0[0], bflo(ya.x), bflo(yb.x)), MMV(a0[1], b0[1], bfhi(ya.x), bfhi(yb.x)));
                w.y = pk2(MMV(a0[2], b0[2], bflo(ya.y), bflo(yb.y)), MMV(a0[3], b0[3], bfhi(ya.y), bfhi(yb.y)));
                w.z = pk2(MMV(a1[0], b1[0], bflo(ya.z), bflo(yb.z)), MMV(a1[1], b1[1], bfhi(ya.z), bfhi(yb.z)));
                w.w = pk2(MMV(a1[2], b1[2], bflo(ya.w), bflo(yb.w)), MMV(a1[3], b1[3], bfhi(ya.w), bfhi(yb.w)));
#undef MMV
                *(u32x4*)(MM + off) = w; }
    }
};
struct EpiN {
    static constexpr bool PERM = true, AFTER_DRAIN = false;
    bf16* O; float* SSQ;
    __device__ __forceinline__ void operator()(const f32x4 (&acc)[2][2][4][2], const pg8::Unit& u, int wr, int wc, int fr, int fq) const {
        const int row0 = u.pm * 256 + wr * 64 + fr;
        store_tile<0>(acc, O, D, row0, u.pn * 256 + wc * 32 + 8 * fq);
#pragma unroll
        for (int ai = 0; ai < 2; ++ai)
#pragma unroll
            for (int m = 0; m < 4; ++m) { float ss = 0.f;
#pragma unroll
                for (int bj = 0; bj < 2; ++bj)
#pragma unroll
                    for (int n = 0; n < 2; ++n) { const f32x4 v = acc[ai][bj][m][n]; ss += (v[0] * v[0] + v[1] * v[1]) + (v[2] * v[2] + v[3] * v[3]); }
                ss += __shfl_xor(ss, 16); ss += __shfl_xor(ss, 32);
                if (fq == 0) SSQ[(size_t)(row0 + ai * 128 + m * 16) * 16 + u.pn * 4 + wc] = ss; }
    }
};
struct SplitOrder {
    int pm0, G, c;
    __device__ __forceinline__ bool next(int i, pg8::Unit& u) const { const int L = i * G + c; if (L >= 256) return false; u.kq = L & 3; u.pn = (L >> 2) & 3; u.pm = pm0 + (L >> 4); return true; }
    __device__ __forceinline__ void a_ready(const pg8::Unit&) const {}
    __device__ __forceinline__ void done(const pg8::Unit&) const {}
};
struct EpiS {
    static constexpr bool PERM = true, AFTER_DRAIN = false;
    bf16* O; bf16* P; int pm0;
    __device__ __forceinline__ void operator()(const f32x4 (&acc)[2][2][4][2], const pg8::Unit& u, int wr, int wc, int fr, int fq) const {
        const int cw = u.pn * 256 + wc * 32 + 8 * fq;
        if (u.kq == 0) store_tile<0>(acc, O, D, u.pm * 256 + wr * 64 + fr, cw);
        else store_tile<0>(acc, P + (size_t)(u.kq - 1) * 4096 * 1024, D, (u.pm - pm0) * 256 + wr * 64 + fr, cw);
    }
};
struct EpiH {
    static constexpr bool PERM = true, AFTER_DRAIN = false;
    bf16* Hd;
    __device__ __forceinline__ void operator()(const f32x4 (&acc)[2][2][4][2], const pg8::Unit& u, int wr, int wc, int fr, int fq) const {
        store_tile<4>(acc, Hd, DFF, u.pm * 256 + wr * 64 + fr, u.pn * 256 + wc * 32 + 8 * fq);
    }
};

template <bool ILV = false> __device__ __forceinline__ void tr_item(const float* W, int ld, int col0, int ncols, int K, bf16* WT, int row_off, LAS float* scr, int item, int lane) {
    const int nblk = ncols >> 5, kb = item / nblk, nb = item - kb * nblk, k0 = 64 * kb, n0 = 32 * nb;
    const int r0 = ILV ? ((n0 & 1023) >> 7) * 256 + (n0 & 127) + (n0 >> 10) * 128 : n0;
#pragma unroll 8
    for (int i = 0; i < 32; ++i) { const int kk = 2 * i + (lane >> 5); scr[kk * 33 + (lane & 31)] = W[(size_t)(k0 + kk) * ld + col0 + n0 + (lane & 31)]; }
    LDS_WAIT(); asm volatile("" ::: "memory");
    const int c = lane & 7;
#pragma unroll
    for (int j = 0; j < 4; ++j) { const int n = (lane >> 3) + 8 * j; const LAS float* s = scr + (8 * c) * 33 + n;
        u32x4 o; o.x = pk2(s[0 * 33], s[1 * 33]); o.y = pk2(s[2 * 33], s[3 * 33]); o.z = pk2(s[4 * 33], s[5 * 33]); o.w = pk2(s[6 * 33], s[7 * 33]);
        *(u32x4*)(WT + (size_t)(row_off + r0 + n) * K + k0 + 8 * c) = o; }
    LDS_WAIT(); asm volatile("" ::: "memory");
}
__device__ __forceinline__ void phase0(const Args& a, LAS unsigned char* lds, int tid, int lane, int wave) {
    LAS float* SIL = (LAS float*)lds;
    LAS float* RED = (LAS float*)(lds + 36864);
    LAS float* SCR = (LAS float*)(lds + 36864 + 18432 + wave * 8448);
    unsigned char* ws = a.ws;
    float* MOD = (float*)(ws + WS_MOD);
    for (int i = tid; i < 9 * 1024; i += 512) { const float c = i < 8192 ? a.in[4][i] : a.in[5][i - 8192]; SIL[i] = siluf_(c); }
    __syncthreads();
    for (int it = blockIdx.x; it < 96; it += gridDim.x) {
        const float* wp = a.in[6] + (size_t)(wave * 128) * 6144 + it * 64 + lane;
        float acc[9];
#pragma unroll
        for (int j = 0; j < 9; ++j) acc[j] = 0.f;
#pragma unroll 8
        for (int k = 0; k < 128; ++k) { const float w = wp[(size_t)k * 6144];
#pragma unroll
            for (int j = 0; j < 9; ++j) acc[j] += SIL[j * 1024 + wave * 128 + k] * w; }
#pragma unroll
        for (int j = 0; j < 9; ++j) RED[(wave * 9 + j) * 64 + lane] = acc[j];
        __syncthreads();
        for (int o = tid; o < 576; o += 512) { const int j = o >> 6, l = o & 63; float s = a.in[7][it * 64 + l];
#pragma unroll
            for (int w = 0; w < 8; ++w) s += RED[(w * 9 + j) * 64 + l];
            MOD[j * 6144 + it * 64 + l] = s; }
        __syncthreads();
    }
    bf16* WL = (bf16*)(ws + WS_WL); bf16* WG = (bf16*)(ws + WS_WG); bf16* WY = (bf16*)(ws + WS_WY);
    bf16* WO = (bf16*)(ws + WS_WO); bf16* W1 = (bf16*)(ws + WS_W1); bf16* W2 = (bf16*)(ws + WS_W2);
    const float* w_in = a.in[9];
    const bool split = gridDim.x >= 192;
    const int gw = split ? ((int)blockIdx.x - 96) * 8 + wave : (int)blockIdx.x * 8 + wave, NGW = split ? ((int)gridDim.x - 96) * 8 : (int)gridDim.x * 8;
    constexpr int NITEMS = 1024 + 16 + 1536 + 1024 + 512 + 512 + 512 + 2048 + 2048;
    for (int it = gw; it < NITEMS && gw >= 0; it += NGW) {
        int r = it;
        if (r < 1024) { tr_item(w_in, NIN, 0, 2048, 1024, WL, 0, SCR, r, lane); continue; } r -= 1024;
        if (r < 16) { tr_item(w_in, NIN, 5120, 32, 1024, WL, 2048, SCR, r, lane); continue; } r -= 16;
        if (r < 1536) { tr_item(w_in, NIN, 2048, 3072, 1024, WG, 0, SCR, r, lane); continue; } r -= 1536;
        if (r < 1024) { tr_item<true>(w_in, NIN, 5152, 2048, 1024, WY, 0, SCR, r, lane); continue; } r -= 1024;
        if (r < 512) { tr_item(a.in[17], 1024, 0, 1024, 1024, WY, 2048, SCR, r, lane); continue; } r -= 512;
        if (r < 512) { tr_item(a.in[21], 1024, 0, 1024, 1024, WY, 3072, SCR, r, lane); continue; } r -= 512;
        if (r < 512) { tr_item(a.in[22], 1024, 0, 1024, 1024, WO, 0, SCR, r, lane); continue; } r -= 512;
        if (r < 2048) { tr_item(a.in[23], 4096, 0, 4096, 1024, W1, 0, SCR, r, lane); continue; } r -= 2048;
        tr_item(a.in[24], 1024, 0, 1024, 4096, W2, 0, SCR, r, lane);
    }
    { u32x4* z = (u32x4*)(WL + (size_t)2080 * 1024); const u32x4 zz = {0u, 0u, 0u, 0u};
      for (int i = blockIdx.x * 512 + tid; i < 224 * 1024 / 8; i += gridDim.x * 512) z[i] = zz; }
}

__device__ __forceinline__ const float* xrow(const Args& a, int m) { return m < MP ? a.in[0] + (size_t)m * D : a.in[1] + (size_t)(m - MP) * D; }
__device__ __forceinline__ int modgrp(int m) { return m < MP ? 8 : ((m - MP) >> 11); }
__device__ __forceinline__ void phase1(const Args& a, bf16* H, int lane, int wave) {
    const float* MOD = (const float*)(a.ws + WS_MOD); const float* ng = a.in[8];
    const int stride = gridDim.x * 8; int m = blockIdx.x * 8 + wave;
    f32x4 v[4];
    if (m < M) { const f32x4* xr = (const f32x4*)xrow(a, m) + lane;
#pragma unroll
        for (int q = 0; q < 4; ++q) v[q] = xr[64 * q]; }
    for (; m < M; m += stride) {
        f32x4 vn[4]; const int mn = m + stride;
#pragma unroll
        for (int q = 0; q < 4; ++q) vn[q] = v[q];
        if (mn < M) { const f32x4* xr = (const f32x4*)xrow(a, mn) + lane;
#pragma unroll
            for (int q = 0; q < 4; ++q) vn[q] = xr[64 * q]; }
        const float* md = MOD + modgrp(m) * 6144;
        float s = 0.f;
#pragma unroll
        for (int q = 0; q < 4; ++q) s += (v[q][0] * v[q][0] + v[q][1] * v[q][1]) + (v[q][2] * v[q][2] + v[q][3] * v[q][3]);
        const float rstd = rsqrtf(wave_sum(s) * (1.f / D) + EPS);
        u32x2* o = (u32x2*)(H + (size_t)m * D) + lane;
#pragma unroll
        for (int q = 0; q < 4; ++q) { const int c = 4 * (lane + 64 * q);
            const f32x4 g = *(const f32x4*)(ng + c), sh = *(const f32x4*)(md + c), sc = *(const f32x4*)(md + 1024 + c);
            const f32x4 r = v[q] * rstd * g * (sc + 1.0f) + sh;
            u32x2 w; w.x = pk2(r[0], r[1]); w.y = pk2(r[2], r[3]); o[64 * q] = w; }
#pragma unroll
        for (int q = 0; q < 4; ++q) v[q] = vn[q];
    }
}

__device__ __forceinline__ void lru_phase(const Args& a, LAS unsigned char* lds, int tid, int lane, int wave) {
    LAS bf16* XC = (LAS bf16*)lds;
    LAS float* AU = (LAS float*)(lds + 18432);
    LAS float* SUBA = (LAS float*)(lds + 18432 + 69632);
    LAS float* HC = SUBA + 8 * 64 * 2;
    const bf16* ZX = (const bf16*)a.out;
    bf16* HF = (bf16*)(a.ws + WS_S0 + 2 * SLOT); bf16* HB = (bf16*)(a.ws + WS_S0);
    const float* conv_w = a.in[10]; const float* conv_b = a.in[11];
    const int col = lane & 15, quad = lane >> 4, mt = wave & 3, nh = wave >> 2;
    const int vcu = (gridDim.x % 8 == 0) ? (int)(blockIdx.x % 8) * (int)(gridDim.x / 8) + (int)(blockIdx.x / 8) : (int)blockIdx.x;
    int cur_key = -1;
    bf16x8 Bf[2][2][2]; float ba_[2], bx_[2], c8_[2]; f32x4 cwv[4][2]; f32x4 cb0, cb1;
    const int tokA = tid >> 3, c8A = (tid & 7) * 8;
    for (int u = vcu; u < 768; u += gridDim.x) {
        const bool lat = u < 256; const int v = lat ? u : u - 256; const int b = v >> 5, blk = (v >> 1) & 15, dir = v & 1;
        const int row_base = lat ? MP + b * 2048 : b * 256, nseg = lat ? 32 : 4;
        bf16* HX = dir ? HB : HF;
        const int ch0A = blk * 64 + c8A;
        if ((blk * 2 + dir) != cur_key) { cur_key = blk * 2 + dir;
        const float* wa = a.in[12] + (size_t)(dir * 16 + blk) * 4096; const float* wx = a.in[14] + (size_t)(dir * 16 + blk) * 4096;
#pragma unroll
        for (int nt = 0; nt < 2; ++nt)
#pragma unroll
            for (int kk = 0; kk < 2; ++kk)
#pragma unroll
                for (int i = 0; i < 8; i += 2) { const int k = kk * 32 + quad * 8 + i, n = nh * 32 + nt * 16 + col;
                    const unsigned pa = pk2(wa[k * 64 + n], wa[(k + 1) * 64 + n]), px = pk2(wx[k * 64 + n], wx[(k + 1) * 64 + n]);
                    Bf[0][nt][kk][i] = (short)(pa & 0xffffu); Bf[0][nt][kk][i + 1] = (short)(pa >> 16);
                    Bf[1][nt][kk][i] = (short)(px & 0xffffu); Bf[1][nt][kk][i + 1] = (short)(px >> 16); }
#pragma unroll
        for (int nt = 0; nt < 2; ++nt) { const int ch = dir * 1024 + blk * 64 + nh * 32 + nt * 16 + col;
            ba_[nt] = -1.4426950408889634f * a.in[13][ch]; bx_[nt] = -1.4426950408889634f * a.in[15][ch]; c8_[nt] = -8.0f * 1.4426950408889634f * log1pf(expf(-a.in[16][ch])); }
#pragma unroll
        for (int j = 0; j < 4; ++j) { cwv[j][0] = *(const f32x4*)(conv_w + j * 1024 + ch0A); cwv[j][1] = *(const f32x4*)(conv_w + j * 1024 + ch0A + 4); }
        cb0 = *(const f32x4*)(conv_b + ch0A); cb1 = *(const f32x4*)(conv_b + ch0A + 4);
        }
        if (tid < 64) HC[tid] = lat ? a.in[2][(size_t)(b * 2 + dir) * 1024 + blk * 64 + tid] : 0.f;
        const int nst = nseg >> 1;
        u32x4 Zg[2][4];
#define LRU_FETCH(t0_) do { _Pragma("unroll") for (int hh_ = 0; hh_ < 2; ++hh_) { const int t0h_ = (t0_) + 64 * hh_; const int lo_ = lat ? t0h_ : 0, hi_ = lat ? t0h_ + 64 : 256; \
            _Pragma("unroll") for (int j_ = 0; j_ < 4; ++j_) { const int t_ = t0h_ + tokA + j_ - 1; \
                Zg[hh_][j_] = (t_ >= lo_ && t_ < hi_) ? *(const u32x4*)(ZX + (size_t)(row_base + t_) * D + ch0A) : (u32x4){0u, 0u, 0u, 0u}; } } } while (0)
        LRU_FETCH((dir ? nst - 1 : 0) * 128);
        for (int s = 0; s < nst; ++s) {
            const int st = dir ? nst - 1 - s : s, t0 = st * 128;
#pragma unroll
            for (int hh = 0; hh < 2; ++hh) {
                f32x4 x0 = cb0, x1 = cb1;
#pragma unroll
                for (int j = 0; j < 4; ++j) { const u32x4 z = Zg[hh][j]; const f32x4 w0 = cwv[j][0], w1 = cwv[j][1];
                    x0[0] += w0[0] * bflo(z.x); x0[1] += w0[1] * bfhi(z.x); x0[2] += w0[2] * bflo(z.y); x0[3] += w0[3] * bfhi(z.y);
                    x1[0] += w1[0] * bflo(z.z); x1[1] += w1[1] * bfhi(z.z); x1[2] += w1[2] * bflo(z.w); x1[3] += w1[3] * bfhi(z.w); }
                u32x4 w; w.x = pk2(x0[0], x0[1]); w.y = pk2(x0[2], x0[3]); w.z = pk2(x1[0], x1[1]); w.w = pk2(x1[2], x1[3]);
                *(LAS u32x4*)(XC + (64 * hh + tokA) * 72 + c8A) = w;
            }
            __syncthreads();
            if (s + 1 < nst) LRU_FETCH((dir ? nst - 2 - s : s + 1) * 128);
#pragma unroll
            for (int hh = 0; hh < 2; ++hh) {
                bf16x8 Af[2];
#pragma unroll
                for (int kk = 0; kk < 2; ++kk) Af[kk] = *(const LAS bf16x8*)(XC + (64 * hh + 16 * mt + col) * 72 + kk * 32 + quad * 8);
                f32x4 ar[2], ai[2];
#pragma unroll
                for (int nt = 0; nt < 2; ++nt) { ar[nt] = (f32x4){0.f, 0.f, 0.f, 0.f}; ai[nt] = (f32x4){0.f, 0.f, 0.f, 0.f};
#pragma unroll
                    for (int kk = 0; kk < 2; ++kk) { ar[nt] = __builtin_amdgcn_mfma_f32_16x16x32_bf16(Af[kk], Bf[0][nt][kk], ar[nt], 0, 0, 0);
                        ai[nt] = __builtin_amdgcn_mfma_f32_16x16x32_bf16(Af[kk], Bf[1][nt][kk], ai[nt], 0, 0, 0); } }
                float xv[2][4];
#pragma unroll
                for (int nt = 0; nt < 2; ++nt)
#pragma unroll
                    for (int j = 0; j < 4; ++j) xv[nt][j] = bf2f((unsigned)XC[(64 * hh + 16 * mt + quad * 4 + j) * 72 + nh * 32 + nt * 16 + col]);
#pragma unroll
                for (int nt = 0; nt < 2; ++nt)
#pragma unroll
                    for (int j = 0; j < 4; ++j) { const int tok = 64 * hh + 16 * mt + quad * 4 + j, chl = nh * 32 + nt * 16 + col;
                        const float er = 1.0f + __builtin_amdgcn_exp2f(fmaf(ar[nt][j], -1.4426950408889634f, ba_[nt])), ei = 1.0f + __builtin_amdgcn_exp2f(fmaf(ai[nt][j], -1.4426950408889634f, bx_[nt]));
                        const float inv = rcpf_(er * ei), r = inv * ei, ig = inv * er;
                        const float aa = __builtin_amdgcn_exp2f(c8_[nt] * r);
                        const float uu = __builtin_amdgcn_sqrtf(fmaxf(1.0f - aa * aa, 0.f)) * ig * xv[nt][j];
                        typedef float f32x2s __attribute__((ext_vector_type(2)));
                        *(LAS f32x2s*)(AU + (tok * 68 + chl) * 2) = (f32x2s){aa, uu}; }
            }
            __syncthreads();
            {
                typedef float f32x2l __attribute__((ext_vector_type(2)));
                f32x2l p[16];
#pragma unroll
                for (int e = 0; e < 16; ++e) { const int i = wave * 16 + e; const int tok = dir ? 127 - i : i; p[e] = *(const LAS f32x2l*)(AU + (tok * 68 + lane) * 2); }
                float hl = 0.f, cp = 1.f;
#pragma unroll
                for (int e = 0; e < 16; ++e) { hl = p[e].x * hl + p[e].y; cp *= p[e].x; p[e].y = hl; p[e].x = cp; }
                *(LAS f32x2l*)(SUBA + (wave * 64 + lane) * 2) = (f32x2l){cp, hl};
                __syncthreads();
                float c = HC[(s & 1) * 64 + lane];
#pragma unroll
                for (int s2 = 0; s2 < 7; ++s2) { const f32x2l q = *(const LAS f32x2l*)(SUBA + (s2 * 64 + lane) * 2); if (s2 < wave) c = q.x * c + q.y; }
#pragma unroll
                for (int e = 0; e < 16; ++e) { const int i = wave * 16 + e; const int tok = dir ? 127 - i : i; *(LAS f32x2l*)(AU + (tok * 68 + lane) * 2) = (f32x2l){p[e].x, p[e].y + p[e].x * c}; }
                if (wave == 7) HC[((s + 1) & 1) * 64 + lane] = p[15].y + p[15].x * c;
            }
            __syncthreads();
#pragma unroll
            for (int hh = 0; hh < 2; ++hh) {
                const LAS f32x4* hq = (const LAS f32x4*)(AU + ((64 * hh + tokA) * 68 + c8A) * 2);
                const f32x4 q0 = hq[0], q1 = hq[1], q2 = hq[2], q3 = hq[3];
                u32x4 w; w.x = pk2(q0[1], q0[3]); w.y = pk2(q1[1], q1[3]); w.z = pk2(q2[1], q2[3]); w.w = pk2(q3[1], q3[3]);
                *(u32x4*)(HX + (size_t)(row_base + t0 + 64 * hh + tokA) * D + blk * 64 + c8A) = w;
            }
        }
#undef LRU_FETCH
        if (!lat && tid < 64) a.out[(size_t)M * D + (size_t)(b * 2 + dir) * 1024 + blk * 64 + tid] = HC[(nst & 1) * 64 + tid];
        __syncthreads();
    }
}

constexpr size_t WS_DEC = 6656 * 1024;
__device__ __forceinline__ void gla_prep(const Args& a, LAS unsigned char* lds, int tid, bf16* ewd, const bf16* ewa, const bf16* ewb) {
    LAS float* LRS = (LAS float*)lds;
    const float* LR = (const float*)(a.ws + WS_LR);
    bf16* EFb = (bf16*)a.out; bf16* EBb = EFb + (size_t)M * 512;
    float* DECg = (float*)(a.ws + WS_DEC);
    const size_t ew_n = (size_t)M * D / 8, ew_stride = (size_t)gridDim.x * 512; size_t ew_i = (size_t)blockIdx.x * 512 + tid;
    for (int it = blockIdx.x; it < 640; it += gridDim.x) {
        const int gc = it >> 1, dir = it & 1; const bool lat = gc >= 64; const int g2 = lat ? gc - 64 : gc;
        const int b = lat ? (g2 >> 5) : (g2 >> 2), cn = lat ? (g2 & 31) : (g2 & 3), p0 = cn * 64;
        const int row_base = lat ? MP + b * 2048 : b * 256;
        bf16* Eb = dir ? EBb : EFb;
        float w2r[16];
#pragma unroll
        for (int r = 0; r < 16; ++r) w2r[r] = a.in[18][(size_t)(dir * 16 + r) * 512 + tid];
        const float b2v = a.in[19][dir * 512 + tid];
        __syncthreads();
        if (tid < 256) { const int i = tid >> 2; const int p_ = dir ? p0 + 63 - i : p0 + i; const int row = lat ? row_base + (p_ & 31) * 64 + (p_ >> 5) : row_base + p_;
            *(LAS f32x4*)(LRS + i * 16 + (tid & 3) * 4) = *(const f32x4*)(LR + (size_t)row * 32 + dir * 16 + (tid & 3) * 4); }
        __syncthreads();
        float run = 0.f;
#pragma unroll 1
        for (int i8 = 0; i8 < 64; i8 += 8) {
            const bool ew_on = ew_i < ew_n; u32x4 ex0 = {0u, 0u, 0u, 0u}, ex1 = ex0, ey0 = ex0;
            if (ew_on) { ex0 = ((const u32x4*)ewa)[ew_i]; ex1 = ((const u32x4*)ewb)[ew_i]; ey0 = ((const u32x4*)ewd)[ew_i]; }
#pragma unroll
            for (int i7 = 0; i7 < 8; ++i7) { const int i = i8 + i7; const int p_ = dir ? p0 + 63 - i : p0 + i; const int row = lat ? row_base + (p_ & 31) * 64 + (p_ >> 5) : row_base + p_;
                const LAS f32x4* lrp = (const LAS f32x4*)(LRS + i * 16);
                const f32x4 l0 = lrp[0], l1 = lrp[1], l2 = lrp[2], l3 = lrp[3];
                float x = b2v;
                x += l0[0] * w2r[0]; x += l0[1] * w2r[1]; x += l0[2] * w2r[2]; x += l0[3] * w2r[3];
                x += l1[0] * w2r[4]; x += l1[1] * w2r[5]; x += l1[2] * w2r[6]; x += l1[3] * w2r[7];
                x += l2[0] * w2r[8]; x += l2[1] * w2r[9]; x += l2[2] * w2r[10]; x += l2[3] * w2r[11];
                x += l3[0] * w2r[12]; x += l3[1] * w2r[13]; x += l3[2] * w2r[14]; x += l3[3] * w2r[15];
                run += (fminf(x, 0.f) - logf_(1.0f + expf_(-fabsf(x)))) * 0.0625f;
                Eb[(size_t)row * 512 + tid] = (bf16)(pk2(expf_(run), 0.f) & 0xffffu); }
            if (ew_on) { u32x4 o;
#pragma unroll
                for (int e = 0; e < 4; ++e) o[e] = pk2((bflo(ex0[e]) + bflo(ex1[e])) * bflo(ey0[e]), (bfhi(ex0[e]) + bfhi(ex1[e])) * bfhi(ey0[e]));
                ((u32x4*)ewd)[ew_i] = o; ew_i += ew_stride; }
        }
        DECg[((size_t)dir * 320 + gc) * 512 + tid] = expf_(run);
    }
    for (; ew_i < ew_n; ew_i += ew_stride) { const u32x4 ex0 = ((const u32x4*)ewa)[ew_i], ex1 = ((const u32x4*)ewb)[ew_i], ey0 = ((const u32x4*)ewd)[ew_i]; u32x4 o;
#pragma unroll
        for (int e = 0; e < 4; ++e) o[e] = pk2((bflo(ex0[e]) + bflo(ex1[e])) * bflo(ey0[e]), (bfhi(ex0[e]) + bfhi(ex1[e])) * bfhi(ey0[e]));
        ((u32x4*)ewd)[ew_i] = o; }
}

__device__ __forceinline__ void gla_phase(const Args& a, LAS unsigned char* lds, int tid, int lane, int wave) {
    LAS bf16* QEA = (LAS bf16*)lds;
    LAS bf16* QEB = QEA + 64 * 136;
    LAS bf16* KE = QEB + 64 * 136;
    LAS bf16* STA = KE + 64 * 136;
    LAS bf16* STB = STA + 64 * 136;
    LAS bf16* KT = STB + 64 * 136;
    LAS bf16* VTA = KT + 128 * 72;
    LAS bf16* VTB = VTA + 64 * 72;
    LAS bf16* PP = VTB + 64 * 72;
    LAS float* DECA = (LAS float*)(PP + 64 * 72);
    LAS float* DECB = DECA + 128;
    const unsigned char* ws = a.ws;
    const bf16* EFb = (const bf16*)a.out; const bf16* EBb = EFb + (size_t)M * 512;
    const float* DECg = (const float*)(ws + WS_DEC);
    const bf16* Qb = (const bf16*)(ws + WS_S0 + 3 * SLOT); const bf16* Kb = Qb + (size_t)M * 512;
    const bf16* Vb = (const bf16*)(ws + WS_S0 + 4 * SLOT);
    bf16* OFb = (bf16*)(a.ws + WS_S0 + 2 * SLOT); bf16* OBb = (bf16*)(a.ws + WS_S0);
    const int ch = tid & 127, sub = __builtin_amdgcn_readfirstlane(tid >> 7);
    const int col = lane & 15, quad = lane >> 4, kt = wave;
    float* SG = a.out + (size_t)M * D + 16 * 2 * 1024;
    const int vcu = (gridDim.x % 8 == 0) ? (int)(blockIdx.x % 8) * (int)(gridDim.x / 8) + (int)(blockIdx.x / 8) : (int)blockIdx.x;
    for (int u = vcu; u < 768; u += gridDim.x) {
        const bool lat = u < 256; const int v = lat ? u : u - 256; const int b = v >> 5, hd = (v >> 3) & 3, dir = (v >> 2) & 1, sl = v & 3;
        const int row_base = lat ? MP + b * 2048 : b * 256, nch = lat ? 32 : 4, gc0 = lat ? 64 + b * 32 : b * 4;
        bf16* Ob = dir ? OBb : OFb; const bf16* Eb = dir ? EBb : EFb;
        f32x4 S[4];
#pragma unroll
        for (int vt = 0; vt < 4; ++vt)
#pragma unroll
            for (int j = 0; j < 4; ++j)
                S[vt][j] = lat ? a.in[3][((((size_t)(b * 2 + dir) * 4 + hd) * 128 + 16 * kt + quad * 4 + j) * 256) + sl * 64 + 16 * vt + col] : 0.f;
#define GROWP(p0_, i) ({ const int p_ = dir ? (p0_) + 63 - (i) : (p0_) + (i); lat ? row_base + (p_ & 31) * 64 + (p_ >> 5) : row_base + p_; })
        u32x4 QgA[2], KgA[2], EgA[2], VgA, QgB[2], KgB[2], EgB[2], VgB; f32x2 etgA, etgB;
#define GLA_FETCH(X, cn_) do { const int p0_ = (cn_) * 64; \
            _Pragma("unroll") for (int e_ = 0; e_ < 2; ++e_) { const int pc_ = tid + e_ * 512; const size_t ro_ = (size_t)GROWP(p0_, pc_ >> 4) * 512 + hd * 128 + (pc_ & 15) * 8; \
                Qg##X[e_] = *(const u32x4*)(Qb + ro_); Kg##X[e_] = *(const u32x4*)(Kb + ro_); Eg##X[e_] = *(const u32x4*)(Eb + ro_); } \
            Vg##X = *(const u32x4*)(Vb + (size_t)GROWP(p0_, tid & 63) * D + hd * 256 + sl * 64 + (tid >> 6) * 8); \
            etg##X = *(const f32x2*)(DECg + ((size_t)dir * 320 + gc0 + (cn_)) * 512 + hd * 128 + 2 * lane); } while (0)
#define GLA_CHUNK(X, n) do { const int cn = dir ? nch - 1 - (n) : (n), p0 = cn * 64; \
_Pragma("unroll") \
            for (int vt = 0; vt < 4; ++vt) { u32x2 w; w.x = pk2(S[vt][0], S[vt][1]); w.y = pk2(S[vt][2], S[vt][3]); \
                *(LAS u32x2*)(ST##X + (16 * vt + col) * 136 + 16 * kt + quad * 4) = w; } \
_Pragma("unroll") \
            for (int e = 0; e < 2; ++e) { const int pc = tid + e * 512, o_ = (pc >> 4) * 136 + (pc & 15) * 8; \
                  \
                const u32x4 qr = Qg##X[e], kr = Kg##X[e], er = Eg##X[e]; u32x4 qo, ko; \
_Pragma("unroll") \
                for (int d_ = 0; d_ < 4; ++d_) { const float E0 = bflo(er[d_]), E1 = bfhi(er[d_]); const float R0 = rcpf_(E0), R1 = rcpf_(E1); \
                    qo[d_] = pk2(bflo(qr[d_]) * E0 * 0.08838834764831845f, bfhi(qr[d_]) * E1 * 0.08838834764831845f); \
                    ko[d_] = pk2(bflo(kr[d_]) * R0, bfhi(kr[d_]) * R1); } \
                *(LAS u32x4*)(QE##X + o_) = qo; *(LAS u32x4*)(KE + o_) = ko; } \
            {   const int i = tid & 63, v8 = (tid >> 6) * 8; const u32x4 z = Vg##X; \
                VT##X[(v8 + 0) * 72 + i] = (bf16)(z.x & 0xffffu); VT##X[(v8 + 1) * 72 + i] = (bf16)(z.x >> 16); \
                VT##X[(v8 + 2) * 72 + i] = (bf16)(z.y & 0xffffu); VT##X[(v8 + 3) * 72 + i] = (bf16)(z.y >> 16); \
                VT##X[(v8 + 4) * 72 + i] = (bf16)(z.z & 0xffffu); VT##X[(v8 + 5) * 72 + i] = (bf16)(z.z >> 16); \
                VT##X[(v8 + 6) * 72 + i] = (bf16)(z.w & 0xffffu); VT##X[(v8 + 7) * 72 + i] = (bf16)(z.w >> 16); } \
            const f32x2 etot = etg##X; \
            if (wave == 0) *(LAS f32x2*)(DEC##X + 2 * lane) = etot; \
            __syncthreads(); \
            if ((n) + 2 < nch) GLA_FETCH(X, dir ? nch - 3 - (n) : (n) + 2); \
            {     \
                unsigned kw_[8]; \
_Pragma("unroll") \
                for (int e = 0; e < 8; ++e) kw_[e] = *(const LAS unsigned*)(KE + (wave * 8 + e) * 136 + 2 * lane); \
                u32x4 w0, w1; \
                w0.x = pk2(bflo(kw_[0]) * etot.x, bflo(kw_[1]) * etot.x); w0.y = pk2(bflo(kw_[2]) * etot.x, bflo(kw_[3]) * etot.x); w0.z = pk2(bflo(kw_[4]) * etot.x, bflo(kw_[5]) * etot.x); w0.w = pk2(bflo(kw_[6]) * etot.x, bflo(kw_[7]) * etot.x); \
                w1.x = pk2(bfhi(kw_[0]) * etot.y, bfhi(kw_[1]) * etot.y); w1.y = pk2(bfhi(kw_[2]) * etot.y, bfhi(kw_[3]) * etot.y); w1.z = pk2(bfhi(kw_[4]) * etot.y, bfhi(kw_[5]) * etot.y); w1.w = pk2(bfhi(kw_[6]) * etot.y, bfhi(kw_[7]) * etot.y); \
                *(LAS u32x4*)(KT + (2 * lane) * 72 + wave * 8) = w0; *(LAS u32x4*)(KT + (2 * lane + 1) * 72 + wave * 8) = w1; } \
              \
            {     \
                const int st = wave >> 1, ct0 = 2 * (wave & 1); \
                f32x4 acc0 = {0.f, 0.f, 0.f, 0.f}, acc1 = {0.f, 0.f, 0.f, 0.f}; \
                if (st <= ct0 + 1) { \
_Pragma("unroll") \
                    for (int kk = 0; kk < 4; ++kk) { const bf16x8 ak = *(const LAS bf16x8*)(KE + (16 * st + col) * 136 + kk * 32 + quad * 8); \
                        if (st <= ct0) { const bf16x8 bq0 = *(const LAS bf16x8*)(QE##X + (16 * ct0 + col) * 136 + kk * 32 + quad * 8); acc0 = __builtin_amdgcn_mfma_f32_16x16x32_bf16(ak, bq0, acc0, 0, 0, 0); } \
                        const bf16x8 bq1 = *(const LAS bf16x8*)(QE##X + (16 * (ct0 + 1) + col) * 136 + kk * 32 + quad * 8); acc1 = __builtin_amdgcn_mfma_f32_16x16x32_bf16(ak, bq1, acc1, 0, 0, 0); } \
                } \
_Pragma("unroll") \
                for (int j = 0; j < 4; ++j) { if (16 * st + quad * 4 + j > 16 * ct0 + col) acc0[j] = 0.f; if (16 * st + quad * 4 + j > 16 * (ct0 + 1) + col) acc1[j] = 0.f; } \
                u32x2 w0, w1; w0.x = pk2(acc0[0], acc0[1]); w0.y = pk2(acc0[2], acc0[3]); w1.x = pk2(acc1[0], acc1[1]); w1.y = pk2(acc1[2], acc1[3]); \
                *(LAS u32x2*)(PP + (16 * ct0 + col) * 72 + 16 * st + quad * 4) = w0; *(LAS u32x2*)(PP + (16 * (ct0 + 1) + col) * 72 + 16 * st + quad * 4) = w1; \
            } \
            __syncthreads(); \
            {     \
                const int vt_ = wave >> 1, ct0 = 2 * (wave & 1); \
                bf16x8 av[2], as_[4]; \
_Pragma("unroll") \
                for (int ks = 0; ks < 2; ++ks) av[ks] = *(const LAS bf16x8*)(VT##X + (16 * vt_ + col) * 72 + ks * 32 + quad * 8); \
_Pragma("unroll") \
                for (int kk = 0; kk < 4; ++kk) as_[kk] = *(const LAS bf16x8*)(ST##X + (16 * vt_ + col) * 136 + kk * 32 + quad * 8); \
                f32x4 acc0 = {0.f, 0.f, 0.f, 0.f}, acc1 = {0.f, 0.f, 0.f, 0.f}; \
_Pragma("unroll") \
                for (int ks = 0; ks < 2; ++ks) { const bf16x8 bp0 = *(const LAS bf16x8*)(PP + (16 * ct0 + col) * 72 + ks * 32 + quad * 8), bp1 = *(const LAS bf16x8*)(PP + (16 * (ct0 + 1) + col) * 72 + ks * 32 + quad * 8); \
                    acc0 = __builtin_amdgcn_mfma_f32_16x16x32_bf16(av[ks], bp0, acc0, 0, 0, 0); acc1 = __builtin_amdgcn_mfma_f32_16x16x32_bf16(av[ks], bp1, acc1, 0, 0, 0); } \
_Pragma("unroll") \
                for (int kk = 0; kk < 4; ++kk) { const bf16x8 bq0 = *(const LAS bf16x8*)(QE##X + (16 * ct0 + col) * 136 + kk * 32 + quad * 8), bq1 = *(const LAS bf16x8*)(QE##X + (16 * (ct0 + 1) + col) * 136 + kk * 32 + quad * 8); \
                    acc0 = __builtin_amdgcn_mfma_f32_16x16x32_bf16(as_[kk], bq0, acc0, 0, 0, 0); acc1 = __builtin_amdgcn_mfma_f32_16x16x32_bf16(as_[kk], bq1, acc1, 0, 0, 0); } \
                const int row0 = GROWP(p0, 16 * ct0 + col), row1 = GROWP(p0, 16 * (ct0 + 1) + col); \
                u32x2 w0, w1; w0.x = pk2(acc0[0], acc0[1]); w0.y = pk2(acc0[2], acc0[3]); w1.x = pk2(acc1[0], acc1[1]); w1.y = pk2(acc1[2], acc1[3]); \
                *(u32x2*)(Ob + (size_t)row0 * D + hd * 256 + sl * 64 + 16 * vt_ + quad * 4) = w0; *(u32x2*)(Ob + (size_t)row1 * D + hd * 256 + sl * 64 + 16 * vt_ + quad * 4) = w1; \
                bf16x8 ak[2]; \
_Pragma("unroll") \
                for (int ks = 0; ks < 2; ++ks) ak[ks] = *(const LAS bf16x8*)(KT + (16 * kt + col) * 72 + ks * 32 + quad * 8); \
                float dk[4]; \
_Pragma("unroll") \
                for (int j = 0; j < 4; ++j) dk[j] = DEC##X[16 * kt + quad * 4 + j]; \
_Pragma("unroll") \
                for (int vt = 0; vt < 4; ++vt) { \
_Pragma("unroll") \
                    for (int j = 0; j < 4; ++j) S[vt][j] *= dk[j]; \
_Pragma("unroll") \
                    for (int ks = 0; ks < 2; ++ks) { const bf16x8 bv = *(const LAS bf16x8*)(VT##X + (16 * vt + col) * 72 + ks * 32 + quad * 8); \
                        S[vt] = __builtin_amdgcn_mfma_f32_16x16x32_bf16(ak[ks], bv, S[vt], 0, 0, 0); } } \
            } \
        } while (0)
        GLA_FETCH(A, dir ? nch - 1 : 0); GLA_FETCH(B, dir ? nch - 2 : 1);
        for (int n = 0; n < nch; n += 2) { GLA_CHUNK(A, n); GLA_CHUNK(B, n + 1); }
#undef GLA_CHUNK
#undef GLA_FETCH
#undef GROWP
        if (!lat) {
#pragma unroll
            for (int vt = 0; vt < 4; ++vt)
#pragma unroll
                for (int j = 0; j < 4; ++j)
                    SG[((((size_t)(b * 2 + dir) * 4 + hd) * 128 + 16 * kt + quad * 4 + j) * 256) + sl * 64 + 16 * vt + col] = S[vt][j];
        }
    }
}

template <int MODE> __device__ __forceinline__ void ew_pass(bf16* dst, const bf16* a0, const bf16* b0, const bf16* a1, const bf16* b1, int tid) {
    const size_t nvec = (size_t)M * D / 8;
    for (size_t i = (size_t)blockIdx.x * 512 + tid; i < nvec; i += (size_t)gridDim.x * 512) {
        const u32x4 x0 = ((const u32x4*)a0)[i], y0 = ((const u32x4*)b0)[i], x1 = ((const u32x4*)a1)[i];
        u32x4 o;
        if (MODE == 0) {
#pragma unroll
            for (int e = 0; e < 4; ++e) o[e] = pk2((bflo(x0[e]) + bflo(x1[e])) * bflo(y0[e]), (bfhi(x0[e]) + bfhi(x1[e])) * bfhi(y0[e]));
        } else {
            const u32x4 y1 = ((const u32x4*)b1)[i];
#pragma unroll
            for (int e = 0; e < 4; ++e) o[e] = pk2(bflo(x0[e]) * bflo(y0[e]) + bflo(x1[e]) * bflo(y1[e]), bfhi(x0[e]) * bfhi(y0[e]) + bfhi(x1[e]) * bfhi(y1[e]));
        }
        ((u32x4*)dst)[i] = o;
    }
}
__device__ __forceinline__ void post_gla(const Args& a, int lane, int wave) {
    const bf16* OFb = (const bf16*)(a.ws + WS_S0 + 2 * SLOT); const bf16* OBb = (const bf16*)(a.ws + WS_S0);
    bf16* G = (bf16*)(a.ws + WS_S0 + 1 * SLOT);
    const f32x4 gn = *(const f32x4*)(a.in[20] + 4 * lane);
    const int stride = gridDim.x * 8; int m = blockIdx.x * 8 + wave;
    u32x2 cf[4], cb[4], cg[4];
    if (m < M) {
#pragma unroll
        for (int hh = 0; hh < 4; ++hh) { const size_t off = (size_t)m * D + hh * 256 + 4 * lane; cf[hh] = *(const u32x2*)(OFb + off); cb[hh] = *(const u32x2*)(OBb + off); cg[hh] = *(const u32x2*)(G + off); } }
    for (; m < M; m += stride) {
        u32x2 nf[4], nb[4], ng_[4]; const int mn = m + stride;
#pragma unroll
        for (int hh = 0; hh < 4; ++hh) { nf[hh] = cf[hh]; nb[hh] = cb[hh]; ng_[hh] = cg[hh]; }
        if (mn < M) {
#pragma unroll
            for (int hh = 0; hh < 4; ++hh) { const size_t off = (size_t)mn * D + hh * 256 + 4 * lane; nf[hh] = *(const u32x2*)(OFb + off); nb[hh] = *(const u32x2*)(OBb + off); ng_[hh] = *(const u32x2*)(G + off); } }
#pragma unroll
        for (int hh = 0; hh < 4; ++hh) { const size_t off = (size_t)m * D + hh * 256 + 4 * lane;
            const u32x2 f = cf[hh], bb = cb[hh], g = cg[hh];
            f32x4 o; o[0] = bflo(f.x) + bflo(bb.x); o[1] = bfhi(f.x) + bfhi(bb.x); o[2] = bflo(f.y) + bflo(bb.y); o[3] = bfhi(f.y) + bfhi(bb.y);
            const float ss = wave_sum((o[0] * o[0] + o[1] * o[1]) + (o[2] * o[2] + o[3] * o[3]));
            const float rstd = rsqrtf(ss * (1.f / 256.f) + EPS);
            u32x2 w; w.x = pk2(o[0] * rstd * gn[0] * bflo(g.x), o[1] * rstd * gn[1] * bfhi(g.x)); w.y = pk2(o[2] * rstd * gn[2] * bflo(g.y), o[3] * rstd * gn[3] * bfhi(g.y));
            *(u32x2*)(G + off) = w; }
#pragma unroll
        for (int hh = 0; hh < 4; ++hh) { cf[hh] = nf[hh]; cb[hh] = nb[hh]; cg[hh] = ng_[hh]; }
    }
}
struct SplitRow { u32x2 o[4]; u32x2 p[3][4]; };
__device__ __forceinline__ void split_row_load(SplitRow& r, const bf16* O, const bf16* P, int m, int lane) {
#pragma unroll
    for (int q = 0; q < 4; ++q) r.o[q] = *(const u32x2*)(O + (size_t)m * D + 4 * (lane + 64 * q));
    if (m >= 16384) {
#pragma unroll
        for (int k = 0; k < 3; ++k)
#pragma unroll
            for (int q = 0; q < 4; ++q) r.p[k][q] = *(const u32x2*)(P + ((size_t)k * 4096 + (m - 16384)) * D + 4 * (lane + 64 * q)); }
}
__device__ __forceinline__ f32x4 split_row_val(const SplitRow& r, int m, int q) {
    f32x4 v; v[0] = bflo(r.o[q].x); v[1] = bfhi(r.o[q].x); v[2] = bflo(r.o[q].y); v[3] = bfhi(r.o[q].y);
    if (m >= 16384) {
#pragma unroll
        for (int k = 0; k < 3; ++k) { v[0] += bflo(r.p[k][q].x); v[1] += bfhi(r.p[k][q].x); v[2] += bflo(r.p[k][q].y); v[3] += bfhi(r.p[k][q].y); } }
    return v;
}
__device__ __forceinline__ void x1_pass(const Args& a, int lane, int wave) {
    const float* MOD = (const float*)(a.ws + WS_MOD); const float* ng = a.in[8];
    const bf16* Mm = (const bf16*)(a.ws + WS_S0 + 2 * SLOT); const bf16* Pm = (const bf16*)(a.ws + WS_S0 + 4 * SLOT); bf16* H2 = (bf16*)(a.ws + WS_S0);
    const int stride = gridDim.x * 8; int m = blockIdx.x * 8 + wave;
    SplitRow cur; f32x4 xc[4];
    if (m < M) { split_row_load(cur, Mm, Pm, m, lane); const f32x4* xr = (const f32x4*)xrow(a, m) + lane;
#pragma unroll
        for (int q = 0; q < 4; ++q) xc[q] = xr[64 * q]; }
    for (; m < M; m += stride) {
        SplitRow nxt = cur; f32x4 xn[4]; const int mn = m + stride;
#pragma unroll
        for (int q = 0; q < 4; ++q) xn[q] = xc[q];
        if (mn < M) { split_row_load(nxt, Mm, Pm, mn, lane); const f32x4* xr = (const f32x4*)xrow(a, mn) + lane;
#pragma unroll
            for (int q = 0; q < 4; ++q) xn[q] = xr[64 * q]; }
        const float* md = MOD + modgrp(m) * 6144;
        f32x4 mv[4]; float s1 = 0.f;
#pragma unroll
        for (int q = 0; q < 4; ++q) { mv[q] = split_row_val(cur, m, q); s1 += (mv[q][0] * mv[q][0] + mv[q][1] * mv[q][1]) + (mv[q][2] * mv[q][2] + mv[q][3] * mv[q][3]); }
        const float rstd1 = rsqrtf(wave_sum(s1) * (1.f / D) + EPS);
        f32x4 v[4]; float s = 0.f;
#pragma unroll
        for (int q = 0; q < 4; ++q) { const int c = 4 * (lane + 64 * q);
            const f32x4 g1 = *(const f32x4*)(md + 2048 + c), n1 = *(const f32x4*)(ng + 1024 + c);
            v[q] = xc[q] + g1 * (mv[q] * rstd1 * n1);
            *(f32x4*)(a.out + (size_t)m * D + c) = v[q];
            s += (v[q][0] * v[q][0] + v[q][1] * v[q][1]) + (v[q][2] * v[q][2] + v[q][3] * v[q][3]); }
        const float rstd = rsqrtf(wave_sum(s) * (1.f / D) + EPS);
#pragma unroll
        for (int q = 0; q < 4; ++q) { const int c = 4 * (lane + 64 * q);
            const f32x4 g = *(const f32x4*)(ng + 2048 + c), sh = *(const f32x4*)(md + 3072 + c), sc = *(const f32x4*)(md + 4096 + c);
            const f32x4 r = v[q] * rstd * g * (sc + 1.0f) + sh;
            u32x2 w; w.x = pk2(r[0], r[1]); w.y = pk2(r[2], r[3]); *(u32x2*)(H2 + (size_t)m * D + c) = w; }
        cur = nxt;
#pragma unroll
        for (int q = 0; q < 4; ++q) xc[q] = xn[q];
    }
}
__device__ __forceinline__ void fin_pass(const Args& a, int lane, int wave) {
    const float* MOD = (const float*)(a.ws + WS_MOD); const float* ng = a.in[8];
    const bf16* F = (const bf16*)(a.ws + WS_S0); const bf16* Pf = (const bf16*)(a.ws + WS_WL);
    const int stride = gridDim.x * 8; int m = blockIdx.x * 8 + wave;
    SplitRow cur; f32x4 yc[4];
    if (m < M) { split_row_load(cur, F, Pf, m, lane);
#pragma unroll
        for (int q = 0; q < 4; ++q) yc[q] = *(const f32x4*)(a.out + (size_t)m * D + 4 * (lane + 64 * q)); }
    for (; m < M; m += stride) {
        SplitRow nxt = cur; f32x4 yn[4]; const int mn = m + stride;
#pragma unroll
        for (int q = 0; q < 4; ++q) yn[q] = yc[q];
        if (mn < M) { split_row_load(nxt, F, Pf, mn, lane);
#pragma unroll
            for (int q = 0; q < 4; ++q) yn[q] = *(const f32x4*)(a.out + (size_t)mn * D + 4 * (lane + 64 * q)); }
        const float* md = MOD + modgrp(m) * 6144;
        f32x4 fv[4]; float s = 0.f;
#pragma unroll
        for (int q = 0; q < 4; ++q) { fv[q] = split_row_val(cur, m, q); s += (fv[q][0] * fv[q][0] + fv[q][1] * fv[q][1]) + (fv[q][2] * fv[q][2] + fv[q][3] * fv[q][3]); }
        const float rstd = rsqrtf(wave_sum(s) * (1.f / D) + EPS);
#pragma unroll
        for (int q = 0; q < 4; ++q) { const int c = 4 * (lane + 64 * q);
            const f32x4 g2 = *(const f32x4*)(md + 5120 + c), n3 = *(const f32x4*)(ng + 3072 + c);
            *(f32x4*)(a.out + (size_t)m * D + c) = yc[q] + g2 * (fv[q] * rstd * n3); }
        cur = nxt;
#pragma unroll
        for (int q = 0; q < 4; ++q) yc[q] = yn[q];
    }
}

constexpr int NPHASE = 14;
__global__ void __launch_bounds__(512, 2) mk_fwd(Args a) {
    extern __shared__ __attribute__((aligned(16))) unsigned char lds_raw[];
    LAS unsigned char* lds = (LAS unsigned char*)lds_raw;
    cg::grid_group grid = cg::this_grid();
    const int tid = threadIdx.x, lane = tid & 63, wave = __builtin_amdgcn_readfirstlane(tid >> 6);
    const int lo = a.ph_lo, hi = a.ph_hi, G = gridDim.x;
    volatile LAS unsigned* MISC = (volatile LAS unsigned*)(lds + LDS_BYTES - 64);
    if (tid < 16) MISC[tid] = 0u;
    __syncthreads();
    const XcdBarrier bar = xcd_barrier_post((unsigned*)(a.ws + WS_BAR), MISC);
    unsigned char* ws = a.ws;
    bf16* S0 = (bf16*)(ws + WS_S0); bf16* S1 = (bf16*)(ws + WS_S0 + SLOT); bf16* S2 = (bf16*)(ws + WS_S0 + 2 * SLOT);
    bf16* S3 = (bf16*)(ws + WS_S0 + 3 * SLOT); bf16* S4 = (bf16*)(ws + WS_S0 + 4 * SLOT);
    bf16* D0 = (bf16*)a.out; bf16* D1 = D0 + (size_t)M * D;
#ifndef MK_MASK
#define MK_MASK 0x3fff
#endif
#define IN(k) (((MK_MASK >> (k)) & 1) && lo <= (k) && (k) < hi)
#define SEAM(k) do { if (IN(k) && IN((k) + 1)) xcd_barrier(bar); } while (0)
    if (lo < 0) grid.sync();
    if (IN(0)) { phase0(a, lds, tid, lane, wave); } SEAM(0);
    if (IN(1)) { phase1(a, S0, lane, wave); } SEAM(1);
    if (IN(2)) {
        pg8::Gemm g{S0, (const bf16*)(ws + WS_WL), M, 5376, 1024, S0, S0, 1 << 30, 1 << 30, 1024}; pg8::StaticOrder S; S.init(M, 5376, G, (int)blockIdx.x);
        EpiLG E{D0, D1, (float*)(ws + WS_LR), S3, S3 + (size_t)M * 512, S4, S1};
        pg8::gemm_phase<EpiLG, pg8::StaticOrder, true, true>(lds, g, S, E);
    } SEAM(2);
    if (IN(3)) { lru_phase(a, lds, tid, lane, wave); } SEAM(3);
    if (IN(4)) {
        gla_prep(a, lds, tid, D1, S2, S0);
    } SEAM(4);
    if (IN(5)) { gla_phase(a, lds, tid, lane, wave); } SEAM(5);
    if (IN(6)) { post_gla(a, lane, wave); phase1(a, S3, lane, wave); } SEAM(6);
    if (IN(7)) {
        pg8::Gemm g{D1, (const bf16*)(ws + WS_WY) + (size_t)2048 * 1024, M, 2048, 1024, S1, S1, 4, 1 << 30, 1024}; pg8::StaticOrder S; S.init(M, 2048, G, (int)blockIdx.x);
        EpiYY E{S4, D0};
        pg8::gemm_phase<EpiYY, pg8::StaticOrder, true, true>(lds, g, S, E);
    } SEAM(7);
    if (IN(8)) {
        pg8::Gemm g{S3, (const bf16*)(ws + WS_WY), M, 2048, 1024, S3, S3, 1 << 30, 1 << 30, 1024}; pg8::StaticOrder S; S.init(M, 2048, G, (int)blockIdx.x);
        EpiMM E{S4, D0, S0};
        pg8::gemm_phase<EpiMM, pg8::StaticOrder, true, true>(lds, g, S, E);
    } SEAM(8);
    if (IN(9)) {
        { pg8::Gemm g{S0, (const bf16*)(ws + WS_WO), 16384, 1024, 1024, S0, S0, 1 << 30, 1 << 30, 1024}; pg8::StaticOrder S; S.init(16384, 1024, G, (int)blockIdx.x);
          EpiS E{S2, S4, 64}; pg8::gemm_phase<EpiS, pg8::StaticOrder, true, true>(lds, g, S, E); }
        { pg8::Gemm g{S0, (const bf16*)(ws + WS_WO), M, 1024, 256, S0, S0, 1 << 30, 1 << 30, 1024}; SplitOrder S{64, G, (int)blockIdx.x};
          EpiS E{S2, S4, 64}; pg8::gemm_phase<EpiS, SplitOrder, true, true>(lds, g, S, E); }
    } SEAM(9);
    if (IN(10)) { x1_pass(a, lane, wave); } SEAM(10);
    if (IN(11)) {
        pg8::Gemm g{S0, (const bf16*)(ws + WS_W1), M, 4096, 1024, S0, S0, 1 << 30, 1 << 30, 1024}; pg8::StaticOrder S; S.init(M, 4096, G, (int)blockIdx.x);
        EpiH E{S1};
        pg8::gemm_phase<EpiH, pg8::StaticOrder, true, true>(lds, g, S, E);
    } SEAM(11);
    if (IN(12)) {
        { pg8::Gemm g{S1, (const bf16*)(ws + WS_W2), 16384, 1024, 4096, S1, S1, 1 << 30, 1 << 30, 4096}; pg8::StaticOrder S; S.init(16384, 1024, G, (int)blockIdx.x);
          EpiS E{S0, (bf16*)(ws + WS_WL), 64}; pg8::gemm_phase<EpiS, pg8::StaticOrder, true, true>(lds, g, S, E); }
        { pg8::Gemm g{S1, (const bf16*)(ws + WS_W2), M, 1024, 1024, S1, S1, 1 << 30, 1 << 30, 4096}; SplitOrder S{64, G, (int)blockIdx.x};
          EpiS E{S0, (bf16*)(ws + WS_WL), 64}; pg8::gemm_phase<EpiS, SplitOrder, true, true>(lds, g, S, E); }
    } SEAM(12);
    if (IN(13)) { fin_pass(a, lane, wave); }
#undef IN
#undef SEAM
}

extern "C" void kernel_launch(void* const* d_in, const int* in_sizes, int n_in, void* d_out, int out_size, void* d_ws, size_t ws_size, hipStream_t stream) {
    static int grid = 0;
    if (grid == 0) {
        if (n_in != 25 || ws_size < WS_END) { fprintf(stderr, "kernel_launch: unexpected n_in %d / ws %zu\n", n_in, ws_size); grid = -1; return; }
        int dev = 0, cus = 0, per_cu = 0;
        hipGetDevice(&dev); hipDeviceGetAttribute(&cus, hipDeviceAttributeMultiprocessorCount, dev);
        if (hipFuncSetAttribute((const void*)mk_fwd, hipFuncAttributeMaxDynamicSharedMemorySize, LDS_BYTES) != hipSuccess) { fprintf(stderr, "kernel_launch: hipFuncSetAttribute failed\n"); grid = -1; return; }
        if (hipOccupancyMaxActiveBlocksPerMultiprocessor(&per_cu, (const void*)mk_fwd, 512, LDS_BYTES) != hipSuccess || per_cu < 1) { fprintf(stderr, "kernel_launch: occupancy query says %d\n", per_cu); per_cu = 1; }
        (void)hipGetLastError();
        grid = cus * 1;
    }
    if (grid < 0) return;
    if (hipMemsetAsync((char*)d_ws + WS_BAR, 0, WS_BAR_BYTES, stream) != hipSuccess) { fprintf(stderr, "kernel_launch: memset failed\n"); return; }
    Args a{};
    for (int i = 0; i < 25; ++i) a.in[i] = (const float*)d_in[i];
    a.out = (float*)d_out; a.ws = (unsigned char*)d_ws;
    constexpr int NL = MK_N_LAUNCHES;
    for (int li = 0; li < NL; ++li) {
        a.ph_lo = (NL == 1) ? 0 : li; a.ph_hi = (NL == 1) ? NPHASE : li + 1;
        void* args[] = {&a};
        hipError_t e = hipLaunchCooperativeKernel((const void*)mk_fwd, dim3(grid), dim3(512), args, LDS_BYTES, stream);
        if (e != hipSuccess) { fprintf(stderr, "kernel_launch: cooperative launch %d failed: %s\n", li, hipGetErrorString(e)); break; }
    }
}
```

```cpp
#include <hip/hip_runtime.h>
#include <hip/hip_cooperative_groups.h>
#include <cstdio>
#include <cstdint>
namespace cg = cooperative_groups;
namespace pg8 {
#define PG8_LAS __attribute__((address_space(3)))
typedef unsigned short bf16_t;
typedef short bf16x8 __attribute__((ext_vector_type(8)));
typedef float f32x4 __attribute__((ext_vector_type(4)));
typedef unsigned u32x4 __attribute__((ext_vector_type(4)));
constexpr int BM = 256, BK = 64, HALF = 128, HTB = HALF * BK * 2  , STAGE_BYTES = 8 * HTB, NXCD = 8, WGM = 8;

__host__ __device__ __forceinline__ int lds_byte(int r, int c) { const int st = (r >> 4) * 2 + (c >> 5), rr = r & 15, cc = c & 31, ob = rr * 64 + cc * 2; return st * 1024 + (ob ^ (((ob >> 9) & 1) << 5)); }
__host__ __device__ __forceinline__ void stage_rc(int b, int& R, int& C) { const int st = b / 1024, sb = b % 1024, swz = sb ^ (((sb >> 9) & 1) << 5); R = (st >> 1) * 16 + swz / 64; C = (st & 1) * 32 + (swz % 64) / 2; }
__host__ __device__ __forceinline__ int perm32(int rho) { const int n = rho >> 4, i = rho & 15; return 8 * (i >> 2) + 4 * n + (i & 3); }

struct Unit { int pm, pn, kq; };
struct Gemm { const bf16_t* A; const bf16_t* Bt; int M, N, K; const bf16_t* A1; const bf16_t* A2; int pn1, pn2; int ld;
    __device__ __forceinline__ const char* abase(int pn) const { return (const char*)(pn < pn1 ? A : (pn < pn2 ? A1 : A2)); } };

struct StaticOrder {
    int nM, nN, nwg, G, c;
    __host__ __device__ void init(int M, int N, int G_, int c_) { nM = M / BM; nN = N / BM; nwg = nM * nN; G = G_; c = c_; }
    __host__ __device__ bool next(int i, Unit& u) const {
        const long L = (long)i * G + c; if (L >= nwg) return false;
        int wgid = (int)L; { const int q = nwg / NXCD, r = nwg % NXCD, xcd = wgid % NXCD, off = wgid / NXCD; wgid = (xcd < r ? xcd * (q + 1) : r * (q + 1) + (xcd - r) * q) + off; }
        const int nig = WGM * nN, gid = wgid / nig, fm = gid * WGM, gsz = (nM - fm) < WGM ? (nM - fm) : WGM;
        u.pm = fm + ((wgid % nig) % gsz); u.pn = (wgid % nig) / gsz; u.kq = 0; return true;
    }
    __device__ __forceinline__ void a_ready(const Unit&) const {}
    __device__ __forceinline__ void done(const Unit&) const {}
};

typedef float f32x2 __attribute__((ext_vector_type(2)));
typedef __bf16 bf16x2_t __attribute__((ext_vector_type(2)));
__device__ __forceinline__ unsigned cvt_pk_bf16(float lo, float hi) { const f32x2 v = {lo, hi}; return __builtin_bit_cast(unsigned, __builtin_convertvector(v, bf16x2_t)); }
template <class Epi, class Sched, bool ALIGN_EPI = false, bool SP2 = false>
__device__ __forceinline__ void gemm_phase(PG8_LAS unsigned char* lds, const Gemm g, const Sched& S, const Epi& E) {
    const int tid = threadIdx.x, wid = __builtin_amdgcn_readfirstlane(tid >> 6), lane = tid & 63, wr = wid >> 2, wc = wid & 3, fr = lane & 15, fq = lane >> 4;
    const int K = g.K, nt = K / BK;
    unsigned voffA[2], voffB[2];
#pragma unroll
    for (int i = 0; i < 2; ++i) { int R, C; stage_rc(tid * 16 + i * 8192, R, C); const int Rb = Epi::PERM ? ((R & ~31) + perm32(R & 31)) : R;
        voffA[i] = (unsigned)(R * g.ld + C) * 2u; voffB[i] = (unsigned)(Rb * g.ld + C) * 2u; }
    const size_t kstep = (size_t)(BK * 2);
    const size_t hstep = (size_t)HALF * g.ld * 2;
    const size_t tstep = 2 * hstep;
    const unsigned ldsw = (unsigned)wid * 1024u;
    const int aoff = lds_byte(wr * 64 + fr, fq * 8), boff = lds_byte(wc * 32 + fr, fq * 8);
#define PG8_SA(b, h) (((b) * 2 + (h)) * HTB)
#define PG8_SB(b, h) ((4 + (b) * 2 + (h)) * HTB)
#define PG8_STAGE(bufoff, gbase, voff) do { _Pragma("unroll") for (int _i = 0; _i < 2; ++_i) \
        __builtin_amdgcn_global_load_lds((const unsigned*)((const char*)(gbase) + (voff)[_i]), (PG8_LAS unsigned*)(lds + (bufoff) + ldsw + _i * 8192), 16, 0, 0); } while (0)
#define PG8_LDA(dst, b, h) do { _Pragma("unroll") for (int m = 0; m < 4; ++m) _Pragma("unroll") for (int k = 0; k < 2; ++k) dst[m][k] = *(const PG8_LAS bf16x8*)(lds + PG8_SA(b, h) + aoff + m * 2048 + k * 1024); } while (0)
#define PG8_LDB(dst, b, h) do { _Pragma("unroll") for (int n = 0; n < 2; ++n) _Pragma("unroll") for (int k = 0; k < 2; ++k) dst[n][k] = *(const PG8_LAS bf16x8*)(lds + PG8_SB(b, h) + boff + n * 2048 + k * 1024); } while (0)
#define PG8_MMA(ai, bj, At, Bt) do { __builtin_amdgcn_s_setprio(1); _Pragma("unroll") for (int m = 0; m < 4; ++m) _Pragma("unroll") for (int n = 0; n < 2; ++n) _Pragma("unroll") for (int k = 0; k < 2; ++k) \
        acc[ai][bj][m][n] = __builtin_amdgcn_mfma_f32_16x16x32_bf16(Bt[n][k], At[m][k], acc[ai][bj][m][n], 0, 0, 0); __builtin_amdgcn_s_setprio(0); } while (0)
#define PG8_WAIT_V(n) asm volatile("s_waitcnt vmcnt(" #n ")" ::: "memory")
#define PG8_WAIT_L(n) asm volatile("s_waitcnt lgkmcnt(" #n ")" ::: "memory")
#define PG8_BAR __builtin_amdgcn_s_barrier()
#define PG8_SCHED __builtin_amdgcn_sched_barrier(0)
    Unit cur, nxt; int ui = 0;
    if (!S.next(0, cur)) return;
    f32x4 acc[2][2][4][2];
#pragma unroll
    for (int a = 0; a < 2; ++a)
#pragma unroll
        for (int b = 0; b < 2; ++b)
#pragma unroll
            for (int m = 0; m < 4; ++m)
#pragma unroll
                for (int n = 0; n < 2; ++n) acc[a][b][m][n] = (f32x4){0.f, 0.f, 0.f, 0.f};
    bf16x8 At[4][2], B0[2][2], B1[2][2];
    const size_t qstep = (size_t)K * 2;
    const char* cA = g.abase(cur.pn) + (size_t)cur.pm * tstep + (size_t)cur.kq * qstep; const char* cB = (const char*)g.Bt + (size_t)cur.pn * tstep + (size_t)cur.kq * qstep;
    S.a_ready(cur);
    if constexpr (SP2) {
        PG8_STAGE(PG8_SB(0, 0), cB, voffB); PG8_STAGE(PG8_SB(0, 1), cB + hstep, voffB); PG8_STAGE(PG8_SA(0, 0), cA, voffA); PG8_STAGE(PG8_SA(0, 1), cA + hstep, voffA);
        if (wr == 1) PG8_BAR;
        PG8_WAIT_V(2); PG8_BAR;
        PG8_STAGE(PG8_SB(1, 0), cB + kstep, voffB); PG8_STAGE(PG8_SA(1, 0), cA + kstep, voffA); PG8_STAGE(PG8_SB(1, 1), cB + hstep + kstep, voffB);
        PG8_WAIT_V(6); PG8_BAR;
    } else {
        PG8_STAGE(PG8_SB(0, 0), cB, voffB); PG8_STAGE(PG8_SA(0, 0), cA, voffA); PG8_STAGE(PG8_SB(0, 1), cB + hstep, voffB); PG8_STAGE(PG8_SA(0, 1), cA + hstep, voffA);
        if (wr == 1) PG8_BAR;
        PG8_WAIT_V(4); PG8_BAR;
        PG8_STAGE(PG8_SB(1, 0), cB + kstep, voffB); PG8_STAGE(PG8_SA(1, 0), cA + kstep, voffA); PG8_STAGE(PG8_SB(1, 1), cB + hstep + kstep, voffB);
        PG8_WAIT_V(6); PG8_BAR;
    }
    for (;;) {
        const bool has_next = S.next(ui + 1, nxt);
        const char* nA = has_next ? g.abase(nxt.pn) + (size_t)nxt.pm * tstep + (size_t)nxt.kq * qstep : cA; const char* nB = has_next ? (const char*)g.Bt + (size_t)nxt.pn * tstep + (size_t)nxt.kq * qstep : cB;
        for (int t = 0; t < nt; t += 2) {
            const bool last = (t == nt - 2);
            const char* a1 = cA + (size_t)(t + 1) * kstep;
            const char* a2 = last ? nA : cA + (size_t)(t + 2) * kstep; const char* b2 = last ? nB : cB + (size_t)(t + 2) * kstep;
            const char* a3 = a2 + kstep; const char* b3 = b2 + kstep;
            if (last && has_next) S.a_ready(nxt);
            if constexpr (SP2) {
            PG8_LDB(B0, 0, 0); PG8_LDB(B1, 0, 1); PG8_SCHED; PG8_LDA(At, 0, 0); PG8_STAGE(PG8_SA(1, 1), a1 + hstep, voffA);
            PG8_WAIT_V(8); PG8_WAIT_L(0); PG8_BAR; PG8_MMA(0, 0, At, B0); PG8_MMA(0, 1, At, B1); PG8_BAR; PG8_SCHED;
            PG8_LDA(At, 0, 1); PG8_STAGE(PG8_SB(0, 0), b2, voffB); PG8_STAGE(PG8_SB(0, 1), b2 + hstep, voffB); PG8_STAGE(PG8_SA(0, 0), a2, voffA);
            PG8_WAIT_V(8); PG8_WAIT_L(0); PG8_BAR; PG8_MMA(1, 0, At, B0); PG8_MMA(1, 1, At, B1); PG8_BAR; PG8_SCHED;
            PG8_LDB(B0, 1, 0); PG8_LDB(B1, 1, 1); PG8_SCHED; PG8_LDA(At, 1, 0); PG8_STAGE(PG8_SA(0, 1), a2 + hstep, voffA);
            PG8_WAIT_V(8); PG8_WAIT_L(0); PG8_BAR; PG8_MMA(0, 0, At, B0); PG8_MMA(0, 1, At, B1); PG8_BAR; PG8_SCHED;
            PG8_LDA(At, 1, 1); PG8_STAGE(PG8_SB(1, 0), b3, voffB); PG8_STAGE(PG8_SB(1, 1), b3 + hstep, voffB); PG8_STAGE(PG8_SA(1, 0), a3, voffA);
            PG8_WAIT_V(8); PG8_WAIT_L(0); PG8_BAR; PG8_MMA(1, 0, At, B0); PG8_MMA(1, 1, At, B1); PG8_BAR; PG8_SCHED;
            } else {
            PG8_LDB(B0, 0, 0); PG8_SCHED; PG8_LDA(At, 0, 0); PG8_STAGE(PG8_SA(1, 1), a1 + hstep, voffA);
            PG8_WAIT_L(8); PG8_BAR; PG8_WAIT_L(0); PG8_MMA(0, 0, At, B0); PG8_BAR; PG8_SCHED;
            PG8_LDB(B1, 0, 1); PG8_STAGE(PG8_SB(0, 0), b2, voffB);
            PG8_BAR; PG8_WAIT_L(0); PG8_MMA(0, 1, At, B1); PG8_BAR;
            PG8_LDA(At, 0, 1); PG8_STAGE(PG8_SA(0, 0), a2, voffA);
            PG8_BAR; PG8_WAIT_L(0); PG8_MMA(1, 0, At, B0); PG8_BAR; PG8_SCHED;
            PG8_STAGE(PG8_SB(0, 1), b2 + hstep, voffB);
            PG8_WAIT_V(6); PG8_BAR; PG8_MMA(1, 1, At, B1); PG8_BAR;
            PG8_LDB(B0, 1, 0); PG8_SCHED; PG8_LDA(At, 1, 0); PG8_STAGE(PG8_SA(0, 1), a2 + hstep, voffA);
            PG8_WAIT_L(8); PG8_BAR; PG8_WAIT_L(0); PG8_MMA(0, 0, At, B0); PG8_BAR; PG8_SCHED;
            PG8_LDB(B1, 1, 1); PG8_STAGE(PG8_SB(1, 0), b3, voffB);
            PG8_BAR; PG8_WAIT_L(0); PG8_MMA(0, 1, At, B1); PG8_BAR;
            PG8_LDA(At, 1, 1); PG8_STAGE(PG8_SA(1, 0), a3, voffA);
            PG8_BAR; PG8_WAIT_L(0); PG8_MMA(1, 0, At, B0); PG8_BAR; PG8_SCHED;
            PG8_STAGE(PG8_SB(1, 1), b3 + hstep, voffB);
            PG8_WAIT_V(6); PG8_BAR; PG8_MMA(1, 1, At, B1); PG8_BAR;
            }
        }
        if constexpr (ALIGN_EPI) { if (wr == 0) PG8_BAR; }
        if constexpr (!Epi::AFTER_DRAIN) { E(acc, cur, wr, wc, fr, fq); S.done(cur); }
        if (!has_next) break;
#pragma unroll
        for (int a = 0; a < 2; ++a)
#pragma unroll
            for (int b = 0; b < 2; ++b)
#pragma unroll
                for (int m = 0; m < 4; ++m)
#pragma unroll
                    for (int n = 0; n < 2; ++n) acc[a][b][m][n] = (f32x4){0.f, 0.f, 0.f, 0.f};
        cur = nxt; cA = nA; cB = nB; ++ui;
        if constexpr (ALIGN_EPI) { if (wr == 1) PG8_BAR; }
    }
    PG8_WAIT_V(0);
    if constexpr (!ALIGN_EPI) { if (wr == 0) PG8_BAR; }
    PG8_BAR;
    if constexpr (Epi::AFTER_DRAIN) { E.fused(acc, cur, wr, wc, fr, fq, lds, wid, lane); S.done(cur); }
#undef PG8_SA
#undef PG8_SB
#undef PG8_STAGE
#undef PG8_LDA
#undef PG8_LDB
#undef PG8_MMA
#undef PG8_WAIT_V
#undef PG8_WAIT_L
#undef PG8_BAR
#undef PG8_SCHED
}
}

#ifndef MK_N_LAUNCHES
#define MK_N_LAUNCHES 1
#endif
#define LAS __attribute__((address_space(3)))
typedef unsigned short bf16;
typedef float f32x4 __attribute__((ext_vector_type(4)));
typedef float f32x2 __attribute__((ext_vector_type(2)));
typedef unsigned u32x4 __attribute__((ext_vector_type(4)));
typedef unsigned u32x2 __attribute__((ext_vector_type(2)));
typedef short bf16x8 __attribute__((ext_vector_type(8)));

constexpr int D = 1024, MP = 4096, ML = 16384, M = MP + ML, NIN = 7200, DFF = 4096;
constexpr float EPS = 1e-6f;
constexpr size_t MiB = 1u << 20;
constexpr size_t WS_MOD = 0;
constexpr size_t WS_BAR = 512 * 1024, WS_BAR_BYTES = 16384;
constexpr size_t WS_SSQ1 = 1 * MiB;
constexpr size_t WS_SSQ2 = 2560 * 1024;
constexpr size_t WS_LR = 4 * MiB;
constexpr size_t WS_WL = 8 * MiB;
constexpr size_t WS_WG = WS_WL + (size_t)2304 * 1024 * 2;
constexpr size_t WS_WY = WS_WG + (size_t)3072 * 1024 * 2;
constexpr size_t WS_WO = WS_WY + (size_t)4096 * 1024 * 2;
constexpr size_t WS_W1 = WS_WO + (size_t)1024 * 1024 * 2;
constexpr size_t WS_W2 = WS_W1 + (size_t)4096 * 1024 * 2;
constexpr size_t WS_S0 = 48 * MiB, SLOT = 40 * MiB;
static_assert(WS_W2 + (size_t)1024 * 4096 * 2 <= WS_S0, "ws map");
constexpr size_t WS_END = WS_S0 + 5 * SLOT;
constexpr int LDS_BYTES = 147456;

struct Args { const float* in[25]; float* out; unsigned char* ws; int ph_lo, ph_hi; };

__device__ __forceinline__ float bf2f(unsigned v) { return __uint_as_float(v << 16); }
__device__ __forceinline__ float bflo(unsigned w) { return __uint_as_float(w << 16); }
__device__ __forceinline__ float bfhi(unsigned w) { return __uint_as_float(w & 0xffff0000u); }
__device__ __forceinline__ unsigned pk2(float lo, float hi) { return pg8::cvt_pk_bf16(lo, hi); }
__device__ __forceinline__ float wave_sum(float v) {
#pragma unroll
    for (int o = 1; o < 64; o <<= 1) v += __shfl_xor(v, o);
    return v;
}
__device__ __forceinline__ float rcpf_(float x) { return __builtin_amdgcn_rcpf(x); }
__device__ __forceinline__ float expf_(float x) { return __builtin_amdgcn_exp2f(x * 1.4426950408889634f); }
__device__ __forceinline__ float logf_(float x) { return __builtin_amdgcn_logf(x) * 0.6931471805599453f; }
__device__ __forceinline__ float sigmoidf_(float x) { return rcpf_(1.0f + expf_(-x)); }
__device__ __forceinline__ float siluf_(float x) { return x * sigmoidf_(x); }
__device__ __forceinline__ float gelu_tanh(float x) { const float t = x * (1.5957691216f + 0.0713548163f * x * x); return x * rcpf_(1.0f + expf_(-t)); }
template <int ACT> __device__ __forceinline__ float actf(float x) {
    if (ACT == 1) return gelu_tanh(x);
    if (ACT == 2) return siluf_(x);
    if (ACT == 3) return sigmoidf_(x);
    if (ACT == 4) { const float m = fmaxf(x, 0.f); return m * m; }
    return x;
}
#define LDS_WAIT() asm volatile("s_waitcnt lgkmcnt(0)" ::: "memory")

#define XB_TMO      128
#define XB_XCNT(j)  (256  + 64 * (j))
#define XB_XSUB(j)  (1280 + 64 * (j))
#define XB_XGEN(j)  (2304 + 64 * (j))
#define XB_TOP      3328
#define XB_TOPGEN   3392
#define XCD_BAR_WORDS 3456
#define XB_SPIN_CAP (1u << 18)

__device__ __forceinline__ unsigned xb_ld(unsigned* p)              { return __hip_atomic_load(p, __ATOMIC_RELAXED, __HIP_MEMORY_SCOPE_AGENT); }
__device__ __forceinline__ unsigned xb_add(unsigned* p, unsigned v) { return __hip_atomic_fetch_add(p, v, __ATOMIC_RELAXED, __HIP_MEMORY_SCOPE_AGENT); }
__device__ __forceinline__ unsigned xb_xcc_id() { return (unsigned)__builtin_amdgcn_s_getreg((3 << 11) | 20) & 0xFu; }
#define XB_SPIN(cond, bar) do { unsigned _sp = 0; while (cond) { __builtin_amdgcn_s_sleep(1); \
    if ((++_sp & 255u) == 0u) { if (xb_ld(&(bar)[XB_TMO])) break; if (_sp > XB_SPIN_CAP) { atomicAdd(&(bar)[XB_TMO], 1u); break; } } } } while (0)

struct XcdBarrier {
    unsigned* bar; unsigned x;
    volatile LAS unsigned* st;
};

__device__ __forceinline__ XcdBarrier xcd_barrier_post(unsigned* bar, volatile LAS unsigned* st) {
    XcdBarrier b; b.bar = bar; b.x = xb_xcc_id(); b.st = st;
    if (threadIdx.x == 0) (void)xb_add(&bar[XB_XCNT(b.x)], 1u);
    return b;
}
__device__ __forceinline__ void xcd_barrier_complete(unsigned* bar, unsigned x, unsigned& nloc, unsigned& nx) {
    const unsigned G = gridDim.x * gridDim.y * gridDim.z;
    unsigned sum, cnt, mine, sp = 0u;
    for (;;) {
        sum = 0u; cnt = 0u; mine = 0u;
#pragma unroll
        for (unsigned j = 0; j < 16; ++j) { const unsigned c = xb_ld(&bar[XB_XCNT(j)]); sum += c; cnt += (c > 0u) ? 1u : 0u; mine = (j == x) ? c : mine; }
        if (sum == G) break;
        __builtin_amdgcn_s_sleep(1);
        if ((++sp & 255u) == 0u) { if (xb_ld(&bar[XB_TMO])) break; if (sp > XB_SPIN_CAP) { atomicAdd(&bar[XB_TMO], 1u); break; } }
    }
    nloc = mine > 0u ? mine : 1u; nx = cnt > 0u ? cnt : 1u;
}

__device__ __forceinline__ void xcd_barrier(const XcdBarrier& b) {
    asm volatile("s_waitcnt vmcnt(0)" ::: "memory");
    __syncthreads();
    if (threadIdx.x == 0) {
        unsigned* bar = b.bar;
        __builtin_amdgcn_s_waitcnt(0);
        unsigned nloc = b.st[0], nx = b.st[1];
        if (nloc == 0u) { xcd_barrier_complete(bar, b.x, nloc, nx); b.st[0] = nloc; b.st[1] = nx; }
        const unsigned old = xb_add(&bar[XB_XSUB(b.x)], 1u);
        const unsigned gen = old / nloc;
        if (old + 1u == (gen + 1u) * nloc) {
            __builtin_amdgcn_fence(__ATOMIC_RELEASE, "agent");
            asm volatile("s_waitcnt vmcnt(0)" ::: "memory");
            const unsigned og = xb_add(&bar[XB_TOP], 1u);
            const unsigned tg = og / nx;
            if (og + 1u == (tg + 1u) * nx) xb_add(&bar[XB_TOPGEN], 1u);
            else XB_SPIN(xb_ld(&bar[XB_TOPGEN]) == tg, bar);
            __builtin_amdgcn_fence(__ATOMIC_ACQUIRE, "agent");
            xb_add(&bar[XB_XGEN(b.x)], 1u);
            asm volatile("s_waitcnt vmcnt(0)" ::: "memory");
        } else {
            XB_SPIN(xb_ld(&bar[XB_XGEN(b.x)]) == gen, bar);
            __builtin_amdgcn_fence(__ATOMIC_ACQUIRE, "agent");
            asm volatile("s_waitcnt vmcnt(0)" ::: "memory");
        }
    }
    __syncthreads();
}

template <int ACT> __device__ __forceinline__ void store_tile(const f32x4 (&acc)[2][2][4][2], bf16* base, int ld, int row0, int col0) {
#pragma unroll
    for (int ai = 0; ai < 2; ++ai)
#pragma unroll
        for (int m = 0; m < 4; ++m) { bf16* rowp = base + (size_t)(row0 + ai * 128 + m * 16) * ld + col0;
#pragma unroll
            for (int bj = 0; bj < 2; ++bj) { const f32x4 v0 = acc[ai][bj][m][0], v1 = acc[ai][bj][m][1];
                u32x4 w; w.x = pk2(actf<ACT>(v0[0]), actf<ACT>(v0[1])); w.y = pk2(actf<ACT>(v0[2]), actf<ACT>(v0[3]));
                w.z = pk2(actf<ACT>(v1[0]), actf<ACT>(v1[1])); w.w = pk2(actf<ACT>(v1[2]), actf<ACT>(v1[3]));
                *(u32x4*)(rowp + bj * 128) = w; } }
}
struct EpiLG {
    static constexpr bool PERM = true, AFTER_DRAIN = false;
    bf16* ZX; bf16* ZG; float* LR; bf16* Q; bf16* K; bf16* V; bf16* G;
    __device__ __forceinline__ void operator()(const f32x4 (&acc)[2][2][4][2], const pg8::Unit& u, int wr, int wc, int fr, int fq) const {
        const int row0 = u.pm * 256 + wr * 64 + fr, cw = wc * 32 + 8 * fq;
        if (u.pn < 4) store_tile<0>(acc, ZX, D, row0, u.pn * 256 + cw);
        else if (u.pn < 8) store_tile<1>(acc, ZG, D, row0, (u.pn - 4) * 256 + cw);
        else if (u.pn == 8) { if (wc == 0) {
#pragma unroll
            for (int ai = 0; ai < 2; ++ai)
#pragma unroll
                for (int m = 0; m < 4; ++m) { float* rp = LR + (size_t)(row0 + ai * 128 + m * 16) * 32 + 8 * fq;
                    *(f32x4*)rp = acc[ai][0][m][0]; *(f32x4*)(rp + 4) = acc[ai][0][m][1]; } } }
        else if (u.pn < 11) store_tile<0>(acc, Q, 512, row0, (u.pn - 9) * 256 + cw);
        else if (u.pn < 13) store_tile<0>(acc, K, 512, row0, (u.pn - 11) * 256 + cw);
        else if (u.pn < 17) store_tile<0>(acc, V, D, row0, (u.pn - 13) * 256 + cw);
        else store_tile<0>(acc, G, D, row0, (u.pn - 17) * 256 + cw);
    }
};
struct EpiYY {
    static constexpr bool PERM = true, AFTER_DRAIN = false;
    bf16* YA; bf16* YB;
    __device__ __forceinline__ void operator()(const f32x4 (&acc)[2][2][4][2], const pg8::Unit& u, int wr, int wc, int fr, int fq) const {
        store_tile<0>(acc, u.pn < 4 ? YA : YB, D, u.pm * 256 + wr * 64 + fr, (u.pn & 3) * 256 + wc * 32 + 8 * fq);
    }
};
struct EpiMM {
    static constexpr bool PERM = true, AFTER_DRAIN = false;
    const bf16* YA; const bf16* YB; bf16* MM;
    __device__ __forceinline__ void operator()(const f32x4 (&acc)[2][2][4][2], const pg8::Unit& u, int wr, int wc, int fr, int fq) const {
        const int row0 = u.pm * 256 + wr * 64 + fr, c0 = u.pn * 128 + wc * 32 + 8 * fq;
#pragma unroll
        for (int ai = 0; ai < 2; ++ai)
#pragma unroll
            for (int m = 0; m < 4; ++m) { const size_t off = (size_t)(row0 + ai * 128 + m * 16) * D + c0;
                const u32x4 ya = *(const u32x4*)(YA + off), yb = *(const u32x4*)(YB + off);
                const f32x4 a0 = acc[ai][0][m][0], a1 = acc[ai][0][m][1], b0 = acc[ai][1][m][0], b1 = acc[ai][1][m][1];
#define MMV(av, bv, yv, zv) ({ const float ea_ = 1.0f + expf_(-(av)), eb_ = 1.0f + expf_(-(bv)); ((yv) * eb_ + (zv) * ea_) * rcpf_(ea_ * eb_); })
                u32x4 w;
                w.x = pk2(MMV(a0[0], b0[0], bflo(ya.x), bflo(yb.x)), MMV(a0[1], b0[1], bfhi(ya.x), bfhi(yb.x)));
                w.y = pk2(MMV(a0[2], b0[2], bflo(ya.y), bflo(yb.y)), MMV(a0[3], b0[3], bfhi(ya.y), bfhi(yb.y)));
                w.z = pk2(MMV(a1[0], b1[0], bflo(ya.z), bflo(yb.z)), MMV(a1[1], b1[1], bfhi(ya.z), bfhi(yb.z)));
                w.w = pk2(MMV(a1[2], b1[2], bflo(ya.w), bflo(yb.w)), MMV(a1[3], b1[3], bfhi(ya.w), bfhi(yb.w)));
#undef MMV
                *(u32x4*)(MM + off) = w; }
    }
};
struct EpiN {
    static constexpr bool PERM = true, AFTER_DRAIN = false;
    bf16* O; float* SSQ;
    __device__ __forceinline__ void operator()(const f32x4 (&acc)[2][2][4][2], const pg8::Unit& u, int wr, int wc, int fr, int fq) const {
        const int row0 = u.pm * 256 + wr * 64 + fr;
        store_tile<0>(acc, O, D, row0, u.pn * 256 + wc * 32 + 8 * fq);
#pragma unroll
        for (int ai = 0; ai < 2; ++ai)
#pragma unroll
            for (int m = 0; m < 4; ++m) { float ss = 0.f;
#pragma unroll
                for (int bj = 0; bj < 2; ++bj)
#pragma unroll
                    for (int n = 0; n < 2; ++n) { const f32x4 v = acc[ai][bj][m][n]; ss += (v[0] * v[0] + v[1] * v[1]) + (v[2] * v[2] + v[3] * v[3]); }
                ss += __shfl_xor(ss, 16); ss += __shfl_xor(ss, 32);
                if (fq == 0) SSQ[(size_t)(row0 + ai * 128 + m * 16) * 16 + u.pn * 4 + wc] = ss; }
    }
};
struct SplitOrder {
    int pm0, G, c;
    __device__ __forceinline__ bool next(int i, pg8::Unit& u) const { const int L = i * G + c; if (L >= 256) return false; u.kq = L & 3; u.pn = (L >> 2) & 3; u.pm = pm0 + (L >> 4); return true; }
    __device__ __forceinline__ void a_ready(const pg8::Unit&) const {}
    __device__ __forceinline__ void done(const pg8::Unit&) const {}
};
struct EpiS {
    static constexpr bool PERM = true, AFTER_DRAIN = false;
    bf16* O; bf16* P; int pm0;
    __device__ __forceinline__ void operator()(const f32x4 (&acc)[2][2][4][2], const pg8::Unit& u, int wr, int wc, int fr, int fq) const {
        const int cw = u.pn * 256 + wc * 32 + 8 * fq;
        if (u.kq == 0) store_tile<0>(acc, O, D, u.pm * 256 + wr * 64 + fr, cw);
        else store_tile<0>(acc, P + (size_t)(u.kq - 1) * 4096 * 1024, D, (u.pm - pm0) * 256 + wr * 64 + fr, cw);
    }
};
struct EpiH {
    static constexpr bool PERM = true, AFTER_DRAIN = false;
    bf16* Hd;
    __device__ __forceinline__ void operator()(const f32x4 (&acc)[2][2][4][2], const pg8::Unit& u, int wr, int wc, int fr, int fq) const {
        store_tile<4>(acc, Hd, DFF, u.pm * 256 + wr * 64 + fr, u.pn * 256 + wc * 32 + 8 * fq);
    }
};

template <bool ILV = false> __device__ __forceinline__ void tr_item(const float* W, int ld, int col0, int ncols, int K, bf16* WT, int row_off, LAS float* scr, int item, int lane) {
    const int nblk = ncols >> 5, kb = item / nblk, nb = item - kb * nblk, k0 = 64 * kb, n0 = 32 * nb;
    const int r0 = ILV ? ((n0 & 1023) >> 7) * 256 + (n0 & 127) + (n0 >> 10) * 128 : n0;
#pragma unroll 8
    for (int i = 0; i < 32; ++i) { const int kk = 2 * i + (lane >> 5); scr[kk * 33 + (lane & 31)] = W[(size_t)(k0 + kk) * ld + col0 + n0 + (lane & 31)]; }
    LDS_WAIT(); asm volatile("" ::: "memory");
    const int c = lane & 7;
#pragma unroll
    for (int j = 0; j < 4; ++j) { const int n = (lane >> 3) + 8 * j; const LAS float* s = scr + (8 * c) * 33 + n;
        u32x4 o; o.x = pk2(s[0 * 33], s[1 * 33]); o.y = pk2(s[2 * 33], s[3 * 33]); o.z = pk2(s[4 * 33], s[5 * 33]); o.w = pk2(s[6 * 33], s[7 * 33]);
        *(u32x4*)(WT + (size_t)(row_off + r0 + n) * K + k0 + 8 * c) = o; }
    LDS_WAIT(); asm volatile("" ::: "memory");
}
__device__ __forceinline__ void phase0(const Args& a, LAS unsigned char* lds, int tid, int lane, int wave) {
    LAS float* SIL = (LAS float*)lds;
    LAS float* RED = (LAS float*)(lds + 36864);
    LAS float* SCR = (LAS float*)(lds + 36864 + 18432 + wave * 8448);
    unsigned char* ws = a.ws;
    float* MOD = (float*)(ws + WS_MOD);
    for (int i = tid; i < 9 * 1024; i += 512) { const float c = i < 8192 ? a.in[4][i] : a.in[5][i - 8192]; SIL[i] = siluf_(c); }
    __syncthreads();
    for (int it = blockIdx.x; it < 96; it += gridDim.x) {
        const float* wp = a.in[6] + (size_t)(wave * 128) * 6144 + it * 64 + lane;
        float acc[9];
#pragma unroll
        for (int j = 0; j < 9; ++j) acc[j] = 0.f;
#pragma unroll 8
        for (int k = 0; k < 128; ++k) { const float w = wp[(size_t)k * 6144];
#pragma unroll
            for (int j = 0; j < 9; ++j) acc[j] += SIL[j * 1024 + wave * 128 + k] * w; }
#pragma unroll
        for (int j = 0; j < 9; ++j) RED[(wave * 9 + j) * 64 + lane] = acc[j];
        __syncthreads();
        for (int o = tid; o < 576; o += 512) { const int j = o >> 6, l = o & 63; float s = a.in[7][it * 64 + l];
#pragma unroll
            for (int w = 0; w < 8; ++w) s += RED[(w * 9 + j) * 64 + l];
            MOD[j * 6144 + it * 64 + l] = s; }
        __syncthreads();
    }
    bf16* WL = (bf16*)(ws + WS_WL); bf16* WG = (bf16*)(ws + WS_WG); bf16* WY = (bf16*)(ws + WS_WY);
    bf16* WO = (bf16*)(ws + WS_WO); bf16* W1 = (bf16*)(ws + WS_W1); bf16* W2 = (bf16*)(ws + WS_W2);
    const float* w_in = a.in[9];
    const bool split = gridDim.x >= 192;
    const int gw = split ? ((int)blockIdx.x - 96) * 8 + wave : (int)blockIdx.x * 8 + wave, NGW = split ? ((int)gridDim.x - 96) * 8 : (int)gridDim.x * 8;
    constexpr int NITEMS = 1024 + 16 + 1536 + 1024 + 512 + 512 + 512 + 2048 + 2048;
    for (int it = gw; it < NITEMS && gw >= 0; it += NGW) {
        int r = it;
        if (r < 1024) { tr_item(w_in, NIN, 0, 2048, 1024, WL, 0, SCR, r, lane); continue; } r -= 1024;
        if (r < 16) { tr_item(w_in, NIN, 5120, 32, 1024, WL, 2048, SCR, r, lane); continue; } r -= 16;
        if (r < 1536) { tr_item(w_in, NIN, 2048, 3072, 1024, WG, 0, SCR, r, lane); continue; } r -= 1536;
        if (r < 1024) { tr_item<true>(w_in, NIN, 5152, 2048, 1024, WY, 0, SCR, r, lane); continue; } r -= 1024;
        if (r < 512) { tr_item(a.in[17], 1024, 0, 1024, 1024, WY, 2048, SCR, r, lane); continue; } r -= 512;
        if (r < 512) { tr_item(a.in[21], 1024, 0, 1024, 1024, WY, 3072, SCR, r, lane); continue; } r -= 512;
        if (r < 512) { tr_item(a.in[22], 1024, 0, 1024, 1024, WO, 0, SCR, r, lane); continue; } r -= 512;
        if (r < 2048) { tr_item(a.in[23], 4096, 0, 4096, 1024, W1, 0, SCR, r, lane); continue; } r -= 2048;
        tr_item(a.in[24], 1024, 0, 1024, 4096, W2, 0, SCR, r, lane);
    }
    { u32x4* z = (u32x4*)(WL + (size_t)2080 * 1024); const u32x4 zz = {0u, 0u, 0u, 0u};
      for (int i = blockIdx.x * 512 + tid; i < 224 * 1024 / 8; i += gridDim.x * 512) z[i] = zz; }
}

__device__ __forceinline__ const float* xrow(const Args& a, int m) { return m < MP ? a.in[0] + (size_t)m * D : a.in[1] + (size_t)(m - MP) * D; }
__device__ __forceinline__ int modgrp(int m) { return m < MP ? 8 : ((m - MP) >> 11); }
__device__ __forceinline__ void phase1(const Args& a, bf16* H, int lane, int wave) {
    const float* MOD = (const float*)(a.ws + WS_MOD); const float* ng = a.in[8];
    const int stride = gridDim.x * 8; int m = blockIdx.x * 8 + wave;
    f32x4 v[4];
    if (m < M) { const f32x4* xr = (const f32x4*)xrow(a, m) + lane;
#pragma unroll
        for (int q = 0; q < 4; ++q) v[q] = xr[64 * q]; }
    for (; m < M; m += stride) {
        f32x4 vn[4]; const int mn = m + stride;
#pragma unroll
        for (int q = 0; q < 4; ++q) vn[q] = v[q];
        if (mn < M) { const f32x4* xr = (const f32x4*)xrow(a, mn) + lane;
#pragma unroll
            for (int q = 0; q < 4; ++q) vn[q] = xr[64 * q]; }
        const float* md = MOD + modgrp(m) * 6144;
        float s = 0.f;
#pragma unroll
        for (int q = 0; q < 4; ++q) s += (v[q][0] * v[q][0] + v[q][1] * v[q][1]) + (v[q][2] * v[q][2] + v[q][3] * v[q][3]);
        const float rstd = rsqrtf(wave_sum(s) * (1.f / D) + EPS);
        u32x2* o = (u32x2*)(H + (size_t)m * D) + lane;
#pragma unroll
        for (int q = 0; q < 4; ++q) { const int c = 4 * (lane + 64 * q);
            const f32x4 g = *(const f32x4*)(ng + c), sh = *(const f32x4*)(md + c), sc = *(const f32x4*)(md + 1024 + c);
            const f32x4 r = v[q] * rstd * g * (sc + 1.0f) + sh;
            u32x2 w; w.x = pk2(r[0], r[1]); w.y = pk2(r[2], r[3]); o[64 * q] = w; }
#pragma unroll
        for (int q = 0; q < 4; ++q) v[q] = vn[q];
    }
}

__device__ __forceinline__ void lru_phase(const Args& a, LAS unsigned char* lds, int tid, int lane, int wave) {
    LAS bf16* XC = (LAS bf16*)lds;
    LAS float* AU = (LAS float*)(lds + 18432);
    LAS float* SUBA = (LAS float*)(lds + 18432 + 69632);
    LAS float* HC = SUBA + 8 * 64 * 2;
    const bf16* ZX = (const bf16*)a.out;
    bf16* HF = (bf16*)(a.ws + WS_S0 + 2 * SLOT); bf16* HB = (bf16*)(a.ws + WS_S0);
    const float* conv_w = a.in[10]; const float* conv_b = a.in[11];
    const int col = lane & 15, quad = lane >> 4, mt = wave & 3, nh = wave >> 2;
    const int vcu = (gridDim.x % 8 == 0) ? (int)(blockIdx.x % 8) * (int)(gridDim.x / 8) + (int)(blockIdx.x / 8) : (int)blockIdx.x;
    int cur_key = -1;
    bf16x8 Bf[2][2][2]; float ba_[2], bx_[2], c8_[2]; f32x4 cwv[4][2]; f32x4 cb0, cb1;
    const int tokA = tid >> 3, c8A = (tid & 7) * 8;
    for (int u = vcu; u < 768; u += gridDim.x) {
        const bool lat = u < 256; const int v = lat ? u : u - 256; const int b = v >> 5, blk = (v >> 1) & 15, dir = v & 1;
        const int row_base = lat ? MP + b * 2048 : b * 256, nseg = lat ? 32 : 4;
        bf16* HX = dir ? HB : HF;
        const int ch0A = blk * 64 + c8A;
        if ((blk * 2 + dir) != cur_key) { cur_key = blk * 2 + dir;
        const float* wa = a.in[12] + (size_t)(dir * 16 + blk) * 4096; const float* wx = a.in[14] + (size_t)(dir * 16 + blk) * 4096;
#pragma unroll
        for (int nt = 0; nt < 2; ++nt)
#pragma unroll
            for (int kk = 0; kk < 2; ++kk)
#pragma unroll
                for (int i = 0; i < 8; i += 2) { const int k = kk * 32 + quad * 8 + i, n = nh * 32 + nt * 16 + col;
                    const unsigned pa = pk2(wa[k * 64 + n], wa[(k + 1) * 64 + n]), px = pk2(wx[k * 64 + n], wx[(k + 1) * 64 + n]);
                    Bf[0][nt][kk][i] = (short)(pa & 0xffffu); Bf[0][nt][kk][i + 1] = (short)(pa >> 16);
                    Bf[1][nt][kk][i] = (short)(px & 0xffffu); Bf[1][nt][kk][i + 1] = (short)(px >> 16); }
#pragma unroll
        for (int nt = 0; nt < 2; ++nt) { const int ch = dir * 1024 + blk * 64 + nh * 32 + nt * 16 + col;
            ba_[nt] = -1.4426950408889634f * a.in[13][ch]; bx_[nt] = -1.4426950408889634f * a.in[15][ch]; c8_[nt] = -8.0f * 1.4426950408889634f * log1pf(expf(-a.in[16][ch])); }
#pragma unroll
        for (int j = 0; j < 4; ++j) { cwv[j][0] = *(const f32x4*)(conv_w + j * 1024 + ch0A); cwv[j][1] = *(const f32x4*)(conv_w + j * 1024 + ch0A + 4); }
        cb0 = *(const f32x4*)(conv_b + ch0A); cb1 = *(const f32x4*)(conv_b + ch0A + 4);
        }
        if (tid < 64) HC[tid] = lat ? a.in[2][(size_t)(b * 2 + dir) * 1024 + blk * 64 + tid] : 0.f;
        const int nst = nseg >> 1;
        u32x4 Zg[2][4];
#define LRU_FETCH(t0_) do { _Pragma("unroll") for (int hh_ = 0; hh_ < 2; ++hh_) { const int t0h_ = (t0_) + 64 * hh_; const int lo_ = lat ? t0h_ : 0, hi_ = lat ? t0h_ + 64 : 256; \
            _Pragma("unroll") for (int j_ = 0; j_ < 4; ++j_) { const int t_ = t0h_ + tokA + j_ - 1; \
                Zg[hh_][j_] = (t_ >= lo_ && t_ < hi_) ? *(const u32x4*)(ZX + (size_t)(row_base + t_) * D + ch0A) : (u32x4){0u, 0u, 0u, 0u}; } } } while (0)
        LRU_FETCH((dir ? nst - 1 : 0) * 128);
        for (int s = 0; s < nst; ++s) {
            const int st = dir ? nst - 1 - s : s, t0 = st * 128;
#pragma unroll
            for (int hh = 0; hh < 2; ++hh) {
                f32x4 x0 = cb0, x1 = cb1;
#pragma unroll
                for (int j = 0; j < 4; ++j) { const u32x4 z = Zg[hh][j]; const f32x4 w0 = cwv[j][0], w1 = cwv[j][1];
                    x0[0] += w0[0] * bflo(z.x); x0[1] += w0[1] * bfhi(z.x); x0[2] += w0[2] * bflo(z.y); x0[3] += w0[3] * bfhi(z.y);
                    x1[0] += w1[0] * bflo(z.z); x1[1] += w1[1] * bfhi(z.z); x1[2] += w1[2] * bflo(z.w); x1[3] += w1[3] * bfhi(z.w); }
                u32x4 w; w.x = pk2(x0[0], x0[1]); w.y = pk2(x0[2], x0[3]); w.z = pk2(x1[0], x1[1]); w.w = pk2(x1[2], x1[3]);
                *(LAS u32x4*)(XC + (64 * hh + tokA) * 72 + c8A) = w;
            }
            __syncthreads();
            if (s + 1 < nst) LRU_FETCH((dir ? nst - 2 - s : s + 1) * 128);
#pragma unroll
            for (int hh = 0; hh < 2; ++hh) {
                bf16x8 Af[2];
#pragma unroll
                for (int kk = 0; kk < 2; ++kk) Af[kk] = *(const LAS bf16x8*)(XC + (64 * hh + 16 * mt + col) * 72 + kk * 32 + quad * 8);
                f32x4 ar[2], ai[2];
#pragma unroll
                for (int nt = 0; nt < 2; ++nt) { ar[nt] = (f32x4){0.f, 0.f, 0.f, 0.f}; ai[nt] = (f32x4){0.f, 0.f, 0.f, 0.f};
#pragma unroll
                    for (int kk = 0; kk < 2; ++kk) { ar[nt] = __builtin_amdgcn_mfma_f32_16x16x32_bf16(Af[kk], Bf[0][nt][kk], ar[nt], 0, 0, 0);
                        ai[nt] = __builtin_amdgcn_mfma_f32_16x16x32_bf16(Af[kk], Bf[1][nt][kk], ai[nt], 0, 0, 0); } }
                float xv[2][4];
#pragma unroll
                for (int nt = 0; nt < 2; ++nt)
#pragma unroll
                    for (int j = 0; j < 4; ++j) xv[nt][j] = bf2f((unsigned)XC[(64 * hh + 16 * mt + quad * 4 + j) * 72 + nh * 32 + nt * 16 + col]);
#pragma unroll
                for (int nt = 0; nt < 2; ++nt)
#pragma unroll
                    for (int j = 0; j < 4; ++j) { const int tok = 64 * hh + 16 * mt + quad * 4 + j, chl = nh * 32 + nt * 16 + col;
                        const float er = 1.0f + __builtin_amdgcn_exp2f(fmaf(ar[nt][j], -1.4426950408889634f, ba_[nt])), ei = 1.0f + __builtin_amdgcn_exp2f(fmaf(ai[nt][j], -1.4426950408889634f, bx_[nt]));
                        const float inv = rcpf_(er * ei), r = inv * ei, ig = inv * er;
                        const float aa = __builtin_amdgcn_exp2f(c8_[nt] * r);
                        const float uu = __builtin_amdgcn_sqrtf(fmaxf(1.0f - aa * aa, 0.f)) * ig * xv[nt][j];
                        typedef float f32x2s __attribute__((ext_vector_type(2)));
                        *(LAS f32x2s*)(AU + (tok * 68 + chl) * 2) = (f32x2s){aa, uu}; }
            }
            __syncthreads();
            {
                typedef float f32x2l __attribute__((ext_vector_type(2)));
                f32x2l p[16];
#pragma unroll
                for (int e = 0; e < 16; ++e) { const int i = wave * 16 + e; const int tok = dir ? 127 - i : i; p[e] = *(const LAS f32x2l*)(AU + (tok * 68 + lane) * 2); }
                float hl = 0.f, cp = 1.f;
#pragma unroll
                for (int e = 0; e < 16; ++e) { hl = p[e].x * hl + p[e].y; cp *= p[e].x; p[e].y = hl; p[e].x = cp; }
                *(LAS f32x2l*)(SUBA + (wave * 64 + lane) * 2) = (f32x2l){cp, hl};
                __syncthreads();
                float c = HC[(s & 1) * 64 + lane];
#pragma unroll
                for (int s2 = 0; s2 < 7; ++s2) { const f32x2l q = *(const LAS f32x2l*)(SUBA + (s2 * 64 + lane) * 2); if (s2 < wave) c = q.x * c + q.y; }
#pragma unroll
                for (int e = 0; e < 16; ++e) { const int i = wave * 16 + e; const int tok = dir ? 127 - i : i; *(LAS f32x2l*)(AU + (tok * 68 + lane) * 2) = (f32x2l){p[e].x, p[e].y + p[e].x * c}; }
                if (wave == 7) HC[((s + 1) & 1) * 64 + lane] = p[15].y + p[15].x * c;
            }
            __syncthreads();
#pragma unroll
            for (int hh = 0; hh < 2; ++hh) {
                const LAS f32x4* hq = (const LAS f32x4*)(AU + ((64 * hh + tokA) * 68 + c8A) * 2);
                const f32x4 q0 = hq[0], q1 = hq[1], q2 = hq[2], q3 = hq[3];
                u32x4 w; w.x = pk2(q0[1], q0[3]); w.y = pk2(q1[1], q1[3]); w.z = pk2(q2[1], q2[3]); w.w = pk2(q3[1], q3[3]);
                *(u32x4*)(HX + (size_t)(row_base + t0 + 64 * hh + tokA) * D + blk * 64 + c8A) = w;
            }
        }
#undef LRU_FETCH
        if (!lat && tid < 64) a.out[(size_t)M * D + (size_t)(b * 2 + dir) * 1024 + blk * 64 + tid] = HC[(nst & 1) * 64 + tid];
        __syncthreads();
    }
}

constexpr size_t WS_DEC = 6656 * 1024;
__device__ __forceinline__ void gla_prep(const Args& a, LAS unsigned char* lds, int tid, bf16* ewd, const bf16* ewa, const bf16* ewb) {
    LAS float* LRS = (LAS float*)lds;
    const float* LR = (const float*)(a.ws + WS_LR);
    bf16* EFb = (bf16*)a.out; bf16* EBb = EFb + (size_t)M * 512;
    float* DECg = (float*)(a.ws + WS_DEC);
    const size_t ew_n = (size_t)M * D / 8, ew_stride = (size_t)gridDim.x * 512; size_t ew_i = (size_t)blockIdx.x * 512 + tid;
    for (int it = blockIdx.x; it < 640; it += gridDim.x) {
        const int gc = it >> 1, dir = it & 1; const bool lat = gc >= 64; const int g2 = lat ? gc - 64 : gc;
        const int b = lat ? (g2 >> 5) : (g2 >> 2), cn = lat ? (g2 & 31) : (g2 & 3), p0 = cn * 64;
        const int row_base = lat ? MP + b * 2048 : b * 256;
        bf16* Eb = dir ? EBb : EFb;
        float w2r[16];
#pragma unroll
        for (int r = 0; r < 16; ++r) w2r[r] = a.in[18][(size_t)(dir * 16 + r) * 512 + tid];
        const float b2v = a.in[19][dir * 512 + tid];
        __syncthreads();
        if (tid < 256) { const int i = tid >> 2; const int p_ = dir ? p0 + 63 - i : p0 + i; const int row = lat ? row_base + (p_ & 31) * 64 + (p_ >> 5) : row_base + p_;
            *(LAS f32x4*)(LRS + i * 16 + (tid & 3) * 4) = *(const f32x4*)(LR + (size_t)row * 32 + dir * 16 + (tid & 3) * 4); }
        __syncthreads();
        float run = 0.f;
#pragma unroll 1
        for (int i8 = 0; i8 < 64; i8 += 8) {
            const bool ew_on = ew_i < ew_n; u32x4 ex0 = {0u, 0u, 0u, 0u}, ex1 = ex0, ey0 = ex0;
            if (ew_on) { ex0 = ((const u32x4*)ewa)[ew_i]; ex1 = ((const u32x4*)ewb)[ew_i]; ey0 = ((const u32x4*)ewd)[ew_i]; }
#pragma unroll
            for (int i7 = 0; i7 < 8; ++i7) { const int i = i8 + i7; const int p_ = dir ? p0 + 63 - i : p0 + i; const int row = lat ? row_base + (p_ & 31) * 64 + (p_ >> 5) : row_base + p_;
                const LAS f32x4* lrp = (const LAS f32x4*)(LRS + i * 16);
                const f32x4 l0 = lrp[0], l1 = lrp[1], l2 = lrp[2], l3 = lrp[3];
                float x = b2v;
                x += l0[0] * w2r[0]; x += l0[1] * w2r[1]; x += l0[2] * w2r[2]; x += l0[3] * w2r[3];
                x += l1[0] * w2r[4]; x += l1[1] * w2r[5]; x += l1[2] * w2r[6]; x += l1[3] * w2r[7];
                x += l2[0] * w2r[8]; x += l2[1] * w2r[9]; x += l2[2] * w2r[10]; x += l2[3] * w2r[11];
                x += l3[0] * w2r[12]; x += l3[1] * w2r[13]; x += l3[2] * w2r[14]; x += l3[3] * w2r[15];
                run += (fminf(x, 0.f) - logf_(1.0f + expf_(-fabsf(x)))) * 0.0625f;
                Eb[(size_t)row * 512 + tid] = (bf16)(pk2(expf_(run), 0.f) & 0xffffu); }
            if (ew_on) { u32x4 o;
#pragma unroll
                for (int e = 0; e < 4; ++e) o[e] = pk2((bflo(ex0[e]) + bflo(ex1[e])) * bflo(ey0[e]), (bfhi(ex0[e]) + bfhi(ex1[e])) * bfhi(ey0[e]));
                ((u32x4*)ewd)[ew_i] = o; ew_i += ew_stride; }
        }
        DECg[((size_t)dir * 320 + gc) * 512 + tid] = expf_(run);
    }
    for (; ew_i < ew_n; ew_i += ew_stride) { const u32x4 ex0 = ((const u32x4*)ewa)[ew_i], ex1 = ((const u32x4*)ewb)[ew_i], ey0 = ((const u32x4*)ewd)[ew_i]; u32x4 o;
#pragma unroll
        for (int e = 0; e < 4; ++e) o[e] = pk2((bflo(ex0[e]) + bflo(ex1[e])) * bflo(ey0[e]), (bfhi(ex0[e]) + bfhi(ex1[e])) * bfhi(ey0[e]));
        ((u32x4*)ewd)[ew_i] = o; }
}

__device__ __forceinline__ void gla_phase(const Args& a, LAS unsigned char* lds, int tid, int lane, int wave) {
    LAS bf16* QEA = (LAS bf16*)lds;
    LAS bf16* QEB = QEA + 64 * 136;
    LAS bf16* KE = QEB + 64 * 136;
    LAS bf16* STA = KE + 64 * 136;
    LAS bf16* STB = STA + 64 * 136;
    LAS bf16* KT = STB + 64 * 136;
    LAS bf16* VTA = KT + 128 * 72;
    LAS bf16* VTB = VTA + 64 * 72;
    LAS bf16* PP = VTB + 64 * 72;
    LAS float* DECA = (LAS float*)(PP + 64 * 72);
    LAS float* DECB = DECA + 128;
    const unsigned char* ws = a.ws;
    const bf16* EFb = (const bf16*)a.out; const bf16* EBb = EFb + (size_t)M * 512;
    const float* DECg = (const float*)(ws + WS_DEC);
    const bf16* Qb = (const bf16*)(ws + WS_S0 + 3 * SLOT); const bf16* Kb = Qb + (size_t)M * 512;
    const bf16* Vb = (const bf16*)(ws + WS_S0 + 4 * SLOT);
    bf16* OFb = (bf16*)(a.ws + WS_S0 + 2 * SLOT); bf16* OBb = (bf16*)(a.ws + WS_S0);
    const int ch = tid & 127, sub = __builtin_amdgcn_readfirstlane(tid >> 7);
    const int col = lane & 15, quad = lane >> 4, kt = wave;
    float* SG = a.out + (size_t)M * D + 16 * 2 * 1024;
    const int vcu = (gridDim.x % 8 == 0) ? (int)(blockIdx.x % 8) * (int)(gridDim.x / 8) + (int)(blockIdx.x / 8) : (int)blockIdx.x;
    for (int u = vcu; u < 768; u += gridDim.x) {
        const bool lat = u < 256; const int v = lat ? u : u - 256; const int b = v >> 5, hd = (v >> 3) & 3, dir = (v >> 2) & 1, sl = v & 3;
        const int row_base = lat ? MP + b * 2048 : b * 256, nch = lat ? 32 : 4, gc0 = lat ? 64 + b * 32 : b * 4;
        bf16* Ob = dir ? OBb : OFb; const bf16* Eb = dir ? EBb : EFb;
        f32x4 S[4];
#pragma unroll
        for (int vt = 0; vt < 4; ++vt)
#pragma unroll
            for (int j = 0; j < 4; ++j)
                S[vt][j] = lat ? a.in[3][((((size_t)(b * 2 + dir) * 4 + hd) * 128 + 16 * kt + quad * 4 + j) * 256) + sl * 64 + 16 * vt + col] : 0.f;
#define GROWP(p0_, i) ({ const int p_ = dir ? (p0_) + 63 - (i) : (p0_) + (i); lat ? row_base + (p_ & 31) * 64 + (p_ >> 5) : row_base + p_; })
        u32x4 QgA[2], KgA[2], EgA[2], VgA, QgB[2], KgB[2], EgB[2], VgB; f32x2 etgA, etgB;
#define GLA_FETCH(X, cn_) do { const int p0_ = (cn_) * 64; \
            _Pragma("unroll") for (int e_ = 0; e_ < 2; ++e_) { const int pc_ = tid + e_ * 512; const size_t ro_ = (size_t)GROWP(p0_, pc_ >> 4) * 512 + hd * 128 + (pc_ & 15) * 8; \
                Qg##X[e_] = *(const u32x4*)(Qb + ro_); Kg##X[e_] = *(const u32x4*)(Kb + ro_); Eg##X[e_] = *(const u32x4*)(Eb + ro_); } \
            Vg##X = *(const u32x4*)(Vb + (size_t)GROWP(p0_, tid & 63) * D + hd * 256 + sl * 64 + (tid >> 6) * 8); \
            etg##X = *(const f32x2*)(DECg + ((size_t)dir * 320 + gc0 + (cn_)) * 512 + hd * 128 + 2 * lane); } while (0)
#define GLA_CHUNK(X, n) do { const int cn = dir ? nch - 1 - (n) : (n), p0 = cn * 64; \
_Pragma("unroll") \
            for (int vt = 0; vt < 4; ++vt) { u32x2 w; w.x = pk2(S[vt][0], S[vt][1]); w.y = pk2(S[vt][2], S[vt][3]); \
                *(LAS u32x2*)(ST##X + (16 * vt + col) * 136 + 16 * kt + quad * 4) = w; } \
_Pragma("unroll") \
            for (int e = 0; e < 2; ++e) { const int pc = tid + e * 512, o_ = (pc >> 4) * 136 + (pc & 15) * 8; \
                  \
                const u32x4 qr = Qg##X[e], kr = Kg##X[e], er = Eg##X[e]; u32x4 qo, ko; \
_Pragma("unroll") \
                for (int d_ = 0; d_ < 4; ++d_) { const float E0 = bflo(er[d_]), E1 = bfhi(er[d_]); const float R0 = rcpf_(E0), R1 = rcpf_(E1); \
                    qo[d_] = pk2(bflo(qr[d_]) * E0 * 0.08838834764831845f, bfhi(qr[d_]) * E1 * 0.08838834764831845f); \
                    ko[d_] = pk2(bflo(kr[d_]) * R0, bfhi(kr[d_]) * R1); } \
                *(LAS u32x4*)(QE##X + o_) = qo; *(LAS u32x4*)(KE + o_) = ko; } \
            {   const int i = tid & 63, v8 = (tid >> 6) * 8; const u32x4 z = Vg##X; \
                VT##X[(v8 + 0) * 72 + i] = (bf16)(z.x & 0xffffu); VT##X[(v8 + 1) * 72 + i] = (bf16)(z.x >> 16); \
                VT##X[(v8 + 2) * 72 + i] = (bf16)(z.y & 0xffffu); VT##X[(v8 + 3) * 72 + i] = (bf16)(z.y >> 16); \
                VT##X[(v8 + 4) * 72 + i] = (bf16)(z.z & 0xffffu); VT##X[(v8 + 5) * 72 + i] = (bf16)(z.z >> 16); \
                VT##X[(v8 + 6) * 72 + i] = (bf16)(z.w & 0xffffu); VT##X[(v8 + 7) * 72 + i] = (bf16)(z.w >> 16); } \
            const f32x2 etot = etg##X; \
            if (wave == 0) *(LAS f32x2*)(DEC##X + 2 * lane) = etot; \
            __syncthreads(); \
            if ((n) + 2 < nch) GLA_FETCH(X, dir ? nch - 3 - (n) : (n) + 2); \
            {     \
                unsigned kw_[8]; \
_Pragma("unroll") \
                for (int e = 0; e < 8; ++e) kw_[e] = *(const LAS unsigned*)(KE + (wave * 8 + e) * 136 + 2 * lane); \
                u32x4 w0, w1; \
                w0.x = pk2(bflo(kw_[0]) * etot.x, bflo(kw_[1]) * etot.x); w0.y = pk2(bflo(kw_[2]) * etot.x, bflo(kw_[3]) * etot.x); w0.z = pk2(bflo(kw_[4]) * etot.x, bflo(kw_[5]) * etot.x); w0.w = pk2(bflo(kw_[6]) * etot.x, bflo(kw_[7]) * etot.x); \
                w1.x = pk2(bfhi(kw_[0]) * etot.y, bfhi(kw_[1]) * etot.y); w1.y = pk2(bfhi(kw_[2]) * etot.y, bfhi(kw_[3]) * etot.y); w1.z = pk2(bfhi(kw_[4]) * etot.y, bfhi(kw_[5]) * etot.y); w1.w = pk2(bfhi(kw_[6]) * etot.y, bfhi(kw_[7]) * etot.y); \
                *(LAS u32x4*)(KT + (2 * lane) * 72 + wave * 8) = w0; *(LAS u32x4*)(KT + (2 * lane + 1) * 72 + wave * 8) = w1; } \
              \
            {     \
                const int st = wave >> 1, ct0 = 2 * (wave & 1); \
                f32x4 acc0 = {0.f, 0.f, 0.f, 0.f}, acc1 = {0.f, 0.f, 0.f, 0.f}; \
                if (st <= ct0 + 1) { \
_Pragma("unroll") \
                    for (int kk = 0; kk < 4; ++kk) { const bf16x8 ak = *(const LAS bf16x8*)(KE + (16 * st + col) * 136 + kk * 32 + quad * 8); \
                        if (st <= ct0) { const bf16x8 bq0 = *(const LAS bf16x8*)(QE##X + (16 * ct0 + col) * 136 + kk * 32 + quad * 8); acc0 = __builtin_amdgcn_mfma_f32_16x16x32_bf16(ak, bq0, acc0, 0, 0, 0); } \
                        const bf16x8 bq1 = *(const LAS bf16x8*)(QE##X + (16 * (ct0 + 1) + col) * 136 + kk * 32 + quad * 8); acc1 = __builtin_amdgcn_mfma_f32_16x16x32_bf16(ak, bq1, acc1, 0, 0, 0); } \
                } \
_Pragma("unroll") \
                for (int j = 0; j < 4; ++j) { if (16 * st + quad * 4 + j > 16 * ct0 + col) acc0[j] = 0.f; if (16 * st + quad * 4 + j > 16 * (ct0 + 1) + col) acc1[j] = 0.f; } \
                u32x2 w0, w1; w0.x = pk2(acc0[0], acc0[1]); w0.y = pk2(acc0[2], acc0[3]); w1.x = pk2(acc1[0], acc1[1]); w1.y = pk2(acc1[2], acc1[3]); \
                *(LAS u32x2*)(PP + (16 * ct0 + col) * 72 + 16 * st + quad * 4) = w0; *(LAS u32x2*)(PP + (16 * (ct0 + 1) + col) * 72 + 16 * st + quad * 4) = w1; \
            } \
            __syncthreads(); \
            {     \
                const int vt_ = wave >> 1, ct0 = 2 * (wave & 1); \
                bf16x8 av[2], as_[4]; \
_Pragma("unroll") \
                for (int ks = 0; ks < 2; ++ks) av[ks] = *(const LAS bf16x8*)(VT##X + (16 * vt_ + col) * 72 + ks * 32 + quad * 8); \
_Pragma("unroll") \
                for (int kk = 0; kk < 4; ++kk) as_[kk] = *(const LAS bf16x8*)(ST##X + (16 * vt_ + col) * 136 + kk * 32 + quad * 8); \
                f32x4 acc0 = {0.f, 0.f, 0.f, 0.f}, acc1 = {0.f, 0.f, 0.f, 0.f}; \
_Pragma("unroll") \
                for (int ks = 0; ks < 2; ++ks) { const bf16x8 bp0 = *(const LAS bf16x8*)(PP + (16 * ct0 + col) * 72 + ks * 32 + quad * 8), bp1 = *(const LAS bf16x8*)(PP + (16 * (ct0 + 1) + col) * 72 + ks * 32 + quad * 8); \
                    acc0 = __builtin_amdgcn_mfma_f32_16x16x32_bf16(av[ks], bp0, acc0, 0, 0, 0); acc1 = __builtin_amdgcn_mfma_f32_16x16x32_bf16(av[ks], bp1, acc1, 0, 0, 0); } \
_Pragma("unroll") \
                for (int kk = 0; kk < 4; ++kk) { const bf16x8 bq0 = *(const LAS bf16x8*)(QE##X + (16 * ct0 + col) * 136 + kk * 32 + quad * 8), bq1 = *(const LAS bf16x8*)(QE##X + (16 * (ct0 + 1) + col) * 136 + kk * 32 + quad * 8); \
                    acc0 = __builtin_amdgcn_mfma_f32_16x16x32_bf16(as_[kk], bq0, acc0, 0, 0, 0); acc1 = __builtin_amdgcn_mfma_f32_16x16x32_bf16(as_[kk], bq1, acc1, 0, 0, 0); } \
                const int row0 = GROWP(p0, 16 * ct0 + col), row1 = GROWP(p0, 16 * (ct0 + 1) + col); \
                u32x2 w0, w1; w0.x = pk2(acc0[0], acc0[1]); w0.y = pk2(acc0[2], acc0[3]); w1.x = pk2(acc1[0], acc1[1]); w1.y = pk2(acc1[2], acc1[3]); \
                *(u32x2*)(Ob + (size_t)row0 * D + hd * 256 + sl * 64 + 16 * vt_ + quad * 4) = w0; *(u32x2*)(Ob + (size_t)row1 * D + hd * 256 + sl * 64 + 16 * vt_ + quad * 4) = w1; \
                bf16x8 ak[2]; \
_Pragma("unroll") \
                for (int ks = 0; ks < 2; ++ks) ak[ks] = *(const LAS bf16x8*)(KT + (16 * kt + col) * 72 + ks * 32 + quad * 8); \
                float dk[4]; \
_Pragma("unroll") \
                for (int j = 0; j < 4; ++j) dk[j] = DEC##X[16 * kt + quad * 4 + j]; \
_Pragma("unroll") \
                for (int vt = 0; vt < 4; ++vt) { \
_Pragma("unroll") \
                    for (int j = 0; j < 4; ++j) S[vt][j] *= dk[j]; \
_Pragma("unroll") \
                    for (int ks = 0; ks < 2; ++ks) { const bf16x8 bv = *(const LAS bf16x8*)(VT##X + (16 * vt + col) * 72 + ks * 32 + quad * 8); \
                        S[vt] = __builtin_amdgcn_mfma_f32_16x16x32_bf16(ak[ks], bv, S[vt], 0, 0, 0); } } \
            } \
        } while (0)
        GLA_FETCH(A, dir ? nch - 1 : 0); GLA_FETCH(B, dir ? nch - 2 : 1);
        for (int n = 0; n < nch; n += 2) { GLA_CHUNK(A, n); GLA_CHUNK(B, n + 1); }
#undef GLA_CHUNK
#undef GLA_FETCH
#undef GROWP
        if (!lat) {
#pragma unroll
            for (int vt = 0; vt < 4; ++vt)
#pragma unroll
                for (int j = 0; j < 4; ++j)
                    SG[((((size_t)(b * 2 + dir) * 4 + hd) * 128 + 16 * kt + quad * 4 + j) * 256) + sl * 64 + 16 * vt + col] = S[vt][j];
        }
    }
}

template <int MODE> __device__ __forceinline__ void ew_pass(bf16* dst, const bf16* a0, const bf16* b0, const bf16* a1, const bf16* b1, int tid) {
    const size_t nvec = (size_t)M * D / 8;
    for (size_t i = (size_t)blockIdx.x * 512 + tid; i < nvec; i += (size_t)gridDim.x * 512) {
        const u32x4 x0 = ((const u32x4*)a0)[i], y0 = ((const u32x4*)b0)[i], x1 = ((const u32x4*)a1)[i];
        u32x4 o;
        if (MODE == 0) {
#pragma unroll
            for (int e = 0; e < 4; ++e) o[e] = pk2((bflo(x0[e]) + bflo(x1[e])) * bflo(y0[e]), (bfhi(x0[e]) + bfhi(x1[e])) * bfhi(y0[e]));
        } else {
            const u32x4 y1 = ((const u32x4*)b1)[i];
#pragma unroll
            for (int e = 0; e < 4; ++e) o[e] = pk2(bflo(x0[e]) * bflo(y0[e]) + bflo(x1[e]) * bflo(y1[e]), bfhi(x0[e]) * bfhi(y0[e]) + bfhi(x1[e]) * bfhi(y1[e]));
        }
        ((u32x4*)dst)[i] = o;
    }
}
__device__ __forceinline__ void post_gla(const Args& a, int lane, int wave) {
    const bf16* OFb = (const bf16*)(a.ws + WS_S0 + 2 * SLOT); const bf16* OBb = (const bf16*)(a.ws + WS_S0);
    bf16* G = (bf16*)(a.ws + WS_S0 + 1 * SLOT);
    const f32x4 gn = *(const f32x4*)(a.in[20] + 4 * lane);
    const int stride = gridDim.x * 8; int m = blockIdx.x * 8 + wave;
    u32x2 cf[4], cb[4], cg[4];
    if (m < M) {
#pragma unroll
        for (int hh = 0; hh < 4; ++hh) { const size_t off = (size_t)m * D + hh * 256 + 4 * lane; cf[hh] = *(const u32x2*)(OFb + off); cb[hh] = *(const u32x2*)(OBb + off); cg[hh] = *(const u32x2*)(G + off); } }
    for (; m < M; m += stride) {
        u32x2 nf[4], nb[4], ng_[4]; const int mn = m + stride;
#pragma unroll
        for (int hh = 0; hh < 4; ++hh) { nf[hh] = cf[hh]; nb[hh] = cb[hh]; ng_[hh] = cg[hh]; }
        if (mn < M) {
#pragma unroll
            for (int hh = 0; hh < 4; ++hh) { const size_t off = (size_t)mn * D + hh * 256 + 4 * lane; nf[hh] = *(const u32x2*)(OFb + off); nb[hh] = *(const u32x2*)(OBb + off); ng_[hh] = *(const u32x2*)(G + off); } }
#pragma unroll
        for (int hh = 0; hh < 4; ++hh) { const size_t off = (size_t)m * D + hh * 256 + 4 * lane;
            const u32x2 f = cf[hh], bb = cb[hh], g = cg[hh];
            f32x4 o; o[0] = bflo(f.x) + bflo(bb.x); o[1] = bfhi(f.x) + bfhi(bb.x); o[2] = bflo(f.y) + bflo(bb.y); o[3] = bfhi(f.y) + bfhi(bb.y);
            const float ss = wave_sum((o[0] * o[0] + o[1] * o[1]) + (o[2] * o[2] + o[3] * o[3]));
            const float rstd = rsqrtf(ss * (1.f / 256.f) + EPS);
            u32x2 w; w.x = pk2(o[0] * rstd * gn[0] * siluf_(bflo(g.x)), o[1] * rstd * gn[1] * siluf_(bfhi(g.x))); w.y = pk2(o[2] * rstd * gn[2] * siluf_(bflo(g.y)), o[3] * rstd * gn[3] * siluf_(bfhi(g.y)));
            *(u32x2*)(G + off) = w; }
#pragma unroll
        for (int hh = 0; hh < 4; ++hh) { cf[hh] = nf[hh]; cb[hh] = nb[hh]; cg[hh] = ng_[hh]; }
    }
}
struct SplitRow { u32x2 o[4]; u32x2 p[3][4]; };
__device__ __forceinline__ void split_row_load(SplitRow& r, const bf16* O, const bf16* P, int m, int lane) {
#pragma unroll
    for (int q = 0; q < 4; ++q) r.o[q] = *(const u32x2*)(O + (size_t)m * D + 4 * (lane + 64 * q));
    if (m >= 16384) {
#pragma unroll
        for (int k = 0; k < 3; ++k)
#pragma unroll
            for (int q = 0; q < 4; ++q) r.p[k][q] = *(const u32x2*)(P + ((size_t)k * 4096 + (m - 16384)) * D + 4 * (lane + 64 * q)); }
}
__device__ __forceinline__ f32x4 split_row_val(const SplitRow& r, int m, int q) {
    f32x4 v; v[0] = bflo(r.o[q].x); v[1] = bfhi(r.o[q].x); v[2] = bflo(r.o[q].y); v[3] = bfhi(r.o[q].y);
    if (m >= 16384) {
#pragma unroll
        for (int k = 0; k < 3; ++k) { v[0] += bflo(r.p[k][q].x); v[1] += bfhi(r.p[k][q].x); v[2] += bflo(r.p[k][q].y); v[3] += bfhi(r.p[k][q].y); } }
    return v;
}
__device__ __forceinline__ void x1_pass(const Args& a, int lane, int wave) {
    const float* MOD = (const float*)(a.ws + WS_MOD); const float* ng = a.in[8];
    const bf16* Mm = (const bf16*)(a.ws + WS_S0 + 2 * SLOT); const bf16* Pm = (const bf16*)(a.ws + WS_S0 + 4 * SLOT); bf16* H2 = (bf16*)(a.ws + WS_S0);
    const int stride = gridDim.x * 8; int m = blockIdx.x * 8 + wave;
    SplitRow cur; f32x4 xc[4];
    if (m < M) { split_row_load(cur, Mm, Pm, m, lane); const f32x4* xr = (const f32x4*)xrow(a, m) + lane;
#pragma unroll
        for (int q = 0; q < 4; ++q) xc[q] = xr[64 * q]; }
    for (; m < M; m += stride) {
        SplitRow nxt = cur; f32x4 xn[4]; const int mn = m + stride;
#pragma unroll
        for (int q = 0; q < 4; ++q) xn[q] = xc[q];
        if (mn < M) { split_row_load(nxt, Mm, Pm, mn, lane); const f32x4* xr = (const f32x4*)xrow(a, mn) + lane;
#pragma unroll
            for (int q = 0; q < 4; ++q) xn[q] = xr[64 * q]; }
        const float* md = MOD + modgrp(m) * 6144;
        f32x4 mv[4]; float s1 = 0.f;
#pragma unroll
        for (int q = 0; q < 4; ++q) { mv[q] = split_row_val(cur, m, q); s1 += (mv[q][0] * mv[q][0] + mv[q][1] * mv[q][1]) + (mv[q][2] * mv[q][2] + mv[q][3] * mv[q][3]); }
        const float rstd1 = rsqrtf(wave_sum(s1) * (1.f / D) + EPS);
        f32x4 v[4]; float s = 0.f;
#pragma unroll
        for (int q = 0; q < 4; ++q) { const int c = 4 * (lane + 64 * q);
            const f32x4 g1 = *(const f32x4*)(md + 2048 + c), n1 = *(const f32x4*)(ng + 1024 + c);
            v[q] = xc[q] + g1 * (mv[q] * rstd1 * n1);
            *(f32x4*)(a.out + (size_t)m * D + c) = v[q];
            s += (v[q][0] * v[q][0] + v[q][1] * v[q][1]) + (v[q][2] * v[q][2] + v[q][3] * v[q][3]); }
        const float rstd = rsqrtf(wave_sum(s) * (1.f / D) + EPS);
#pragma unroll
        for (int q = 0; q < 4; ++q) { const int c = 4 * (lane + 64 * q);
            const f32x4 g = *(const f32x4*)(ng + 2048 + c), sh = *(const f32x4*)(md + 3072 + c), sc = *(const f32x4*)(md + 4096 + c);
            const f32x4 r = v[q] * rstd * g * (sc + 1.0f) + sh;
            u32x2 w; w.x = pk2(r[0], r[1]); w.y = pk2(r[2], r[3]); *(u32x2*)(H2 + (size_t)m * D + c) = w; }
        cur = nxt;
#pragma unroll
        for (int q = 0; q < 4; ++q) xc[q] = xn[q];
    }
}
__device__ __forceinline__ void fin_pass(const Args& a, int lane, int wave) {
    const float* MOD = (const float*)(a.ws + WS_MOD); const float* ng = a.in[8];
    const bf16* F = (const bf16*)(a.ws + WS_S0); const bf16* Pf = (const bf16*)(a.ws + WS_WL);
    const int stride = gridDim.x * 8; int m = blockIdx.x * 8 + wave;
    SplitRow cur; f32x4 yc[4];
    if (m < M) { split_row_load(cur, F, Pf, m, lane);
#pragma unroll
        for (int q = 0; q < 4; ++q) yc[q] = *(const f32x4*)(a.out + (size_t)m * D + 4 * (lane + 64 * q)); }
    for (; m < M; m += stride) {
        SplitRow nxt = cur; f32x4 yn[4]; const int mn = m + stride;
#pragma unroll
        for (int q = 0; q < 4; ++q) yn[q] = yc[q];
        if (mn < M) { split_row_load(nxt, F, Pf, mn, lane);
#pragma unroll
            for (int q = 0; q < 4; ++q) yn[q] = *(const f32x4*)(a.out + (size_t)mn * D + 4 * (lane + 64 * q)); }
        const float* md = MOD + modgrp(m) * 6144;
        f32x4 fv[4]; float s = 0.f;
#pragma unroll
        for (int q = 0; q < 4; ++q) { fv[q] = split_row_val(cur, m, q); s += (fv[q][0] * fv[q][0] + fv[q][1] * fv[q][1]) + (fv[q][2] * fv[q][2] + fv[q][3] * fv[q][3]); }
        const float rstd = rsqrtf(wave_sum(s) * (1.f / D) + EPS);
#pragma unroll
        for (int q = 0; q < 4; ++q) { const int c = 4 * (lane + 64 * q);
            const f32x4 g2 = *(const f32x4*)(md + 5120 + c), n3 = *(const f32x4*)(ng + 3072 + c);
            *(f32x4*)(a.out + (size_t)m * D + c) = yc[q] + g2 * (fv[q] * rstd * n3); }
        cur = nxt;
#pragma unroll
        for (int q = 0; q < 4; ++q) yc[q] = yn[q];
    }
}

constexpr int NPHASE = 14;
__global__ void __launch_bounds__(512, 2) mk_fwd(Args a) {
    extern __shared__ __attribute__((aligned(16))) unsigned char lds_raw[];
    LAS unsigned char* lds = (LAS unsigned char*)lds_raw;
    cg::grid_group grid = cg::this_grid();
    const int tid = threadIdx.x, lane = tid & 63, wave = __builtin_amdgcn_readfirstlane(tid >> 6);
    const int lo = a.ph_lo, hi = a.ph_hi, G = gridDim.x;
    volatile LAS unsigned* MISC = (volatile LAS unsigned*)(lds + LDS_BYTES - 64);
    if (tid < 16) MISC[tid] = 0u;
    __syncthreads();
    const XcdBarrier bar = xcd_barrier_post((unsigned*)(a.ws + WS_BAR), MISC);
    unsigned char* ws = a.ws;
    bf16* S0 = (bf16*)(ws + WS_S0); bf16* S1 = (bf16*)(ws + WS_S0 + SLOT); bf16* S2 = (bf16*)(ws + WS_S0 + 2 * SLOT);
    bf16* S3 = (bf16*)(ws + WS_S0 + 3 * SLOT); bf16* S4 = (bf16*)(ws + WS_S0 + 4 * SLOT);
    bf16* D0 = (bf16*)a.out; bf16* D1 = D0 + (size_t)M * D;
#ifndef MK_MASK
#define MK_MASK 0x3fff
#endif
#define IN(k) (((MK_MASK >> (k)) & 1) && lo <= (k) && (k) < hi)
#define SEAM(k) do { if (IN(k) && IN((k) + 1)) xcd_barrier(bar); } while (0)
    if (lo < 0) grid.sync();
    if (IN(0)) { phase0(a, lds, tid, lane, wave); } SEAM(0);
    if (IN(1)) { phase1(a, S0, lane, wave); } SEAM(1);
    if (IN(2)) {
        pg8::Gemm g{S0, (const bf16*)(ws + WS_WL), M, 5376, 1024, S0, S0, 1 << 30, 1 << 30, 1024}; pg8::StaticOrder S; S.init(M, 5376, G, (int)blockIdx.x);
        EpiLG E{D0, D1, (float*)(ws + WS_LR), S3, S3 + (size_t)M * 512, S4, S1};
        pg8::gemm_phase<EpiLG, pg8::StaticOrder, true, true>(lds, g, S, E);
    } SEAM(2);
    if (IN(3)) { lru_phase(a, lds, tid, lane, wave); } SEAM(3);
    if (IN(4)) {
        gla_prep(a, lds, tid, D1, S2, S0);
    } SEAM(4);
    if (IN(5)) { gla_phase(a, lds, tid, lane, wave); } SEAM(5);
    if (IN(6)) { post_gla(a, lane, wave); phase1(a, S3, lane, wave); } SEAM(6);
    if (IN(7)) {
        pg8::Gemm g{D1, (const bf16*)(ws + WS_WY) + (size_t)2048 * 1024, M, 2048, 1024, S1, S1, 4, 1 << 30, 1024}; pg8::StaticOrder S; S.init(M, 2048, G, (int)blockIdx.x);
        EpiYY E{S4, D0};
        pg8::gemm_phase<EpiYY, pg8::StaticOrder, true, true>(lds, g, S, E);
    } SEAM(7);
    if (IN(8)) {
        pg8::Gemm g{S3, (const bf16*)(ws + WS_WY), M, 2048, 1024, S3, S3, 1 << 30, 1 << 30, 1024}; pg8::StaticOrder S; S.init(M, 2048, G, (int)blockIdx.x);
        EpiMM E{S4, D0, S0};
        pg8::gemm_phase<EpiMM, pg8::StaticOrder, true, true>(lds, g, S, E);
    } SEAM(8);
    if (IN(9)) {
        { pg8::Gemm g{S0, (const bf16*)(ws + WS_WO), 16384, 1024, 1024, S0, S0, 1 << 30, 1 << 30, 1024}; pg8::StaticOrder S; S.init(16384, 1024, G, (int)blockIdx.x);
          EpiS E{S2, S4, 64}; pg8::gemm_phase<EpiS, pg8::StaticOrder, true, true>(lds, g, S, E); }
        { pg8::Gemm g{S0, (const bf16*)(ws + WS_WO), M, 1024, 256, S0, S0, 1 << 30, 1 << 30, 1024}; SplitOrder S{64, G, (int)blockIdx.x};
          EpiS E{S2, S4, 64}; pg8::gemm_phase<EpiS, SplitOrder, true, true>(lds, g, S, E); }
    } SEAM(9);
    if (IN(10)) { x1_pass(a, lane, wave); } SEAM(10);
    if (IN(11)) {
        pg8::Gemm g{S0, (const bf16*)(ws + WS_W1), M, 4096, 1024, S0, S0, 1 << 30, 1 << 30, 1024}; pg8::StaticOrder S; S.init(M, 4096, G, (int)blockIdx.x);
        EpiH E{S1};
        pg8::gemm_phase<EpiH, pg8::StaticOrder, true, true>(lds, g, S, E);
    } SEAM(11);
    if (IN(12)) {
        { pg8::Gemm g{S1, (const bf16*)(ws + WS_W2), 16384, 1024, 4096, S1, S1, 1 << 30, 1 << 30, 4096}; pg8::StaticOrder S; S.init(16384, 1024, G, (int)blockIdx.x);
          EpiS E{S0, (bf16*)(ws + WS_WL), 64}; pg8::gemm_phase<EpiS, pg8::StaticOrder, true, true>(lds, g, S, E); }
        { pg8::Gemm g{S1, (const bf16*)(ws + WS_W2), M, 1024, 1024, S1, S1, 1 << 30, 1 << 30, 4096}; SplitOrder S{64, G, (int)blockIdx.x};
          EpiS E{S0, (bf16*)(ws + WS_WL), 64}; pg8::gemm_phase<EpiS, SplitOrder, true, true>(lds, g, S, E); }
    } SEAM(12);
    if (IN(13)) { fin_pass(a, lane, wave); }
#undef IN
#undef SEAM
}

extern "C" void kernel_launch(void* const* d_in, const int* in_sizes, int n_in, void* d_out, int out_size, void* d_ws, size_t ws_size, hipStream_t stream) {
    static int grid = 0;
    if (grid == 0) {
        if (n_in != 25 || ws_size < WS_END) { fprintf(stderr, "kernel_launch: unexpected n_in %d / ws %zu\n", n_in, ws_size); grid = -1; return; }
        int dev = 0, cus = 0, per_cu = 0;
        hipGetDevice(&dev); hipDeviceGetAttribute(&cus, hipDeviceAttributeMultiprocessorCount, dev);
        if (hipFuncSetAttribute((const void*)mk_fwd, hipFuncAttributeMaxDynamicSharedMemorySize, LDS_BYTES) != hipSuccess) { fprintf(stderr, "kernel_launch: hipFuncSetAttribute failed\n"); grid = -1; return; }
        if (hipOccupancyMaxActiveBlocksPerMultiprocessor(&per_cu, (const void*)mk_fwd, 512, LDS_BYTES) != hipSuccess || per_cu < 1) { fprintf(stderr, "kernel_launch: occupancy query says %d\n", per_cu); per_cu = 1; }
        (void)hipGetLastError();
        grid = cus * 1;
    }
    if (grid < 0) return;
    if (hipMemsetAsync((char*)d_ws + WS_BAR, 0, WS_BAR_BYTES, stream) != hipSuccess) { fprintf(stderr, "kernel_launch: memset failed\n"); return; }
    Args a{};
    for (int i = 0; i < 25; ++i) a.in[i] = (const float*)d_in[i];
    a.out = (float*)d_out; a.ws = (unsigned char*)d_ws;
    constexpr int NL = MK_N_LAUNCHES;
    for (int li = 0; li < NL; ++li) {
        a.ph_lo = (NL == 1) ? 0 : li; a.ph_hi = (NL == 1) ? NPHASE : li + 1;
        void* args[] = {&a};
        hipError_t e = hipLaunchCooperativeKernel((const void*)mk_fwd, dim3(grid), dim3(512), args, LDS_BYTES, stream);
        if (e != hipSuccess) { fprintf(stderr, "kernel_launch: cooperative launch %d failed: %s\n", li, hipGetErrorString(e)); break; }
    }
}
```

```cpp
#include <hip/hip_runtime.h>
#include <hip/hip_cooperative_groups.h>
#include <cstdio>
#include <cstdint>
namespace cg = cooperative_groups;
namespace pg8 {
#define PG8_LAS __attribute__((address_space(3)))
typedef unsigned short bf16_t;
typedef short bf16x8 __attribute__((ext_vector_type(8)));
typedef float f32x4 __attribute__((ext_vector_type(4)));
typedef unsigned u32x4 __attribute__((ext_vector_type(4)));
constexpr int BM = 256, BK = 64, HALF = 128, HTB = HALF * BK * 2  , STAGE_BYTES = 8 * HTB, NXCD = 8, WGM = 8;

__host__ __device__ __forceinline__ int lds_byte(int r, int c) { const int st = (r >> 4) * 2 + (c >> 5), rr = r & 15, cc = c & 31, ob = rr * 64 + cc * 2; return st * 1024 + (ob ^ (((ob >> 9) & 1) << 5)); }
__host__ __device__ __forceinline__ void stage_rc(int b, int& R, int& C) { const int st = b / 1024, sb = b % 1024, swz = sb ^ (((sb >> 9) & 1) << 5); R = (st >> 1) * 16 + swz / 64; C = (st & 1) * 32 + (swz % 64) / 2; }
__host__ __device__ __forceinline__ int perm32(int rho) { const int n = rho >> 4, i = rho & 15; return 8 * (i >> 2) + 4 * n + (i & 3); }

struct Unit { int pm, pn, kq; };
struct Gemm { const bf16_t* A; const bf16_t* Bt; int M, N, K; const bf16_t* A1; const bf16_t* A2; int pn1, pn2; int ld;
    __device__ __forceinline__ const char* abase(int pn) const { return (const char*)(pn < pn1 ? A : (pn < pn2 ? A1 : A2)); } };

struct StaticOrder {
    int nM, nN, nwg, G, c;
    __host__ __device__ void init(int M, int N, int G_, int c_) { nM = M / BM; nN = N / BM; nwg = nM * nN; G = G_; c = c_; }
    __host__ __device__ bool next(int i, Unit& u) const {
        const long L = (long)i * G + c; if (L >= nwg) return false;
        int wgid = (int)L; { const int q = nwg / NXCD, r = nwg % NXCD, xcd = wgid % NXCD, off = wgid / NXCD; wgid = (xcd < r ? xcd * (q + 1) : r * (q + 1) + (xcd - r) * q) + off; }
        const int nig = WGM * nN, gid = wgid / nig, fm = gid * WGM, gsz = (nM - fm) < WGM ? (nM - fm) : WGM;
        u.pm = fm + ((wgid % nig) % gsz); u.pn = (wgid % nig) / gsz; u.kq = 0; return true;
    }
    __device__ __forceinline__ void a_ready(const Unit&) const {}
    __device__ __forceinline__ void done(const Unit&) const {}
};

typedef float f32x2 __attribute__((ext_vector_type(2)));
typedef __bf16 bf16x2_t __attribute__((ext_vector_type(2)));
__device__ __forceinline__ unsigned cvt_pk_bf16(float lo, float hi) { const f32x2 v = {lo, hi}; return __builtin_bit_cast(unsigned, __builtin_convertvector(v, bf16x2_t)); }
template <class Epi, class Sched, bool ALIGN_EPI = false, bool SP2 = false>
__device__ __forceinline__ void gemm_phase(PG8_LAS unsigned char* lds, const Gemm g, const Sched& S, const Epi& E) {
    const int tid = threadIdx.x, wid = __builtin_amdgcn_readfirstlane(tid >> 6), lane = tid & 63, wr = wid >> 2, wc = wid & 3, fr = lane & 15, fq = lane >> 4;
    const int K = g.K, nt = K / BK;
    unsigned voffA[2], voffB[2];
#pragma unroll
    for (int i = 0; i < 2; ++i) { int R, C; stage_rc(tid * 16 + i * 8192, R, C); const int Rb = Epi::PERM ? ((R & ~31) + perm32(R & 31)) : R;
        voffA[i] = (unsigned)(R * g.ld + C) * 2u; voffB[i] = (unsigned)(Rb * g.ld + C) * 2u; }
    const size_t kstep = (size_t)(BK * 2);
    const size_t hstep = (size_t)HALF * g.ld * 2;
    const size_t tstep = 2 * hstep;
    const unsigned ldsw = (unsigned)wid * 1024u;
    const int aoff = lds_byte(wr * 64 + fr, fq * 8), boff = lds_byte(wc * 32 + fr, fq * 8);
#define PG8_SA(b, h) (((b) * 2 + (h)) * HTB)
#define PG8_SB(b, h) ((4 + (b) * 2 + (h)) * HTB)
#define PG8_STAGE(bufoff, gbase, voff) do { _Pragma("unroll") for (int _i = 0; _i < 2; ++_i) \
        __builtin_amdgcn_global_load_lds((const unsigned*)((const char*)(gbase) + (voff)[_i]), (PG8_LAS unsigned*)(lds + (bufoff) + ldsw + _i * 8192), 16, 0, 0); } while (0)
#define PG8_LDA(dst, b, h) do { _Pragma("unroll") for (int m = 0; m < 4; ++m) _Pragma("unroll") for (int k = 0; k < 2; ++k) dst[m][k] = *(const PG8_LAS bf16x8*)(lds + PG8_SA(b, h) + aoff + m * 2048 + k * 1024); } while (0)
#define PG8_LDB(dst, b, h) do { _Pragma("unroll") for (int n = 0; n < 2; ++n) _Pragma("unroll") for (int k = 0; k < 2; ++k) dst[n][k] = *(const PG8_LAS bf16x8*)(lds + PG8_SB(b, h) + boff + n * 2048 + k * 1024); } while (0)
#define PG8_MMA(ai, bj, At, Bt) do { __builtin_amdgcn_s_setprio(1); _Pragma("unroll") for (int m = 0; m < 4; ++m) _Pragma("unroll") for (int n = 0; n < 2; ++n) _Pragma("unroll") for (int k = 0; k < 2; ++k) \
        acc[ai][bj][m][n] = __builtin_amdgcn_mfma_f32_16x16x32_bf16(Bt[n][k], At[m][k], acc[ai][bj][m][n], 0, 0, 0); __builtin_amdgcn_s_setprio(0); } while (0)
#define PG8_WAIT_V(n) asm volatile("s_waitcnt vmcnt(" #n ")" ::: "memory")
#define PG8_WAIT_L(n) asm volatile("s_waitcnt lgkmcnt(" #n ")" ::: "memory")
#define PG8_BAR __builtin_amdgcn_s_barrier()
#define PG8_SCHED __builtin_amdgcn_sched_barrier(0)
    Unit cur, nxt; int ui = 0;
    if (!S.next(0, cur)) return;
    f32x4 acc[2][2][4][2];
#pragma unroll
    for (int a = 0; a < 2; ++a)
#pragma unroll
        for (int b = 0; b < 2; ++b)
#pragma unroll
            for (int m = 0; m < 4; ++m)
#pragma unroll
                for (int n = 0; n < 2; ++n) acc[a][b][m][n] = (f32x4){0.f, 0.f, 0.f, 0.f};
    bf16x8 At[4][2], B0[2][2], B1[2][2];
    const size_t qstep = (size_t)K * 2;
    const char* cA = g.abase(cur.pn) + (size_t)cur.pm * tstep + (size_t)cur.kq * qstep; const char* cB = (const char*)g.Bt + (size_t)cur.pn * tstep + (size_t)cur.kq * qstep;
    S.a_ready(cur);
    if constexpr (SP2) {
        PG8_STAGE(PG8_SB(0, 0), cB, voffB); PG8_STAGE(PG8_SB(0, 1), cB + hstep, voffB); PG8_STAGE(PG8_SA(0, 0), cA, voffA); PG8_STAGE(PG8_SA(0, 1), cA + hstep, voffA);
        if (wr == 1) PG8_BAR;
        PG8_WAIT_V(2); PG8_BAR;
        PG8_STAGE(PG8_SB(1, 0), cB + kstep, voffB); PG8_STAGE(PG8_SA(1, 0), cA + kstep, voffA); PG8_STAGE(PG8_SB(1, 1), cB + hstep + kstep, voffB);
        PG8_WAIT_V(6); PG8_BAR;
    } else {
        PG8_STAGE(PG8_SB(0, 0), cB, voffB); PG8_STAGE(PG8_SA(0, 0), cA, voffA); PG8_STAGE(PG8_SB(0, 1), cB + hstep, voffB); PG8_STAGE(PG8_SA(0, 1), cA + hstep, voffA);
        if (wr == 1) PG8_BAR;
        PG8_WAIT_V(4); PG8_BAR;
        PG8_STAGE(PG8_SB(1, 0), cB + kstep, voffB); PG8_STAGE(PG8_SA(1, 0), cA + kstep, voffA); PG8_STAGE(PG8_SB(1, 1), cB + hstep + kstep, voffB);
        PG8_WAIT_V(6); PG8_BAR;
    }
    for (;;) {
        const bool has_next = S.next(ui + 1, nxt);
        const char* nA = has_next ? g.abase(nxt.pn) + (size_t)nxt.pm * tstep + (size_t)nxt.kq * qstep : cA; const char* nB = has_next ? (const char*)g.Bt + (size_t)nxt.pn * tstep + (size_t)nxt.kq * qstep : cB;
        for (int t = 0; t < nt; t += 2) {
            const bool last = (t == nt - 2);
            const char* a1 = cA + (size_t)(t + 1) * kstep;
            const char* a2 = last ? nA : cA + (size_t)(t + 2) * kstep; const char* b2 = last ? nB : cB + (size_t)(t + 2) * kstep;
            const char* a3 = a2 + kstep; const char* b3 = b2 + kstep;
            if (last && has_next) S.a_ready(nxt);
            if constexpr (SP2) {
            PG8_LDB(B0, 0, 0); PG8_LDB(B1, 0, 1); PG8_SCHED; PG8_LDA(At, 0, 0); PG8_STAGE(PG8_SA(1, 1), a1 + hstep, voffA);
            PG8_WAIT_V(8); PG8_WAIT_L(0); PG8_BAR; PG8_MMA(0, 0, At, B0); PG8_MMA(0, 1, At, B1); PG8_BAR; PG8_SCHED;
            PG8_LDA(At, 0, 1); PG8_STAGE(PG8_SB(0, 0), b2, voffB); PG8_STAGE(PG8_SB(0, 1), b2 + hstep, voffB); PG8_STAGE(PG8_SA(0, 0), a2, voffA);
            PG8_WAIT_V(8); PG8_WAIT_L(0); PG8_BAR; PG8_MMA(1, 0, At, B0); PG8_MMA(1, 1, At, B1); PG8_BAR; PG8_SCHED;
            PG8_LDB(B0, 1, 0); PG8_LDB(B1, 1, 1); PG8_SCHED; PG8_LDA(At, 1, 0); PG8_STAGE(PG8_SA(0, 1), a2 + hstep, voffA);
            PG8_WAIT_V(8); PG8_WAIT_L(0); PG8_BAR; PG8_MMA(0, 0, At, B0); PG8_MMA(0, 1, At, B1); PG8_BAR; PG8_SCHED;
            PG8_LDA(At, 1, 1); PG8_STAGE(PG8_SB(1, 0), b3, voffB); PG8_STAGE(PG8_SB(1, 1), b3 + hstep, voffB); PG8_STAGE(PG8_SA(1, 0), a3, voffA);
            PG8_WAIT_V(8); PG8_WAIT_L(0); PG8_BAR; PG8_MMA(1, 0, At, B0); PG8_MMA(1, 1, At, B1); PG8_BAR; PG8_SCHED;
            } else {
            PG8_LDB(B0, 0, 0); PG8_SCHED; PG8_LDA(At, 0, 0); PG8_STAGE(PG8_SA(1, 1), a1 + hstep, voffA);
            PG8_WAIT_L(8); PG8_BAR; PG8_WAIT_L(0); PG8_MMA(0, 0, At, B0); PG8_BAR; PG8_SCHED;
            PG8_LDB(B1, 0, 1); PG8_STAGE(PG8_SB(0, 0), b2, voffB);
            PG8_BAR; PG8_WAIT_L(0); PG8_MMA(0, 1, At, B1); PG8_BAR;
            PG8_LDA(At, 0, 1); PG8_STAGE(PG8_SA(0, 0), a2, voffA);
            PG8_BAR; PG8_WAIT_L(0); PG8_MMA(1, 0, At, B0); PG8_BAR; PG8_SCHED;
            PG8_STAGE(PG8_SB(0, 1), b2 + hstep, voffB);
            PG8_WAIT_V(6); PG8_BAR; PG8_MMA(1, 1, At, B1); PG8_BAR;
            PG8_LDB(B0, 1, 0); PG8_SCHED; PG8_LDA(At, 1, 0); PG8_STAGE(PG8_SA(0, 1), a2 + hstep, voffA);
            PG8_WAIT_L(8); PG8_BAR; PG8_WAIT_L(0); PG8_MMA(0, 0, At, B0); PG8_BAR; PG8_SCHED;
            PG8_LDB(B1, 1, 1); PG8_STAGE(PG8_SB(1, 0), b3, voffB);
            PG8_BAR; PG8_WAIT_L(0); PG8_MMA(0, 1, At, B1); PG8_BAR;
            PG8_LDA(At, 1, 1); PG8_STAGE(PG8_SA(1, 0), a3, voffA);
            PG8_BAR; PG8_WAIT_L(0); PG8_MMA(1, 0, At, B0); PG8_BAR; PG8_SCHED;
            PG8_STAGE(PG8_SB(1, 1), b3 + hstep, voffB);
            PG8_WAIT_V(6); PG8_BAR; PG8_MMA(1, 1, At, B1); PG8_BAR;
            }
        }
        if constexpr (ALIGN_EPI) { if (wr == 0) PG8_BAR; }
        if constexpr (!Epi::AFTER_DRAIN) { E(acc, cur, wr, wc, fr, fq); S.done(cur); }
        if (!has_next) break;
#pragma unroll
        for (int a = 0; a < 2; ++a)
#pragma unroll
            for (int b = 0; b < 2; ++b)
#pragma unroll
                for (int m = 0; m < 4; ++m)
#pragma unroll
                    for (int n = 0; n < 2; ++n) acc[a][b][m][n] = (f32x4){0.f, 0.f, 0.f, 0.f};
        cur = nxt; cA = nA; cB = nB; ++ui;
        if constexpr (ALIGN_EPI) { if (wr == 1) PG8_BAR; }
    }
    PG8_WAIT_V(0);
    if constexpr (!ALIGN_EPI) { if (wr == 0) PG8_BAR; }
    PG8_BAR;
    if constexpr (Epi::AFTER_DRAIN) { E.fused(acc, cur, wr, wc, fr, fq, lds, wid, lane); S.done(cur); }
#undef PG8_SA
#undef PG8_SB
#undef PG8_STAGE
#undef PG8_LDA
#undef PG8_LDB
#undef PG8_MMA
#undef PG8_WAIT_V
#undef PG8_WAIT_L
#undef PG8_BAR
#undef PG8_SCHED
}
}

#ifndef MK_N_LAUNCHES
#define MK_N_LAUNCHES 1
#endif
#define LAS __attribute__((address_space(3)))
typedef unsigned short bf16;
typedef float f32x4 __attribute__((ext_vector_type(4)));
typedef float f32x2 __attribute__((ext_vector_type(2)));
typedef unsigned u32x4 __attribute__((ext_vector_type(4)));
typedef unsigned u32x2 __attribute__((ext_vector_type(2)));
typedef short bf16x8 __attribute__((ext_vector_type(8)));

constexpr int D = 1024, MP = 4096, ML = 16384, M = MP + ML, NIN = 7200, DFF = 4096;
constexpr float EPS = 1e-6f;
constexpr size_t MiB = 1u << 20;
constexpr size_t WS_MOD = 0;
constexpr size_t WS_BAR = 512 * 1024, WS_BAR_BYTES = 16384;
constexpr size_t WS_SSQ1 = 1 * MiB;
constexpr size_t WS_SSQ2 = 2560 * 1024;
constexpr size_t WS_LR = 4 * MiB;
constexpr size_t WS_WL = 8 * MiB;
constexpr size_t WS_WG = WS_WL + (size_t)2304 * 1024 * 2;
constexpr size_t WS_WY = WS_WG + (size_t)3072 * 1024 * 2;
constexpr size_t WS_WO = WS_WY + (size_t)4096 * 1024 * 2;
constexpr size_t WS_W1 = WS_WO + (size_t)1024 * 1024 * 2;
constexpr size_t WS_W2 = WS_W1 + (size_t)4096 * 1024 * 2;
constexpr size_t WS_S0 = 48 * MiB, SLOT = 40 * MiB;
static_assert(WS_W2 + (size_t)1024 * 4096 * 2 <= WS_S0, "ws map");
constexpr size_t WS_END = WS_S0 + 5 * SLOT;
constexpr int LDS_BYTES = 147456;

struct Args { const float* in[25]; float* out; unsigned char* ws; int ph_lo, ph_hi; };

__device__ __forceinline__ float bf2f(unsigned v) { return __uint_as_float(v << 16); }
__device__ __forceinline__ float bflo(unsigned w) { return __uint_as_float(w << 16); }
__device__ __forceinline__ float bfhi(unsigned w) { return __uint_as_float(w & 0xffff0000u); }
__device__ __forceinline__ unsigned pk2(float lo, float hi) { return pg8::cvt_pk_bf16(lo, hi); }
__device__ __forceinline__ float wave_sum(float v) {
#pragma unroll
    for (int o = 1; o < 64; o <<= 1) v += __shfl_xor(v, o);
    return v;
}
__device__ __forceinline__ float rcpf_(float x) { return __builtin_amdgcn_rcpf(x); }
__device__ __forceinline__ float expf_(float x) { return __builtin_amdgcn_exp2f(x * 1.4426950408889634f); }
__device__ __forceinline__ float logf_(float x) { return __builtin_amdgcn_logf(x) * 0.6931471805599453f; }
__device__ __forceinline__ float sigmoidf_(float x) { return rcpf_(1.0f + expf_(-x)); }
__device__ __forceinline__ float siluf_(float x) { return x * sigmoidf_(x); }
__device__ __forceinline__ float gelu_tanh(float x) { const float t = x * (1.5957691216f + 0.0713548163f * x * x); return x * rcpf_(1.0f + expf_(-t)); }
template <int ACT> __device__ __forceinline__ float actf(float x) {
    if (ACT == 1) return gelu_tanh(x);
    if (ACT == 2) return siluf_(x);
    if (ACT == 3) return sigmoidf_(x);
    if (ACT == 4) { const float m = fmaxf(x, 0.f); return m * m; }
    return x;
}
#define LDS_WAIT() asm volatile("s_waitcnt lgkmcnt(0)" ::: "memory")

#define XB_TMO      128
#define XB_XCNT(j)  (256  + 64 * (j))
#define XB_XSUB(j)  (1280 + 64 * (j))
#define XB_XGEN(j)  (2304 + 64 * (j))
#define XB_TOP      3328
#define XB_TOPGEN   3392
#define XCD_BAR_WORDS 3456
#define XB_SPIN_CAP (1u << 18)

__device__ __forceinline__ unsigned xb_ld(unsigned* p)              { return __hip_atomic_load(p, __ATOMIC_RELAXED, __HIP_MEMORY_SCOPE_AGENT); }
__device__ __forceinline__ unsigned xb_add(unsigned* p, unsigned v) { return __hip_atomic_fetch_add(p, v, __ATOMIC_RELAXED, __HIP_MEMORY_SCOPE_AGENT); }
__device__ __forceinline__ unsigned xb_xcc_id() { return (unsigned)__builtin_amdgcn_s_getreg((3 << 11) | 20) & 0xFu; }
#define XB_SPIN(cond, bar) do { unsigned _sp = 0; while (cond) { __builtin_amdgcn_s_sleep(1); \
    if ((++_sp & 255u) == 0u) { if (xb_ld(&(bar)[XB_TMO])) break; if (_sp > XB_SPIN_CAP) { atomicAdd(&(bar)[XB_TMO], 1u); break; } } } } while (0)

struct XcdBarrier {
    unsigned* bar; unsigned x;
    volatile LAS unsigned* st;
};

__device__ __forceinline__ XcdBarrier xcd_barrier_post(unsigned* bar, volatile LAS unsigned* st) {
    XcdBarrier b; b.bar = bar; b.x = xb_xcc_id(); b.st = st;
    if (threadIdx.x == 0) (void)xb_add(&bar[XB_XCNT(b.x)], 1u);
    return b;
}
__device__ __forceinline__ void xcd_barrier_complete(unsigned* bar, unsigned x, unsigned& nloc, unsigned& nx) {
    const unsigned G = gridDim.x * gridDim.y * gridDim.z;
    unsigned sum, cnt, mine, sp = 0u;
    for (;;) {
        sum = 0u; cnt = 0u; mine = 0u;
#pragma unroll
        for (unsigned j = 0; j < 16; ++j) { const unsigned c = xb_ld(&bar[XB_XCNT(j)]); sum += c; cnt += (c > 0u) ? 1u : 0u; mine = (j == x) ? c : mine; }
        if (sum == G) break;
        __builtin_amdgcn_s_sleep(1);
        if ((++sp & 255u) == 0u) { if (xb_ld(&bar[XB_TMO])) break; if (sp > XB_SPIN_CAP) { atomicAdd(&bar[XB_TMO], 1u); break; } }
    }
    nloc = mine > 0u ? mine : 1u; nx = cnt > 0u ? cnt : 1u;
}

__device__ __forceinline__ void xcd_barrier(const XcdBarrier& b) {
    asm volatile("s_waitcnt vmcnt(0)" ::: "memory");
    __syncthreads();
    if (threadIdx.x == 0) {
        unsigned* bar = b.bar;
        __builtin_amdgcn_s_waitcnt(0);
        unsigned nloc = b.st[0], nx = b.st[1];
        if (nloc == 0u) { xcd_barrier_complete(bar, b.x, nloc, nx); b.st[0] = nloc; b.st[1] = nx; }
        const unsigned old = xb_add(&bar[XB_XSUB(b.x)], 1u);
        const unsigned gen = old / nloc;
        if (old + 1u == (gen + 1u) * nloc) {
            __builtin_amdgcn_fence(__ATOMIC_RELEASE, "agent");
            asm volatile("s_waitcnt vmcnt(0)" ::: "memory");
            const unsigned og = xb_add(&bar[XB_TOP], 1u);
            const unsigned tg = og / nx;
            if (og + 1u == (tg + 1u) * nx) xb_add(&bar[XB_TOPGEN], 1u);
            else XB_SPIN(xb_ld(&bar[XB_TOPGEN]) == tg, bar);
            __builtin_amdgcn_fence(__ATOMIC_ACQUIRE, "agent");
            xb_add(&bar[XB_XGEN(b.x)], 1u);
            asm volatile("s_waitcnt vmcnt(0)" ::: "memory");
        } else {
            XB_SPIN(xb_ld(&bar[XB_XGEN(b.x)]) == gen, bar);
            __builtin_amdgcn_fence(__ATOMIC_ACQUIRE, "agent");
            asm volatile("s_waitcnt vmcnt(0)" ::: "memory");
        }
    }
    __syncthreads();
}

template <int ACT> __device__ __forceinline__ void store_tile(const f32x4 (&acc)[2][2][4][2], bf16* base, int ld, int row0, int col0) {
#pragma unroll
    for (int ai = 0; ai < 2; ++ai)
#pragma unroll
        for (int m = 0; m < 4; ++m) { bf16* rowp = base + (size_t)(row0 + ai * 128 + m * 16) * ld + col0;
#pragma unroll
            for (int bj = 0; bj < 2; ++bj) { const f32x4 v0 = acc[ai][bj][m][0], v1 = acc[ai][bj][m][1];
                u32x4 w; w.x = pk2(actf<ACT>(v0[0]), actf<ACT>(v0[1])); w.y = pk2(actf<ACT>(v0[2]), actf<ACT>(v0[3]));
                w.z = pk2(actf<ACT>(v1[0]), actf<ACT>(v1[1])); w.w = pk2(actf<ACT>(v1[2]), actf<ACT>(v1[3]));
                *(u32x4*)(rowp + bj * 128) = w; } }
}
struct EpiLG {
    static constexpr bool PERM = true, AFTER_DRAIN = false;
    bf16* ZX; bf16* ZG; float* LR; bf16* Q; bf16* K; bf16* V; bf16* G;
    __device__ __forceinline__ void operator()(const f32x4 (&acc)[2][2][4][2], const pg8::Unit& u, int wr, int wc, int fr, int fq) const {
        const int row0 = u.pm * 256 + wr * 64 + fr, cw = wc * 32 + 8 * fq;
        if (u.pn < 4) store_tile<0>(acc, ZX, D, row0, u.pn * 256 + cw);
        else if (u.pn < 8) store_tile<1>(acc, ZG, D, row0, (u.pn - 4) * 256 + cw);
        else if (u.pn == 8) { if (wc == 0) {
#pragma unroll
            for (int ai = 0; ai < 2; ++ai)
#pragma unroll
                for (int m = 0; m < 4; ++m) { float* rp = LR + (size_t)(row0 + ai * 128 + m * 16) * 32 + 8 * fq;
                    *(f32x4*)rp = acc[ai][0][m][0]; *(f32x4*)(rp + 4) = acc[ai][0][m][1]; } } }
        else if (u.pn < 11) store_tile<0>(acc, Q, 512, row0, (u.pn - 9) * 256 + cw);
        else if (u.pn < 13) store_tile<0>(acc, K, 512, row0, (u.pn - 11) * 256 + cw);
        else if (u.pn < 17) store_tile<0>(acc, V, D, row0, (u.pn - 13) * 256 + cw);
        else store_tile<0>(acc, G, D, row0, (u.pn - 17) * 256 + cw);
    }
};
struct EpiYY {
    static constexpr bool PERM = true, AFTER_DRAIN = false;
    bf16* YA; bf16* YB;
    __device__ __forceinline__ void operator()(const f32x4 (&acc)[2][2][4][2], const pg8::Unit& u, int wr, int wc, int fr, int fq) const {
        store_tile<0>(acc, u.pn < 4 ? YA : YB, D, u.pm * 256 + wr * 64 + fr, (u.pn & 3) * 256 + wc * 32 + 8 * fq);
    }
};
struct EpiMM {
    static constexpr bool PERM = true, AFTER_DRAIN = false;
    const bf16* YA; const bf16* YB; bf16* MM;
    __device__ __forceinline__ void operator()(const f32x4 (&acc)[2][2][4][2], const pg8::Unit& u, int wr, int wc, int fr, int fq) const {
        const int row0 = u.pm * 256 + wr * 64 + fr, c0 = u.pn * 128 + wc * 32 + 8 * fq;
#pragma unroll
        for (int ai = 0; ai < 2; ++ai)
#pragma unroll
            for (int m = 0; m < 4; ++m) { const size_t off = (size_t)(row0 + ai * 128 + m * 16) * D + c0;
                const u32x4 ya = *(const u32x4*)(YA + off), yb = *(const u32x4*)(YB + off);
                const f32x4 a0 = acc[ai][0][m][0], a1 = acc[ai][0][m][1], b0 = acc[ai][1][m][0], b1 = acc[ai][1][m][1];
#define MMV(av, bv, yv, zv) ({ const float ea_ = 1.0f + expf_(-(av)), eb_ = 1.0f + expf_(-(bv)); ((yv) * eb_ + (zv) * ea_) * rcpf_(ea_ * eb_); })
                u32x4 w;
                w.x = pk2(MMV(a0[0], b0[0], bflo(ya.x), bflo(yb.x)), MMV(a0[1], b0[1], bfhi(ya.x), bfhi(yb.x)));
                w.y = pk2(MMV(a0[2], b0[2], bflo(ya.y), bflo(yb.y)), MMV(a0[3], b0[3], bfhi(ya.y), bfhi(yb.y)));
                w.z = pk2(MMV(a1[0], b1[0], bflo(ya.z), bflo(yb.z)), MMV(a1[1], b1[1], bfhi(ya.z), bfhi(yb.z)));
                w.w = pk2(MMV(a1[2], b1[2], bflo(ya.w), bflo(yb.w)), MMV(a1[3], b1[3], bfhi(ya.w), bfhi(yb.w)));
#undef MMV
                *(u32x4*)(MM + off) = w; }
    }
};
struct EpiN {
    static constexpr bool PERM = true, AFTER_DRAIN = false;
    bf16* O; float* SSQ;
    __device__ __forceinline__ void operator()(const f32x4 (&acc)[2][2][4][2], const pg8::Unit& u, int wr, int wc, int fr, int fq) const {
        const int row0 = u.pm * 256 + wr * 64 + fr;
        store_tile<0>(acc, O, D, row0, u.pn * 256 + wc * 32 + 8 * fq);
#pragma unroll
        for (int ai = 0; ai < 2; ++ai)
#pragma unroll
            for (int m = 0; m < 4; ++m) { float ss = 0.f;
#pragma unroll
                for (int bj = 0; bj < 2; ++bj)
#pragma unroll
                    for (int n = 0; n < 2; ++n) { const f32x4 v = acc[ai][bj][m][n]; ss += (v[0] * v[0] + v[1] * v[1]) + (v[2] * v[2] + v[3] * v[3]); }
                ss += __shfl_xor(ss, 16); ss += __shfl_xor(ss, 32);
                if (fq == 0) SSQ[(size_t)(row0 + ai * 128 + m * 16) * 16 + u.pn * 4 + wc] = ss; }
    }
};
struct SplitOrder {
    int pm0, G, c;
    __device__ __forceinline__ bool next(int i, pg8::Unit& u) const { const int L = i * G + c; if (L >= 256) return false; u.kq = L & 3; u.pn = (L >> 2) & 3; u.pm = pm0 + (L >> 4); return true; }
    __device__ __forceinline__ void a_ready(const pg8::Unit&) const {}
    __device__ __forceinline__ void done(const pg8::Unit&) const {}
};
struct EpiS {
    static constexpr bool PERM = true, AFTER_DRAIN = false;
    bf16* O; bf16* P; int pm0;
    __device__ __forceinline__ void operator()(const f32x4 (&acc)[2][2][4][2], const pg8::Unit& u, int wr, int wc, int fr, int fq) const {
        const int cw = u.pn * 256 + wc * 32 + 8 * fq;
        if (u.kq == 0) store_tile<0>(acc, O, D, u.pm * 256 + wr * 64 + fr, cw);
        else store_tile<0>(acc, P + (size_t)(u.kq - 1) * 4096 * 1024, D, (u.pm - pm0) * 256 + wr * 64 + fr, cw);
    }
};
struct EpiH {
    static constexpr bool PERM = true, AFTER_DRAIN = false;
    bf16* Hd;
    __device__ __forceinline__ void operator()(const f32x4 (&acc)[2][2][4][2], const pg8::Unit& u, int wr, int wc, int fr, int fq) const {
        store_tile<4>(acc, Hd, DFF, u.pm * 256 + wr * 64 + fr, u.pn * 256 + wc * 32 + 8 * fq);
    }
};

template <bool ILV = false> __device__ __forceinline__ void tr_item(const float* W, int ld, int col0, int ncols, int K, bf16* WT, int row_off, LAS float* scr, int item, int lane) {
    const int nblk = ncols >> 5, kb = item / nblk, nb = item - kb * nblk, k0 = 64 * kb, n0 = 32 * nb;
    const int r0 = ILV ? ((n0 & 1023) >> 7) * 256 + (n0 & 127) + (n0 >> 10) * 128 : n0;
#pragma unroll 8
    for (int i = 0; i < 32; ++i) { const int kk = 2 * i + (lane >> 5); scr[kk * 33 + (lane & 31)] = W[(size_t)(k0 + kk) * ld + col0 + n0 + (lane & 31)]; }
    LDS_WAIT(); asm volatile("" ::: "memory");
    const int c = lane & 7;
#pragma unroll
    for (int j = 0; j < 4; ++j) { const int n = (lane >> 3) + 8 * j; const LAS float* s = scr + (8 * c) * 33 + n;
        u32x4 o; o.x = pk2(s[0 * 33], s[1 * 33]); o.y = pk2(s[2 * 33], s[3 * 33]); o.z = pk2(s[4 * 33], s[5 * 33]); o.w = pk2(s[6 * 33], s[7 * 33]);
        *(u32x4*)(WT + (size_t)(row_off + r0 + n) * K + k0 + 8 * c) = o; }
    LDS_WAIT(); asm volatile("" ::: "memory");
}
__device__ __forceinline__ void phase0(const Args& a, LAS unsigned char* lds, int tid, int lane, int wave) {
    LAS float* SIL = (LAS float*)lds;
    LAS float* RED = (LAS float*)(lds + 36864);
    LAS float* SCR = (LAS float*)(lds + 36864 + 18432 + wave * 8448);
    unsigned char* ws = a.ws;
    float* MOD = (float*)(ws + WS_MOD);
    for (int i = tid; i < 9 * 1024; i += 512) { const float c = i < 8192 ? a.in[4][i] : a.in[5][i - 8192]; SIL[i] = siluf_(c); }
    __syncthreads();
    for (int it = blockIdx.x; it < 96; it += gridDim.x) {
        const float* wp = a.in[6] + (size_t)(wave * 128) * 6144 + it * 64 + lane;
        float acc[9];
#pragma unroll
        for (int j = 0; j < 9; ++j) acc[j] = 0.f;
#pragma unroll 8
        for (int k = 0; k < 128; ++k) { const float w = wp[(size_t)k * 6144];
#pragma unroll
            for (int j = 0; j < 9; ++j) acc[j] += SIL[j * 1024 + wave * 128 + k] * w; }
#pragma unroll
        for (int j = 0; j < 9; ++j) RED[(wave * 9 + j) * 64 + lane] = acc[j];
        __syncthreads();
        for (int o = tid; o < 576; o += 512) { const int j = o >> 6, l = o & 63; float s = a.in[7][it * 64 + l];
#pragma unroll
            for (int w = 0; w < 8; ++w) s += RED[(w * 9 + j) * 64 + l];
            MOD[j * 6144 + it * 64 + l] = s; }
        __syncthreads();
    }
    bf16* WL = (bf16*)(ws + WS_WL); bf16* WG = (bf16*)(ws + WS_WG); bf16* WY = (bf16*)(ws + WS_WY);
    bf16* WO = (bf16*)(ws + WS_WO); bf16* W1 = (bf16*)(ws + WS_W1); bf16* W2 = (bf16*)(ws + WS_W2);
    const float* w_in = a.in[9];
    const bool split = gridDim.x >= 192;
    const int gw = split ? ((int)blockIdx.x - 96) * 8 + wave : (int)blockIdx.x * 8 + wave, NGW = split ? ((int)gridDim.x - 96) * 8 : (int)gridDim.x * 8;
    constexpr int NITEMS = 1024 + 16 + 1536 + 1024 + 512 + 512 + 512 + 2048 + 2048;
    for (int it = gw; it < NITEMS && gw >= 0; it += NGW) {
        int r = it;
        if (r < 1024) { tr_item(w_in, NIN, 0, 2048, 1024, WL, 0, SCR, r, lane); continue; } r -= 1024;
        if (r < 16) { tr_item(w_in, NIN, 5120, 32, 1024, WL, 2048, SCR, r, lane); continue; } r -= 16;
        if (r < 1536) { tr_item(w_in, NIN, 2048, 3072, 1024, WG, 0, SCR, r, lane); continue; } r -= 1536;
        if (r < 1024) { tr_item<true>(w_in, NIN, 5152, 2048, 1024, WY, 0, SCR, r, lane); continue; } r -= 1024;
        if (r < 512) { tr_item(a.in[17], 1024, 0, 1024, 1024, WY, 2048, SCR, r, lane); continue; } r -= 512;
        if (r < 512) { tr_item(a.in[21], 1024, 0, 1024, 1024, WY, 3072, SCR, r, lane); continue; } r -= 512;
        if (r < 512) { tr_item(a.in[22], 1024, 0, 1024, 1024, WO, 0, SCR, r, lane); continue; } r -= 512;
        if (r < 2048) { tr_item(a.in[23], 4096, 0, 4096, 1024, W1, 0, SCR, r, lane); continue; } r -= 2048;
        tr_item(a.in[24], 1024, 0, 1024, 4096, W2, 0, SCR, r, lane);
    }
    { u32x4* z = (u32x4*)(WL + (size_t)2080 * 1024); const u32x4 zz = {0u, 0u, 0u, 0u};
      for (int i = blockIdx.x * 512 + tid; i < 224 * 1024 / 8; i += gridDim.x * 512) z[i] = zz; }
}

__device__ __forceinline__ const float* xrow(const Args& a, int m) { return m < MP ? a.in[0] + (size_t)m * D : a.in[1] + (size_t)(m - MP) * D; }
__device__ __forceinline__ int modgrp(int m) { return m < MP ? 8 : ((m - MP) >> 11); }
__device__ __forceinline__ void phase1(const Args& a, bf16* H, int lane, int wave) {
    const float* MOD = (const float*)(a.ws + WS_MOD); const float* ng = a.in[8];
    const int stride = gridDim.x * 8; int m = blockIdx.x * 8 + wave;
    f32x4 v[4];
    if (m < M) { const f32x4* xr = (const f32x4*)xrow(a, m);
#pragma unroll
        for (int q = 0; q < 2; ++q) { v[2 * q] = xr[2 * (lane + 64 * q)]; v[2 * q + 1] = xr[2 * (lane + 64 * q) + 1]; } }
    for (; m < M; m += stride) {
        f32x4 vn[4]; const int mn = m + stride;
#pragma unroll
        for (int q = 0; q < 4; ++q) vn[q] = v[q];
        if (mn < M) { const f32x4* xr = (const f32x4*)xrow(a, mn);
#pragma unroll
            for (int q = 0; q < 2; ++q) { vn[2 * q] = xr[2 * (lane + 64 * q)]; vn[2 * q + 1] = xr[2 * (lane + 64 * q) + 1]; } }
        const float* md = MOD + modgrp(m) * 6144;
        float s = 0.f;
#pragma unroll
        for (int q = 0; q < 4; ++q) s += (v[q][0] * v[q][0] + v[q][1] * v[q][1]) + (v[q][2] * v[q][2] + v[q][3] * v[q][3]);
        const float rstd = rsqrtf(wave_sum(s) * (1.f / D) + EPS);
#pragma unroll
        for (int q = 0; q < 2; ++q) { const int c = 8 * (lane + 64 * q); u32x4 w;
#pragma unroll
            for (int h = 0; h < 2; ++h) { const int cc = c + 4 * h;
                const f32x4 g = *(const f32x4*)(ng + cc), sh = *(const f32x4*)(md + cc), sc = *(const f32x4*)(md + 1024 + cc);
                const f32x4 r = v[2 * q + h] * rstd * g * (sc + 1.0f) + sh;
                w[2 * h] = pk2(r[0], r[1]); w[2 * h + 1] = pk2(r[2], r[3]); }
            *(u32x4*)(H + (size_t)m * D + c) = w; }
#pragma unroll
        for (int q = 0; q < 4; ++q) v[q] = vn[q];
    }
}

__device__ __forceinline__ void lru_phase(const Args& a, LAS unsigned char* lds, int tid, int lane, int wave) {
    LAS bf16* XC = (LAS bf16*)lds;
    LAS float* AU = (LAS float*)(lds + 18432);
    LAS float* SUBA = (LAS float*)(lds + 18432 + 69632);
    LAS float* HC = SUBA + 8 * 64 * 2;
    const bf16* ZX = (const bf16*)a.out;
    bf16* HF = (bf16*)(a.ws + WS_S0 + 2 * SLOT); bf16* HB = (bf16*)(a.ws + WS_S0);
    const float* conv_w = a.in[10]; const float* conv_b = a.in[11];
    const int col = lane & 15, quad = lane >> 4, mt = wave & 3, nh = wave >> 2;
    const int vcu = (gridDim.x % 8 == 0) ? (int)(blockIdx.x % 8) * (int)(gridDim.x / 8) + (int)(blockIdx.x / 8) : (int)blockIdx.x;
    int cur_key = -1;
    bf16x8 Bf[2][2][2]; float ba_[2], bx_[2], c8_[2]; f32x4 cwv[4][2]; f32x4 cb0, cb1;
    const int tokA = tid >> 3, c8A = (tid & 7) * 8;
    for (int u = vcu; u < 768; u += gridDim.x) {
        const bool lat = u < 256; const int v = lat ? u : u - 256; const int b = v >> 5, blk = (v >> 1) & 15, dir = v & 1;
        const int row_base = lat ? MP + b * 2048 : b * 256, nseg = lat ? 32 : 4;
        bf16* HX = dir ? HB : HF;
        const int ch0A = blk * 64 + c8A;
        if ((blk * 2 + dir) != cur_key) { cur_key = blk * 2 + dir;
        const float* wa = a.in[12] + (size_t)(dir * 16 + blk) * 4096; const float* wx = a.in[14] + (size_t)(dir * 16 + blk) * 4096;
#pragma unroll
        for (int nt = 0; nt < 2; ++nt)
#pragma unroll
            for (int kk = 0; kk < 2; ++kk)
#pragma unroll
                for (int i = 0; i < 8; i += 2) { const int k = kk * 32 + quad * 8 + i, n = nh * 32 + nt * 16 + col;
                    const unsigned pa = pk2(wa[k * 64 + n], wa[(k + 1) * 64 + n]), px = pk2(wx[k * 64 + n], wx[(k + 1) * 64 + n]);
                    Bf[0][nt][kk][i] = (short)(pa & 0xffffu); Bf[0][nt][kk][i + 1] = (short)(pa >> 16);
                    Bf[1][nt][kk][i] = (short)(px & 0xffffu); Bf[1][nt][kk][i + 1] = (short)(px >> 16); }
#pragma unroll
        for (int nt = 0; nt < 2; ++nt) { const int ch = dir * 1024 + blk * 64 + nh * 32 + nt * 16 + col;
            ba_[nt] = -1.4426950408889634f * a.in[13][ch]; bx_[nt] = -1.4426950408889634f * a.in[15][ch]; c8_[nt] = -8.0f * 1.4426950408889634f * log1pf(expf(-a.in[16][ch])); }
#pragma unroll
        for (int j = 0; j < 4; ++j) { cwv[j][0] = *(const f32x4*)(conv_w + j * 1024 + ch0A); cwv[j][1] = *(const f32x4*)(conv_w + j * 1024 + ch0A + 4); }
        cb0 = *(const f32x4*)(conv_b + ch0A); cb1 = *(const f32x4*)(conv_b + ch0A + 4);
        }
        if (tid < 64) HC[tid] = lat ? a.in[2][(size_t)(b * 2 + dir) * 1024 + blk * 64 + tid] : 0.f;
        const int nst = nseg >> 1;
        u32x4 Zg[2][4];
#define LRU_FETCH(t0_) do { _Pragma("unroll") for (int hh_ = 0; hh_ < 2; ++hh_) { const int t0h_ = (t0_) + 64 * hh_; const int lo_ = lat ? t0h_ : 0, hi_ = lat ? t0h_ + 64 : 256; \
            _Pragma("unroll") for (int j_ = 0; j_ < 4; ++j_) { const int t_ = t0h_ + tokA + j_ - 1; \
                Zg[hh_][j_] = (t_ >= lo_ && t_ < hi_) ? *(const u32x4*)(ZX + (size_t)(row_base + t_) * D + ch0A) : (u32x4){0u, 0u, 0u, 0u}; } } } while (0)
        LRU_FETCH((dir ? nst - 1 : 0) * 128);
        for (int s = 0; s < nst; ++s) {
            const int st = dir ? nst - 1 - s : s, t0 = st * 128;
#pragma unroll
            for (int hh = 0; hh < 2; ++hh) {
                f32x4 x0 = cb0, x1 = cb1;
#pragma unroll
                for (int j = 0; j < 4; ++j) { const u32x4 z = Zg[hh][j]; const f32x4 w0 = cwv[j][0], w1 = cwv[j][1];
                    x0[0] += w0[0] * bflo(z.x); x0[1] += w0[1] * bfhi(z.x); x0[2] += w0[2] * bflo(z.y); x0[3] += w0[3] * bfhi(z.y);
                    x1[0] += w1[0] * bflo(z.z); x1[1] += w1[1] * bfhi(z.z); x1[2] += w1[2] * bflo(z.w); x1[3] += w1[3] * bfhi(z.w); }
                u32x4 w; w.x = pk2(x0[0], x0[1]); w.y = pk2(x0[2], x0[3]); w.z = pk2(x1[0], x1[1]); w.w = pk2(x1[2], x1[3]);
                *(LAS u32x4*)(XC + (64 * hh + tokA) * 72 + c8A) = w;
            }
            __syncthreads();
            if (s + 1 < nst) LRU_FETCH((dir ? nst - 2 - s : s + 1) * 128);
#pragma unroll
            for (int hh = 0; hh < 2; ++hh) {
                bf16x8 Af[2];
#pragma unroll
                for (int kk = 0; kk < 2; ++kk) Af[kk] = *(const LAS bf16x8*)(XC + (64 * hh + 16 * mt + col) * 72 + kk * 32 + quad * 8);
                f32x4 ar[2], ai[2];
#pragma unroll
                for (int nt = 0; nt < 2; ++nt) { ar[nt] = (f32x4){0.f, 0.f, 0.f, 0.f}; ai[nt] = (f32x4){0.f, 0.f, 0.f, 0.f};
#pragma unroll
                    for (int kk = 0; kk < 2; ++kk) { ar[nt] = __builtin_amdgcn_mfma_f32_16x16x32_bf16(Af[kk], Bf[0][nt][kk], ar[nt], 0, 0, 0);
                        ai[nt] = __builtin_amdgcn_mfma_f32_16x16x32_bf16(Af[kk], Bf[1][nt][kk], ai[nt], 0, 0, 0); } }
                float xv[2][4];
#pragma unroll
                for (int nt = 0; nt < 2; ++nt)
#pragma unroll
                    for (int j = 0; j < 4; ++j) xv[nt][j] = bf2f((unsigned)XC[(64 * hh + 16 * mt + quad * 4 + j) * 72 + nh * 32 + nt * 16 + col]);
#pragma unroll
                for (int nt = 0; nt < 2; ++nt)
#pragma unroll
                    for (int j = 0; j < 4; ++j) { const int tok = 64 * hh + 16 * mt + quad * 4 + j, chl = nh * 32 + nt * 16 + col;
                        const float er = 1.0f + __builtin_amdgcn_exp2f(fmaf(ar[nt][j], -1.4426950408889634f, ba_[nt])), ei = 1.0f + __builtin_amdgcn_exp2f(fmaf(ai[nt][j], -1.4426950408889634f, bx_[nt]));
                        const float inv = rcpf_(er * ei), r = inv * ei, ig = inv * er;
                        const float aa = __builtin_amdgcn_exp2f(c8_[nt] * r);
                        const float uu = __builtin_amdgcn_sqrtf(fmaxf(1.0f - aa * aa, 0.f)) * ig * xv[nt][j];
                        typedef float f32x2s __attribute__((ext_vector_type(2)));
                        *(LAS f32x2s*)(AU + (tok * 68 + chl) * 2) = (f32x2s){aa, uu}; }
            }
            __syncthreads();
            {
                typedef float f32x2l __attribute__((ext_vector_type(2)));
                f32x2l p[16];
#pragma unroll
                for (int e = 0; e < 16; ++e) { const int i = wave * 16 + e; const int tok = dir ? 127 - i : i; p[e] = *(const LAS f32x2l*)(AU + (tok * 68 + lane) * 2); }
                float hl = 0.f, cp = 1.f;
#pragma unroll
                for (int e = 0; e < 16; ++e) { hl = p[e].x * hl + p[e].y; cp *= p[e].x; p[e].y = hl; p[e].x = cp; }
                *(LAS f32x2l*)(SUBA + (wave * 64 + lane) * 2) = (f32x2l){cp, hl};
                __syncthreads();
                float c = HC[(s & 1) * 64 + lane];
#pragma unroll
                for (int s2 = 0; s2 < 7; ++s2) { const f32x2l q = *(const LAS f32x2l*)(SUBA + (s2 * 64 + lane) * 2); if (s2 < wave) c = q.x * c + q.y; }
#pragma unroll
                for (int e = 0; e < 16; ++e) { const int i = wave * 16 + e; const int tok = dir ? 127 - i : i; *(LAS f32x2l*)(AU + (tok * 68 + lane) * 2) = (f32x2l){p[e].x, p[e].y + p[e].x * c}; }
                if (wave == 7) HC[((s + 1) & 1) * 64 + lane] = p[15].y + p[15].x * c;
            }
            __syncthreads();
#pragma unroll
            for (int hh = 0; hh < 2; ++hh) {
                const LAS f32x4* hq = (const LAS f32x4*)(AU + ((64 * hh + tokA) * 68 + c8A) * 2);
                const f32x4 q0 = hq[0], q1 = hq[1], q2 = hq[2], q3 = hq[3];
                u32x4 w; w.x = pk2(q0[1], q0[3]); w.y = pk2(q1[1], q1[3]); w.z = pk2(q2[1], q2[3]); w.w = pk2(q3[1], q3[3]);
                *(u32x4*)(HX + (size_t)(row_base + t0 + 64 * hh + tokA) * D + blk * 64 + c8A) = w;
            }
        }
#undef LRU_FETCH
        if (!lat && tid < 64) a.out[(size_t)M * D + (size_t)(b * 2 + dir) * 1024 + blk * 64 + tid] = HC[(nst & 1) * 64 + tid];
        __syncthreads();
    }
}

constexpr size_t WS_DEC = 6656 * 1024;
__device__ __forceinline__ void gla_prep(const Args& a, LAS unsigned char* lds, int tid, bf16* ewd, const bf16* ewa, const bf16* ewb) {
    LAS float* LRS = (LAS float*)lds;
    const float* LR = (const float*)(a.ws + WS_LR);
    bf16* EFb = (bf16*)a.out; bf16* EBb = EFb + (size_t)M * 512;
    float* DECg = (float*)(a.ws + WS_DEC);
    const size_t ew_n = (size_t)M * D / 8, ew_stride = (size_t)gridDim.x * 512; size_t ew_i = (size_t)blockIdx.x * 512 + tid;
    for (int it = blockIdx.x; it < 640; it += gridDim.x) {
        const int gc = it >> 1, dir = it & 1; const bool lat = gc >= 64; const int g2 = lat ? gc - 64 : gc;
        const int b = lat ? (g2 >> 5) : (g2 >> 2), cn = lat ? (g2 & 31) : (g2 & 3), p0 = cn * 64;
        const int row_base = lat ? MP + b * 2048 : b * 256;
        bf16* Eb = dir ? EBb : EFb;
        float w2r[16];
#pragma unroll
        for (int r = 0; r < 16; ++r) w2r[r] = a.in[18][(size_t)(dir * 16 + r) * 512 + tid];
        const float b2v = a.in[19][dir * 512 + tid];
        __syncthreads();
        if (tid < 256) { const int i = tid >> 2; const int p_ = dir ? p0 + 63 - i : p0 + i; const int row = lat ? row_base + (p_ & 31) * 64 + (p_ >> 5) : row_base + p_;
            *(LAS f32x4*)(LRS + i * 16 + (tid & 3) * 4) = *(const f32x4*)(LR + (size_t)row * 32 + dir * 16 + (tid & 3) * 4); }
        __syncthreads();
        float run = 0.f;
#pragma unroll 1
        for (int i8 = 0; i8 < 64; i8 += 8) {
            const bool ew_on = ew_i < ew_n; u32x4 ex0 = {0u, 0u, 0u, 0u}, ex1 = ex0, ey0 = ex0;
            if (ew_on) { ex0 = ((const u32x4*)ewa)[ew_i]; ex1 = ((const u32x4*)ewb)[ew_i]; ey0 = ((const u32x4*)ewd)[ew_i]; }
#pragma unroll
            for (int i7 = 0; i7 < 8; ++i7) { const int i = i8 + i7; const int p_ = dir ? p0 + 63 - i : p0 + i; const int row = lat ? row_base + (p_ & 31) * 64 + (p_ >> 5) : row_base + p_;
                const LAS f32x4* lrp = (const LAS f32x4*)(LRS + i * 16);
                const f32x4 l0 = lrp[0], l1 = lrp[1], l2 = lrp[2], l3 = lrp[3];
                float x = b2v;
                x += l0[0] * w2r[0]; x += l0[1] * w2r[1]; x += l0[2] * w2r[2]; x += l0[3] * w2r[3];
                x += l1[0] * w2r[4]; x += l1[1] * w2r[5]; x += l1[2] * w2r[6]; x += l1[3] * w2r[7];
                x += l2[0] * w2r[8]; x += l2[1] * w2r[9]; x += l2[2] * w2r[10]; x += l2[3] * w2r[11];
                x += l3[0] * w2r[12]; x += l3[1] * w2r[13]; x += l3[2] * w2r[14]; x += l3[3] * w2r[15];
                run += (fminf(x, 0.f) - logf_(1.0f + expf_(-fabsf(x)))) * 0.0625f;
                Eb[(size_t)row * 512 + tid] = (bf16)(pk2(expf_(run), 0.f) & 0xffffu); }
            if (ew_on) { u32x4 o;
#pragma unroll
                for (int e = 0; e < 4; ++e) o[e] = pk2((bflo(ex0[e]) + bflo(ex1[e])) * bflo(ey0[e]), (bfhi(ex0[e]) + bfhi(ex1[e])) * bfhi(ey0[e]));
                ((u32x4*)ewd)[ew_i] = o; ew_i += ew_stride; }
        }
        DECg[((size_t)dir * 320 + gc) * 512 + tid] = expf_(run);
    }
    for (; ew_i < ew_n; ew_i += ew_stride) { const u32x4 ex0 = ((const u32x4*)ewa)[ew_i], ex1 = ((const u32x4*)ewb)[ew_i], ey0 = ((const u32x4*)ewd)[ew_i]; u32x4 o;
#pragma unroll
        for (int e = 0; e < 4; ++e) o[e] = pk2((bflo(ex0[e]) + bflo(ex1[e])) * bflo(ey0[e]), (bfhi(ex0[e]) + bfhi(ex1[e])) * bfhi(ey0[e]));
        ((u32x4*)ewd)[ew_i] = o; }
}

__device__ __forceinline__ void gla_phase(const Args& a, LAS unsigned char* lds, int tid, int lane, int wave) {
    LAS bf16* QEA = (LAS bf16*)lds;
    LAS bf16* QEB = QEA + 64 * 136;
    LAS bf16* KE = QEB + 64 * 136;
    LAS bf16* STA = KE + 64 * 136;
    LAS bf16* STB = STA + 64 * 136;
    LAS bf16* KT = STB + 64 * 136;
    LAS bf16* VTA = KT + 128 * 72;
    LAS bf16* VTB = VTA + 64 * 72;
    LAS bf16* PP = VTB + 64 * 72;
    LAS float* DECA = (LAS float*)(PP + 64 * 72);
    LAS float* DECB = DECA + 128;
    const unsigned char* ws = a.ws;
    const bf16* EFb = (const bf16*)a.out; const bf16* EBb = EFb + (size_t)M * 512;
    const float* DECg = (const float*)(ws + WS_DEC);
    const bf16* Qb = (const bf16*)(ws + WS_S0 + 3 * SLOT); const bf16* Kb = Qb + (size_t)M * 512;
    const bf16* Vb = (const bf16*)(ws + WS_S0 + 4 * SLOT);
    bf16* OFb = (bf16*)(a.ws + WS_S0 + 2 * SLOT); bf16* OBb = (bf16*)(a.ws + WS_S0);
    const int ch = tid & 127, sub = __builtin_amdgcn_readfirstlane(tid >> 7);
    const int col = lane & 15, quad = lane >> 4, kt = wave;
    float* SG = a.out + (size_t)M * D + 16 * 2 * 1024;
    const int vcu = (gridDim.x % 8 == 0) ? (int)(blockIdx.x % 8) * (int)(gridDim.x / 8) + (int)(blockIdx.x / 8) : (int)blockIdx.x;
    for (int u = vcu; u < 768; u += gridDim.x) {
        const bool lat = u < 256; const int v = lat ? u : u - 256; const int b = v >> 5, hd = (v >> 3) & 3, dir = (v >> 2) & 1, sl = v & 3;
        const int row_base = lat ? MP + b * 2048 : b * 256, nch = lat ? 32 : 4, gc0 = lat ? 64 + b * 32 : b * 4;
        bf16* Ob = dir ? OBb : OFb; const bf16* Eb = dir ? EBb : EFb;
        f32x4 S[4];
#pragma unroll
        for (int vt = 0; vt < 4; ++vt)
#pragma unroll
            for (int j = 0; j < 4; ++j)
                S[vt][j] = lat ? a.in[3][((((size_t)(b * 2 + dir) * 4 + hd) * 128 + 16 * kt + quad * 4 + j) * 256) + sl * 64 + 16 * vt + col] : 0.f;
#define GROWP(p0_, i) ({ const int p_ = dir ? (p0_) + 63 - (i) : (p0_) + (i); lat ? row_base + (p_ & 31) * 64 + (p_ >> 5) : row_base + p_; })
        u32x4 QgA[2], KgA[2], EgA[2], VgA, QgB[2], KgB[2], EgB[2], VgB; f32x2 etgA, etgB;
#define GLA_FETCH(X, cn_) do { const int p0_ = (cn_) * 64; \
            _Pragma("unroll") for (int e_ = 0; e_ < 2; ++e_) { const int pc_ = tid + e_ * 512; const size_t ro_ = (size_t)GROWP(p0_, pc_ >> 4) * 512 + hd * 128 + (pc_ & 15) * 8; \
                Qg##X[e_] = *(const u32x4*)(Qb + ro_); Kg##X[e_] = *(const u32x4*)(Kb + ro_); Eg##X[e_] = *(const u32x4*)(Eb + ro_); } \
            Vg##X = *(const u32x4*)(Vb + (size_t)GROWP(p0_, tid & 63) * D + hd * 256 + sl * 64 + (tid >> 6) * 8); \
            etg##X = *(const f32x2*)(DECg + ((size_t)dir * 320 + gc0 + (cn_)) * 512 + hd * 128 + 2 * lane); } while (0)
#define GLA_CHUNK(X, n) do { const int cn = dir ? nch - 1 - (n) : (n), p0 = cn * 64; \
_Pragma("unroll") \
            for (int vt = 0; vt < 4; ++vt) { u32x2 w; w.x = pk2(S[vt][0], S[vt][1]); w.y = pk2(S[vt][2], S[vt][3]); \
                *(LAS u32x2*)(ST##X + (16 * vt + col) * 136 + 16 * kt + quad * 4) = w; } \
_Pragma("unroll") \
            for (int e = 0; e < 2; ++e) { const int pc = tid + e * 512, o_ = (pc >> 4) * 136 + (pc & 15) * 8; \
                  \
                const u32x4 qr = Qg##X[e], kr = Kg##X[e], er = Eg##X[e]; u32x4 qo, ko; \
_Pragma("unroll") \
                for (int d_ = 0; d_ < 4; ++d_) { const float E0 = bflo(er[d_]), E1 = bfhi(er[d_]); const float R0 = rcpf_(E0), R1 = rcpf_(E1); \
                    qo[d_] = pk2(bflo(qr[d_]) * E0 * 0.08838834764831845f, bfhi(qr[d_]) * E1 * 0.08838834764831845f); \
                    ko[d_] = pk2(bflo(kr[d_]) * R0, bfhi(kr[d_]) * R1); } \
                *(LAS u32x4*)(QE##X + o_) = qo; *(LAS u32x4*)(KE + o_) = ko; } \
            {   const int i = tid & 63, v8 = (tid >> 6) * 8; const u32x4 z = Vg##X; \
                VT##X[(v8 + 0) * 72 + i] = (bf16)(z.x & 0xffffu); VT##X[(v8 + 1) * 72 + i] = (bf16)(z.x >> 16); \
                VT##X[(v8 + 2) * 72 + i] = (bf16)(z.y & 0xffffu); VT##X[(v8 + 3) * 72 + i] = (bf16)(z.y >> 16); \
                VT##X[(v8 + 4) * 72 + i] = (bf16)(z.z & 0xffffu); VT##X[(v8 + 5) * 72 + i] = (bf16)(z.z >> 16); \
                VT##X[(v8 + 6) * 72 + i] = (bf16)(z.w & 0xffffu); VT##X[(v8 + 7) * 72 + i] = (bf16)(z.w >> 16); } \
            const f32x2 etot = etg##X; \
            if (wave == 0) *(LAS f32x2*)(DEC##X + 2 * lane) = etot; \
            __syncthreads(); \
            if ((n) + 2 < nch) GLA_FETCH(X, dir ? nch - 3 - (n) : (n) + 2); \
            {     \
                unsigned kw_[8]; \
_Pragma("unroll") \
                for (int e = 0; e < 8; ++e) kw_[e] = *(const LAS unsigned*)(KE + (wave * 8 + e) * 136 + 2 * lane); \
                u32x4 w0, w1; \
                w0.x = pk2(bflo(kw_[0]) * etot.x, bflo(kw_[1]) * etot.x); w0.y = pk2(bflo(kw_[2]) * etot.x, bflo(kw_[3]) * etot.x); w0.z = pk2(bflo(kw_[4]) * etot.x, bflo(kw_[5]) * etot.x); w0.w = pk2(bflo(kw_[6]) * etot.x, bflo(kw_[7]) * etot.x); \
                w1.x = pk2(bfhi(kw_[0]) * etot.y, bfhi(kw_[1]) * etot.y); w1.y = pk2(bfhi(kw_[2]) * etot.y, bfhi(kw_[3]) * etot.y); w1.z = pk2(bfhi(kw_[4]) * etot.y, bfhi(kw_[5]) * etot.y); w1.w = pk2(bfhi(kw_[6]) * etot.y, bfhi(kw_[7]) * etot.y); \
                *(LAS u32x4*)(KT + (2 * lane) * 72 + wave * 8) = w0; *(LAS u32x4*)(KT + (2 * lane + 1) * 72 + wave * 8) = w1; } \
              \
            {     \
                const int st = wave >> 1, ct0 = 2 * (wave & 1); \
                f32x4 acc0 = {0.f, 0.f, 0.f, 0.f}, acc1 = {0.f, 0.f, 0.f, 0.f}; \
                if (st <= ct0 + 1) { \
_Pragma("unroll") \
                    for (int kk = 0; kk < 4; ++kk) { const bf16x8 ak = *(const LAS bf16x8*)(KE + (16 * st + col) * 136 + kk * 32 + quad * 8); \
                        if (st <= ct0) { const bf16x8 bq0 = *(const LAS bf16x8*)(QE##X + (16 * ct0 + col) * 136 + kk * 32 + quad * 8); acc0 = __builtin_amdgcn_mfma_f32_16x16x32_bf16(ak, bq0, acc0, 0, 0, 0); } \
                        const bf16x8 bq1 = *(const LAS bf16x8*)(QE##X + (16 * (ct0 + 1) + col) * 136 + kk * 32 + quad * 8); acc1 = __builtin_amdgcn_mfma_f32_16x16x32_bf16(ak, bq1, acc1, 0, 0, 0); } \
                } \
_Pragma("unroll") \
                for (int j = 0; j < 4; ++j) { if (16 * st + quad * 4 + j > 16 * ct0 + col) acc0[j] = 0.f; if (16 * st + quad * 4 + j > 16 * (ct0 + 1) + col) acc1[j] = 0.f; } \
                u32x2 w0, w1; w0.x = pk2(acc0[0], acc0[1]); w0.y = pk2(acc0[2], acc0[3]); w1.x = pk2(acc1[0], acc1[1]); w1.y = pk2(acc1[2], acc1[3]); \
                *(LAS u32x2*)(PP + (16 * ct0 + col) * 72 + 16 * st + quad * 4) = w0; *(LAS u32x2*)(PP + (16 * (ct0 + 1) + col) * 72 + 16 * st + quad * 4) = w1; \
            } \
            __syncthreads(); \
            {     \
                const int vt_ = wave >> 1, ct0 = 2 * (wave & 1); \
                bf16x8 av[2], as_[4]; \
_Pragma("unroll") \
                for (int ks = 0; ks < 2; ++ks) av[ks] = *(const LAS bf16x8*)(VT##X + (16 * vt_ + col) * 72 + ks * 32 + quad * 8); \
_Pragma("unroll") \
                for (int kk = 0; kk < 4; ++kk) as_[kk] = *(const LAS bf16x8*)(ST##X + (16 * vt_ + col) * 136 + kk * 32 + quad * 8); \
                f32x4 acc0 = {0.f, 0.f, 0.f, 0.f}, acc1 = {0.f, 0.f, 0.f, 0.f}; \
_Pragma("unroll") \
                for (int ks = 0; ks < 2; ++ks) { const bf16x8 bp0 = *(const LAS bf16x8*)(PP + (16 * ct0 + col) * 72 + ks * 32 + quad * 8), bp1 = *(const LAS bf16x8*)(PP + (16 * (ct0 + 1) + col) * 72 + ks * 32 + quad * 8); \
                    acc0 = __builtin_amdgcn_mfma_f32_16x16x32_bf16(av[ks], bp0, acc0, 0, 0, 0); acc1 = __builtin_amdgcn_mfma_f32_16x16x32_bf16(av[ks], bp1, acc1, 0, 0, 0); } \
_Pragma("unroll") \
                for (int kk = 0; kk < 4; ++kk) { const bf16x8 bq0 = *(const LAS bf16x8*)(QE##X + (16 * ct0 + col) * 136 + kk * 32 + quad * 8), bq1 = *(const LAS bf16x8*)(QE##X + (16 * (ct0 + 1) + col) * 136 + kk * 32 + quad * 8); \
                    acc0 = __builtin_amdgcn_mfma_f32_16x16x32_bf16(as_[kk], bq0, acc0, 0, 0, 0); acc1 = __builtin_amdgcn_mfma_f32_16x16x32_bf16(as_[kk], bq1, acc1, 0, 0, 0); } \
                const int row0 = GROWP(p0, 16 * ct0 + col), row1 = GROWP(p0, 16 * (ct0 + 1) + col); \
                u32x2 w0, w1; w0.x = pk2(acc0[0], acc0[1]); w0.y = pk2(acc0[2], acc0[3]); w1.x = pk2(acc1[0], acc1[1]); w1.y = pk2(acc1[2], acc1[3]); \
                *(u32x2*)(Ob + (size_t)row0 * D + hd * 256 + sl * 64 + 16 * vt_ + quad * 4) = w0; *(u32x2*)(Ob + (size_t)row1 * D + hd * 256 + sl * 64 + 16 * vt_ + quad * 4) = w1; \
                bf16x8 ak[2]; \
_Pragma("unroll") \
                for (int ks = 0; ks < 2; ++ks) ak[ks] = *(const LAS bf16x8*)(KT + (16 * kt + col) * 72 + ks * 32 + quad * 8); \
                float dk[4]; \
_Pragma("unroll") \
                for (int j = 0; j < 4; ++j) dk[j] = DEC##X[16 * kt + quad * 4 + j]; \
_Pragma("unroll") \
                for (int vt = 0; vt < 4; ++vt) { \
_Pragma("unroll") \
                    for (int j = 0; j < 4; ++j) S[vt][j] *= dk[j]; \
_Pragma("unroll") \
                    for (int ks = 0; ks < 2; ++ks) { const bf16x8 bv = *(const LAS bf16x8*)(VT##X + (16 * vt + col) * 72 + ks * 32 + quad * 8); \
                        S[vt] = __builtin_amdgcn_mfma_f32_16x16x32_bf16(ak[ks], bv, S[vt], 0, 0, 0); } } \
            } \
        } while (0)
        GLA_FETCH(A, dir ? nch - 1 : 0); GLA_FETCH(B, dir ? nch - 2 : 1);
        for (int n = 0; n < nch; n += 2) { GLA_CHUNK(A, n); GLA_CHUNK(B, n + 1); }
#undef GLA_CHUNK
#undef GLA_FETCH
#undef GROWP
        if (!lat) {
#pragma unroll
            for (int vt = 0; vt < 4; ++vt)
#pragma unroll
                for (int j = 0; j < 4; ++j)
                    SG[((((size_t)(b * 2 + dir) * 4 + hd) * 128 + 16 * kt + quad * 4 + j) * 256) + sl * 64 + 16 * vt + col] = S[vt][j];
        }
    }
}

template <int MODE> __device__ __forceinline__ void ew_pass(bf16* dst, const bf16* a0, const bf16* b0, const bf16* a1, const bf16* b1, int tid) {
    const size_t nvec = (size_t)M * D / 8;
    for (size_t i = (size_t)blockIdx.x * 512 + tid; i < nvec; i += (size_t)gridDim.x * 512) {
        const u32x4 x0 = ((const u32x4*)a0)[i], y0 = ((const u32x4*)b0)[i], x1 = ((const u32x4*)a1)[i];
        u32x4 o;
        if (MODE == 0) {
#pragma unroll
            for (int e = 0; e < 4; ++e) o[e] = pk2((bflo(x0[e]) + bflo(x1[e])) * bflo(y0[e]), (bfhi(x0[e]) + bfhi(x1[e])) * bfhi(y0[e]));
        } else {
            const u32x4 y1 = ((const u32x4*)b1)[i];
#pragma unroll
            for (int e = 0; e < 4; ++e) o[e] = pk2(bflo(x0[e]) * bflo(y0[e]) + bflo(x1[e]) * bflo(y1[e]), bfhi(x0[e]) * bfhi(y0[e]) + bfhi(x1[e]) * bfhi(y1[e]));
        }
        ((u32x4*)dst)[i] = o;
    }
}
__device__ __forceinline__ void post_gla(const Args& a, int lane, int wave) {
    const bf16* OFb = (const bf16*)(a.ws + WS_S0 + 2 * SLOT); const bf16* OBb = (const bf16*)(a.ws + WS_S0);
    bf16* G = (bf16*)(a.ws + WS_S0 + 1 * SLOT);
    const f32x4 gn = *(const f32x4*)(a.in[20] + 4 * lane);
    const int stride = gridDim.x * 8; int m = blockIdx.x * 8 + wave;
    u32x2 cf[4], cb[4], cg[4];
    if (m < M) {
#pragma unroll
        for (int hh = 0; hh < 4; ++hh) { const size_t off = (size_t)m * D + hh * 256 + 4 * lane; cf[hh] = *(const u32x2*)(OFb + off); cb[hh] = *(const u32x2*)(OBb + off); cg[hh] = *(const u32x2*)(G + off); } }
    for (; m < M; m += stride) {
        u32x2 nf[4], nb[4], ng_[4]; const int mn = m + stride;
#pragma unroll
        for (int hh = 0; hh < 4; ++hh) { nf[hh] = cf[hh]; nb[hh] = cb[hh]; ng_[hh] = cg[hh]; }
        if (mn < M) {
#pragma unroll
            for (int hh = 0; hh < 4; ++hh) { const size_t off = (size_t)mn * D + hh * 256 + 4 * lane; nf[hh] = *(const u32x2*)(OFb + off); nb[hh] = *(const u32x2*)(OBb + off); ng_[hh] = *(const u32x2*)(G + off); } }
#pragma unroll
        for (int hh = 0; hh < 4; ++hh) { const size_t off = (size_t)m * D + hh * 256 + 4 * lane;
            const u32x2 f = cf[hh], bb = cb[hh], g = cg[hh];
            f32x4 o; o[0] = bflo(f.x) + bflo(bb.x); o[1] = bfhi(f.x) + bfhi(bb.x); o[2] = bflo(f.y) + bflo(bb.y); o[3] = bfhi(f.y) + bfhi(bb.y);
            const float ss = wave_sum((o[0] * o[0] + o[1] * o[1]) + (o[2] * o[2] + o[3] * o[3]));
            const float rstd = rsqrtf(ss * (1.f / 256.f) + EPS);
            u32x2 w; w.x = pk2(o[0] * rstd * gn[0] * siluf_(bflo(g.x)), o[1] * rstd * gn[1] * siluf_(bfhi(g.x))); w.y = pk2(o[2] * rstd * gn[2] * siluf_(bflo(g.y)), o[3] * rstd * gn[3] * siluf_(bfhi(g.y)));
            *(u32x2*)(G + off) = w; }
#pragma unroll
        for (int hh = 0; hh < 4; ++hh) { cf[hh] = nf[hh]; cb[hh] = nb[hh]; cg[hh] = ng_[hh]; }
    }
}
struct SplitRow { u32x4 o[2]; u32x4 p[3][2]; };
__device__ __forceinline__ void split_row_load(SplitRow& r, const bf16* O, const bf16* P, int m, int lane) {
#pragma unroll
    for (int q = 0; q < 2; ++q) r.o[q] = *(const u32x4*)(O + (size_t)m * D + 8 * (lane + 64 * q));
    if (m >= 16384) {
#pragma unroll
        for (int k = 0; k < 3; ++k)
#pragma unroll
            for (int q = 0; q < 2; ++q) r.p[k][q] = *(const u32x4*)(P + ((size_t)k * 4096 + (m - 16384)) * D + 8 * (lane + 64 * q)); }
}
__device__ __forceinline__ f32x4 split_row_val(const SplitRow& r, int m, int i) {
    const int q = i >> 1, h = i & 1;
    const unsigned w0 = r.o[q][2 * h], w1 = r.o[q][2 * h + 1];
    f32x4 v; v[0] = bflo(w0); v[1] = bfhi(w0); v[2] = bflo(w1); v[3] = bfhi(w1);
    if (m >= 16384) {
#pragma unroll
        for (int k = 0; k < 3; ++k) { const unsigned p0 = r.p[k][q][2 * h], p1 = r.p[k][q][2 * h + 1]; v[0] += bflo(p0); v[1] += bfhi(p0); v[2] += bflo(p1); v[3] += bfhi(p1); } }
    return v;
}
__device__ __forceinline__ void x1_pass(const Args& a, int lane, int wave) {
    const float* MOD = (const float*)(a.ws + WS_MOD); const float* ng = a.in[8];
    const bf16* Mm = (const bf16*)(a.ws + WS_S0 + 2 * SLOT); const bf16* Pm = (const bf16*)(a.ws + WS_S0 + 4 * SLOT); bf16* H2 = (bf16*)(a.ws + WS_S0);
    const int stride = gridDim.x * 8; int m = blockIdx.x * 8 + wave;
    SplitRow cur; f32x4 xc[4];
    if (m < M) { split_row_load(cur, Mm, Pm, m, lane); const f32x4* xr = (const f32x4*)xrow(a, m);
#pragma unroll
        for (int q = 0; q < 2; ++q) { xc[2 * q] = xr[2 * (lane + 64 * q)]; xc[2 * q + 1] = xr[2 * (lane + 64 * q) + 1]; } }
    for (; m < M; m += stride) {
        SplitRow nxt = cur; f32x4 xn[4]; const int mn = m + stride;
#pragma unroll
        for (int q = 0; q < 4; ++q) xn[q] = xc[q];
        if (mn < M) { split_row_load(nxt, Mm, Pm, mn, lane); const f32x4* xr = (const f32x4*)xrow(a, mn);
#pragma unroll
            for (int q = 0; q < 2; ++q) { xn[2 * q] = xr[2 * (lane + 64 * q)]; xn[2 * q + 1] = xr[2 * (lane + 64 * q) + 1]; } }
        const float* md = MOD + modgrp(m) * 6144;
        f32x4 mv[4]; float s1 = 0.f;
#pragma unroll
        for (int i = 0; i < 4; ++i) { mv[i] = split_row_val(cur, m, i); s1 += (mv[i][0] * mv[i][0] + mv[i][1] * mv[i][1]) + (mv[i][2] * mv[i][2] + mv[i][3] * mv[i][3]); }
        const float rstd1 = rsqrtf(wave_sum(s1) * (1.f / D) + EPS);
        f32x4 v[4]; float s = 0.f;
#pragma unroll
        for (int i = 0; i < 4; ++i) { const int c = 8 * (lane + 64 * (i >> 1)) + 4 * (i & 1);
            const f32x4 g1 = *(const f32x4*)(md + 2048 + c), n1 = *(const f32x4*)(ng + 1024 + c);
            v[i] = xc[i] + g1 * (mv[i] * rstd1 * n1);
            *(f32x4*)(a.out + (size_t)m * D + c) = v[i];
            s += (v[i][0] * v[i][0] + v[i][1] * v[i][1]) + (v[i][2] * v[i][2] + v[i][3] * v[i][3]); }
        const float rstd = rsqrtf(wave_sum(s) * (1.f / D) + EPS);
#pragma unroll
        for (int q = 0; q < 2; ++q) { const int c = 8 * (lane + 64 * q); u32x4 w;
#pragma unroll
            for (int h = 0; h < 2; ++h) { const int cc = c + 4 * h;
                const f32x4 g = *(const f32x4*)(ng + 2048 + cc), sh = *(const f32x4*)(md + 3072 + cc), sc = *(const f32x4*)(md + 4096 + cc);
                const f32x4 r = v[2 * q + h] * rstd * g * (sc + 1.0f) + sh;
                w[2 * h] = pk2(r[0], r[1]); w[2 * h + 1] = pk2(r[2], r[3]); }
            *(u32x4*)(H2 + (size_t)m * D + c) = w; }
        cur = nxt;
#pragma unroll
        for (int q = 0; q < 4; ++q) xc[q] = xn[q];
    }
}
__device__ __forceinline__ void fin_pass(const Args& a, int lane, int wave) {
    const float* MOD = (const float*)(a.ws + WS_MOD); const float* ng = a.in[8];
    const bf16* F = (const bf16*)(a.ws + WS_S0); const bf16* Pf = (const bf16*)(a.ws + WS_WL);
    const int stride = gridDim.x * 8; int m = blockIdx.x * 8 + wave;
    SplitRow cur; f32x4 yc[4];
    if (m < M) { split_row_load(cur, F, Pf, m, lane); const f32x4* yr = (const f32x4*)(a.out + (size_t)m * D);
#pragma unroll
        for (int q = 0; q < 2; ++q) { yc[2 * q] = yr[2 * (lane + 64 * q)]; yc[2 * q + 1] = yr[2 * (lane + 64 * q) + 1]; } }
    for (; m < M; m += stride) {
        SplitRow nxt = cur; f32x4 yn[4]; const int mn = m + stride;
#pragma unroll
        for (int q = 0; q < 4; ++q) yn[q] = yc[q];
        if (mn < M) { split_row_load(nxt, F, Pf, mn, lane); const f32x4* yr = (const f32x4*)(a.out + (size_t)mn * D);
#pragma unroll
            for (int q = 0; q < 2; ++q) { yn[2 * q] = yr[2 * (lane + 64 * q)]; yn[2 * q + 1] = yr[2 * (lane + 64 * q) + 1]; } }
        const float* md = MOD + modgrp(m) * 6144;
        f32x4 fv[4]; float s = 0.f;
#pragma unroll
        for (int i = 0; i < 4; ++i) { fv[i] = split_row_val(cur, m, i); s += (fv[i][0] * fv[i][0] + fv[i][1] * fv[i][1]) + (fv[i][2] * fv[i][2] + fv[i][3] * fv[i][3]); }
        const float rstd = rsqrtf(wave_sum(s) * (1.f / D) + EPS);
#pragma unroll
        for (int i = 0; i < 4; ++i) { const int c = 8 * (lane + 64 * (i >> 1)) + 4 * (i & 1);
            const f32x4 g2 = *(const f32x4*)(md + 5120 + c), n3 = *(const f32x4*)(ng + 3072 + c);
            *(f32x4*)(a.out + (size_t)m * D + c) = yc[i] + g2 * (fv[i] * rstd * n3); }
        cur = nxt;
#pragma unroll
        for (int q = 0; q < 4; ++q) yc[q] = yn[q];
    }
}

constexpr int NPHASE = 14;
__global__ void __launch_bounds__(512, 2) mk_fwd(Args a) {
    extern __shared__ __attribute__((aligned(16))) unsigned char lds_raw[];
    LAS unsigned char* lds = (LAS unsigned char*)lds_raw;
    cg::grid_group grid = cg::this_grid();
    const int tid = threadIdx.x, lane = tid & 63, wave = __builtin_amdgcn_readfirstlane(tid >> 6);
    const int lo = a.ph_lo, hi = a.ph_hi, G = gridDim.x;
    volatile LAS unsigned* MISC = (volatile LAS unsigned*)(lds + LDS_BYTES - 64);
    if (tid < 16) MISC[tid] = 0u;
    __syncthreads();
    const XcdBarrier bar = xcd_barrier_post((unsigned*)(a.ws + WS_BAR), MISC);
    unsigned char* ws = a.ws;
    bf16* S0 = (bf16*)(ws + WS_S0); bf16* S1 = (bf16*)(ws + WS_S0 + SLOT); bf16* S2 = (bf16*)(ws + WS_S0 + 2 * SLOT);
    bf16* S3 = (bf16*)(ws + WS_S0 + 3 * SLOT); bf16* S4 = (bf16*)(ws + WS_S0 + 4 * SLOT);
    bf16* D0 = (bf16*)a.out; bf16* D1 = D0 + (size_t)M * D;
#ifndef MK_MASK
#define MK_MASK 0x3fff
#endif
#define IN(k) (((MK_MASK >> (k)) & 1) && lo <= (k) && (k) < hi)
#define SEAM(k) do { if (IN(k) && IN((k) + 1)) xcd_barrier(bar); } while (0)
    if (lo < 0) grid.sync();
    if (IN(0)) { phase0(a, lds, tid, lane, wave); } SEAM(0);
    if (IN(1)) { phase1(a, S0, lane, wave); } SEAM(1);
    if (IN(2)) {
        pg8::Gemm g{S0, (const bf16*)(ws + WS_WL), M, 5376, 1024, S0, S0, 1 << 30, 1 << 30, 1024}; pg8::StaticOrder S; S.init(M, 5376, G, (int)blockIdx.x);
        EpiLG E{D0, D1, (float*)(ws + WS_LR), S3, S3 + (size_t)M * 512, S4, S1};
        pg8::gemm_phase<EpiLG, pg8::StaticOrder, true, true>(lds, g, S, E);
    } SEAM(2);
    if (IN(3)) { lru_phase(a, lds, tid, lane, wave); } SEAM(3);
    if (IN(4)) {
        gla_prep(a, lds, tid, D1, S2, S0);
    } SEAM(4);
    if (IN(5)) { gla_phase(a, lds, tid, lane, wave); } SEAM(5);
    if (IN(6)) { post_gla(a, lane, wave); phase1(a, S3, lane, wave); } SEAM(6);
    if (IN(7)) {
        pg8::Gemm g{D1, (const bf16*)(ws + WS_WY) + (size_t)2048 * 1024, M, 2048, 1024, S1, S1, 4, 1 << 30, 1024}; pg8::StaticOrder S; S.init(M, 2048, G, (int)blockIdx.x);
        EpiYY E{S4, D0};
        pg8::gemm_phase<EpiYY, pg8::StaticOrder, true, true>(lds, g, S, E);
    } SEAM(7);
    if (IN(8)) {
        pg8::Gemm g{S3, (const bf16*)(ws + WS_WY), M, 2048, 1024, S3, S3, 1 << 30, 1 << 30, 1024}; pg8::StaticOrder S; S.init(M, 2048, G, (int)blockIdx.x);
        EpiMM E{S4, D0, S0};
        pg8::gemm_phase<EpiMM, pg8::StaticOrder, true, true>(lds, g, S, E);
    } SEAM(8);
    if (IN(9)) {
        { pg8::Gemm g{S0, (const bf16*)(ws + WS_WO), 16384, 1024, 1024, S0, S0, 1 << 30, 1 << 30, 1024}; pg8::StaticOrder S; S.init(16384, 1024, G, (int)blockIdx.x);
          EpiS E{S2, S4, 64}; pg8::gemm_phase<EpiS, pg8::StaticOrder, true, true>(lds, g, S, E); }
        { pg8::Gemm g{S0, (const bf16*)(ws + WS_WO), M, 1024, 256, S0, S0, 1 << 30, 1 << 30, 1024}; SplitOrder S{64, G, (int)blockIdx.x};
          EpiS E{S2, S4, 64}; pg8::gemm_phase<EpiS, SplitOrder, true, true>(lds, g, S, E); }
    } SEAM(9);
    if (IN(10)) { x1_pass(a, lane, wave); } SEAM(10);
    if (IN(11)) {
        pg8::Gemm g{S0, (const bf16*)(ws + WS_W1), M, 4096, 1024, S0, S0, 1 << 30, 1 << 30, 1024}; pg8::StaticOrder S; S.init(M, 4096, G, (int)blockIdx.x);
        EpiH E{S1};
        pg8::gemm_phase<EpiH, pg8::StaticOrder, true, true>(lds, g, S, E);
    } SEAM(11);
    if (IN(12)) {
        { pg8::Gemm g{S1, (const bf16*)(ws + WS_W2), 16384, 1024, 4096, S1, S1, 1 << 30, 1 << 30, 4096}; pg8::StaticOrder S; S.init(16384, 1024, G, (int)blockIdx.x);
          EpiS E{S0, (bf16*)(ws + WS_WL), 64}; pg8::gemm_phase<EpiS, pg8::StaticOrder, true, true>(lds, g, S, E); }
        { pg8::Gemm g{S1, (const bf16*)(ws + WS_W2), M, 1024, 1024, S1, S1, 1 << 30, 1 << 30, 4096}; SplitOrder S{64, G, (int)blockIdx.x};
          EpiS E{S0, (bf16*)(ws + WS_WL), 64}; pg8::gemm_phase<EpiS, SplitOrder, true, true>(lds, g, S, E); }
    } SEAM(12);
    if (IN(13)) { fin_pass(a, lane, wave); }
#undef IN
#undef SEAM
}

extern "C" void kernel_launch(void* const* d_in, const int* in_sizes, int n_in, void* d_out, int out_size, void* d_ws, size_t ws_size, hipStream_t stream) {
    static int grid = 0;
    if (grid == 0) {
        if (n_in != 25 || ws_size < WS_END) { fprintf(stderr, "kernel_launch: unexpected n_in %d / ws %zu\n", n_in, ws_size); grid = -1; return; }
        int dev = 0, cus = 0, per_cu = 0;
        hipGetDevice(&dev); hipDeviceGetAttribute(&cus, hipDeviceAttributeMultiprocessorCount, dev);
        if (hipFuncSetAttribute((const void*)mk_fwd, hipFuncAttributeMaxDynamicSharedMemorySize, LDS_BYTES) != hipSuccess) { fprintf(stderr, "kernel_launch: hipFuncSetAttribute failed\n"); grid = -1; return; }
        if (hipOccupancyMaxActiveBlocksPerMultiprocessor(&per_cu, (const void*)mk_fwd, 512, LDS_BYTES) != hipSuccess || per_cu < 1) { fprintf(stderr, "kernel_launch: occupancy query says %d\n", per_cu); per_cu = 1; }
        (void)hipGetLastError();
        grid = cus * 1;
    }
    if (grid < 0) return;
    if (hipMemsetAsync((char*)d_ws + WS_BAR, 0, WS_BAR_BYTES, stream) != hipSuccess) { fprintf(stderr, "kernel_launch: memset failed\n"); return; }
    Args a{};
    for (int i = 0; i < 25; ++i) a.in[i] = (const float*)d_in[i];
    a.out = (float*)d_out; a.ws = (unsigned char*)d_ws;
    constexpr int NL = MK_N_LAUNCHES;
    for (int li = 0; li < NL; ++li) {
        a.ph_lo = (NL == 1) ? 0 : li; a.ph_hi = (NL == 1) ? NPHASE : li + 1;
        void* args[] = {&a};
        hipError_t e = hipLaunchCooperativeKernel((const void*)mk_fwd, dim3(grid), dim3(512), args, LDS_BYTES, stream);
        if (e != hipSuccess) { fprintf(stderr, "kernel_launch: cooperative launch %d failed: %s\n", li, hipGetErrorString(e)); break; }
    }
}
```

```cpp
#include <hip/hip_runtime.h>
#include <hip/hip_cooperative_groups.h>
#include <cstdio>
#include <cstdint>
namespace cg = cooperative_groups;
namespace pg8 {
#define PG8_LAS __attribute__((address_space(3)))
typedef unsigned short bf16_t;
typedef short bf16x8 __attribute__((ext_vector_type(8)));
typedef float f32x4 __attribute__((ext_vector_type(4)));
typedef unsigned u32x4 __attribute__((ext_vector_type(4)));
constexpr int BM = 256, BK = 64, HALF = 128, HTB = HALF * BK * 2  , STAGE_BYTES = 8 * HTB, NXCD = 8, WGM = 8;

__host__ __device__ __forceinline__ int lds_byte(int r, int c) { const int st = (r >> 4) * 2 + (c >> 5), rr = r & 15, cc = c & 31, ob = rr * 64 + cc * 2; return st * 1024 + (ob ^ (((ob >> 9) & 1) << 5)); }
__host__ __device__ __forceinline__ void stage_rc(int b, int& R, int& C) { const int st = b / 1024, sb = b % 1024, swz = sb ^ (((sb >> 9) & 1) << 5); R = (st >> 1) * 16 + swz / 64; C = (st & 1) * 32 + (swz % 64) / 2; }
__host__ __device__ __forceinline__ int perm32(int rho) { const int n = rho >> 4, i = rho & 15; return 8 * (i >> 2) + 4 * n + (i & 3); }

struct Unit { int pm, pn, kq; };
struct Gemm { const bf16_t* A; const bf16_t* Bt; int M, N, K; const bf16_t* A1; const bf16_t* A2; int pn1, pn2; int ld;
    __device__ __forceinline__ const char* abase(int pn) const { return (const char*)(pn < pn1 ? A : (pn < pn2 ? A1 : A2)); } };

struct StaticOrder {
    int nM, nN, nwg, G, c;
    __host__ __device__ void init(int M, int N, int G_, int c_) { nM = M / BM; nN = N / BM; nwg = nM * nN; G = G_; c = c_; }
    __host__ __device__ bool next(int i, Unit& u) const {
        const long L = (long)i * G + c; if (L >= nwg) return false;
        int wgid = (int)L; { const int q = nwg / NXCD, r = nwg % NXCD, xcd = wgid % NXCD, off = wgid / NXCD; wgid = (xcd < r ? xcd * (q + 1) : r * (q + 1) + (xcd - r) * q) + off; }
        const int nig = WGM * nN, gid = wgid / nig, fm = gid * WGM, gsz = (nM - fm) < WGM ? (nM - fm) : WGM;
        u.pm = fm + ((wgid % nig) % gsz); u.pn = (wgid % nig) / gsz; u.kq = 0; return true;
    }
    __device__ __forceinline__ void a_ready(const Unit&) const {}
    __device__ __forceinline__ void done(const Unit&) const {}
};

typedef float f32x2 __attribute__((ext_vector_type(2)));
typedef __bf16 bf16x2_t __attribute__((ext_vector_type(2)));
__device__ __forceinline__ unsigned cvt_pk_bf16(float lo, float hi) { const f32x2 v = {lo, hi}; return __builtin_bit_cast(unsigned, __builtin_convertvector(v, bf16x2_t)); }
template <class Epi, class Sched, bool ALIGN_EPI = false, bool SP2 = false>
__device__ __forceinline__ void gemm_phase(PG8_LAS unsigned char* lds, const Gemm g, const Sched& S, const Epi& E) {
    const int tid = threadIdx.x, wid = __builtin_amdgcn_readfirstlane(tid >> 6), lane = tid & 63, wr = wid >> 2, wc = wid & 3, fr = lane & 15, fq = lane >> 4;
    const int K = g.K, nt = K / BK;
    unsigned voffA[2], voffB[2];
#pragma unroll
    for (int i = 0; i < 2; ++i) { int R, C; stage_rc(tid * 16 + i * 8192, R, C); const int Rb = Epi::PERM ? ((R & ~31) + perm32(R & 31)) : R;
        voffA[i] = (unsigned)(R * g.ld + C) * 2u; voffB[i] = (unsigned)(Rb * g.ld + C) * 2u; }
    const size_t kstep = (size_t)(BK * 2);
    const size_t hstep = (size_t)HALF * g.ld * 2;
    const size_t tstep = 2 * hstep;
    const unsigned ldsw = (unsigned)wid * 1024u;
    const int aoff = lds_byte(wr * 64 + fr, fq * 8), boff = lds_byte(wc * 32 + fr, fq * 8);
#define PG8_SA(b, h) (((b) * 2 + (h)) * HTB)
#define PG8_SB(b, h) ((4 + (b) * 2 + (h)) * HTB)
#define PG8_STAGE(bufoff, gbase, voff) do { _Pragma("unroll") for (int _i = 0; _i < 2; ++_i) \
        __builtin_amdgcn_global_load_lds((const unsigned*)((const char*)(gbase) + (voff)[_i]), (PG8_LAS unsigned*)(lds + (bufoff) + ldsw + _i * 8192), 16, 0, 0); } while (0)
#define PG8_LDA(dst, b, h) do { _Pragma("unroll") for (int m = 0; m < 4; ++m) _Pragma("unroll") for (int k = 0; k < 2; ++k) dst[m][k] = *(const PG8_LAS bf16x8*)(lds + PG8_SA(b, h) + aoff + m * 2048 + k * 1024); } while (0)
#define PG8_LDB(dst, b, h) do { _Pragma("unroll") for (int n = 0; n < 2; ++n) _Pragma("unroll") for (int k = 0; k < 2; ++k) dst[n][k] = *(const PG8_LAS bf16x8*)(lds + PG8_SB(b, h) + boff + n * 2048 + k * 1024); } while (0)
#define PG8_MMA(ai, bj, At, Bt) do { __builtin_amdgcn_s_setprio(1); _Pragma("unroll") for (int m = 0; m < 4; ++m) _Pragma("unroll") for (int n = 0; n < 2; ++n) _Pragma("unroll") for (int k = 0; k < 2; ++k) \
        acc[ai][bj][m][n] = __builtin_amdgcn_mfma_f32_16x16x32_bf16(Bt[n][k], At[m][k], acc[ai][bj][m][n], 0, 0, 0); __builtin_amdgcn_s_setprio(0); } while (0)
#define PG8_WAIT_V(n) asm volatile("s_waitcnt vmcnt(" #n ")" ::: "memory")
#define PG8_WAIT_L(n) asm volatile("s_waitcnt lgkmcnt(" #n ")" ::: "memory")
#define PG8_BAR __builtin_amdgcn_s_barrier()
#define PG8_SCHED __builtin_amdgcn_sched_barrier(0)
    Unit cur, nxt; int ui = 0;
    if (!S.next(0, cur)) return;
    f32x4 acc[2][2][4][2];
#pragma unroll
    for (int a = 0; a < 2; ++a)
#pragma unroll
        for (int b = 0; b < 2; ++b)
#pragma unroll
            for (int m = 0; m < 4; ++m)
#pragma unroll
                for (int n = 0; n < 2; ++n) acc[a][b][m][n] = (f32x4){0.f, 0.f, 0.f, 0.f};
    bf16x8 At[4][2], B0[2][2], B1[2][2];
    const size_t qstep = (size_t)K * 2;
    const char* cA = g.abase(cur.pn) + (size_t)cur.pm * tstep + (size_t)cur.kq * qstep; const char* cB = (const char*)g.Bt + (size_t)cur.pn * tstep + (size_t)cur.kq * qstep;
    S.a_ready(cur);
    if constexpr (SP2) {
        PG8_STAGE(PG8_SB(0, 0), cB, voffB); PG8_STAGE(PG8_SB(0, 1), cB + hstep, voffB); PG8_STAGE(PG8_SA(0, 0), cA, voffA); PG8_STAGE(PG8_SA(0, 1), cA + hstep, voffA);
        if (wr == 1) PG8_BAR;
        PG8_WAIT_V(2); PG8_BAR;
        PG8_STAGE(PG8_SB(1, 0), cB + kstep, voffB); PG8_STAGE(PG8_SA(1, 0), cA + kstep, voffA); PG8_STAGE(PG8_SB(1, 1), cB + hstep + kstep, voffB);
        PG8_WAIT_V(6); PG8_BAR;
    } else {
        PG8_STAGE(PG8_SB(0, 0), cB, voffB); PG8_STAGE(PG8_SA(0, 0), cA, voffA); PG8_STAGE(PG8_SB(0, 1), cB + hstep, voffB); PG8_STAGE(PG8_SA(0, 1), cA + hstep, voffA);
        if (wr == 1) PG8_BAR;
        PG8_WAIT_V(4); PG8_BAR;
        PG8_STAGE(PG8_SB(1, 0), cB + kstep, voffB); PG8_STAGE(PG8_SA(1, 0), cA + kstep, voffA); PG8_STAGE(PG8_SB(1, 1), cB + hstep + kstep, voffB);
        PG8_WAIT_V(6); PG8_BAR;
    }
    for (;;) {
        const bool has_next = S.next(ui + 1, nxt);
        const char* nA = has_next ? g.abase(nxt.pn) + (size_t)nxt.pm * tstep + (size_t)nxt.kq * qstep : cA; const char* nB = has_next ? (const char*)g.Bt + (size_t)nxt.pn * tstep + (size_t)nxt.kq * qstep : cB;
        for (int t = 0; t < nt; t += 2) {
            const bool last = (t == nt - 2);
            const char* a1 = cA + (size_t)(t + 1) * kstep;
            const char* a2 = last ? nA : cA + (size_t)(t + 2) * kstep; const char* b2 = last ? nB : cB + (size_t)(t + 2) * kstep;
            const char* a3 = a2 + kstep; const char* b3 = b2 + kstep;
            if (last && has_next) S.a_ready(nxt);
            if constexpr (SP2) {
            PG8_LDB(B0, 0, 0); PG8_LDB(B1, 0, 1); PG8_SCHED; PG8_LDA(At, 0, 0); PG8_STAGE(PG8_SA(1, 1), a1 + hstep, voffA);
            PG8_WAIT_V(8); PG8_WAIT_L(0); PG8_BAR; PG8_MMA(0, 0, At, B0); PG8_MMA(0, 1, At, B1); PG8_BAR; PG8_SCHED;
            PG8_LDA(At, 0, 1); PG8_STAGE(PG8_SB(0, 0), b2, voffB); PG8_STAGE(PG8_SB(0, 1), b2 + hstep, voffB); PG8_STAGE(PG8_SA(0, 0), a2, voffA);
            PG8_WAIT_V(8); PG8_WAIT_L(0); PG8_BAR; PG8_MMA(1, 0, At, B0); PG8_MMA(1, 1, At, B1); PG8_BAR; PG8_SCHED;
            PG8_LDB(B0, 1, 0); PG8_LDB(B1, 1, 1); PG8_SCHED; PG8_LDA(At, 1, 0); PG8_STAGE(PG8_SA(0, 1), a2 + hstep, voffA);
            PG8_WAIT_V(8); PG8_WAIT_L(0); PG8_BAR; PG8_MMA(0, 0, At, B0); PG8_MMA(0, 1, At, B1); PG8_BAR; PG8_SCHED;
            PG8_LDA(At, 1, 1); PG8_STAGE(PG8_SB(1, 0), b3, voffB); PG8_STAGE(PG8_SB(1, 1), b3 + hstep, voffB); PG8_STAGE(PG8_SA(1, 0), a3, voffA);
            PG8_WAIT_V(8); PG8_WAIT_L(0); PG8_BAR; PG8_MMA(1, 0, At, B0); PG8_MMA(1, 1, At, B1); PG8_BAR; PG8_SCHED;
            } else {
            PG8_LDB(B0, 0, 0); PG8_SCHED; PG8_LDA(At, 0, 0); PG8_STAGE(PG8_SA(1, 1), a1 + hstep, voffA);
            PG8_WAIT_L(8); PG8_BAR; PG8_WAIT_L(0); PG8_MMA(0, 0, At, B0); PG8_BAR; PG8_SCHED;
            PG8_LDB(B1, 0, 1); PG8_STAGE(PG8_SB(0, 0), b2, voffB);
            PG8_BAR; PG8_WAIT_L(0); PG8_MMA(0, 1, At, B1); PG8_BAR;
            PG8_LDA(At, 0, 1); PG8_STAGE(PG8_SA(0, 0), a2, voffA);
            PG8_BAR; PG8_WAIT_L(0); PG8_MMA(1, 0, At, B0); PG8_BAR; PG8_SCHED;
            PG8_STAGE(PG8_SB(0, 1), b2 + hstep, voffB);
            PG8_WAIT_V(6); PG8_BAR; PG8_MMA(1, 1, At, B1); PG8_BAR;
            PG8_LDB(B0, 1, 0); PG8_SCHED; PG8_LDA(At, 1, 0); PG8_STAGE(PG8_SA(0, 1), a2 + hstep, voffA);
            PG8_WAIT_L(8); PG8_BAR; PG8_WAIT_L(0); PG8_MMA(0, 0, At, B0); PG8_BAR; PG8_SCHED;
            PG8_LDB(B1, 1, 1); PG8_STAGE(PG8_SB(1, 0), b3, voffB);
            PG8_BAR; PG8_WAIT_L(0); PG8_MMA(0, 1, At, B1); PG8_BAR;
            PG8_LDA(At, 1, 1); PG8_STAGE(PG8_SA(1, 0), a3, voffA);
            PG8_BAR; PG8_WAIT_L(0); PG8_MMA(1, 0, At, B0); PG8_BAR; PG8_SCHED;
            PG8_STAGE(PG8_SB(1, 1), b3 + hstep, voffB);
            PG8_WAIT_V(6); PG8_BAR; PG8_MMA(1, 1, At, B1); PG8_BAR;
            }
        }
        if constexpr (ALIGN_EPI) { if (wr == 0) PG8_BAR; }
        if constexpr (!Epi::AFTER_DRAIN) { E(acc, cur, wr, wc, fr, fq); S.done(cur); }
        if (!has_next) break;
#pragma unroll
        for (int a = 0; a < 2; ++a)
#pragma unroll
            for (int b = 0; b < 2; ++b)
#pragma unroll
                for (int m = 0; m < 4; ++m)
#pragma unroll
                    for (int n = 0; n < 2; ++n) acc[a][b][m][n] = (f32x4){0.f, 0.f, 0.f, 0.f};
        cur = nxt; cA = nA; cB = nB; ++ui;
        if constexpr (ALIGN_EPI) { if (wr == 1) PG8_BAR; }
    }
    PG8_WAIT_V(0);
    if constexpr (!ALIGN_EPI) { if (wr == 0) PG8_BAR; }
    PG8_BAR;
    if constexpr (Epi::AFTER_DRAIN) { E.fused(acc, cur, wr, wc, fr, fq, lds, wid, lane); S.done(cur); }
#undef PG8_SA
#undef PG8_SB
#undef PG8_STAGE
#undef PG8_LDA
#undef PG8_LDB
#undef PG8_MMA
#undef PG8_WAIT_V
#undef PG8_WAIT_L
#undef PG8_BAR
#undef PG8_SCHED
}
}

#ifndef MK_N_LAUNCHES
#define MK_N_LAUNCHES 1
#endif
#define LAS __attribute__((address_space(3)))
typedef unsigned short bf16;
typedef float f32x4 __attribute__((ext_vector_type(4)));
typedef float f32x2 __attribute__((ext_vector_type(2)));
typedef unsigned u32x4 __attribute__((ext_vector_type(4)));
typedef unsigned u32x2 __attribute__((ext_vector_type(2)));
typedef short bf16x8 __attribute__((ext_vector_type(8)));

constexpr int D = 1024, MP = 4096, ML = 16384, M = MP + ML, NIN = 7200, DFF = 4096;
constexpr float EPS = 1e-6f;
constexpr size_t MiB = 1u << 20;
constexpr size_t WS_MOD = 0;
constexpr size_t WS_BAR = 512 * 1024, WS_BAR_BYTES = 16384;
constexpr size_t WS_SSQ1 = 1 * MiB;
constexpr size_t WS_SSQ2 = 2560 * 1024;
constexpr size_t WS_LR = 4 * MiB;
constexpr size_t WS_WL = 8 * MiB;
constexpr size_t WS_WG = WS_WL + (size_t)2304 * 1024 * 2;
constexpr size_t WS_WY = WS_WG + (size_t)3072 * 1024 * 2;
constexpr size_t WS_WO = WS_WY + (size_t)4096 * 1024 * 2;
constexpr size_t WS_W1 = WS_WO + (size_t)1024 * 1024 * 2;
constexpr size_t WS_W2 = WS_W1 + (size_t)4096 * 1024 * 2;
constexpr size_t WS_S0 = 48 * MiB, SLOT = 40 * MiB;
static_assert(WS_W2 + (size_t)1024 * 4096 * 2 <= WS_S0, "ws map");
constexpr size_t WS_END = WS_S0 + 5 * SLOT;
constexpr int LDS_BYTES = 147456;

struct Args { const float* in[25]; float* out; unsigned char* ws; int ph_lo, ph_hi; };

__device__ __forceinline__ float bf2f(unsigned v) { return __uint_as_float(v << 16); }
__device__ __forceinline__ float bflo(unsigned w) { return __uint_as_float(w << 16); }
__device__ __forceinline__ float bfhi(unsigned w) { return __uint_as_float(w & 0xffff0000u); }
__device__ __forceinline__ unsigned pk2(float lo, float hi) { return pg8::cvt_pk_bf16(lo, hi); }
__device__ __forceinline__ float wave_sum(float v) {
#pragma unroll
    for (int o = 1; o < 64; o <<= 1) v += __shfl_xor(v, o);
    return v;
}
__device__ __forceinline__ float rcpf_(float x) { return __builtin_amdgcn_rcpf(x); }
__device__ __forceinline__ float expf_(float x) { return __builtin_amdgcn_exp2f(x * 1.4426950408889634f); }
__device__ __forceinline__ float logf_(float x) { return __builtin_amdgcn_logf(x) * 0.6931471805599453f; }
__device__ __forceinline__ float sigmoidf_(float x) { return rcpf_(1.0f + expf_(-x)); }
__device__ __forceinline__ float siluf_(float x) { return x * sigmoidf_(x); }
__device__ __forceinline__ float gelu_tanh(float x) { const float t = x * (1.5957691216f + 0.0713548163f * x * x); return x * rcpf_(1.0f + expf_(-t)); }
template <int ACT> __device__ __forceinline__ float actf(float x) {
    if (ACT == 1) return gelu_tanh(x);
    if (ACT == 2) return siluf_(x);
    if (ACT == 3) return sigmoidf_(x);
    if (ACT == 4) { const float m = fmaxf(x, 0.f); return m * m; }
    return x;
}
#define LDS_WAIT() asm volatile("s_waitcnt lgkmcnt(0)" ::: "memory")

#define XB_TMO      128
#define XB_XCNT(j)  (256  + 64 * (j))
#define XB_XSUB(j)  (1280 + 64 * (j))
#define XB_XGEN(j)  (2304 + 64 * (j))
#define XB_TOP      3328
#define XB_TOPGEN   3392
#define XCD_BAR_WORDS 3456
#define XB_SPIN_CAP (1u << 18)

__device__ __forceinline__ unsigned xb_ld(unsigned* p)              { return __hip_atomic_load(p, __ATOMIC_RELAXED, __HIP_MEMORY_SCOPE_AGENT); }
__device__ __forceinline__ unsigned xb_add(unsigned* p, unsigned v) { return __hip_atomic_fetch_add(p, v, __ATOMIC_RELAXED, __HIP_MEMORY_SCOPE_AGENT); }
__device__ __forceinline__ unsigned xb_xcc_id() { return (unsigned)__builtin_amdgcn_s_getreg((3 << 11) | 20) & 0xFu; }
#define XB_SPIN(cond, bar) do { unsigned _sp = 0; while (cond) { __builtin_amdgcn_s_sleep(1); \
    if ((++_sp & 255u) == 0u) { if (xb_ld(&(bar)[XB_TMO])) break; if (_sp > XB_SPIN_CAP) { atomicAdd(&(bar)[XB_TMO], 1u); break; } } } } while (0)

struct XcdBarrier {
    unsigned* bar; unsigned x;
    volatile LAS unsigned* st;
};

__device__ __forceinline__ XcdBarrier xcd_barrier_post(unsigned* bar, volatile LAS unsigned* st) {
    XcdBarrier b; b.bar = bar; b.x = xb_xcc_id(); b.st = st;
    if (threadIdx.x == 0) (void)xb_add(&bar[XB_XCNT(b.x)], 1u);
    return b;
}
__device__ __forceinline__ void xcd_barrier_complete(unsigned* bar, unsigned x, unsigned& nloc, unsigned& nx) {
    const unsigned G = gridDim.x * gridDim.y * gridDim.z;
    unsigned sum, cnt, mine, sp = 0u;
    for (;;) {
        sum = 0u; cnt = 0u; mine = 0u;
#pragma unroll
        for (unsigned j = 0; j < 16; ++j) { const unsigned c = xb_ld(&bar[XB_XCNT(j)]); sum += c; cnt += (c > 0u) ? 1u : 0u; mine = (j == x) ? c : mine; }
        if (sum == G) break;
        __builtin_amdgcn_s_sleep(1);
        if ((++sp & 255u) == 0u) { if (xb_ld(&bar[XB_TMO])) break; if (sp > XB_SPIN_CAP) { atomicAdd(&bar[XB_TMO], 1u); break; } }
    }
    nloc = mine > 0u ? mine : 1u; nx = cnt > 0u ? cnt : 1u;
}

__device__ __forceinline__ void xcd_barrier(const XcdBarrier& b) {
    asm volatile("s_waitcnt vmcnt(0)" ::: "memory");
    __syncthreads();
    if (threadIdx.x == 0) {
        unsigned* bar = b.bar;
        __builtin_amdgcn_s_waitcnt(0);
        unsigned nloc = b.st[0], nx = b.st[1];
        if (nloc == 0u) { xcd_barrier_complete(bar, b.x, nloc, nx); b.st[0] = nloc; b.st[1] = nx; }
        const unsigned old = xb_add(&bar[XB_XSUB(b.x)], 1u);
        const unsigned gen = old / nloc;
        if (old + 1u == (gen + 1u) * nloc) {
            __builtin_amdgcn_fence(__ATOMIC_RELEASE, "agent");
            asm volatile("s_waitcnt vmcnt(0)" ::: "memory");
            const unsigned og = xb_add(&bar[XB_TOP], 1u);
            const unsigned tg = og / nx;
            if (og + 1u == (tg + 1u) * nx) xb_add(&bar[XB_TOPGEN], 1u);
            else XB_SPIN(xb_ld(&bar[XB_TOPGEN]) == tg, bar);
            __builtin_amdgcn_fence(__ATOMIC_ACQUIRE, "agent");
            xb_add(&bar[XB_XGEN(b.x)], 1u);
            asm volatile("s_waitcnt vmcnt(0)" ::: "memory");
        } else {
            XB_SPIN(xb_ld(&bar[XB_XGEN(b.x)]) == gen, bar);
            __builtin_amdgcn_fence(__ATOMIC_ACQUIRE, "agent");
            asm volatile("s_waitcnt vmcnt(0)" ::: "memory");
        }
    }
    __syncthreads();
}

template <int ACT> __device__ __forceinline__ void store_tile(const f32x4 (&acc)[2][2][4][2], bf16* base, int ld, int row0, int col0) {
#pragma unroll
    for (int ai = 0; ai < 2; ++ai)
#pragma unroll
        for (int m = 0; m < 4; ++m) { bf16* rowp = base + (size_t)(row0 + ai * 128 + m * 16) * ld + col0;
#pragma unroll
            for (int bj = 0; bj < 2; ++bj) { const f32x4 v0 = acc[ai][bj][m][0], v1 = acc[ai][bj][m][1];
                u32x4 w; w.x = pk2(actf<ACT>(v0[0]), actf<ACT>(v0[1])); w.y = pk2(actf<ACT>(v0[2]), actf<ACT>(v0[3]));
                w.z = pk2(actf<ACT>(v1[0]), actf<ACT>(v1[1])); w.w = pk2(actf<ACT>(v1[2]), actf<ACT>(v1[3]));
                *(u32x4*)(rowp + bj * 128) = w; } }
}
struct EpiLG {
    static constexpr bool PERM = true, AFTER_DRAIN = false;
    bf16* ZX; bf16* ZG; float* LR; bf16* Q; bf16* K; bf16* V; bf16* G;
    __device__ __forceinline__ void operator()(const f32x4 (&acc)[2][2][4][2], const pg8::Unit& u, int wr, int wc, int fr, int fq) const {
        const int row0 = u.pm * 256 + wr * 64 + fr, cw = wc * 32 + 8 * fq;
        if (u.pn < 4) store_tile<0>(acc, ZX, D, row0, u.pn * 256 + cw);
        else if (u.pn < 8) store_tile<1>(acc, ZG, D, row0, (u.pn - 4) * 256 + cw);
        else if (u.pn == 8) { if (wc == 0) {
#pragma unroll
            for (int ai = 0; ai < 2; ++ai)
#pragma unroll
                for (int m = 0; m < 4; ++m) { float* rp = LR + (size_t)(row0 + ai * 128 + m * 16) * 32 + 8 * fq;
                    *(f32x4*)rp = acc[ai][0][m][0]; *(f32x4*)(rp + 4) = acc[ai][0][m][1]; } } }
        else if (u.pn < 11) store_tile<0>(acc, Q, 512, row0, (u.pn - 9) * 256 + cw);
        else if (u.pn < 13) store_tile<0>(acc, K, 512, row0, (u.pn - 11) * 256 + cw);
        else if (u.pn < 17) store_tile<0>(acc, V, D, row0, (u.pn - 13) * 256 + cw);
        else store_tile<0>(acc, G, D, row0, (u.pn - 17) * 256 + cw);
    }
};
struct EpiYY {
    static constexpr bool PERM = true, AFTER_DRAIN = false;
    bf16* YA; bf16* YB;
    __device__ __forceinline__ void operator()(const f32x4 (&acc)[2][2][4][2], const pg8::Unit& u, int wr, int wc, int fr, int fq) const {
        store_tile<0>(acc, u.pn < 4 ? YA : YB, D, u.pm * 256 + wr * 64 + fr, (u.pn & 3) * 256 + wc * 32 + 8 * fq);
    }
};
struct EpiMM {
    static constexpr bool PERM = true, AFTER_DRAIN = false;
    const bf16* YA; const bf16* YB; bf16* MM;
    __device__ __forceinline__ void operator()(const f32x4 (&acc)[2][2][4][2], const pg8::Unit& u, int wr, int wc, int fr, int fq) const {
        const int row0 = u.pm * 256 + wr * 64 + fr, c0 = u.pn * 128 + wc * 32 + 8 * fq;
#pragma unroll
        for (int ai = 0; ai < 2; ++ai)
#pragma unroll
            for (int m = 0; m < 4; ++m) { const size_t off = (size_t)(row0 + ai * 128 + m * 16) * D + c0;
                const u32x4 ya = *(const u32x4*)(YA + off), yb = *(const u32x4*)(YB + off);
                const f32x4 a0 = acc[ai][0][m][0], a1 = acc[ai][0][m][1], b0 = acc[ai][1][m][0], b1 = acc[ai][1][m][1];
#define MMV(av, bv, yv, zv) ({ const float ea_ = 1.0f + expf_(-(av)), eb_ = 1.0f + expf_(-(bv)); ((yv) * eb_ + (zv) * ea_) * rcpf_(ea_ * eb_); })
                u32x4 w;
                w.x = pk2(MMV(a0[0], b0[0], bflo(ya.x), bflo(yb.x)), MMV(a0[1], b0[1], bfhi(ya.x), bfhi(yb.x)));
                w.y = pk2(MMV(a0[2], b0[2], bflo(ya.y), bflo(yb.y)), MMV(a0[3], b0[3], bfhi(ya.y), bfhi(yb.y)));
                w.z = pk2(MMV(a1[0], b1[0], bflo(ya.z), bflo(yb.z)), MMV(a1[1], b1[1], bfhi(ya.z), bfhi(yb.z)));
                w.w = pk2(MMV(a1[2], b1[2], bflo(ya.w), bflo(yb.w)), MMV(a1[3], b1[3], bfhi(ya.w), bfhi(yb.w)));
#undef MMV
                *(u32x4*)(MM + off) = w; }
    }
};
struct EpiN {
    static constexpr bool PERM = true, AFTER_DRAIN = false;
    bf16* O; float* SSQ;
    __device__ __forceinline__ void operator()(const f32x4 (&acc)[2][2][4][2], const pg8::Unit& u, int wr, int wc, int fr, int fq) const {
        const int row0 = u.pm * 256 + wr * 64 + fr;
        store_tile<0>(acc, O, D, row0, u.pn * 256 + wc * 32 + 8 * fq);
#pragma unroll
        for (int ai = 0; ai < 2; ++ai)
#pragma unroll
            for (int m = 0; m < 4; ++m) { float ss = 0.f;
#pragma unroll
                for (int bj = 0; bj < 2; ++bj)
#pragma unroll
                    for (int n = 0; n < 2; ++n) { const f32x4 v = acc[ai][bj][m][n]; ss += (v[0] * v[0] + v[1] * v[1]) + (v[2] * v[2] + v[3] * v[3]); }
                ss += __shfl_xor(ss, 16); ss += __shfl_xor(ss, 32);
                if (fq == 0) SSQ[(size_t)(row0 + ai * 128 + m * 16) * 16 + u.pn * 4 + wc] = ss; }
    }
};
struct SplitOrder {
    int pm0, G, c;
    __device__ __forceinline__ bool next(int i, pg8::Unit& u) const { const int L = i * G + c; if (L >= 256) return false; u.kq = L & 3; u.pn = (L >> 2) & 3; u.pm = pm0 + (L >> 4); return true; }
    __device__ __forceinline__ void a_ready(const pg8::Unit&) const {}
    __device__ __forceinline__ void done(const pg8::Unit&) const {}
};
struct EpiS {
    static constexpr bool PERM = true, AFTER_DRAIN = false;
    bf16* O; bf16* P; int pm0;
    __device__ __forceinline__ void operator()(const f32x4 (&acc)[2][2][4][2], const pg8::Unit& u, int wr, int wc, int fr, int fq) const {
        const int cw = u.pn * 256 + wc * 32 + 8 * fq;
        if (u.kq == 0) store_tile<0>(acc, O, D, u.pm * 256 + wr * 64 + fr, cw);
        else store_tile<0>(acc, P + (size_t)(u.kq - 1) * 4096 * 1024, D, (u.pm - pm0) * 256 + wr * 64 + fr, cw);
    }
};
struct EpiH {
    static constexpr bool PERM = true, AFTER_DRAIN = false;
    bf16* Hd;
    __device__ __forceinline__ void operator()(const f32x4 (&acc)[2][2][4][2], const pg8::Unit& u, int wr, int wc, int fr, int fq) const {
        store_tile<4>(acc, Hd, DFF, u.pm * 256 + wr * 64 + fr, u.pn * 256 + wc * 32 + 8 * fq);
    }
};

template <bool ILV = false> __device__ __forceinline__ void tr_item(const float* W, int ld, int col0, int ncols, int K, bf16* WT, int row_off, LAS float* scr, int item, int lane) {
    const int nblk = ncols >> 5, kb = item / nblk, nb = item - kb * nblk, k0 = 64 * kb, n0 = 32 * nb;
    const int r0 = ILV ? ((n0 & 1023) >> 7) * 256 + (n0 & 127) + (n0 >> 10) * 128 : n0;
#pragma unroll 8
    for (int i = 0; i < 32; ++i) { const int kk = 2 * i + (lane >> 5); scr[kk * 33 + (lane & 31)] = W[(size_t)(k0 + kk) * ld + col0 + n0 + (lane & 31)]; }
    LDS_WAIT(); asm volatile("" ::: "memory");
    const int c = lane & 7;
#pragma unroll
    for (int j = 0; j < 4; ++j) { const int n = (lane >> 3) + 8 * j; const LAS float* s = scr + (8 * c) * 33 + n;
        u32x4 o; o.x = pk2(s[0 * 33], s[1 * 33]); o.y = pk2(s[2 * 33], s[3 * 33]); o.z = pk2(s[4 * 33], s[5 * 33]); o.w = pk2(s[6 * 33], s[7 * 33]);
        *(u32x4*)(WT + (size_t)(row_off + r0 + n) * K + k0 + 8 * c) = o; }
    LDS_WAIT(); asm volatile("" ::: "memory");
}
__device__ __forceinline__ void phase0(const Args& a, LAS unsigned char* lds, int tid, int lane, int wave) {
    LAS float* SIL = (LAS float*)lds;
    LAS float* RED = (LAS float*)(lds + 36864);
    LAS float* SCR = (LAS float*)(lds + 36864 + 18432 + wave * 8448);
    unsigned char* ws = a.ws;
    float* MOD = (float*)(ws + WS_MOD);
    for (int i = tid; i < 9 * 1024; i += 512) { const float c = i < 8192 ? a.in[4][i] : a.in[5][i - 8192]; SIL[i] = siluf_(c); }
    __syncthreads();
    for (int it = blockIdx.x; it < 96; it += gridDim.x) {
        const float* wp = a.in[6] + (size_t)(wave * 128) * 6144 + it * 64 + lane;
        float acc[9];
#pragma unroll
        for (int j = 0; j < 9; ++j) acc[j] = 0.f;
#pragma unroll 8
        for (int k = 0; k < 128; ++k) { const float w = wp[(size_t)k * 6144];
#pragma unroll
            for (int j = 0; j < 9; ++j) acc[j] += SIL[j * 1024 + wave * 128 + k] * w; }
#pragma unroll
        for (int j = 0; j < 9; ++j) RED[(wave * 9 + j) * 64 + lane] = acc[j];
        __syncthreads();
        for (int o = tid; o < 576; o += 512) { const int j = o >> 6, l = o & 63; float s = a.in[7][it * 64 + l];
#pragma unroll
            for (int w = 0; w < 8; ++w) s += RED[(w * 9 + j) * 64 + l];
            MOD[j * 6144 + it * 64 + l] = s; }
        __syncthreads();
    }
    bf16* WL = (bf16*)(ws + WS_WL); bf16* WG = (bf16*)(ws + WS_WG); bf16* WY = (bf16*)(ws + WS_WY);
    bf16* WO = (bf16*)(ws + WS_WO); bf16* W1 = (bf16*)(ws + WS_W1); bf16* W2 = (bf16*)(ws + WS_W2);
    const float* w_in = a.in[9];
    const bool split = gridDim.x >= 192;
    const int gw = split ? ((int)blockIdx.x - 96) * 8 + wave : (int)blockIdx.x * 8 + wave, NGW = split ? ((int)gridDim.x - 96) * 8 : (int)gridDim.x * 8;
    constexpr int NITEMS = 1024 + 16 + 1536 + 1024 + 512 + 512 + 512 + 2048 + 2048;
    for (int it = gw; it < NITEMS && gw >= 0; it += NGW) {
        int r = it;
        if (r < 1024) { tr_item(w_in, NIN, 0, 2048, 1024, WL, 0, SCR, r, lane); continue; } r -= 1024;
        if (r < 16) { tr_item(w_in, NIN, 5120, 32, 1024, WL, 2048, SCR, r, lane); continue; } r -= 16;
        if (r < 1536) { tr_item(w_in, NIN, 2048, 3072, 1024, WG, 0, SCR, r, lane); continue; } r -= 1536;
        if (r < 1024) { tr_item<true>(w_in, NIN, 5152, 2048, 1024, WY, 0, SCR, r, lane); continue; } r -= 1024;
        if (r < 512) { tr_item(a.in[17], 1024, 0, 1024, 1024, WY, 2048, SCR, r, lane); continue; } r -= 512;
        if (r < 512) { tr_item(a.in[21], 1024, 0, 1024, 1024, WY, 3072, SCR, r, lane); continue; } r -= 512;
        if (r < 512) { tr_item(a.in[22], 1024, 0, 1024, 1024, WO, 0, SCR, r, lane); continue; } r -= 512;
        if (r < 2048) { tr_item(a.in[23], 4096, 0, 4096, 1024, W1, 0, SCR, r, lane); continue; } r -= 2048;
        tr_item(a.in[24], 1024, 0, 1024, 4096, W2, 0, SCR, r, lane);
    }
    { u32x4* z = (u32x4*)(WL + (size_t)2080 * 1024); const u32x4 zz = {0u, 0u, 0u, 0u};
      for (int i = blockIdx.x * 512 + tid; i < 224 * 1024 / 8; i += gridDim.x * 512) z[i] = zz; }
}

__device__ __forceinline__ const float* xrow(const Args& a, int m) { return m < MP ? a.in[0] + (size_t)m * D : a.in[1] + (size_t)(m - MP) * D; }
__device__ __forceinline__ int modgrp(int m) { return m < MP ? 8 : ((m - MP) >> 11); }
__device__ __forceinline__ void phase1(const Args& a, bf16* H, int lane, int wave) {
    const float* MOD = (const float*)(a.ws + WS_MOD); const float* ng = a.in[8];
    const int stride = gridDim.x * 8; int m = blockIdx.x * 8 + wave;
    f32x4 v[4];
    if (m < M) { const f32x4* xr = (const f32x4*)xrow(a, m);
#pragma unroll
        for (int q = 0; q < 2; ++q) { v[2 * q] = xr[2 * (lane + 64 * q)]; v[2 * q + 1] = xr[2 * (lane + 64 * q) + 1]; } }
    for (; m < M; m += stride) {
        f32x4 vn[4]; const int mn = m + stride;
#pragma unroll
        for (int q = 0; q < 4; ++q) vn[q] = v[q];
        if (mn < M) { const f32x4* xr = (const f32x4*)xrow(a, mn);
#pragma unroll
            for (int q = 0; q < 2; ++q) { vn[2 * q] = xr[2 * (lane + 64 * q)]; vn[2 * q + 1] = xr[2 * (lane + 64 * q) + 1]; } }
        const float* md = MOD + modgrp(m) * 6144;
        float s = 0.f;
#pragma unroll
        for (int q = 0; q < 4; ++q) s += (v[q][0] * v[q][0] + v[q][1] * v[q][1]) + (v[q][2] * v[q][2] + v[q][3] * v[q][3]);
        const float rstd = rsqrtf(wave_sum(s) * (1.f / D) + EPS);
#pragma unroll
        for (int q = 0; q < 2; ++q) { const int c = 8 * (lane + 64 * q); u32x4 w;
#pragma unroll
            for (int h = 0; h < 2; ++h) { const int cc = c + 4 * h;
                const f32x4 g = *(const f32x4*)(ng + cc), sh = *(const f32x4*)(md + cc), sc = *(const f32x4*)(md + 1024 + cc);
                const f32x4 r = v[2 * q + h] * rstd * g * (sc + 1.0f) + sh;
                w[2 * h] = pk2(r[0], r[1]); w[2 * h + 1] = pk2(r[2], r[3]); }
            *(u32x4*)(H + (size_t)m * D + c) = w; }
#pragma unroll
        for (int q = 0; q < 4; ++q) v[q] = vn[q];
    }
}

__device__ __forceinline__ void lru_phase(const Args& a, LAS unsigned char* lds, int tid, int lane, int wave) {
    LAS bf16* XC = (LAS bf16*)lds;
    LAS float* AU = (LAS float*)(lds + 18432);
    LAS float* SUBA = (LAS float*)(lds + 18432 + 69632);
    LAS float* HC = SUBA + 8 * 64 * 2;
    const bf16* ZX = (const bf16*)a.out;
    bf16* HF = (bf16*)(a.ws + WS_S0 + 2 * SLOT); bf16* HB = (bf16*)(a.ws + WS_S0);
    const float* conv_w = a.in[10]; const float* conv_b = a.in[11];
    const int col = lane & 15, quad = lane >> 4, mt = wave & 3, nh = wave >> 2;
    const int vcu = (gridDim.x % 8 == 0) ? (int)(blockIdx.x % 8) * (int)(gridDim.x / 8) + (int)(blockIdx.x / 8) : (int)blockIdx.x;
    int cur_key = -1;
    bf16x8 Bf[2][2][2]; float ba_[2], bx_[2], c8_[2]; f32x4 cwv[4][2]; f32x4 cb0, cb1;
    const int tokA = tid >> 3, c8A = (tid & 7) * 8;
    for (int u = vcu; u < 768; u += gridDim.x) {
        const bool lat = u < 256; const int v = lat ? u : u - 256; const int b = v >> 5, blk = (v >> 1) & 15, dir = v & 1;
        const int row_base = lat ? MP + b * 2048 : b * 256, nseg = lat ? 32 : 4;
        bf16* HX = dir ? HB : HF;
        const int ch0A = blk * 64 + c8A;
        if ((blk * 2 + dir) != cur_key) { cur_key = blk * 2 + dir;
        const float* wa = a.in[12] + (size_t)(dir * 16 + blk) * 4096; const float* wx = a.in[14] + (size_t)(dir * 16 + blk) * 4096;
#pragma unroll
        for (int nt = 0; nt < 2; ++nt)
#pragma unroll
            for (int kk = 0; kk < 2; ++kk)
#pragma unroll
                for (int i = 0; i < 8; i += 2) { const int k = kk * 32 + quad * 8 + i, n = nh * 32 + nt * 16 + col;
                    const unsigned pa = pk2(wa[k * 64 + n], wa[(k + 1) * 64 + n]), px = pk2(wx[k * 64 + n], wx[(k + 1) * 64 + n]);
                    Bf[0][nt][kk][i] = (short)(pa & 0xffffu); Bf[0][nt][kk][i + 1] = (short)(pa >> 16);
                    Bf[1][nt][kk][i] = (short)(px & 0xffffu); Bf[1][nt][kk][i + 1] = (short)(px >> 16); }
#pragma unroll
        for (int nt = 0; nt < 2; ++nt) { const int ch = dir * 1024 + blk * 64 + nh * 32 + nt * 16 + col;
            ba_[nt] = -1.4426950408889634f * a.in[13][ch]; bx_[nt] = -1.4426950408889634f * a.in[15][ch]; c8_[nt] = -8.0f * 1.4426950408889634f * log1pf(expf(-a.in[16][ch])); }
#pragma unroll
        for (int j = 0; j < 4; ++j) { cwv[j][0] = *(const f32x4*)(conv_w + j * 1024 + ch0A); cwv[j][1] = *(const f32x4*)(conv_w + j * 1024 + ch0A + 4); }
        cb0 = *(const f32x4*)(conv_b + ch0A); cb1 = *(const f32x4*)(conv_b + ch0A + 4);
        }
        if (tid < 64) HC[tid] = lat ? a.in[2][(size_t)(b * 2 + dir) * 1024 + blk * 64 + tid] : 0.f;
        const int nst = nseg >> 1;
        u32x4 Zg[2][4];
#define LRU_FETCH(t0_) do { _Pragma("unroll") for (int hh_ = 0; hh_ < 2; ++hh_) { const int t0h_ = (t0_) + 64 * hh_; const int lo_ = lat ? t0h_ : 0, hi_ = lat ? t0h_ + 64 : 256; \
            _Pragma("unroll") for (int j_ = 0; j_ < 4; ++j_) { const int t_ = t0h_ + tokA + j_ - 1; \
                Zg[hh_][j_] = (t_ >= lo_ && t_ < hi_) ? *(const u32x4*)(ZX + (size_t)(row_base + t_) * D + ch0A) : (u32x4){0u, 0u, 0u, 0u}; } } } while (0)
        LRU_FETCH((dir ? nst - 1 : 0) * 128);
        for (int s = 0; s < nst; ++s) {
            const int st = dir ? nst - 1 - s : s, t0 = st * 128;
#pragma unroll
            for (int hh = 0; hh < 2; ++hh) {
                f32x4 x0 = cb0, x1 = cb1;
#pragma unroll
                for (int j = 0; j < 4; ++j) { const u32x4 z = Zg[hh][j]; const f32x4 w0 = cwv[j][0], w1 = cwv[j][1];
                    x0[0] += w0[0] * bflo(z.x); x0[1] += w0[1] * bfhi(z.x); x0[2] += w0[2] * bflo(z.y); x0[3] += w0[3] * bfhi(z.y);
                    x1[0] += w1[0] * bflo(z.z); x1[1] += w1[1] * bfhi(z.z); x1[2] += w1[2] * bflo(z.w); x1[3] += w1[3] * bfhi(z.w); }
                u32x4 w; w.x = pk2(x0[0], x0[1]); w.y = pk2(x0[2], x0[3]); w.z = pk2(x1[0], x1[1]); w.w = pk2(x1[2], x1[3]);
                *(LAS u32x4*)(XC + (64 * hh + tokA) * 72 + c8A) = w;
            }
            __syncthreads();
            if (s + 1 < nst) LRU_FETCH((dir ? nst - 2 - s : s + 1) * 128);
#pragma unroll
            for (int hh = 0; hh < 2; ++hh) {
                bf16x8 Af[2];
#pragma unroll
                for (int kk = 0; kk < 2; ++kk) Af[kk] = *(const LAS bf16x8*)(XC + (64 * hh + 16 * mt + col) * 72 + kk * 32 + quad * 8);
                f32x4 ar[2], ai[2];
#pragma unroll
                for (int nt = 0; nt < 2; ++nt) { ar[nt] = (f32x4){0.f, 0.f, 0.f, 0.f}; ai[nt] = (f32x4){0.f, 0.f, 0.f, 0.f};
#pragma unroll
                    for (int kk = 0; kk < 2; ++kk) { ar[nt] = __builtin_amdgcn_mfma_f32_16x16x32_bf16(Af[kk], Bf[0][nt][kk], ar[nt], 0, 0, 0);
                        ai[nt] = __builtin_amdgcn_mfma_f32_16x16x32_bf16(Af[kk], Bf[1][nt][kk], ai[nt], 0, 0, 0); } }
                float xv[2][4];
#pragma unroll
                for (int nt = 0; nt < 2; ++nt)
#pragma unroll
                    for (int j = 0; j < 4; ++j) xv[nt][j] = bf2f((unsigned)XC[(64 * hh + 16 * mt + quad * 4 + j) * 72 + nh * 32 + nt * 16 + col]);
#pragma unroll
                for (int nt = 0; nt < 2; ++nt)
#pragma unroll
                    for (int j = 0; j < 4; ++j) { const int tok = 64 * hh + 16 * mt + quad * 4 + j, chl = nh * 32 + nt * 16 + col;
                        const float er = 1.0f + __builtin_amdgcn_exp2f(fmaf(ar[nt][j], -1.4426950408889634f, ba_[nt])), ei = 1.0f + __builtin_amdgcn_exp2f(fmaf(ai[nt][j], -1.4426950408889634f, bx_[nt]));
                        const float inv = rcpf_(er * ei), r = inv * ei, ig = inv * er;
                        const float aa = __builtin_amdgcn_exp2f(c8_[nt] * r);
                        const float uu = __builtin_amdgcn_sqrtf(fmaxf(1.0f - aa * aa, 0.f)) * ig * xv[nt][j];
                        typedef float f32x2s __attribute__((ext_vector_type(2)));
                        *(LAS f32x2s*)(AU + (tok * 68 + chl) * 2) = (f32x2s){aa, uu}; }
            }
            __syncthreads();
            {
                typedef float f32x2l __attribute__((ext_vector_type(2)));
                f32x2l p[16];
#pragma unroll
                for (int e = 0; e < 16; ++e) { const int i = wave * 16 + e; const int tok = dir ? 127 - i : i; p[e] = *(const LAS f32x2l*)(AU + (tok * 68 + lane) * 2); }
                float hl = 0.f, cp = 1.f;
#pragma unroll
                for (int e = 0; e < 16; ++e) { hl = p[e].x * hl + p[e].y; cp *= p[e].x; p[e].y = hl; p[e].x = cp; }
                *(LAS f32x2l*)(SUBA + (wave * 64 + lane) * 2) = (f32x2l){cp, hl};
                __syncthreads();
                float c = HC[(s & 1) * 64 + lane];
#pragma unroll
                for (int s2 = 0; s2 < 7; ++s2) { const f32x2l q = *(const LAS f32x2l*)(SUBA + (s2 * 64 + lane) * 2); if (s2 < wave) c = q.x * c + q.y; }
#pragma unroll
                for (int e = 0; e < 16; ++e) { const int i = wave * 16 + e; const int tok = dir ? 127 - i : i; *(LAS f32x2l*)(AU + (tok * 68 + lane) * 2) = (f32x2l){p[e].x, p[e].y + p[e].x * c}; }
                if (wave == 7) HC[((s + 1) & 1) * 64 + lane] = p[15].y + p[15].x * c;
            }
            __syncthreads();
#pragma unroll
            for (int hh = 0; hh < 2; ++hh) {
                const LAS f32x4* hq = (const LAS f32x4*)(AU + ((64 * hh + tokA) * 68 + c8A) * 2);
                const f32x4 q0 = hq[0], q1 = hq[1], q2 = hq[2], q3 = hq[3];
                u32x4 w; w.x = pk2(q0[1], q0[3]); w.y = pk2(q1[1], q1[3]); w.z = pk2(q2[1], q2[3]); w.w = pk2(q3[1], q3[3]);
                *(u32x4*)(HX + (size_t)(row_base + t0 + 64 * hh + tokA) * D + blk * 64 + c8A) = w;
            }
        }
#undef LRU_FETCH
        if (!lat && tid < 64) a.out[(size_t)M * D + (size_t)(b * 2 + dir) * 1024 + blk * 64 + tid] = HC[(nst & 1) * 64 + tid];
        __syncthreads();
    }
}

constexpr size_t WS_DEC = 6656 * 1024;
__device__ __forceinline__ void gla_prep(const Args& a, LAS unsigned char* lds, int tid, bf16* ewd, const bf16* ewa, const bf16* ewb) {
    LAS float* LRS = (LAS float*)lds;
    const float* LR = (const float*)(a.ws + WS_LR);
    bf16* EFb = (bf16*)a.out; bf16* EBb = EFb + (size_t)M * 512;
    float* DECg = (float*)(a.ws + WS_DEC);
    const size_t ew_n = (size_t)M * D / 8, ew_stride = (size_t)gridDim.x * 512; size_t ew_i = (size_t)blockIdx.x * 512 + tid;
    for (int it = blockIdx.x; it < 640; it += gridDim.x) {
        const int gc = it >> 1, dir = it & 1; const bool lat = gc >= 64; const int g2 = lat ? gc - 64 : gc;
        const int b = lat ? (g2 >> 5) : (g2 >> 2), cn = lat ? (g2 & 31) : (g2 & 3), p0 = cn * 64;
        const int row_base = lat ? MP + b * 2048 : b * 256;
        bf16* Eb = dir ? EBb : EFb;
        float w2r[16];
#pragma unroll
        for (int r = 0; r < 16; ++r) w2r[r] = a.in[18][(size_t)(dir * 16 + r) * 512 + tid];
        const float b2v = a.in[19][dir * 512 + tid];
        __syncthreads();
        if (tid < 256) { const int i = tid >> 2; const int p_ = dir ? p0 + 63 - i : p0 + i; const int row = lat ? row_base + (p_ & 31) * 64 + (p_ >> 5) : row_base + p_;
            *(LAS f32x4*)(LRS + i * 16 + (tid & 3) * 4) = *(const f32x4*)(LR + (size_t)row * 32 + dir * 16 + (tid & 3) * 4); }
        __syncthreads();
        float run = 0.f;
#pragma unroll 1
        for (int i8 = 0; i8 < 64; i8 += 8) {
            const bool ew_on = ew_i < ew_n; u32x4 ex0 = {0u, 0u, 0u, 0u}, ex1 = ex0, ey0 = ex0;
            if (ew_on) { ex0 = ((const u32x4*)ewa)[ew_i]; ex1 = ((const u32x4*)ewb)[ew_i]; ey0 = ((const u32x4*)ewd)[ew_i]; }
#pragma unroll
            for (int i7 = 0; i7 < 8; ++i7) { const int i = i8 + i7; const int p_ = dir ? p0 + 63 - i : p0 + i; const int row = lat ? row_base + (p_ & 31) * 64 + (p_ >> 5) : row_base + p_;
                const LAS f32x4* lrp = (const LAS f32x4*)(LRS + i * 16);
                const f32x4 l0 = lrp[0], l1 = lrp[1], l2 = lrp[2], l3 = lrp[3];
                float x = b2v;
                x += l0[0] * w2r[0]; x += l0[1] * w2r[1]; x += l0[2] * w2r[2]; x += l0[3] * w2r[3];
                x += l1[0] * w2r[4]; x += l1[1] * w2r[5]; x += l1[2] * w2r[6]; x += l1[3] * w2r[7];
                x += l2[0] * w2r[8]; x += l2[1] * w2r[9]; x += l2[2] * w2r[10]; x += l2[3] * w2r[11];
                x += l3[0] * w2r[12]; x += l3[1] * w2r[13]; x += l3[2] * w2r[14]; x += l3[3] * w2r[15];
                run += (fminf(x, 0.f) - logf_(1.0f + expf_(-fabsf(x)))) * 0.0625f;
                Eb[(size_t)row * 512 + tid] = (bf16)(pk2(expf_(run), 0.f) & 0xffffu); }
            if (ew_on) { u32x4 o;
#pragma unroll
                for (int e = 0; e < 4; ++e) o[e] = pk2((bflo(ex0[e]) + bflo(ex1[e])) * bflo(ey0[e]), (bfhi(ex0[e]) + bfhi(ex1[e])) * bfhi(ey0[e]));
                ((u32x4*)ewd)[ew_i] = o; ew_i += ew_stride; }
        }
        DECg[((size_t)dir * 320 + gc) * 512 + tid] = expf_(run);
    }
    for (; ew_i < ew_n; ew_i += ew_stride) { const u32x4 ex0 = ((const u32x4*)ewa)[ew_i], ex1 = ((const u32x4*)ewb)[ew_i], ey0 = ((const u32x4*)ewd)[ew_i]; u32x4 o;
#pragma unroll
        for (int e = 0; e < 4; ++e) o[e] = pk2((bflo(ex0[e]) + bflo(ex1[e])) * bflo(ey0[e]), (bfhi(ex0[e]) + bfhi(ex1[e])) * bfhi(ey0[e]));
        ((u32x4*)ewd)[ew_i] = o; }
}

__device__ __forceinline__ void gla_phase(const Args& a, LAS unsigned char* lds, int tid, int lane, int wave) {
    LAS bf16* QEA = (LAS bf16*)lds;
    LAS bf16* QEB = QEA + 64 * 136;
    LAS bf16* KE = QEB + 64 * 136;
    LAS bf16* STA = KE + 64 * 136;
    LAS bf16* STB = STA + 64 * 136;
    LAS bf16* KT = STB + 64 * 136;
    LAS bf16* VTA = KT + 128 * 72;
    LAS bf16* VTB = VTA + 64 * 72;
    LAS bf16* PP = VTB + 64 * 72;
    LAS float* DECA = (LAS float*)(PP + 64 * 72);
    LAS float* DECB = DECA + 128;
    const unsigned char* ws = a.ws;
    const bf16* EFb = (const bf16*)a.out; const bf16* EBb = EFb + (size_t)M * 512;
    const float* DECg = (const float*)(ws + WS_DEC);
    const bf16* Qb = (const bf16*)(ws + WS_S0 + 3 * SLOT); const bf16* Kb = Qb + (size_t)M * 512;
    const bf16* Vb = (const bf16*)(ws + WS_S0 + 4 * SLOT);
    bf16* OFb = (bf16*)(a.ws + WS_S0 + 2 * SLOT); bf16* OBb = (bf16*)(a.ws + WS_S0);
    const int ch = tid & 127, sub = __builtin_amdgcn_readfirstlane(tid >> 7);
    const int col = lane & 15, quad = lane >> 4, kt = wave;
    float* SG = a.out + (size_t)M * D + 16 * 2 * 1024;
    const int vcu = (gridDim.x % 8 == 0) ? (int)(blockIdx.x % 8) * (int)(gridDim.x / 8) + (int)(blockIdx.x / 8) : (int)blockIdx.x;
    for (int u = vcu; u < 768; u += gridDim.x) {
        const bool lat = u < 256; const int v = lat ? u : u - 256; const int b = v >> 5, hd = (v >> 3) & 3, dir = (v >> 2) & 1, sl = v & 3;
        const int row_base = lat ? MP + b * 2048 : b * 256, nch = lat ? 32 : 4, gc0 = lat ? 64 + b * 32 : b * 4;
        bf16* Ob = dir ? OBb : OFb; const bf16* Eb = dir ? EBb : EFb;
        f32x4 S[4];
#pragma unroll
        for (int vt = 0; vt < 4; ++vt)
#pragma unroll
            for (int j = 0; j < 4; ++j)
                S[vt][j] = lat ? a.in[3][((((size_t)(b * 2 + dir) * 4 + hd) * 128 + 16 * kt + quad * 4 + j) * 256) + sl * 64 + 16 * vt + col] : 0.f;
#define GROWP(p0_, i) ({ const int p_ = dir ? (p0_) + 63 - (i) : (p0_) + (i); lat ? row_base + (p_ & 31) * 64 + (p_ >> 5) : row_base + p_; })
        u32x4 QgA[2], KgA[2], EgA[2], VgA, QgB[2], KgB[2], EgB[2], VgB; f32x2 etgA, etgB;
#define GLA_FETCH(X, cn_) do { const int p0_ = (cn_) * 64; \
            _Pragma("unroll") for (int e_ = 0; e_ < 2; ++e_) { const int pc_ = tid + e_ * 512; const size_t ro_ = (size_t)GROWP(p0_, pc_ >> 4) * 512 + hd * 128 + (pc_ & 15) * 8; \
                Qg##X[e_] = *(const u32x4*)(Qb + ro_); Kg##X[e_] = *(const u32x4*)(Kb + ro_); Eg##X[e_] = *(const u32x4*)(Eb + ro_); } \
            Vg##X = *(const u32x4*)(Vb + (size_t)GROWP(p0_, tid & 63) * D + hd * 256 + sl * 64 + (tid >> 6) * 8); \
            etg##X = *(const f32x2*)(DECg + ((size_t)dir * 320 + gc0 + (cn_)) * 512 + hd * 128 + 2 * lane); } while (0)
#define GLA_CHUNK(X, n) do { const int cn = dir ? nch - 1 - (n) : (n), p0 = cn * 64; \
_Pragma("unroll") \
            for (int vt = 0; vt < 4; ++vt) { u32x2 w; w.x = pk2(S[vt][0], S[vt][1]); w.y = pk2(S[vt][2], S[vt][3]); \
                *(LAS u32x2*)(ST##X + (16 * vt + col) * 136 + 16 * kt + quad * 4) = w; } \
_Pragma("unroll") \
            for (int e = 0; e < 2; ++e) { const int pc = tid + e * 512, o_ = (pc >> 4) * 136 + (pc & 15) * 8; \
                  \
                const u32x4 qr = Qg##X[e], kr = Kg##X[e], er = Eg##X[e]; u32x4 qo, ko; \
_Pragma("unroll") \
                for (int d_ = 0; d_ < 4; ++d_) { const float E0 = bflo(er[d_]), E1 = bfhi(er[d_]); const float R0 = rcpf_(E0), R1 = rcpf_(E1); \
                    qo[d_] = pk2(bflo(qr[d_]) * E0 * 0.08838834764831845f, bfhi(qr[d_]) * E1 * 0.08838834764831845f); \
                    ko[d_] = pk2(bflo(kr[d_]) * R0, bfhi(kr[d_]) * R1); } \
                *(LAS u32x4*)(QE##X + o_) = qo; *(LAS u32x4*)(KE + o_) = ko; } \
            {   const int i = tid & 63, v8 = (tid >> 6) * 8; const u32x4 z = Vg##X; \
                VT##X[(v8 + 0) * 72 + i] = (bf16)(z.x & 0xffffu); VT##X[(v8 + 1) * 72 + i] = (bf16)(z.x >> 16); \
                VT##X[(v8 + 2) * 72 + i] = (bf16)(z.y & 0xffffu); VT##X[(v8 + 3) * 72 + i] = (bf16)(z.y >> 16); \
                VT##X[(v8 + 4) * 72 + i] = (bf16)(z.z & 0xffffu); VT##X[(v8 + 5) * 72 + i] = (bf16)(z.z >> 16); \
                VT##X[(v8 + 6) * 72 + i] = (bf16)(z.w & 0xffffu); VT##X[(v8 + 7) * 72 + i] = (bf16)(z.w >> 16); } \
            const f32x2 etot = etg##X; \
            if (wave == 0) *(LAS f32x2*)(DEC##X + 2 * lane) = etot; \
            __syncthreads(); \
            if ((n) + 2 < nch) GLA_FETCH(X, dir ? nch - 3 - (n) : (n) + 2); \
            {     \
                unsigned kw_[8]; \
_Pragma("unroll") \
                for (int e = 0; e < 8; ++e) kw_[e] = *(const LAS unsigned*)(KE + (wave * 8 + e) * 136 + 2 * lane); \
                u32x4 w0, w1; \
                w0.x = pk2(bflo(kw_[0]) * etot.x, bflo(kw_[1]) * etot.x); w0.y = pk2(bflo(kw_[2]) * etot.x, bflo(kw_[3]) * etot.x); w0.z = pk2(bflo(kw_[4]) * etot.x, bflo(kw_[5]) * etot.x); w0.w = pk2(bflo(kw_[6]) * etot.x, bflo(kw_[7]) * etot.x); \
                w1.x = pk2(bfhi(kw_[0]) * etot.y, bfhi(kw_[1]) * etot.y); w1.y = pk2(bfhi(kw_[2]) * etot.y, bfhi(kw_[3]) * etot.y); w1.z = pk2(bfhi(kw_[4]) * etot.y, bfhi(kw_[5]) * etot.y); w1.w = pk2(bfhi(kw_[6]) * etot.y, bfhi(kw_[7]) * etot.y); \
                *(LAS u32x4*)(KT + (2 * lane) * 72 + wave * 8) = w0; *(LAS u32x4*)(KT + (2 * lane + 1) * 72 + wave * 8) = w1; } \
              \
            {     \
                const int st = wave >> 1, ct0 = 2 * (wave & 1); \
                f32x4 acc0 = {0.f, 0.f, 0.f, 0.f}, acc1 = {0.f, 0.f, 0.f, 0.f}; \
                if (st <= ct0 + 1) { \
_Pragma("unroll") \
                    for (int kk = 0; kk < 4; ++kk) { const bf16x8 ak = *(const LAS bf16x8*)(KE + (16 * st + col) * 136 + kk * 32 + quad * 8); \
                        if (st <= ct0) { const bf16x8 bq0 = *(const LAS bf16x8*)(QE##X + (16 * ct0 + col) * 136 + kk * 32 + quad * 8); acc0 = __builtin_amdgcn_mfma_f32_16x16x32_bf16(ak, bq0, acc0, 0, 0, 0); } \
                        const bf16x8 bq1 = *(const LAS bf16x8*)(QE##X + (16 * (ct0 + 1) + col) * 136 + kk * 32 + quad * 8); acc1 = __builtin_amdgcn_mfma_f32_16x16x32_bf16(ak, bq1, acc1, 0, 0, 0); } \
                } \
_Pragma("unroll") \
                for (int j = 0; j < 4; ++j) { if (16 * st + quad * 4 + j > 16 * ct0 + col) acc0[j] = 0.f; if (16 * st + quad * 4 + j > 16 * (ct0 + 1) + col) acc1[j] = 0.f; } \
                u32x2 w0, w1; w0.x = pk2(acc0[0], acc0[1]); w0.y = pk2(acc0[2], acc0[3]); w1.x = pk2(acc1[0], acc1[1]); w1.y = pk2(acc1[2], acc1[3]); \
                *(LAS u32x2*)(PP + (16 * ct0 + col) * 72 + 16 * st + quad * 4) = w0; *(LAS u32x2*)(PP + (16 * (ct0 + 1) + col) * 72 + 16 * st + quad * 4) = w1; \
            } \
            __syncthreads(); \
            {     \
                const int vt_ = wave >> 1, ct0 = 2 * (wave & 1); \
                bf16x8 av[2], as_[4]; \
_Pragma("unroll") \
                for (int ks = 0; ks < 2; ++ks) av[ks] = *(const LAS bf16x8*)(VT##X + (16 * vt_ + col) * 72 + ks * 32 + quad * 8); \
_Pragma("unroll") \
                for (int kk = 0; kk < 4; ++kk) as_[kk] = *(const LAS bf16x8*)(ST##X + (16 * vt_ + col) * 136 + kk * 32 + quad * 8); \
                f32x4 acc0 = {0.f, 0.f, 0.f, 0.f}, acc1 = {0.f, 0.f, 0.f, 0.f}; \
_Pragma("unroll") \
                for (int ks = 0; ks < 2; ++ks) { const bf16x8 bp0 = *(const LAS bf16x8*)(PP + (16 * ct0 + col) * 72 + ks * 32 + quad * 8), bp1 = *(const LAS bf16x8*)(PP + (16 * (ct0 + 1) + col) * 72 + ks * 32 + quad * 8); \
                    acc0 = __builtin_amdgcn_mfma_f32_16x16x32_bf16(av[ks], bp0, acc0, 0, 0, 0); acc1 = __builtin_amdgcn_mfma_f32_16x16x32_bf16(av[ks], bp1, acc1, 0, 0, 0); } \
_Pragma("unroll") \
                for (int kk = 0; kk < 4; ++kk) { const bf16x8 bq0 = *(const LAS bf16x8*)(QE##X + (16 * ct0 + col) * 136 + kk * 32 + quad * 8), bq1 = *(const LAS bf16x8*)(QE##X + (16 * (ct0 + 1) + col) * 136 + kk * 32 + quad * 8); \
                    acc0 = __builtin_amdgcn_mfma_f32_16x16x32_bf16(as_[kk], bq0, acc0, 0, 0, 0); acc1 = __builtin_amdgcn_mfma_f32_16x16x32_bf16(as_[kk], bq1, acc1, 0, 0, 0); } \
                const int row0 = GROWP(p0, 16 * ct0 + col), row1 = GROWP(p0, 16 * (ct0 + 1) + col); \
                u32x2 w0, w1; w0.x = pk2(acc0[0], acc0[1]); w0.y = pk2(acc0[2], acc0[3]); w1.x = pk2(acc1[0], acc1[1]); w1.y = pk2(acc1[2], acc1[3]); \
                *(u32x2*)(Ob + (size_t)row0 * D + hd * 256 + sl * 64 + 16 * vt_ + quad * 4) = w0; *(u32x2*)(Ob + (size_t)row1 * D + hd * 256 + sl * 64 + 16 * vt_ + quad * 4) = w1; \
                bf16x8 ak[2]; \
_Pragma("unroll") \
                for (int ks = 0; ks < 2; ++ks) ak[ks] = *(const LAS bf16x8*)(KT + (16 * kt + col) * 72 + ks * 32 + quad * 8); \
                float dk[4]; \
_Pragma("unroll") \
                for (int j = 0; j < 4; ++j) dk[j] = DEC##X[16 * kt + quad * 4 + j]; \
_Pragma("unroll") \
                for (int vt = 0; vt < 4; ++vt) { \
_Pragma("unroll") \
                    for (int j = 0; j < 4; ++j) S[vt][j] *= dk[j]; \
_Pragma("unroll") \
                    for (int ks = 0; ks < 2; ++ks) { const bf16x8 bv = *(const LAS bf16x8*)(VT##X + (16 * vt + col) * 72 + ks * 32 + quad * 8); \
                        S[vt] = __builtin_amdgcn_mfma_f32_16x16x32_bf16(ak[ks], bv, S[vt], 0, 0, 0); } } \
            } \
        } while (0)
        GLA_FETCH(A, dir ? nch - 1 : 0); GLA_FETCH(B, dir ? nch - 2 : 1);
        for (int n = 0; n < nch; n += 2) { GLA_CHUNK(A, n); GLA_CHUNK(B, n + 1); }
#undef GLA_CHUNK
#undef GLA_FETCH
#undef GROWP
        if (!lat) {
#pragma unroll
            for (int vt = 0; vt < 4; ++vt)
#pragma unroll
                for (int j = 0; j < 4; ++j)
                    SG[((((size_t)(b * 2 + dir) * 4 + hd) * 128 + 16 * kt + quad * 4 + j) * 256) + sl * 64 + 16 * vt + col] = S[vt][j];
        }
    }
}

template <int MODE> __device__ __forceinline__ void ew_pass(bf16* dst, const bf16* a0, const bf16* b0, const bf16* a1, const bf16* b1, int tid) {
    const size_t nvec = (size_t)M * D / 8;
    for (size_t i = (size_t)blockIdx.x * 512 + tid; i < nvec; i += (size_t)gridDim.x * 512) {
        const u32x4 x0 = ((const u32x4*)a0)[i], y0 = ((const u32x4*)b0)[i], x1 = ((const u32x4*)a1)[i];
        u32x4 o;
        if (MODE == 0) {
#pragma unroll
            for (int e = 0; e < 4; ++e) o[e] = pk2((bflo(x0[e]) + bflo(x1[e])) * bflo(y0[e]), (bfhi(x0[e]) + bfhi(x1[e])) * bfhi(y0[e]));
        } else {
            const u32x4 y1 = ((const u32x4*)b1)[i];
#pragma unroll
            for (int e = 0; e < 4; ++e) o[e] = pk2(bflo(x0[e]) * bflo(y0[e]) + bflo(x1[e]) * bflo(y1[e]), bfhi(x0[e]) * bfhi(y0[e]) + bfhi(x1[e]) * bfhi(y1[e]));
        }
        ((u32x4*)dst)[i] = o;
    }
}
__device__ __forceinline__ void post_gla(const Args& a, int lane, int wave) {
    const bf16* OFb = (const bf16*)(a.ws + WS_S0 + 2 * SLOT); const bf16* OBb = (const bf16*)(a.ws + WS_S0);
    bf16* G = (bf16*)(a.ws + WS_S0 + 1 * SLOT);
    const f32x4 gn0 = *(const f32x4*)(a.in[20] + 8 * (lane & 31)), gn1 = *(const f32x4*)(a.in[20] + 8 * (lane & 31) + 4);
    const int stride = gridDim.x * 8; int m = blockIdx.x * 8 + wave;
    u32x4 cf[2], cb[2], cg[2];
    if (m < M) {
#pragma unroll
        for (int q = 0; q < 2; ++q) { const size_t off = (size_t)m * D + 8 * (lane + 64 * q); cf[q] = *(const u32x4*)(OFb + off); cb[q] = *(const u32x4*)(OBb + off); cg[q] = *(const u32x4*)(G + off); } }
    for (; m < M; m += stride) {
        u32x4 nf[2], nb[2], ng_[2]; const int mn = m + stride;
#pragma unroll
        for (int q = 0; q < 2; ++q) { nf[q] = cf[q]; nb[q] = cb[q]; ng_[q] = cg[q]; }
        if (mn < M) {
#pragma unroll
            for (int q = 0; q < 2; ++q) { const size_t off = (size_t)mn * D + 8 * (lane + 64 * q); nf[q] = *(const u32x4*)(OFb + off); nb[q] = *(const u32x4*)(OBb + off); ng_[q] = *(const u32x4*)(G + off); } }
#pragma unroll
        for (int q = 0; q < 2; ++q) { const size_t off = (size_t)m * D + 8 * (lane + 64 * q);
            float o[8]; float ss = 0.f;
#pragma unroll
            for (int e = 0; e < 4; ++e) { o[2 * e] = bflo(cf[q][e]) + bflo(cb[q][e]); o[2 * e + 1] = bfhi(cf[q][e]) + bfhi(cb[q][e]); ss += o[2 * e] * o[2 * e] + o[2 * e + 1] * o[2 * e + 1]; }
#pragma unroll
            for (int x = 1; x < 32; x <<= 1) ss += __shfl_xor(ss, x);
            const float rstd = rsqrtf(ss * (1.f / 256.f) + EPS);
            u32x4 w;
            w.x = pk2(o[0] * rstd * gn0[0] * siluf_(bflo(cg[q].x)), o[1] * rstd * gn0[1] * siluf_(bfhi(cg[q].x)));
            w.y = pk2(o[2] * rstd * gn0[2] * siluf_(bflo(cg[q].y)), o[3] * rstd * gn0[3] * siluf_(bfhi(cg[q].y)));
            w.z = pk2(o[4] * rstd * gn1[0] * siluf_(bflo(cg[q].z)), o[5] * rstd * gn1[1] * siluf_(bfhi(cg[q].z)));
            w.w = pk2(o[6] * rstd * gn1[2] * siluf_(bflo(cg[q].w)), o[7] * rstd * gn1[3] * siluf_(bfhi(cg[q].w)));
            *(u32x4*)(G + off) = w; }
#pragma unroll
        for (int q = 0; q < 2; ++q) { cf[q] = nf[q]; cb[q] = nb[q]; cg[q] = ng_[q]; }
    }
}
struct SplitRow { u32x4 o[2]; u32x4 p[3][2]; };
__device__ __forceinline__ void split_row_load(SplitRow& r, const bf16* O, const bf16* P, int m, int lane) {
#pragma unroll
    for (int q = 0; q < 2; ++q) r.o[q] = *(const u32x4*)(O + (size_t)m * D + 8 * (lane + 64 * q));
    if (m >= 16384) {
#pragma unroll
        for (int k = 0; k < 3; ++k)
#pragma unroll
            for (int q = 0; q < 2; ++q) r.p[k][q] = *(const u32x4*)(P + ((size_t)k * 4096 + (m - 16384)) * D + 8 * (lane + 64 * q)); }
}
__device__ __forceinline__ f32x4 split_row_val(const SplitRow& r, int m, int i) {
    const int q = i >> 1, h = i & 1;
    const unsigned w0 = r.o[q][2 * h], w1 = r.o[q][2 * h + 1];
    f32x4 v; v[0] = bflo(w0); v[1] = bfhi(w0); v[2] = bflo(w1); v[3] = bfhi(w1);
    if (m >= 16384) {
#pragma unroll
        for (int k = 0; k < 3; ++k) { const unsigned p0 = r.p[k][q][2 * h], p1 = r.p[k][q][2 * h + 1]; v[0] += bflo(p0); v[1] += bfhi(p0); v[2] += bflo(p1); v[3] += bfhi(p1); } }
    return v;
}
__device__ __forceinline__ void x1_pass(const Args& a, int lane, int wave) {
    const float* MOD = (const float*)(a.ws + WS_MOD); const float* ng = a.in[8];
    const bf16* Mm = (const bf16*)(a.ws + WS_S0 + 2 * SLOT); const bf16* Pm = (const bf16*)(a.ws + WS_S0 + 4 * SLOT); bf16* H2 = (bf16*)(a.ws + WS_S0);
    const int stride = gridDim.x * 8; int m = blockIdx.x * 8 + wave;
    SplitRow cur; f32x4 xc[4];
    if (m < M) { split_row_load(cur, Mm, Pm, m, lane); const f32x4* xr = (const f32x4*)xrow(a, m);
#pragma unroll
        for (int q = 0; q < 2; ++q) { xc[2 * q] = xr[2 * (lane + 64 * q)]; xc[2 * q + 1] = xr[2 * (lane + 64 * q) + 1]; } }
    for (; m < M; m += stride) {
        SplitRow nxt = cur; f32x4 xn[4]; const int mn = m + stride;
#pragma unroll
        for (int q = 0; q < 4; ++q) xn[q] = xc[q];
        if (mn < M) { split_row_load(nxt, Mm, Pm, mn, lane); const f32x4* xr = (const f32x4*)xrow(a, mn);
#pragma unroll
            for (int q = 0; q < 2; ++q) { xn[2 * q] = xr[2 * (lane + 64 * q)]; xn[2 * q + 1] = xr[2 * (lane + 64 * q) + 1]; } }
        const float* md = MOD + modgrp(m) * 6144;
        f32x4 mv[4]; float s1 = 0.f;
#pragma unroll
        for (int i = 0; i < 4; ++i) { mv[i] = split_row_val(cur, m, i); s1 += (mv[i][0] * mv[i][0] + mv[i][1] * mv[i][1]) + (mv[i][2] * mv[i][2] + mv[i][3] * mv[i][3]); }
        const float rstd1 = rsqrtf(wave_sum(s1) * (1.f / D) + EPS);
        f32x4 v[4]; float s = 0.f;
#pragma unroll
        for (int i = 0; i < 4; ++i) { const int c = 8 * (lane + 64 * (i >> 1)) + 4 * (i & 1);
            const f32x4 g1 = *(const f32x4*)(md + 2048 + c), n1 = *(const f32x4*)(ng + 1024 + c);
            v[i] = xc[i] + g1 * (mv[i] * rstd1 * n1);
            *(f32x4*)(a.out + (size_t)m * D + c) = v[i];
            s += (v[i][0] * v[i][0] + v[i][1] * v[i][1]) + (v[i][2] * v[i][2] + v[i][3] * v[i][3]); }
        const float rstd = rsqrtf(wave_sum(s) * (1.f / D) + EPS);
#pragma unroll
        for (int q = 0; q < 2; ++q) { const int c = 8 * (lane + 64 * q); u32x4 w;
#pragma unroll
            for (int h = 0; h < 2; ++h) { const int cc = c + 4 * h;
                const f32x4 g = *(const f32x4*)(ng + 2048 + cc), sh = *(const f32x4*)(md + 3072 + cc), sc = *(const f32x4*)(md + 4096 + cc);
                const f32x4 r = v[2 * q + h] * rstd * g * (sc + 1.0f) + sh;
                w[2 * h] = pk2(r[0], r[1]); w[2 * h + 1] = pk2(r[2], r[3]); }
            *(u32x4*)(H2 + (size_t)m * D + c) = w; }
        cur = nxt;
#pragma unroll
        for (int q = 0; q < 4; ++q) xc[q] = xn[q];
    }
}
__device__ __forceinline__ void fin_pass(const Args& a, int lane, int wave) {
    const float* MOD = (const float*)(a.ws + WS_MOD); const float* ng = a.in[8];
    const bf16* F = (const bf16*)(a.ws + WS_S0); const bf16* Pf = (const bf16*)(a.ws + WS_WL);
    const int stride = gridDim.x * 8; int m = blockIdx.x * 8 + wave;
    SplitRow cur; f32x4 yc[4];
    if (m < M) { split_row_load(cur, F, Pf, m, lane); const f32x4* yr = (const f32x4*)(a.out + (size_t)m * D);
#pragma unroll
        for (int q = 0; q < 2; ++q) { yc[2 * q] = yr[2 * (lane + 64 * q)]; yc[2 * q + 1] = yr[2 * (lane + 64 * q) + 1]; } }
    for (; m < M; m += stride) {
        SplitRow nxt = cur; f32x4 yn[4]; const int mn = m + stride;
#pragma unroll
        for (int q = 0; q < 4; ++q) yn[q] = yc[q];
        if (mn < M) { split_row_load(nxt, F, Pf, mn, lane); const f32x4* yr = (const f32x4*)(a.out + (size_t)mn * D);
#pragma unroll
            for (int q = 0; q < 2; ++q) { yn[2 * q] = yr[2 * (lane + 64 * q)]; yn[2 * q + 1] = yr[2 * (lane + 64 * q) + 1]; } }
        const float* md = MOD + modgrp(m) * 6144;
        f32x4 fv[4]; float s = 0.f;
#pragma unroll
        for (int i = 0; i < 4; ++i) { fv[i] = split_row_val(cur, m, i); s += (fv[i][0] * fv[i][0] + fv[i][1] * fv[i][1]) + (fv[i][2] * fv[i][2] + fv[i][3] * fv[i][3]); }
        const float rstd = rsqrtf(wave_sum(s) * (1.f / D) + EPS);
#pragma unroll
        for (int i = 0; i < 4; ++i) { const int c = 8 * (lane + 64 * (i >> 1)) + 4 * (i & 1);
            const f32x4 g2 = *(const f32x4*)(md + 5120 + c), n3 = *(const f32x4*)(ng + 3072 + c);
            *(f32x4*)(a.out + (size_t)m * D + c) = yc[i] + g2 * (fv[i] * rstd * n3); }
        cur = nxt;
#pragma unroll
        for (int q = 0; q < 4; ++q) yc[q] = yn[q];
    }
}

constexpr int NPHASE = 14;
__global__ void __launch_bounds__(512, 2) mk_fwd(Args a) {
    extern __shared__ __attribute__((aligned(16))) unsigned char lds_raw[];
    LAS unsigned char* lds = (LAS unsigned char*)lds_raw;
    cg::grid_group grid = cg::this_grid();
    const int tid = threadIdx.x, lane = tid & 63, wave = __builtin_amdgcn_readfirstlane(tid >> 6);
    const int lo = a.ph_lo, hi = a.ph_hi, G = gridDim.x;
    volatile LAS unsigned* MISC = (volatile LAS unsigned*)(lds + LDS_BYTES - 64);
    if (tid < 16) MISC[tid] = 0u;
    __syncthreads();
    const XcdBarrier bar = xcd_barrier_post((unsigned*)(a.ws + WS_BAR), MISC);
    unsigned char* ws = a.ws;
    bf16* S0 = (bf16*)(ws + WS_S0); bf16* S1 = (bf16*)(ws + WS_S0 + SLOT); bf16* S2 = (bf16*)(ws + WS_S0 + 2 * SLOT);
    bf16* S3 = (bf16*)(ws + WS_S0 + 3 * SLOT); bf16* S4 = (bf16*)(ws + WS_S0 + 4 * SLOT);
    bf16* D0 = (bf16*)a.out; bf16* D1 = D0 + (size_t)M * D;
#ifndef MK_MASK
#define MK_MASK 0x3fff
#endif
#define IN(k) (((MK_MASK >> (k)) & 1) && lo <= (k) && (k) < hi)
#define SEAM(k) do { if (IN(k) && IN((k) + 1)) xcd_barrier(bar); } while (0)
    if (lo < 0) grid.sync();
    if (IN(0)) { phase0(a, lds, tid, lane, wave); } SEAM(0);
    if (IN(1)) { phase1(a, S0, lane, wave); } SEAM(1);
    if (IN(2)) {
        pg8::Gemm g{S0, (const bf16*)(ws + WS_WL), M, 5376, 1024, S0, S0, 1 << 30, 1 << 30, 1024}; pg8::StaticOrder S; S.init(M, 5376, G, (int)blockIdx.x);
        EpiLG E{D0, D1, (float*)(ws + WS_LR), S3, S3 + (size_t)M * 512, S4, S1};
        pg8::gemm_phase<EpiLG, pg8::StaticOrder, true, true>(lds, g, S, E);
    } SEAM(2);
    if (IN(3)) { lru_phase(a, lds, tid, lane, wave); } SEAM(3);
    if (IN(4)) {
        gla_prep(a, lds, tid, D1, S2, S0);
    } SEAM(4);
    if (IN(5)) { gla_phase(a, lds, tid, lane, wave); } SEAM(5);
    if (IN(6)) { post_gla(a, lane, wave); phase1(a, S3, lane, wave); } SEAM(6);
    if (IN(7)) {
        pg8::Gemm g{D1, (const bf16*)(ws + WS_WY) + (size_t)2048 * 1024, M, 2048, 1024, S1, S1, 4, 1 << 30, 1024}; pg8::StaticOrder S; S.init(M, 2048, G, (int)blockIdx.x);
        EpiYY E{S4, D0};
        pg8::gemm_phase<EpiYY, pg8::StaticOrder, true, true>(lds, g, S, E);
    } SEAM(7);
    if (IN(8)) {
        pg8::Gemm g{S3, (const bf16*)(ws + WS_WY), M, 2048, 1024, S3, S3, 1 << 30, 1 << 30, 1024}; pg8::StaticOrder S; S.init(M, 2048, G, (int)blockIdx.x);
        EpiMM E{S4, D0, S0};
        pg8::gemm_phase<EpiMM, pg8::StaticOrder, true, true>(lds, g, S, E);
    } SEAM(8);
    if (IN(9)) {
        { pg8::Gemm g{S0, (const bf16*)(ws + WS_WO), 16384, 1024, 1024, S0, S0, 1 << 30, 1 << 30, 1024}; pg8::StaticOrder S; S.init(16384, 1024, G, (int)blockIdx.x);
          EpiS E{S2, S4, 64}; pg8::gemm_phase<EpiS, pg8::StaticOrder, true, true>(lds, g, S, E); }
        { pg8::Gemm g{S0, (const bf16*)(ws + WS_WO), M, 1024, 256, S0, S0, 1 << 30, 1 << 30, 1024}; SplitOrder S{64, G, (int)blockIdx.x};
          EpiS E{S2, S4, 64}; pg8::gemm_phase<EpiS, SplitOrder, true, true>(lds, g, S, E); }
    } SEAM(9);
    if (IN(10)) { x1_pass(a, lane, wave); } SEAM(10);
    if (IN(11)) {
        pg8::Gemm g{S0, (const bf16*)(ws + WS_W1), M, 4096, 1024, S0, S0, 1 << 30, 1 << 30, 1024}; pg8::StaticOrder S; S.init(M, 4096, G, (int)blockIdx.x);
        EpiH E{S1};
        pg8::gemm_phase<EpiH, pg8::StaticOrder, true, true>(lds, g, S, E);
    } SEAM(11);
    if (IN(12)) {
        { pg8::Gemm g{S1, (const bf16*)(ws + WS_W2), 16384, 1024, 4096, S1, S1, 1 << 30, 1 << 30, 4096}; pg8::StaticOrder S; S.init(16384, 1024, G, (int)blockIdx.x);
          EpiS E{S0, (bf16*)(ws + WS_WL), 64}; pg8::gemm_phase<EpiS, pg8::StaticOrder, true, true>(lds, g, S, E); }
        { pg8::Gemm g{S1, (const bf16*)(ws + WS_W2), M, 1024, 1024, S1, S1, 1 << 30, 1 << 30, 4096}; SplitOrder S{64, G, (int)blockIdx.x};
          EpiS E{S0, (bf16*)(ws + WS_WL), 64}; pg8::gemm_phase<EpiS, SplitOrder, true, true>(lds, g, S, E); }
    } SEAM(12);
    if (IN(13)) { fin_pass(a, lane, wave); }
#undef IN
#undef SEAM
}

extern "C" void kernel_launch(void* const* d_in, const int* in_sizes, int n_in, void* d_out, int out_size, void* d_ws, size_t ws_size, hipStream_t stream) {
    static int grid = 0;
    if (grid == 0) {
        if (n_in != 25 || ws_size < WS_END) { fprintf(stderr, "kernel_launch: unexpected n_in %d / ws %zu\n", n_in, ws_size); grid = -1; return; }
        int dev = 0, cus = 0, per_cu = 0;
        hipGetDevice(&dev); hipDeviceGetAttribute(&cus, hipDeviceAttributeMultiprocessorCount, dev);
        if (hipFuncSetAttribute((const void*)mk_fwd, hipFuncAttributeMaxDynamicSharedMemorySize, LDS_BYTES) != hipSuccess) { fprintf(stderr, "kernel_launch: hipFuncSetAttribute failed\n"); grid = -1; return; }
        if (hipOccupancyMaxActiveBlocksPerMultiprocessor(&per_cu, (const void*)mk_fwd, 512, LDS_BYTES) != hipSuccess || per_cu < 1) { fprintf(stderr, "kernel_launch: occupancy query says %d\n", per_cu); per_cu = 1; }
        (void)hipGetLastError();
        grid = cus * 1;
    }
    if (grid < 0) return;
    if (hipMemsetAsync((char*)d_ws + WS_BAR, 0, WS_BAR_BYTES, stream) != hipSuccess) { fprintf(stderr, "kernel_launch: memset failed\n"); return; }
    Args a{};
    for (int i = 0; i < 25; ++i) a.in[i] = (const float*)d_in[i];
    a.out = (float*)d_out; a.ws = (unsigned char*)d_ws;
    constexpr int NL = MK_N_LAUNCHES;
    for (int li = 0; li < NL; ++li) {
        a.ph_lo = (NL == 1) ? 0 : li; a.ph_hi = (NL == 1) ? NPHASE : li + 1;
        void* args[] = {&a};
        hipError_t e = hipLaunchCooperativeKernel((const void*)mk_fwd, dim3(grid), dim3(512), args, LDS_BYTES, stream);
        if (e != hipSuccess) { fprintf(stderr, "kernel_launch: cooperative launch %d failed: %s\n", li, hipGetErrorString(e)); break; }
    }
}
```
